# Optimizing an MI355X kernel written in HIP

```python
import jax, jax.numpy as jnp
from jax import lax
import numpy as np

D_MODEL = 1024
BATCH = 8
SEQ = 4096
DEPTH = 2

HEAD_DIM = 64
D_MIX = D_MODEL
NSA_HEADS = (D_MIX // 2) // HEAD_DIM
NSA_KV_HEADS = 2
NSA_GROUP = NSA_HEADS // NSA_KV_HEADS
CMP_LEN = 32
CMP_STRIDE = 16
CMP_HIDDEN = 256
SLC_BLOCK = 64
SLC_TOPK = 16
WINDOW = 512
WIN_BLOCK = 128
SEL_QBLOCK = 64
N_BRANCH = 3
CONV_CH = D_MIX // 4
CONV_K = 31
RET_HEADS = (D_MIX // 4) // HEAD_DIM
RET_CHUNK = 128
ROPE_BASE = 10000.0
D_FF = ((8 * D_MODEL // 3 + 255) // 256) * 256
N_EXPERTS = 8
TOP_K = 2
MOE_BLOCK = 256
NSA_Q_W = NSA_HEADS * HEAD_DIM
NSA_KV_W = NSA_KV_HEADS * HEAD_DIM
NSA_GATE_W = NSA_HEADS * N_BRANCH
RET_W = RET_HEADS * HEAD_DIM
IN_SPLITS = (NSA_Q_W, NSA_KV_W, NSA_KV_W, NSA_KV_W, NSA_KV_W, NSA_KV_W, NSA_KV_W, NSA_GATE_W, 2 * CONV_CH, RET_W, RET_W, RET_W, RET_W)
D_IN = NSA_Q_W + 6 * NSA_KV_W + NSA_GATE_W + 2 * CONV_CH + 4 * RET_W
NEG_INF = -1e30
FORCE_SCORE = 1e9
EPS = 1e-6

kernel_name = 'hybrid_nsa_conformer_retention_moe'


def rmsnorm(x, g):
    xf = x.astype(jnp.float32)
    xf = xf * lax.rsqrt(jnp.mean(xf * xf, axis=-1, keepdims=True) + EPS)
    return (xf * g.astype(jnp.float32)).astype(x.dtype)


def masked_softmax(s, mask):
    s = jnp.where(mask, s.astype(jnp.float32), NEG_INF)
    p = jax.nn.softmax(s, axis=-1)
    return jnp.where(mask, p, 0.0)


def compress_blocks(kv, pe, w1, w2):
    B, T, G, hd = kv.shape
    r = CMP_LEN // CMP_STRIDE
    ns = T // CMP_STRIDE
    sub = kv.reshape(B, ns, CMP_STRIDE, G, hd)
    blocks = jnp.concatenate([sub[:, j:ns - r + 1 + j] for j in range(r)], axis=2)
    blocks = blocks + pe[None, None, :, None, :]
    nc = blocks.shape[1]
    flat = blocks.transpose(0, 1, 3, 2, 4).reshape(B, nc, G, CMP_LEN * hd)
    return jax.nn.silu(flat @ w1) @ w2


def nsa_mixer(q, k_c, v_c, k_s, v_s, k_w, v_w, gate_logits, cmp_pe, cmp_w1, cmp_w2):
    B, T, _ = q.shape
    G, HPG, hd = NSA_KV_HEADS, NSA_GROUP, HEAD_DIM
    scale = hd ** -0.5
    q5 = q.reshape(B, T, G, HPG, hd)
    kv4 = lambda a: a.reshape(B, T, G, hd)
    k_c, v_c, k_s, v_s, k_w, v_w = map(kv4, (k_c, v_c, k_s, v_s, k_w, v_w))
    t_pos = jnp.arange(T)

    kc = compress_blocks(k_c, cmp_pe[0], cmp_w1[0], cmp_w2[0])
    vc = compress_blocks(v_c, cmp_pe[1], cmp_w1[1], cmp_w2[1])
    nc = kc.shape[1]
    cmp_start = jnp.arange(nc) * CMP_STRIDE
    cmp_mask = (cmp_start + CMP_LEN - 1)[None, :] <= t_pos[:, None]
    s_cmp = jnp.einsum('btghd,bcgd->bghtc', q5, kc) * scale
    p_cmp = masked_softmax(s_cmp, cmp_mask[None, None, None])
    o_cmp = jnp.einsum('bghtc,bcgd->btghd', p_cmp, vc.astype(jnp.float32))

    ns = T // SLC_BLOCK
    slc_start = jnp.arange(ns) * SLC_BLOCK
    overlap = ((cmp_start[:, None] < slc_start[None, :] + SLC_BLOCK) &
               (cmp_start[:, None] + CMP_LEN > slc_start[None, :])).astype(jnp.float32)
    imp = jnp.einsum('bgtc,cs->bgts', p_cmp.sum(axis=2), overlap)
    cur = t_pos // SLC_BLOCK
    j = jnp.arange(ns)
    valid = j[None, :] <= cur[:, None]
    forced = (j[None, :] == 0) | (j[None, :] == cur[:, None]) | (j[None, :] == cur[:, None] - 1)
    imp = jnp.where(valid, jnp.where(forced, FORCE_SCORE, imp), NEG_INF)
    k_top = min(SLC_TOPK, ns)
    _, idx = lax.top_k(imp, k_top)

    ks_blocks = k_s.reshape(B, ns, SLC_BLOCK, G, hd).transpose(0, 3, 1, 2, 4)
    vs_blocks = v_s.reshape(B, ns, SLC_BLOCK, G, hd).transpose(0, 3, 1, 2, 4)
    nq = T // SEL_QBLOCK
    q_ch = q5.reshape(B, nq, SEL_QBLOCK, G, HPG, hd).transpose(1, 0, 3, 2, 4, 5)
    idx_ch = idx.reshape(B, G, nq, SEL_QBLOCK, k_top).transpose(2, 0, 1, 3, 4)
    t_ch = t_pos.reshape(nq, SEL_QBLOCK)
    gather = jax.vmap(jax.vmap(lambda blk, ix: blk[ix]))
    n_sel = k_top * SLC_BLOCK

    def sel_block(args):
        qb, ib, tb = args
        kg = gather(ks_blocks, ib).reshape(B, G, SEL_QBLOCK, n_sel, hd)
        vg = gather(vs_blocks, ib).reshape(B, G, SEL_QBLOCK, n_sel, hd)
        kpos = (ib[..., None] * SLC_BLOCK + jnp.arange(SLC_BLOCK)).reshape(B, G, SEL_QBLOCK, n_sel)
        mask = kpos <= tb[None, None, :, None]
        s = jnp.einsum('bgqhd,bgqnd->bgqhn', qb, kg) * scale
        p = masked_softmax(s, mask[:, :, :, None, :])
        return jnp.einsum('bgqhn,bgqnd->bgqhd', p, vg.astype(jnp.float32))

    o_sel = lax.map(sel_block, (q_ch, idx_ch, t_ch))
    o_sel = o_sel.transpose(1, 0, 3, 2, 4, 5).reshape(B, T, G, HPG, hd)

    nb = T // WIN_BLOCK
    nwb = WINDOW // WIN_BLOCK
    qb = q5.reshape(B, nb, WIN_BLOCK, G, HPG, hd)
    def band(a):
        a = a.reshape(B, nb, WIN_BLOCK, G, hd)
        a = jnp.pad(a, ((0, 0), (nwb, 0), (0, 0), (0, 0), (0, 0)))
        return jnp.concatenate([a[:, j:j + nb] for j in range(nwb + 1)], axis=2)
    kwin, vwin = band(k_w), band(v_w)
    qpos = jnp.arange(nb)[:, None] * WIN_BLOCK + jnp.arange(WIN_BLOCK)[None, :]
    kpos = (jnp.arange(nb)[:, None] - nwb) * WIN_BLOCK + jnp.arange((nwb + 1) * WIN_BLOCK)[None, :]
    dpos = qpos[:, :, None] - kpos[:, None, :]
    wmask = (dpos >= 0) & (dpos < WINDOW) & (kpos[:, None, :] >= 0)
    s_w = jnp.einsum('bnqghd,bnkgd->bnghqk', qb, kwin) * scale
    p_w = masked_softmax(s_w, wmask[None, :, None, None])
    o_win = jnp.einsum('bnghqk,bnkgd->bnqghd', p_w, vwin.astype(jnp.float32)).reshape(B, T, G, HPG, hd)

    g = jax.nn.sigmoid(gate_logits.astype(jnp.float32)).reshape(B, T, G, HPG, N_BRANCH)
    o = g[..., 0:1] * o_cmp + g[..., 1:2] * o_sel + g[..., 2:3] * o_win
    return o.reshape(B, T, NSA_Q_W).astype(q.dtype)


def conformer_conv(u, conv_w, conv_b, ln_g, ln_b, conv_pw):
    a, gt = jnp.split(u, 2, axis=-1)
    h = a * jax.nn.sigmoid(gt)
    h = lax.conv_general_dilated(h, conv_w[:, None, :].astype(h.dtype), window_strides=(1,),
                                 padding=[(CONV_K - 1, 0)], dimension_numbers=('NWC', 'WIO', 'NWC'),
                                 feature_group_count=CONV_CH) + conv_b
    hf = h.astype(jnp.float32)
    mu = jnp.mean(hf, axis=-1, keepdims=True)
    var = jnp.mean(jnp.square(hf - mu), axis=-1, keepdims=True)
    hf = (hf - mu) * lax.rsqrt(var + 1e-5) * ln_g + ln_b
    return jax.nn.silu(hf).astype(u.dtype) @ conv_pw


def rotary(x, pos):
    half = HEAD_DIM // 2
    inv = ROPE_BASE ** (-jnp.arange(half, dtype=jnp.float32) / half)
    ang = pos[:, None] * inv[None, :]
    cos, sin = jnp.cos(ang), jnp.sin(ang)
    x1, x2 = x[..., :half], x[..., half:]
    return jnp.concatenate([x1 * cos - x2 * sin, x1 * sin + x2 * cos], axis=-1)


def retention(q, k, v, gate, gn_g):
    B, T, _ = q.shape
    heads = lambda a: a.astype(jnp.float32).reshape(B, T, RET_HEADS, HEAD_DIM).transpose(0, 2, 1, 3)
    q, k, v = heads(q), heads(k), heads(v)
    pos = jnp.arange(T, dtype=jnp.float32)
    q = rotary(q, pos)
    k = rotary(k, pos) * HEAD_DIM ** -0.5
    log_gamma = jnp.log1p(-jnp.exp2(-5.0 - jnp.arange(RET_HEADS, dtype=jnp.float32)))
    i = jnp.arange(RET_CHUNK, dtype=jnp.float32)
    rel = i[:, None] - i[None, :]
    decay = jnp.where(rel >= 0, jnp.exp(jnp.maximum(rel, 0.0)[None] * log_gamma[:, None, None]), 0.0)
    xi = jnp.exp((i + 1.0)[None, :] * log_gamma[:, None])
    zeta = jnp.exp((RET_CHUNK - 1.0 - i)[None, :] * log_gamma[:, None])
    g_chunk = jnp.exp(RET_CHUNK * log_gamma)
    nc = T // RET_CHUNK
    chunks = lambda a: a.reshape(B, RET_HEADS, nc, RET_CHUNK, HEAD_DIM).transpose(2, 0, 1, 3, 4)
    qc, kc, vc = chunks(q), chunks(k), chunks(v)
    intra = jnp.einsum('nbhqd,nbhkd->nbhqk', qc, kc) * decay[None, None]
    intra = jnp.einsum('nbhqk,nbhkd->nbhqd', intra, vc)

    def step(S, inp):
        qi, ki, vi = inp
        cross = jnp.einsum('bhqd,bhde->bhqe', qi, S) * xi[None, :, :, None]
        S = g_chunk[None, :, None, None] * S + jnp.einsum('bhkd,bhke->bhde', ki * zeta[None, :, :, None], vi)
        return S, cross

    S0 = jnp.zeros((B, RET_HEADS, HEAD_DIM, HEAD_DIM), jnp.float32)
    _, cross = lax.scan(step, S0, (qc, kc, vc))
    o = (intra + cross).transpose(1, 0, 3, 2, 4).reshape(B, T, RET_HEADS, HEAD_DIM)
    mu = jnp.mean(o, axis=-1, keepdims=True)
    var = jnp.mean(jnp.square(o - mu), axis=-1, keepdims=True)
    o = ((o - mu) * lax.rsqrt(var + 1e-5)).reshape(B, T, RET_W) * gn_g
    return (jax.nn.silu(gate.astype(jnp.float32)) * o).astype(gate.dtype)


def token_mixer(h, w_in, cmp_pe, cmp_w1, cmp_w2, conv_w, conv_b, conv_ln_g, conv_ln_b, conv_pw, ret_gn, w_out):
    proj = h @ w_in
    offs = np.cumsum(IN_SPLITS)[:-1].tolist()
    (q, k_c, v_c, k_s, v_s, k_w, v_w, gl, conv_in, rq, rk, rv, rg) = jnp.split(proj, offs, axis=-1)
    o_a = nsa_mixer(q, k_c, v_c, k_s, v_s, k_w, v_w, gl, cmp_pe, cmp_w1, cmp_w2)
    o_b = conformer_conv(conv_in, conv_w, conv_b, conv_ln_g, conv_ln_b, conv_pw)
    o_c = retention(rq, rk, rv, rg, ret_gn)
    return jnp.concatenate([o_a, o_b, o_c], axis=-1) @ w_out


def swiglu(h, w13, w2):
    a, b = jnp.split(h @ w13, 2, axis=-1)
    return (jax.nn.silu(a) * b) @ w2


def moe_ffn(h, router, w13, w2):
    B, T, D = h.shape
    N = B * T
    xf = h.reshape(N, D)
    logits = (xf @ router).astype(jnp.float32)
    top_logit, top_e = lax.top_k(logits, TOP_K)
    gates = jax.nn.softmax(top_logit, axis=-1)
    e_flat = top_e.reshape(-1)
    tok_flat = jnp.repeat(jnp.arange(N, dtype=jnp.int32), TOP_K)
    g_flat = gates.reshape(-1)
    order = jnp.argsort(e_flat)
    e_sorted = e_flat[order]
    counts = jnp.bincount(e_flat, length=N_EXPERTS)
    padded = ((counts + MOE_BLOCK - 1) // MOE_BLOCK) * MOE_BLOCK
    starts = jnp.cumsum(counts) - counts
    pends = jnp.cumsum(padded)
    pstarts = pends - padded
    dest = pstarts[e_sorted] + (jnp.arange(N * TOP_K) - starts[e_sorted])
    P = ((N * TOP_K + MOE_BLOCK - 1) // MOE_BLOCK) * MOE_BLOCK + N_EXPERTS * MOE_BLOCK
    buf_tok = jnp.full((P,), N, jnp.int32).at[dest].set(tok_flat[order])
    buf_gate = jnp.zeros((P,), jnp.float32).at[dest].set(g_flat[order])
    nblk = P // MOE_BLOCK
    blk_e = jnp.minimum(jnp.searchsorted(pends, jnp.arange(nblk) * MOE_BLOCK, side='right'), N_EXPERTS - 1)
    x_pad = jnp.concatenate([xf, jnp.zeros((1, D), xf.dtype)], axis=0)
    xb = x_pad[buf_tok].reshape(nblk, MOE_BLOCK, D)
    yb = lax.map(lambda a: swiglu(a[0], w13[a[1]], w2[a[1]]), (xb, blk_e))
    y = jax.ops.segment_sum(yb.reshape(P, D) * buf_gate[:, None].astype(yb.dtype), buf_tok, num_segments=N + 1)
    return y[:N].reshape(B, T, D)


def setup_inputs(seed: int = 0) -> dict:
    key = jax.random.key(seed)
    ks = jax.random.split(key, 20)
    L = DEPTH
    ND = (DEPTH + 1) // 2
    NM = DEPTH // 2
    nrm = lambda k, shape, s: jax.random.normal(k, shape, jnp.float32) * s
    return {
        'x': nrm(ks[0], (BATCH, SEQ, D_MODEL), 1.0),
        'ln_attn': 1.0 + nrm(ks[1], (L, D_MODEL), 0.1),
        'w_in': nrm(ks[2], (L, D_MODEL, D_IN), D_MODEL ** -0.5),
        'cmp_pe': nrm(ks[3], (L, 2, CMP_LEN, HEAD_DIM), 0.1),
        'cmp_w1': nrm(ks[4], (L, 2, CMP_LEN * HEAD_DIM, CMP_HIDDEN), (CMP_LEN * HEAD_DIM) ** -0.5),
        'cmp_w2': nrm(ks[5], (L, 2, CMP_HIDDEN, HEAD_DIM), CMP_HIDDEN ** -0.5),
        'conv_w': nrm(ks[6], (L, CONV_K, CONV_CH), CONV_K ** -0.5),
        'conv_b': nrm(ks[7], (L, CONV_CH), 0.02),
        'conv_ln_g': 1.0 + nrm(ks[8], (L, CONV_CH), 0.1),
        'conv_ln_b': nrm(ks[9], (L, CONV_CH), 0.02),
        'conv_pw': nrm(ks[10], (L, CONV_CH, CONV_CH), CONV_CH ** -0.5),
        'ret_gn': 1.0 + nrm(ks[11], (L, RET_W), 0.1),
        'w_out': nrm(ks[12], (L, D_MIX, D_MODEL), D_MIX ** -0.5),
        'ln_ffn': 1.0 + nrm(ks[13], (L, D_MODEL), 0.1),
        'ffn_w13': nrm(ks[14], (ND, D_MODEL, 2 * D_FF), D_MODEL ** -0.5),
        'ffn_w2': nrm(ks[15], (ND, D_FF, D_MODEL), D_FF ** -0.5),
        'router': nrm(ks[16], (NM, D_MODEL, N_EXPERTS), D_MODEL ** -0.5),
        'moe_w13': nrm(ks[17], (NM, N_EXPERTS, D_MODEL, 2 * D_FF), D_MODEL ** -0.5),
        'moe_w2': nrm(ks[18], (NM, N_EXPERTS, D_FF, D_MODEL), D_FF ** -0.5),
        'ln_final': 1.0 + nrm(ks[19], (D_MODEL,), 0.1),
    }


def reference(x, ln_attn, w_in, cmp_pe, cmp_w1, cmp_w2, conv_w, conv_b, conv_ln_g, conv_ln_b, conv_pw,
              ret_gn, w_out, ln_ffn, ffn_w13, ffn_w2, router, moe_w13, moe_w2, ln_final):
    for l in range(DEPTH):
        h = rmsnorm(x, ln_attn[l])
        x = x + token_mixer(h, w_in[l], cmp_pe[l], cmp_w1[l], cmp_w2[l], conv_w[l], conv_b[l],
                            conv_ln_g[l], conv_ln_b[l], conv_pw[l], ret_gn[l], w_out[l])
        h = rmsnorm(x, ln_ffn[l])
        if l % 2 == 0:
            x = x + swiglu(h, ffn_w13[l // 2], ffn_w2[l // 2])
        else:
            x = x + moe_ffn(h, router[l // 2], moe_w13[l // 2], moe_w2[l // 2])
    return rmsnorm(x, ln_final)
```

```cpp
#include <hip/hip_runtime.h>
#include <stdint.h>
#include <stdio.h>

typedef unsigned short bf16_t;
typedef short bf16x8 __attribute__((ext_vector_type(8)));
typedef float f32x4 __attribute__((ext_vector_type(4)));

constexpr int NTOK = 32768, DM = 1024, NB = 8, SEQ = 4096;
constexpr int DIN = 2840, DINP = 3072, DFF = 2816, NEXP = 8;
constexpr int C_Q = 0, C_KC = 512, C_VC = 640, C_KS = 768, C_VS = 896, C_KW = 1024, C_VW = 1152, C_GL = 1280,
              C_CONV = 1304, C_RQ = 1816, C_RK = 2072, C_RV = 2328, C_RG = 2584;
constexpr int NSLOT = 16;
constexpr int PMAX = 65536 + 8 * 256;

__device__ __forceinline__ bf16_t f2bf(float f) { unsigned u = __float_as_uint(f); u += 0x7fffu + ((u >> 16) & 1u); return (bf16_t)(u >> 16); }
__device__ __forceinline__ float bf2f(bf16_t h) { return __uint_as_float(((unsigned)h) << 16); }
__device__ __forceinline__ float wsum(float v) { for (int o = 32; o > 0; o >>= 1) v += __shfl_xor(v, o); return v; }
__device__ __forceinline__ float wmax(float v) { for (int o = 32; o > 0; o >>= 1) v = fmaxf(v, __shfl_xor(v, o)); return v; }
__device__ __forceinline__ float siluf(float x) { return x / (1.f + __expf(-x)); }
__device__ __forceinline__ float sigmf(float x) { return 1.f / (1.f + __expf(-x)); }
__device__ __forceinline__ float row_rstd(const float* ssq, int row) { float s = 0.f; for (int i = 0; i < NSLOT; ++i) s += ssq[(size_t)row * NSLOT + i]; return rsqrtf(s * (1.f / DM) + 1e-6f); }

struct MapPlain { int n, pad; __device__ int col(int c) const { return c < n ? c : -1; } __device__ float scale(int, int) const { return 1.f; } };
struct MapWin { const float* g; __device__ int col(int c) const { return c < DIN ? c : -1; }
    __device__ float scale(int k, int c) const { return g[k] * ((c < 512 || (c >= C_RK && c < C_RV)) ? 0.125f : 1.f); } };
struct MapW13 { const float* g; __device__ int col(int c) const { int pn = c >> 8, i = c & 255; return i < 128 ? 128 * pn + i : DFF + 128 * pn + (i - 128); }
    __device__ float scale(int k, int) const { return g[k]; } };

template <class Map> __global__ void k_convT(const float* __restrict__ src, bf16_t* __restrict__ dst, int2 dims, Map map) {
    const int ldsrc = dims.x, K = dims.y;
    __shared__ float tile[64][65];
    const int n0 = blockIdx.x * 64, k0 = blockIdx.y * 64, tx = threadIdx.x & 63, ty = threadIdx.x >> 6;
    const int sc = map.col(n0 + tx);
    for (int r = ty; r < 64; r += 4) tile[r][tx] = sc >= 0 ? src[(size_t)(k0 + r) * ldsrc + sc] * map.scale(k0 + r, n0 + tx) : 0.f;
    __syncthreads();
    for (int r = ty; r < 64; r += 4) dst[(size_t)(n0 + r) * K + k0 + tx] = f2bf(tile[tx][r]);
}
__global__ void k_bias1(const float* __restrict__ pe, const float* __restrict__ w1, float* __restrict__ out) {
    __shared__ float red[4][64];
    const int nl = threadIdx.x & 63, kp = threadIdx.x >> 6, n = blockIdx.x * 64 + nl;
    float s = 0.f; for (int k = kp; k < 2048; k += 4) s += pe[k] * w1[(size_t)k * 256 + n];
    red[kp][nl] = s; __syncthreads();
    if (kp == 0) out[n] = red[0][nl] + red[1][nl] + red[2][nl] + red[3][nl];
}
__global__ void k_rot(float* __restrict__ cs) {
    const int idx = blockIdx.x * 256 + threadIdx.x; if (idx >= 4096 * 32) return;
    const int pos = idx >> 5, i = idx & 31; const float inv = powf(10000.f, -(float)i / 32.f), ang = (float)pos * inv;
    cs[idx * 2] = cosf(ang); cs[idx * 2 + 1] = sinf(ang);
}
__global__ void k_xprep(const float* __restrict__ x, bf16_t* __restrict__ xb, float* __restrict__ ssq) {
    const int row = blockIdx.x * 4 + (threadIdx.x >> 6), lane = threadIdx.x & 63; float s = 0.f;
    for (int c = lane * 4; c < DM; c += 256) { const float4 v = *(const float4*)(x + (size_t)row * DM + c); s += v.x * v.x + v.y * v.y + v.z * v.z + v.w * v.w;
        ushort4 o; o.x = f2bf(v.x); o.y = f2bf(v.y); o.z = f2bf(v.z); o.w = f2bf(v.w); *(ushort4*)(xb + (size_t)row * DM + c) = o; }
    s = wsum(s); if (lane < NSLOT) ssq[(size_t)row * NSLOT + lane] = lane == 0 ? s : 0.f;
}

struct APlain { const bf16_t* A; int lda, pad; __device__ const bf16_t* ptr(int row, int k) const { return A + (size_t)row * lda + k; } };
struct AGather { const bf16_t* A; const int* row_tok; int lda, pad; __device__ const bf16_t* ptr(int row, int k) const { const int t = row_tok[row]; return t < 0 ? nullptr : A + (size_t)t * lda + k; } };
struct ACmp { const bf16_t* proj; int coloff, pad;
    __device__ const bf16_t* ptr(int row, int k) const { const int c = row & 255, g = (row >> 8) & 1, b = row >> 9; if (c == 255) return nullptr;
        return proj + (size_t)(b * SEQ + 16 * c + (k >> 6)) * DINP + coloff + g * 64 + (k & 63); } };
struct SchedPlain { int nM, nN; __device__ int count() const { return nM * nN; }
    __device__ void get(int u, int& row0, int& col0, size_t& boff) const { row0 = (u / nN) * 128; col0 = (u % nN) * 256; boff = 0; } };
struct SchedMoe { const int* meta; const int* tile_exp; size_t estride; int nN, pad;
    __device__ int count() const { return meta[0] * 2 * nN; }
    __device__ void get(int u, int& row0, int& col0, size_t& boff) const { row0 = (u / nN) * 128; col0 = (u % nN) * 256; boff = (size_t)tile_exp[row0 >> 8] * estride; } };

struct EpiIn { bf16_t* proj; const float* ssq;
    __device__ void apply(const f32x4 (&acc)[2][16], int rowb, int col0, int lane) const {
        for (int mi = 0; mi < 2; ++mi) for (int r = 0; r < 4; ++r) { const int row = rowb + mi * 16 + (lane >> 4) * 4 + r; const float rs = row_rstd(ssq, row);
            for (int n = 0; n < 16; ++n) proj[(size_t)row * DINP + col0 + n * 16 + (lane & 15)] = f2bf(acc[mi][n][r] * rs); } } };
struct EpiRes { const float* xold; float* xnew; bf16_t* xb; float* ssq;
    __device__ void apply(const f32x4 (&acc)[2][16], int rowb, int col0, int lane) const {
        for (int mi = 0; mi < 2; ++mi) for (int r = 0; r < 4; ++r) { const int row = rowb + mi * 16 + (lane >> 4) * 4 + r; float s = 0.f;
            for (int n = 0; n < 16; ++n) { const size_t o = (size_t)row * DM + col0 + n * 16 + (lane & 15); const float v = xold[o] + acc[mi][n][r]; xnew[o] = v; xb[o] = f2bf(v); s += v * v; }
            s += __shfl_xor(s, 1); s += __shfl_xor(s, 2); s += __shfl_xor(s, 4); s += __shfl_xor(s, 8);
            if ((lane & 15) < 4) ssq[(size_t)row * NSLOT + (col0 >> 8) * 4 + (lane & 15)] = (lane & 15) == 0 ? s : 0.f; } } };
struct EpiSwiglu { bf16_t* h; const float* ssq; const int* row_tok;
    __device__ void apply(const f32x4 (&acc)[2][16], int rowb, int col0, int lane) const {
        for (int mi = 0; mi < 2; ++mi) for (int r = 0; r < 4; ++r) { const int row = rowb + mi * 16 + (lane >> 4) * 4 + r; const int t = row_tok ? row_tok[row] : row;
            const float rs = t < 0 ? 0.f : row_rstd(ssq, t);
            for (int n = 0; n < 8; ++n) { const float a = acc[mi][n][r] * rs, b = acc[mi][n + 8][r] * rs; h[(size_t)row * DFF + (col0 >> 1) + n * 16 + (lane & 15)] = f2bf(siluf(a) * b); } } } };
struct EpiStore { bf16_t* out; int ldc, coloff, ncols, pad;
    __device__ void apply(const f32x4 (&acc)[2][16], int rowb, int col0, int lane) const {
        for (int mi = 0; mi < 2; ++mi) for (int r = 0; r < 4; ++r) { const int row = rowb + mi * 16 + (lane >> 4) * 4 + r;
            for (int n = 0; n < 16; ++n) { const int c = col0 + n * 16 + (lane & 15); if (c < ncols) out[(size_t)row * ldc + coloff + c] = f2bf(acc[mi][n][r]); } } } };
struct EpiSiluBias { bf16_t* out; const float* bias; int ldc, pad;
    __device__ void apply(const f32x4 (&acc)[2][16], int rowb, int col0, int lane) const {
        for (int mi = 0; mi < 2; ++mi) for (int r = 0; r < 4; ++r) { const int row = rowb + mi * 16 + (lane >> 4) * 4 + r;
            for (int n = 0; n < 16; ++n) { const int c = col0 + n * 16 + (lane & 15); out[(size_t)row * ldc + c] = f2bf(siluf(acc[mi][n][r] + bias[c])); } } } };

template <class AS, class Epi, class Sched>
__global__ __launch_bounds__(256) void k_gemm(AS as, const bf16_t* __restrict__ Bt, long long K_, Epi epi, Sched sched) {
    const int K = (int)K_;
    __shared__ __attribute__((aligned(16))) bf16_t sA[128 * 40];
    __shared__ __attribute__((aligned(16))) bf16_t sB[256 * 40];
    const int tid = threadIdx.x, wave = tid >> 6, lane = tid & 63;
    const int nunits = sched.count();
    for (int u = blockIdx.x; u < nunits; u += gridDim.x) {
        int row0, col0; size_t boff; sched.get(u, row0, col0, boff);
        const bf16_t* Bu = Bt + boff;
        f32x4 acc[2][16];
#pragma unroll
        for (int mi = 0; mi < 2; ++mi)
#pragma unroll
            for (int n = 0; n < 16; ++n) acc[mi][n] = (f32x4){0.f, 0.f, 0.f, 0.f};
        for (int k0 = 0; k0 < K; k0 += 32) {
#pragma unroll
            for (int i = 0; i < 2; ++i) { const int c = tid + i * 256, r = c >> 2, kc = (c & 3) * 8; const bf16_t* p = as.ptr(row0 + r, k0 + kc);
                uint4 v = make_uint4(0u, 0u, 0u, 0u); if (p) v = *(const uint4*)p; *(uint4*)&sA[r * 40 + kc] = v; }
#pragma unroll
            for (int i = 0; i < 4; ++i) { const int c = tid + i * 256, r = c >> 2, kc = (c & 3) * 8;
                *(uint4*)&sB[r * 40 + kc] = *(const uint4*)(Bu + (size_t)(col0 + r) * K + k0 + kc); }
            __syncthreads();
            bf16x8 af[2];
#pragma unroll
            for (int mi = 0; mi < 2; ++mi) af[mi] = *(const bf16x8*)&sA[(wave * 32 + mi * 16 + (lane & 15)) * 40 + (lane >> 4) * 8];
#pragma unroll
            for (int n = 0; n < 16; ++n) { const bf16x8 bfr = *(const bf16x8*)&sB[(n * 16 + (lane & 15)) * 40 + (lane >> 4) * 8];
#pragma unroll
                for (int mi = 0; mi < 2; ++mi) acc[mi][n] = __builtin_amdgcn_mfma_f32_16x16x32_bf16(af[mi], bfr, acc[mi][n], 0, 0, 0); }
            __syncthreads();
        }
        epi.apply(acc, row0 + wave * 32, col0, lane);
    }
}

struct Br { float m[4], l[4], o[4]; };
__device__ __forceinline__ void attend_tile(Br& a, const bf16_t* kp, const bf16_t* vb, size_t vstride, const float (*qs)[64], float (*ps)[64], int lane) {
    const unsigned long long vm = __ballot(kp != nullptr); if (vm == 0ull) return;
    float s[4] = {0.f, 0.f, 0.f, 0.f};
    if (kp) { for (int c = 0; c < 8; ++c) { const uint4 raw = *(const uint4*)(kp + c * 8); const unsigned w[4] = {raw.x, raw.y, raw.z, raw.w};
            for (int e = 0; e < 4; ++e) { const float k0 = __uint_as_float(w[e] << 16), k1 = __uint_as_float(w[e] & 0xffff0000u); const int d = c * 8 + e * 2;
                for (int h = 0; h < 4; ++h) s[h] += k0 * qs[h][d] + k1 * qs[h][d + 1]; } } }
    for (int h = 0; h < 4; ++h) { const float sv = kp ? s[h] : -INFINITY; const float mn = fmaxf(a.m[h], wmax(sv)); const float al = a.m[h] == -INFINITY ? 0.f : __expf(a.m[h] - mn);
        const float p = kp ? __expf(sv - mn) : 0.f; a.l[h] = a.l[h] * al + wsum(p); a.o[h] *= al; a.m[h] = mn; ps[h][lane] = p; }
    __syncthreads();
    for (int k = 0; k < 64; ++k) if ((vm >> k) & 1ull) { const float v = bf2f(vb[(size_t)k * vstride + lane]); for (int h = 0; h < 4; ++h) a.o[h] += ps[h][k] * v; }
    __syncthreads();
}
__global__ __launch_bounds__(64) void k_nsa_naive(const bf16_t* __restrict__ proj, const bf16_t* __restrict__ kc, const bf16_t* __restrict__ vc, bf16_t* __restrict__ ocat) {
    __shared__ float qs[4][64]; __shared__ float ps[4][64]; __shared__ float pc[4][256]; __shared__ float psum[256];
    const int lane = threadIdx.x, gid = blockIdx.x, t = gid & (SEQ - 1), g = (gid >> 12) & 1, b = gid >> 13;
    const size_t row = (size_t)b * SEQ + t; const bf16_t* prow = proj + row * DINP;
    for (int h = 0; h < 4; ++h) qs[h][lane] = bf2f(prow[C_Q + g * 256 + h * 64 + lane]);
    __syncthreads();
    const bf16_t* kcb = kc + (size_t)(b * 2 + g) * 256 * 64; const bf16_t* vcb = vc + (size_t)(b * 2 + g) * 256 * 64;
    const int cmax = t >= 31 ? (t - 31) >> 4 : -1;
    float sc[4][4]; float mh[4] = {-INFINITY, -INFINITY, -INFINITY, -INFINITY};
    for (int ti = 0; ti < 4; ++ti) { const int c = ti * 64 + lane; const bool ok = c <= cmax; float s[4] = {0.f, 0.f, 0.f, 0.f};
        if (ok) { const bf16_t* kp = kcb + (size_t)c * 64; for (int d = 0; d < 64; ++d) { const float kv = bf2f(kp[d]); for (int h = 0; h < 4; ++h) s[h] += kv * qs[h][d]; } }
        for (int h = 0; h < 4; ++h) { sc[ti][h] = ok ? s[h] : -INFINITY; mh[h] = fmaxf(mh[h], sc[ti][h]); } }
    float ocmp[4] = {0.f, 0.f, 0.f, 0.f};
    for (int i = lane; i < 256; i += 64) psum[i] = 0.f;
    if (cmax >= 0) {
        float lh[4];
        for (int h = 0; h < 4; ++h) { mh[h] = wmax(mh[h]); float l = 0.f; for (int ti = 0; ti < 4; ++ti) l += sc[ti][h] == -INFINITY ? 0.f : __expf(sc[ti][h] - mh[h]); lh[h] = wsum(l); }
        for (int ti = 0; ti < 4; ++ti) { float tot = 0.f; for (int h = 0; h < 4; ++h) { const float p = sc[ti][h] == -INFINITY ? 0.f : __expf(sc[ti][h] - mh[h]) / lh[h]; pc[h][ti * 64 + lane] = p; tot += p; } psum[ti * 64 + lane] = tot; }
        __syncthreads();
        for (int c = 0; c <= cmax; ++c) { const float v = bf2f(vcb[(size_t)c * 64 + lane]); for (int h = 0; h < 4; ++h) ocmp[h] += pc[h][c] * v; }
    }
    __syncthreads();
    const int cur = t >> 6; float imp = 0.f;
    for (int c = 4 * lane - 1; c <= 4 * lane + 3; ++c) if (c >= 0 && c <= 254) imp += psum[c];
    const bool valid = lane <= cur, forced = lane == 0 || lane == cur || lane == cur - 1;
    const float val = valid ? (forced ? 1e9f : imp) : -1e30f; int rank = 0;
    for (int s2 = 0; s2 < 64; ++s2) { const float v2 = __shfl(val, s2); rank += (v2 > val || (v2 == val && s2 < lane)) ? 1 : 0; }
    const unsigned long long selmask = __ballot(valid && rank < 16);
    Br sb; for (int h = 0; h < 4; ++h) { sb.m[h] = -INFINITY; sb.l[h] = 0.f; sb.o[h] = 0.f; }
    for (int j = 0; j <= cur; ++j) if ((selmask >> j) & 1ull) { const int key = j * 64 + lane; const bf16_t* base = proj + ((size_t)b * SEQ + j * 64) * DINP;
        attend_tile(sb, key <= t ? base + (size_t)lane * DINP + C_KS + g * 64 : nullptr, base + C_VS + g * 64, DINP, qs, ps, lane); }
    Br wb; for (int h = 0; h < 4; ++h) { wb.m[h] = -INFINITY; wb.l[h] = 0.f; wb.o[h] = 0.f; }
    const int wstart = t - 511 > 0 ? t - 511 : 0;
    for (int j = wstart >> 6; j <= cur; ++j) { const int key = j * 64 + lane; const bf16_t* base = proj + ((size_t)b * SEQ + j * 64) * DINP;
        attend_tile(wb, (key >= wstart && key <= t) ? base + (size_t)lane * DINP + C_KW + g * 64 : nullptr, base + C_VW + g * 64, DINP, qs, ps, lane); }
    for (int h = 0; h < 4; ++h) { const int hh = g * 4 + h; const float g0 = sigmf(bf2f(prow[C_GL + hh * 3 + 0])), g1 = sigmf(bf2f(prow[C_GL + hh * 3 + 1])), g2 = sigmf(bf2f(prow[C_GL + hh * 3 + 2]));
        const float o = g0 * ocmp[h] + g1 * (sb.l[h] > 0.f ? sb.o[h] / sb.l[h] : 0.f) + g2 * (wb.l[h] > 0.f ? wb.o[h] / wb.l[h] : 0.f);
        ocat[row * DM + hh * 64 + lane] = f2bf(o); }
}

__global__ __launch_bounds__(256) void k_conv_naive(const bf16_t* __restrict__ proj, const float* __restrict__ cw, const float* __restrict__ cb, const float* __restrict__ lg, const float* __restrict__ lb, bf16_t* __restrict__ hconv) {
    __shared__ float hs[62][256];
    const int c = threadIdx.x, tile = blockIdx.x, b = tile >> 7, t0 = (tile & 127) * 32;
    for (int i = 0; i < 62; ++i) { const int t = t0 - 30 + i; float v = 0.f;
        if (t >= 0) { const bf16_t* p = proj + ((size_t)b * SEQ + t) * DINP + C_CONV; v = bf2f(p[c]) * sigmf(bf2f(p[256 + c])); }
        hs[i][c] = v; }
    float w[31]; for (int k = 0; k < 31; ++k) w[k] = cw[k * 256 + c];
    const float bias = cb[c];
    __syncthreads();
    float outv[32];
    for (int tt = 0; tt < 32; ++tt) { float a = bias; for (int k = 0; k < 31; ++k) a += hs[tt + k][c] * w[k]; outv[tt] = a; }
    __syncthreads();
    for (int tt = 0; tt < 32; ++tt) hs[tt][c] = outv[tt];
    __syncthreads();
    const int wave = c >> 6, lane = c & 63;
    for (int tt = wave; tt < 32; tt += 4) { float v[4], s = 0.f; for (int i = 0; i < 4; ++i) { v[i] = hs[tt][lane + 64 * i]; s += v[i]; }
        const float mu = wsum(s) * (1.f / 256.f); float q = 0.f; for (int i = 0; i < 4; ++i) q += (v[i] - mu) * (v[i] - mu);
        const float rs = rsqrtf(wsum(q) * (1.f / 256.f) + 1e-5f);
        for (int i = 0; i < 4; ++i) { const int ch = lane + 64 * i; const float y = (v[i] - mu) * rs * lg[ch] + lb[ch]; hconv[((size_t)b * SEQ + t0 + tt) * 256 + ch] = f2bf(siluf(y)); } }
}

__global__ void k_ret_rot(const bf16_t* __restrict__ proj, const float* __restrict__ cs, float* __restrict__ qr, float* __restrict__ kr) {
    const size_t idx = (size_t)blockIdx.x * 256 + threadIdx.x;
    const int i = idx & 31, h = (idx >> 5) & 3; const size_t row = idx >> 7; const int pos = row & (SEQ - 1);
    const float co = cs[(pos * 32 + i) * 2], si = cs[(pos * 32 + i) * 2 + 1];
    const bf16_t* p = proj + row * DINP;
    { const float x1 = bf2f(p[C_RQ + h * 64 + i]), x2 = bf2f(p[C_RQ + h * 64 + 32 + i]); qr[row * 256 + h * 64 + i] = x1 * co - x2 * si; qr[row * 256 + h * 64 + 32 + i] = x1 * si + x2 * co; }
    { const float x1 = bf2f(p[C_RK + h * 64 + i]), x2 = bf2f(p[C_RK + h * 64 + 32 + i]); kr[row * 256 + h * 64 + i] = x1 * co - x2 * si; kr[row * 256 + h * 64 + 32 + i] = x1 * si + x2 * co; }
}
__device__ __forceinline__ float ret_lg(int h) { return log1pf(-exp2f(-5.f - (float)h)); }
__global__ __launch_bounds__(256) void k_ret_kv(const bf16_t* __restrict__ proj, const float* __restrict__ kr, float* __restrict__ KV) {
    const int u = blockIdx.x, c = u & 31, h = (u >> 5) & 3, b = u >> 7; const float lg = ret_lg(h);
    const int dk = threadIdx.x >> 2, dv0 = (threadIdx.x & 3) * 16; float a[16]; for (int i = 0; i < 16; ++i) a[i] = 0.f;
    for (int k = 0; k < 128; ++k) { const size_t row = (size_t)b * SEQ + c * 128 + k; const float z = __expf((127.f - (float)k) * lg) * kr[row * 256 + h * 64 + dk];
        const bf16_t* vp = proj + row * DINP + C_RV + h * 64 + dv0; for (int i = 0; i < 16; ++i) a[i] += z * bf2f(vp[i]); }
    for (int i = 0; i < 16; ++i) KV[(size_t)u * 4096 + dk * 64 + dv0 + i] = a[i];
}
__global__ void k_ret_scan(const float* __restrict__ KV, float* __restrict__ S) {
    const int idx = blockIdx.x * 256 + threadIdx.x, e = idx & 4095, bh = idx >> 12, h = bh & 3; const float gc = __expf(128.f * ret_lg(h)); float s = 0.f;
    for (int c = 0; c < 32; ++c) { const size_t o = ((size_t)bh * 32 + c) * 4096 + e; S[o] = s; s = gc * s + KV[o]; }
}
__global__ __launch_bounds__(256) void k_ret_out(const bf16_t* __restrict__ proj, const float* __restrict__ qr, const float* __restrict__ kr, const float* __restrict__ S, const float* __restrict__ gn, bf16_t* __restrict__ ocat) {
    __shared__ float A[64][128];
    const int u = blockIdx.x, half = u & 1, c = (u >> 1) & 31, h = (u >> 6) & 3, b = u >> 8; const float lg = ret_lg(h);
    const size_t r0 = (size_t)b * SEQ + c * 128;
    for (int e = threadIdx.x; e < 64 * 128; e += 256) { const int i = e >> 7, j = e & 127, ig = half * 64 + i; float s = 0.f;
        if (j <= ig) { const float* qp = qr + (r0 + ig) * 256 + h * 64; const float* kp = kr + (r0 + j) * 256 + h * 64; for (int d = 0; d < 64; ++d) s += qp[d] * kp[d]; s *= __expf((float)(ig - j) * lg); }
        A[i][j] = s; }
    __syncthreads();
    const int i = threadIdx.x >> 2, d0 = (threadIdx.x & 3) * 16, ig = half * 64 + i; float o[16]; for (int x = 0; x < 16; ++x) o[x] = 0.f;
    for (int j = 0; j <= ig; ++j) { const float a = A[i][j]; const bf16_t* vp = proj + (r0 + j) * DINP + C_RV + h * 64 + d0; for (int x = 0; x < 16; ++x) o[x] += a * bf2f(vp[x]); }
    { const float xi = __expf((float)(ig + 1) * lg); const float* qp = qr + (r0 + ig) * 256 + h * 64; const float* Sp = S + (((size_t)(b * 4 + h) * 32 + c) * 4096);
      float cr[16]; for (int x = 0; x < 16; ++x) cr[x] = 0.f;
      for (int dk = 0; dk < 64; ++dk) { const float q = qp[dk]; for (int x = 0; x < 16; ++x) cr[x] += q * Sp[dk * 64 + d0 + x]; }
      for (int x = 0; x < 16; ++x) o[x] += xi * cr[x]; }
    float s = 0.f; for (int x = 0; x < 16; ++x) s += o[x]; s += __shfl_xor(s, 1); s += __shfl_xor(s, 2); const float mu = s * (1.f / 64.f);
    float q = 0.f; for (int x = 0; x < 16; ++x) q += (o[x] - mu) * (o[x] - mu); q += __shfl_xor(q, 1); q += __shfl_xor(q, 2); const float rs = rsqrtf(q * (1.f / 64.f) + 1e-5f);
    const bf16_t* gp = proj + (r0 + ig) * DINP + C_RG + h * 64 + d0;
    for (int x = 0; x < 16; ++x) { const float gt = bf2f(gp[x]); ocat[(r0 + ig) * DM + 768 + h * 64 + d0 + x] = f2bf(siluf(gt) * (o[x] - mu) * rs * gn[h * 64 + d0 + x]); }
}

__global__ void k_route(const float* __restrict__ x, const float* __restrict__ ssq, const float* __restrict__ g, const float* __restrict__ router, int* __restrict__ cnt, int* __restrict__ tok_list, float* __restrict__ gate) {
    const int row = blockIdx.x * 4 + (threadIdx.x >> 6), lane = threadIdx.x & 63; float lg[8]; for (int e = 0; e < 8; ++e) lg[e] = 0.f;
    for (int k = lane; k < DM; k += 64) { const float xv = x[(size_t)row * DM + k] * g[k]; for (int e = 0; e < 8; ++e) lg[e] += xv * router[k * 8 + e]; }
    const float rs = row_rstd(ssq, row);
    for (int e = 0; e < 8; ++e) lg[e] = wsum(lg[e]) * rs;
    int e1 = 0; float v1 = lg[0];
#pragma unroll
    for (int e = 1; e < 8; ++e) if (lg[e] > v1) { v1 = lg[e]; e1 = e; }
    int e2 = -1; float v2 = -INFINITY;
#pragma unroll
    for (int e = 0; e < 8; ++e) if (e != e1 && lg[e] > v2) { v2 = lg[e]; e2 = e; }
    if (lane == 0) { const float g1 = 1.f / (1.f + __expf(v2 - v1)); gate[row * 2] = g1; gate[row * 2 + 1] = 1.f - g1;
        const int i1 = atomicAdd(&cnt[e1], 1); tok_list[e1 * NTOK + i1] = row * 2; const int i2 = atomicAdd(&cnt[e2], 1); tok_list[e2 * NTOK + i2] = row * 2 + 1; }
}
__global__ void k_route_build(const int* __restrict__ cnt, const int* __restrict__ tok_list, int* __restrict__ row_tok, int* __restrict__ slot, int* __restrict__ tile_exp, int* __restrict__ meta) {
    const int idx = blockIdx.x * 256 + threadIdx.x, e = idx >> 15, i = idx & (NTOK - 1);
    int ps = 0; for (int q = 0; q < e; ++q) ps += (cnt[q] + 255) & ~255;
    const int ce = cnt[e], pe = (ce + 255) & ~255;
    if (i < ce) { const int en = tok_list[e * NTOK + i]; row_tok[ps + i] = en >> 1; slot[en] = ps + i; } else if (i < pe) row_tok[ps + i] = -1;
    if (i < pe && (i & 255) == 0) tile_exp[(ps + i) >> 8] = e;
    if (idx == 0) { int tot = 0; for (int q = 0; q < 8; ++q) tot += (cnt[q] + 255) & ~255; meta[0] = tot >> 8; }
}
__global__ void k_final(float* __restrict__ xio, const bf16_t* __restrict__ ys, const int* __restrict__ slot, const float* __restrict__ gate, const float* __restrict__ gfin) {
    const int row = blockIdx.x * 4 + (threadIdx.x >> 6), lane = threadIdx.x & 63; const int s1 = slot[row * 2], s2 = slot[row * 2 + 1]; const float g1 = gate[row * 2], g2 = gate[row * 2 + 1];
    float v[16]; float ss = 0.f;
    for (int i = 0; i < 4; ++i) { const int c = lane * 4 + i * 256; const float4 xv = *(const float4*)(xio + (size_t)row * DM + c);
        const ushort4 a = *(const ushort4*)(ys + (size_t)s1 * DM + c), bq = *(const ushort4*)(ys + (size_t)s2 * DM + c);
        v[i * 4 + 0] = xv.x + g1 * bf2f(a.x) + g2 * bf2f(bq.x); v[i * 4 + 1] = xv.y + g1 * bf2f(a.y) + g2 * bf2f(bq.y);
        v[i * 4 + 2] = xv.z + g1 * bf2f(a.z) + g2 * bf2f(bq.z); v[i * 4 + 3] = xv.w + g1 * bf2f(a.w) + g2 * bf2f(bq.w);
        for (int j = 0; j < 4; ++j) ss += v[i * 4 + j] * v[i * 4 + j]; }
    const float rs = rsqrtf(wsum(ss) * (1.f / DM) + 1e-6f);
    for (int i = 0; i < 4; ++i) { const int c = lane * 4 + i * 256; float4 o; o.x = v[i * 4] * rs * gfin[c]; o.y = v[i * 4 + 1] * rs * gfin[c + 1]; o.z = v[i * 4 + 2] * rs * gfin[c + 2]; o.w = v[i * 4 + 3] * rs * gfin[c + 3];
        *(float4*)(xio + (size_t)row * DM + c) = o; }
}

static inline size_t al256(size_t x) { return (x + 255) & ~(size_t)255; }
extern "C" void kernel_launch(void* const* d_in, const int* in_sizes, int n_in, void* d_out, int out_size, void* d_ws, size_t ws_size, hipStream_t stream) {
    const float* x = (const float*)d_in[0];       const float* ln_attn = (const float*)d_in[1]; const float* w_in = (const float*)d_in[2];
    const float* cmp_pe = (const float*)d_in[3];  const float* cmp_w1 = (const float*)d_in[4];  const float* cmp_w2 = (const float*)d_in[5];
    const float* conv_w = (const float*)d_in[6];  const float* conv_b = (const float*)d_in[7];  const float* conv_lg = (const float*)d_in[8];
    const float* conv_lb = (const float*)d_in[9]; const float* conv_pw = (const float*)d_in[10]; const float* ret_gn = (const float*)d_in[11];
    const float* w_out = (const float*)d_in[12];  const float* ln_ffn = (const float*)d_in[13]; const float* ffn_w13 = (const float*)d_in[14];
    const float* ffn_w2 = (const float*)d_in[15]; const float* router = (const float*)d_in[16]; const float* moe_w13 = (const float*)d_in[17];
    const float* moe_w2 = (const float*)d_in[18]; const float* ln_final = (const float*)d_in[19];
    float* xres = (float*)d_out;
    char* w = (char*)d_ws; size_t off = 0;
    auto take = [&](size_t bytes) { char* p = w + off; off = al256(off + bytes); return p; };
    char* regY = w + off;
    bf16_t* Wm13 = (bf16_t*)take((size_t)NEXP * 2 * DFF * DM * 2);
    bf16_t* Win = (bf16_t*)take((size_t)2 * DINP * DM * 2);
    bf16_t* Wout = (bf16_t*)take((size_t)2 * DM * DM * 2);
    bf16_t* W13 = (bf16_t*)take((size_t)2 * DFF * DM * 2);
    bf16_t* W2 = (bf16_t*)take((size_t)DM * DFF * 2);
    bf16_t* xb = (bf16_t*)take((size_t)NTOK * DM * 2);
    bf16_t* ysorted = (bf16_t*)regY;
    bf16_t* Wm2 = (bf16_t*)take((size_t)NEXP * DM * DFF * 2);
    bf16_t* W1b = (bf16_t*)take((size_t)4 * 256 * 2048 * 2);
    bf16_t* W2b = (bf16_t*)take((size_t)4 * 256 * 256 * 2);
    bf16_t* Wpw = (bf16_t*)take((size_t)2 * 256 * 256 * 2);
    float* bias1 = (float*)take(4 * 256 * 4);
    float* rot = (float*)take((size_t)4096 * 32 * 2 * 4);
    float* ssq = (float*)take((size_t)NTOK * NSLOT * 4);
    int* cnt = (int*)take(256);
    int* meta = (int*)take(256);
    int* tok_list = (int*)take((size_t)NEXP * NTOK * 4);
    int* row_tok = (int*)take((size_t)PMAX * 4);
    int* slot = (int*)take((size_t)NTOK * 2 * 4);
    int* tile_exp = (int*)take(1024 * 4);
    float* gate = (float*)take((size_t)NTOK * 2 * 4);
    char* regR = w + off;
    bf16_t* proj = (bf16_t*)take((size_t)NTOK * DINP * 2);
    bf16_t* ocat = (bf16_t*)take((size_t)NTOK * DM * 2);
    bf16_t* hc = (bf16_t*)take((size_t)2 * 4096 * 256 * 2);
    bf16_t* kcb = (bf16_t*)take((size_t)4096 * 64 * 2);
    bf16_t* vcb = (bf16_t*)take((size_t)4096 * 64 * 2);
    bf16_t* hconv = (bf16_t*)take((size_t)NTOK * 256 * 2);
    float* qr = (float*)take((size_t)NTOK * 256 * 4);
    float* kr = (float*)take((size_t)NTOK * 256 * 4);
    float* KV = (float*)take((size_t)1024 * 4096 * 4);
    float* Sst = (float*)take((size_t)1024 * 4096 * 4);
    bf16_t* hbuf = (bf16_t*)regR;
    const size_t need = (size_t)(regR - w) + (size_t)PMAX * DFF * 2;
    if (need > ws_size || off > ws_size) { fprintf(stderr, "workspace too small: need %zu have %zu\n", need, ws_size); return; }

    for (int l = 0; l < 2; ++l) {
        hipLaunchKernelGGL(k_convT<MapWin>, dim3(DINP / 64, DM / 64), dim3(256), 0, stream, w_in + (size_t)l * DM * DIN, Win + (size_t)l * DINP * DM, make_int2(DIN, DM), MapWin{ln_attn + l * DM});
        hipLaunchKernelGGL(k_convT<MapPlain>, dim3(DM / 64, DM / 64), dim3(256), 0, stream, w_out + (size_t)l * DM * DM, Wout + (size_t)l * DM * DM, make_int2(DM, DM), MapPlain{DM, 0});
        hipLaunchKernelGGL(k_convT<MapPlain>, dim3(256 / 64, 256 / 64), dim3(256), 0, stream, conv_pw + (size_t)l * 65536, Wpw + (size_t)l * 65536, make_int2(256, 256), MapPlain{256, 0});
        for (int kv = 0; kv < 2; ++kv) { const int i = l * 2 + kv;
            hipLaunchKernelGGL(k_convT<MapPlain>, dim3(256 / 64, 2048 / 64), dim3(256), 0, stream, cmp_w1 + (size_t)i * 2048 * 256, W1b + (size_t)i * 256 * 2048, make_int2(256, 2048), MapPlain{256, 0});
            hipLaunchKernelGGL(k_convT<MapPlain>, dim3(256 / 64, 256 / 64), dim3(256), 0, stream, cmp_w2 + (size_t)i * 256 * 64, W2b + (size_t)i * 256 * 256, make_int2(64, 256), MapPlain{64, 0});
            hipLaunchKernelGGL(k_bias1, dim3(4), dim3(256), 0, stream, cmp_pe + (size_t)i * 2048, cmp_w1 + (size_t)i * 2048 * 256, bias1 + i * 256); }
    }
    hipLaunchKernelGGL(k_convT<MapW13>, dim3(2 * DFF / 64, DM / 64), dim3(256), 0, stream, ffn_w13, W13, make_int2(2 * DFF, DM), MapW13{ln_ffn});
    hipLaunchKernelGGL(k_convT<MapPlain>, dim3(DM / 64, DFF / 64), dim3(256), 0, stream, ffn_w2, W2, make_int2(DM, DFF), MapPlain{DM, 0});
    for (int e = 0; e < NEXP; ++e) {
        hipLaunchKernelGGL(k_convT<MapW13>, dim3(2 * DFF / 64, DM / 64), dim3(256), 0, stream, moe_w13 + (size_t)e * DM * 2 * DFF, Wm13 + (size_t)e * 2 * DFF * DM, make_int2(2 * DFF, DM), MapW13{ln_ffn + DM});
        hipLaunchKernelGGL(k_convT<MapPlain>, dim3(DM / 64, DFF / 64), dim3(256), 0, stream, moe_w2 + (size_t)e * DFF * DM, Wm2 + (size_t)e * DM * DFF, make_int2(DM, DFF), MapPlain{DM, 0}); }
    hipLaunchKernelGGL(k_rot, dim3(512), dim3(256), 0, stream, rot);
    hipLaunchKernelGGL(k_xprep, dim3(NTOK / 4), dim3(256), 0, stream, x, xb, ssq);
    (void)hipMemsetAsync(cnt, 0, 256, stream);

    const int G = 512;
    for (int l = 0; l < 2; ++l) {
        hipLaunchKernelGGL((k_gemm<APlain, EpiIn, SchedPlain>), dim3(G), dim3(256), 0, stream, APlain{xb, DM, 0}, Win + (size_t)l * DINP * DM, (long long)DM, EpiIn{proj, ssq}, SchedPlain{NTOK / 128, DINP / 256});
        for (int kv = 0; kv < 2; ++kv) { const int i = l * 2 + kv;
            hipLaunchKernelGGL((k_gemm<ACmp, EpiSiluBias, SchedPlain>), dim3(32), dim3(256), 0, stream, ACmp{proj, kv ? C_VC : C_KC, 0}, W1b + (size_t)i * 256 * 2048, (long long)2048, EpiSiluBias{hc + (size_t)kv * 4096 * 256, bias1 + i * 256, 256, 0}, SchedPlain{4096 / 128, 1});
            hipLaunchKernelGGL((k_gemm<APlain, EpiStore, SchedPlain>), dim3(32), dim3(256), 0, stream, APlain{hc + (size_t)kv * 4096 * 256, 256, 0}, W2b + (size_t)i * 256 * 256, (long long)256, EpiStore{kv ? vcb : kcb, 64, 0, 64, 0}, SchedPlain{4096 / 128, 1}); }
        hipLaunchKernelGGL(k_conv_naive, dim3(NTOK / 32), dim3(256), 0, stream, proj, conv_w + (size_t)l * 31 * 256, conv_b + l * 256, conv_lg + l * 256, conv_lb + l * 256, hconv);
        hipLaunchKernelGGL((k_gemm<APlain, EpiStore, SchedPlain>), dim3(256), dim3(256), 0, stream, APlain{hconv, 256, 0}, Wpw + (size_t)l * 65536, (long long)256, EpiStore{ocat, DM, 512, 256, 0}, SchedPlain{NTOK / 128, 1});
        hipLaunchKernelGGL(k_ret_rot, dim3(NTOK * 128 / 256), dim3(256), 0, stream, proj, rot, qr, kr);
        hipLaunchKernelGGL(k_ret_kv, dim3(1024), dim3(256), 0, stream, proj, kr, KV);
        hipLaunchKernelGGL(k_ret_scan, dim3(32 * 4096 / 256), dim3(256), 0, stream, KV, Sst);
        hipLaunchKernelGGL(k_ret_out, dim3(2048), dim3(256), 0, stream, proj, qr, kr, Sst, ret_gn + l * 256, ocat);
        hipLaunchKernelGGL(k_nsa_naive, dim3(NB * 2 * SEQ), dim3(64), 0, stream, proj, kcb, vcb, ocat);
        hipLaunchKernelGGL((k_gemm<APlain, EpiRes, SchedPlain>), dim3(G), dim3(256), 0, stream, APlain{ocat, DM, 0}, Wout + (size_t)l * DM * DM, (long long)DM, EpiRes{l == 0 ? x : xres, xres, xb, ssq}, SchedPlain{NTOK / 128, DM / 256});
        if (l == 0) {
            hipLaunchKernelGGL((k_gemm<APlain, EpiSwiglu, SchedPlain>), dim3(G), dim3(256), 0, stream, APlain{xb, DM, 0}, W13, (long long)DM, EpiSwiglu{hbuf, ssq, nullptr}, SchedPlain{NTOK / 128, 2 * DFF / 256});
            hipLaunchKernelGGL((k_gemm<APlain, EpiRes, SchedPlain>), dim3(G), dim3(256), 0, stream, APlain{hbuf, DFF, 0}, W2, (long long)DFF, EpiRes{xres, xres, xb, ssq}, SchedPlain{NTOK / 128, DM / 256});
        } else {
            hipLaunchKernelGGL(k_route, dim3(NTOK / 4), dim3(256), 0, stream, xres, ssq, ln_ffn + DM, router, cnt, tok_list, gate);
            hipLaunchKernelGGL(k_route_build, dim3(NEXP * NTOK / 256), dim3(256), 0, stream, cnt, tok_list, row_tok, slot, tile_exp, meta);
            hipLaunchKernelGGL((k_gemm<AGather, EpiSwiglu, SchedMoe>), dim3(G), dim3(256), 0, stream, AGather{xb, row_tok, DM, 0}, Wm13, (long long)DM, EpiSwiglu{hbuf, ssq, row_tok}, SchedMoe{meta, tile_exp, (size_t)2 * DFF * DM, 2 * DFF / 256, 0});
            hipLaunchKernelGGL((k_gemm<APlain, EpiStore, SchedMoe>), dim3(G), dim3(256), 0, stream, APlain{hbuf, DFF, 0}, Wm2, (long long)DFF, EpiStore{ysorted, DM, 0, DM, 0}, SchedMoe{meta, tile_exp, (size_t)DM * DFF, DM / 256, 0});
            hipLaunchKernelGGL(k_final, dim3(NTOK / 4), dim3(256), 0, stream, xres, ysorted, slot, gate, ln_final);
        }
    }
}
```

```cpp
#include <hip/hip_runtime.h>
#include <stdint.h>
#include <stdio.h>

typedef unsigned short bf16_t;
typedef short bf16x8 __attribute__((ext_vector_type(8)));
typedef float f32x4 __attribute__((ext_vector_type(4)));

constexpr int NTOK = 32768, DM = 1024, NB = 8, SEQ = 4096;
constexpr int DIN = 2840, DINP = 3072, DFF = 2816, NEXP = 8;
constexpr int C_Q = 0, C_KC = 512, C_VC = 640, C_KS = 768, C_VS = 896, C_KW = 1024, C_VW = 1152, C_GL = 1280,
              C_CONV = 1304, C_RQ = 1816, C_RK = 2072, C_RV = 2328, C_RG = 2584;
constexpr int NSLOT = 16;
constexpr int PMAX = 65536 + 8 * 256;
constexpr int NT = 512, NW = 8;
constexpr int LDS_BYTES = 144 * 1024, MISC_OFF = LDS_BYTES - 256;

#define XB_TMO      128
#define XB_XCNT(j)  (256  + 64 * (j))
#define XB_XSUB(j)  (1280 + 64 * (j))
#define XB_XGEN(j)  (2304 + 64 * (j))
#define XB_TOP      3328
#define XB_TOPGEN   3392
#define XCD_BAR_WORDS 3456
#define XB_SPIN_CAP (1u << 20)
#define LAS __attribute__((address_space(3)))
__device__ __forceinline__ unsigned xb_ld(unsigned* p)              { return __hip_atomic_load(p, __ATOMIC_RELAXED, __HIP_MEMORY_SCOPE_AGENT); }
__device__ __forceinline__ unsigned xb_add(unsigned* p, unsigned v) { return __hip_atomic_fetch_add(p, v, __ATOMIC_RELAXED, __HIP_MEMORY_SCOPE_AGENT); }
__device__ __forceinline__ unsigned xb_xcc_id() { return (unsigned)__builtin_amdgcn_s_getreg((3 << 11) | 20) & 0xFu; }
#define XB_SPIN(cond, bar) do { unsigned _sp = 0; while (cond) { __builtin_amdgcn_s_sleep(1); \
    if ((++_sp & 255u) == 0u) { if (xb_ld(&(bar)[XB_TMO])) break; if (_sp > XB_SPIN_CAP) { atomicAdd(&(bar)[XB_TMO], 1u); break; } } } } while (0)
struct XcdBarrier { unsigned* bar; unsigned x; volatile LAS unsigned* st; };
__device__ __forceinline__ XcdBarrier xcd_barrier_post(unsigned* bar, volatile LAS unsigned* st) {
    XcdBarrier b; b.bar = bar; b.x = xb_xcc_id(); b.st = st;
    if (threadIdx.x == 0) (void)xb_add(&bar[XB_XCNT(b.x)], 1u);
    return b;
}
__device__ __forceinline__ void xcd_barrier_complete(unsigned* bar, unsigned x, unsigned& nloc, unsigned& nx) {
    const unsigned G = gridDim.x * gridDim.y * gridDim.z;
    unsigned sum, cnt, mine, sp = 0u;
    for (;;) {
        sum = 0u; cnt = 0u; mine = 0u;
#pragma unroll
        for (unsigned j = 0; j < 16; ++j) { const unsigned c = xb_ld(&bar[XB_XCNT(j)]); sum += c; cnt += (c > 0u) ? 1u : 0u; mine = (j == x) ? c : mine; }
        if (sum == G) break;
        __builtin_amdgcn_s_sleep(1);
        if ((++sp & 255u) == 0u) { if (xb_ld(&bar[XB_TMO])) break; if (sp > XB_SPIN_CAP) { atomicAdd(&bar[XB_TMO], 1u); break; } }
    }
    nloc = mine > 0u ? mine : 1u; nx = cnt > 0u ? cnt : 1u;
}
__device__ __forceinline__ void xcd_barrier(const XcdBarrier& b) {
    asm volatile("s_waitcnt vmcnt(0)" ::: "memory");
    __syncthreads();
    if (threadIdx.x == 0) {
        unsigned* bar = b.bar;
        __builtin_amdgcn_s_waitcnt(0);
        unsigned nloc = b.st[0], nx = b.st[1];
        if (nloc == 0u) { xcd_barrier_complete(bar, b.x, nloc, nx); b.st[0] = nloc; b.st[1] = nx; }
        const unsigned old = xb_add(&bar[XB_XSUB(b.x)], 1u);
        const unsigned gen = old / nloc;
        if (old + 1u == (gen + 1u) * nloc) {
            __builtin_amdgcn_fence(__ATOMIC_RELEASE, "agent");
            asm volatile("s_waitcnt vmcnt(0)" ::: "memory");
            const unsigned og = xb_add(&bar[XB_TOP], 1u);
            const unsigned tg = og / nx;
            if (og + 1u == (tg + 1u) * nx) xb_add(&bar[XB_TOPGEN], 1u);
            else XB_SPIN(xb_ld(&bar[XB_TOPGEN]) == tg, bar);
            __builtin_amdgcn_fence(__ATOMIC_ACQUIRE, "agent");
            xb_add(&bar[XB_XGEN(b.x)], 1u);
            asm volatile("s_waitcnt vmcnt(0)" ::: "memory");
        } else {
            XB_SPIN(xb_ld(&bar[XB_XGEN(b.x)]) == gen, bar);
            __builtin_amdgcn_fence(__ATOMIC_ACQUIRE, "agent");
            asm volatile("s_waitcnt vmcnt(0)" ::: "memory");
        }
    }
    __syncthreads();
}

__device__ __forceinline__ bf16_t f2bf(float f) { unsigned u = __float_as_uint(f); u += 0x7fffu + ((u >> 16) & 1u); return (bf16_t)(u >> 16); }
__device__ __forceinline__ float bf2f(bf16_t h) { return __uint_as_float(((unsigned)h) << 16); }
__device__ __forceinline__ float wsum(float v) {
#pragma unroll
    for (int o = 32; o > 0; o >>= 1) v += __shfl_xor(v, o);
    return v; }
__device__ __forceinline__ float wmax(float v) {
#pragma unroll
    for (int o = 32; o > 0; o >>= 1) v = fmaxf(v, __shfl_xor(v, o));
    return v; }
__device__ __forceinline__ float siluf(float x) { return x / (1.f + __expf(-x)); }
__device__ __forceinline__ float sigmf(float x) { return 1.f / (1.f + __expf(-x)); }
__device__ __forceinline__ float row_rstd(const float* ssq, int row) { float s = 0.f;
#pragma unroll
    for (int i = 0; i < NSLOT; ++i) s += ssq[(size_t)row * NSLOT + i];
    return rsqrtf(s * (1.f / DM) + 1e-6f); }

struct Args {
    const float *x, *ln_attn, *w_in, *cmp_pe, *cmp_w1, *cmp_w2, *conv_w, *conv_b, *conv_lg, *conv_lb, *conv_pw, *ret_gn, *w_out, *ln_ffn, *ffn_w13, *ffn_w2, *router, *moe_w13, *moe_w2, *ln_final;
    float* xres;
    bf16_t *Wm13, *Win, *Wout, *W13, *W2, *xb, *ysorted, *Wm2, *W1b, *W2b, *Wpw;
    float *bias1, *rot, *ssq; int *cnt, *meta, *tok_list, *row_tok, *slot, *tile_exp; float* gate;
    bf16_t *proj, *ocat, *hc, *kcb, *vcb, *hconv; float *qr, *kr, *KV, *Sst; bf16_t* hbuf;
    unsigned* bar;
};

struct ConvJob { const float* src; bf16_t* dst; const float* g; int ldsrc, K, Npad, nvalid, mode, pad; };
__device__ __forceinline__ ConvJob get_job(const Args& a, int j) {
    ConvJob c; c.g = nullptr; c.mode = 0; c.pad = 0;
    if (j < 2) { c.src = a.w_in + (size_t)j * DM * DIN; c.dst = a.Win + (size_t)j * DINP * DM; c.g = a.ln_attn + j * DM; c.ldsrc = DIN; c.K = DM; c.Npad = DINP; c.nvalid = DIN; c.mode = 1; }
    else if (j < 4) { const int l = j - 2; c.src = a.w_out + (size_t)l * DM * DM; c.dst = a.Wout + (size_t)l * DM * DM; c.ldsrc = DM; c.K = DM; c.Npad = DM; c.nvalid = DM; }
    else if (j < 6) { const int l = j - 4; c.src = a.conv_pw + (size_t)l * 65536; c.dst = a.Wpw + (size_t)l * 65536; c.ldsrc = 256; c.K = 256; c.Npad = 256; c.nvalid = 256; }
    else if (j < 10) { const int i = j - 6; c.src = a.cmp_w1 + (size_t)i * 2048 * 256; c.dst = a.W1b + (size_t)i * 256 * 2048; c.ldsrc = 256; c.K = 2048; c.Npad = 256; c.nvalid = 256; }
    else if (j < 14) { const int i = j - 10; c.src = a.cmp_w2 + (size_t)i * 256 * 64; c.dst = a.W2b + (size_t)i * 256 * 256; c.ldsrc = 64; c.K = 256; c.Npad = 256; c.nvalid = 64; }
    else if (j == 14) { c.src = a.ffn_w13; c.dst = a.W13; c.g = a.ln_ffn; c.ldsrc = 2 * DFF; c.K = DM; c.Npad = 2 * DFF; c.nvalid = 2 * DFF; c.mode = 2; }
    else if (j == 15) { c.src = a.ffn_w2; c.dst = a.W2; c.ldsrc = DM; c.K = DFF; c.Npad = DM; c.nvalid = DM; }
    else if (j < 24) { const int e = j - 16; c.src = a.moe_w13 + (size_t)e * DM * 2 * DFF; c.dst = a.Wm13 + (size_t)e * 2 * DFF * DM; c.g = a.ln_ffn + DM; c.ldsrc = 2 * DFF; c.K = DM; c.Npad = 2 * DFF; c.nvalid = 2 * DFF; c.mode = 2; }
    else { const int e = j - 24; c.src = a.moe_w2 + (size_t)e * DFF * DM; c.dst = a.Wm2 + (size_t)e * DM * DFF; c.ldsrc = DM; c.K = DFF; c.Npad = DM; c.nvalid = DM; }
    return c;
}
constexpr int NJOBS = 32;
__device__ __forceinline__ void conv_tile(const ConvJob& c, int tile, float* lt  , int tid_) {
    const int ntn = c.Npad / 64, n0 = (tile % ntn) * 64, k0 = (tile / ntn) * 64, tx = tid_ & 63, ty = tid_ >> 6;
    const int n = n0 + tx; int sc; float cs = 1.f;
    if (c.mode == 2) { const int pn = n >> 8, i = n & 255; sc = i < 128 ? 128 * pn + i : DFF + 128 * pn + (i - 128); }
    else { sc = n < c.nvalid ? n : -1; if (c.mode == 1) cs = (n < 512 || (n >= C_RK && n < C_RV)) ? 0.125f : 1.f; }
    for (int r = ty; r < 64; r += NW) { float v = 0.f; if (sc >= 0) { v = c.src[(size_t)(k0 + r) * c.ldsrc + sc] * cs; if (c.g) v *= c.g[k0 + r]; } lt[r * 65 + tx] = v; }
    __syncthreads();
    for (int r = ty; r < 64; r += NW) c.dst[(size_t)(n0 + r) * c.K + k0 + tx] = f2bf(lt[tx * 65 + r]);
    __syncthreads();
}
__device__ __forceinline__ void ph_prologue(const Args& a, char* lds, int vcu, int G) {
    int tid_ = threadIdx.x; asm volatile("" : "+v"(tid_)); asm volatile("" : "+s"(vcu));
    float* lt = (float*)lds; int acc = 0;
    for (int j = 0; j < NJOBS; ++j) { const ConvJob c = get_job(a, j); const int nt = (c.Npad / 64) * (c.K / 64);
        int t0 = vcu - (acc % G); if (t0 < 0) t0 += G;
        for (int t = t0; t < nt; t += G) conv_tile(c, t, lt, tid_);
        acc += nt; }
    for (int u = vcu; u < 16; u += G) { const int i = u >> 2, nl = tid_ & 63, kp = tid_ >> 6, n = (u & 3) * 64 + nl; float s = 0.f;
        const float* pe = a.cmp_pe + (size_t)i * 2048; const float* w1 = a.cmp_w1 + (size_t)i * 2048 * 256;
        for (int k = kp; k < 2048; k += NW) s += pe[k] * w1[(size_t)k * 256 + n];
        lt[kp * 64 + nl] = s; __syncthreads();
        if (kp == 0) { float t = 0.f; for (int q = 0; q < NW; ++q) t += lt[q * 64 + nl]; a.bias1[i * 256 + n] = t; }
        __syncthreads(); }
    for (int idx = vcu * NT + tid_; idx < 4096 * 32; idx += G * NT) { const int pos = idx >> 5, i = idx & 31; const float inv = powf(10000.f, -(float)i / 32.f), ang = (float)pos * inv;
        a.rot[idx * 2] = cosf(ang); a.rot[idx * 2 + 1] = sinf(ang); }
    const int lane = tid_ & 63;
    for (int row = vcu * NW + (tid_ >> 6); row < NTOK; row += G * NW) { float s = 0.f;
        for (int c = lane * 4; c < DM; c += 256) { const float4 v = *(const float4*)(a.x + (size_t)row * DM + c); s += v.x * v.x + v.y * v.y + v.z * v.z + v.w * v.w;
            ushort4 o; o.x = f2bf(v.x); o.y = f2bf(v.y); o.z = f2bf(v.z); o.w = f2bf(v.w); *(ushort4*)(a.xb + (size_t)row * DM + c) = o; }
        s = wsum(s); if (lane < NSLOT) a.ssq[(size_t)row * NSLOT + lane] = lane == 0 ? s : 0.f; }
}

struct APlain { const bf16_t* A; int lda; __device__ __forceinline__ const bf16_t* ptr(int row, int k) const { return A + (size_t)row * lda + k; } };
struct AGather { const bf16_t* A; const int* row_tok; int lda; __device__ __forceinline__ const bf16_t* ptr(int row, int k) const { const int t = row_tok[row]; return t < 0 ? nullptr : A + (size_t)t * lda + k; } };
struct ACmp { const bf16_t* proj; int coloff;
    __device__ __forceinline__ const bf16_t* ptr(int row, int k) const { const int c = row & 255, g = (row >> 8) & 1, b = row >> 9; if (c == 255) return nullptr;
        return proj + (size_t)(b * SEQ + 16 * c + (k >> 6)) * DINP + coloff + g * 64 + (k & 63); } };
struct SchedPlain { int nM, nN; __device__ __forceinline__ int count() const { return nM * nN; }
    __device__ __forceinline__ void get(int u, int& row0, int& col0, size_t& boff) const { row0 = (u / nN) * 256; col0 = (u % nN) * 256; boff = 0; } };
struct SchedMoe { const int* meta; const int* tile_exp; size_t estride; int nN;
    __device__ __forceinline__ int count() const { return meta[0] * nN; }
    __device__ __forceinline__ void get(int u, int& row0, int& col0, size_t& boff) const { row0 = (u / nN) * 256; col0 = (u % nN) * 256; boff = (size_t)tile_exp[row0 >> 8] * estride; } };

struct EpiIn { bf16_t* proj; const float* ssq;
    __device__ __forceinline__ void apply(const f32x4 (&acc)[2][16], int rowb, int col0, int lane) const {
#pragma unroll
        for (int mi = 0; mi < 2; ++mi)
#pragma unroll
            for (int r = 0; r < 4; ++r) { const int row = rowb + mi * 16 + (lane >> 4) * 4 + r; const float rs = row_rstd(ssq, row);
#pragma unroll
                for (int n = 0; n < 16; ++n) proj[(size_t)row * DINP + col0 + n * 16 + (lane & 15)] = f2bf(acc[mi][n][r] * rs); } } };
struct EpiRes { const float* xold; float* xnew; bf16_t* xb; float* ssq;
    __device__ __forceinline__ void apply(const f32x4 (&acc)[2][16], int rowb, int col0, int lane) const {
#pragma unroll
        for (int mi = 0; mi < 2; ++mi)
#pragma unroll
            for (int r = 0; r < 4; ++r) { const int row = rowb + mi * 16 + (lane >> 4) * 4 + r; float s = 0.f;
#pragma unroll
                for (int n = 0; n < 16; ++n) { const size_t o = (size_t)row * DM + col0 + n * 16 + (lane & 15); const float v = xold[o] + acc[mi][n][r]; xnew[o] = v; xb[o] = f2bf(v); s += v * v; }
                s += __shfl_xor(s, 1); s += __shfl_xor(s, 2); s += __shfl_xor(s, 4); s += __shfl_xor(s, 8);
                if ((lane & 15) < 4) ssq[(size_t)row * NSLOT + (col0 >> 8) * 4 + (lane & 15)] = (lane & 15) == 0 ? s : 0.f; } } };
struct EpiSwiglu { bf16_t* h; const float* ssq; const int* row_tok;
    __device__ __forceinline__ void apply(const f32x4 (&acc)[2][16], int rowb, int col0, int lane) const {
#pragma unroll
        for (int mi = 0; mi < 2; ++mi)
#pragma unroll
            for (int r = 0; r < 4; ++r) { const int row = rowb + mi * 16 + (lane >> 4) * 4 + r; const int t = row_tok ? row_tok[row] : row;
                const float rs = t < 0 ? 0.f : row_rstd(ssq, t < 0 ? 0 : t);
#pragma unroll
                for (int n = 0; n < 8; ++n) { const float av = acc[mi][n][r] * rs, bv = acc[mi][n + 8][r] * rs; h[(size_t)row * DFF + (col0 >> 1) + n * 16 + (lane & 15)] = f2bf(siluf(av) * bv); } } } };
struct EpiStore { bf16_t* out; int ldc, coloff, ncols;
    __device__ __forceinline__ void apply(const f32x4 (&acc)[2][16], int rowb, int col0, int lane) const {
#pragma unroll
        for (int mi = 0; mi < 2; ++mi)
#pragma unroll
            for (int r = 0; r < 4; ++r) { const int row = rowb + mi * 16 + (lane >> 4) * 4 + r;
#pragma unroll
                for (int n = 0; n < 16; ++n) { const int c = col0 + n * 16 + (lane & 15); if (c < ncols) out[(size_t)row * ldc + coloff + c] = f2bf(acc[mi][n][r]); } } } };
struct EpiSiluBias { bf16_t* out; const float* bias; int ldc;
    __device__ __forceinline__ void apply(const f32x4 (&acc)[2][16], int rowb, int col0, int lane) const {
#pragma unroll
        for (int mi = 0; mi < 2; ++mi)
#pragma unroll
            for (int r = 0; r < 4; ++r) { const int row = rowb + mi * 16 + (lane >> 4) * 4 + r;
#pragma unroll
                for (int n = 0; n < 16; ++n) { const int c = col0 + n * 16 + (lane & 15); out[(size_t)row * ldc + c] = f2bf(siluf(acc[mi][n][r] + bias[c])); } } } };

template <class AS, class Epi, class Sched>
__device__ __forceinline__ void ph_gemm(char* lds, const AS as, const bf16_t* __restrict__ Bt, const int K, const Epi epi, const Sched sched, int vcu, int G) {
    int tid_ = threadIdx.x; asm volatile("" : "+v"(tid_)); asm volatile("" : "+s"(vcu));
    bf16_t* sA = (bf16_t*)lds; bf16_t* sB = (bf16_t*)(lds + 256 * 40 * 2);
    const int tid = tid_, wave = tid >> 6, lane = tid & 63;
    const int nunits = sched.count();
    for (int u = vcu; u < nunits; u += G) {
        int row0, col0; size_t boff; sched.get(u, row0, col0, boff);
        const bf16_t* Bu = Bt + boff;
        f32x4 acc[2][16];
#pragma unroll
        for (int mi = 0; mi < 2; ++mi)
#pragma unroll
            for (int n = 0; n < 16; ++n) acc[mi][n] = (f32x4){0.f, 0.f, 0.f, 0.f};
#pragma unroll 1
        for (int k0 = 0; k0 < K; k0 += 32) {
#pragma unroll
            for (int i = 0; i < 2; ++i) { const int c = tid + i * NT, r = c >> 2, kc = (c & 3) * 8; const bf16_t* p = as.ptr(row0 + r, k0 + kc);
                uint4 v = make_uint4(0u, 0u, 0u, 0u); if (p) v = *(const uint4*)p; *(uint4*)&sA[r * 40 + kc] = v; }
#pragma unroll
            for (int i = 0; i < 2; ++i) { const int c = tid + i * NT, r = c >> 2, kc = (c & 3) * 8;
                *(uint4*)&sB[r * 40 + kc] = *(const uint4*)(Bu + (size_t)(col0 + r) * K + k0 + kc); }
            __syncthreads();
            bf16x8 af[2];
#pragma unroll
            for (int mi = 0; mi < 2; ++mi) af[mi] = *(const bf16x8*)&sA[(wave * 32 + mi * 16 + (lane & 15)) * 40 + (lane >> 4) * 8];
#pragma unroll
            for (int n = 0; n < 16; ++n) { const bf16x8 bfr = *(const bf16x8*)&sB[(n * 16 + (lane & 15)) * 40 + (lane >> 4) * 8];
#pragma unroll
                for (int mi = 0; mi < 2; ++mi) acc[mi][n] = __builtin_amdgcn_mfma_f32_16x16x32_bf16(af[mi], bfr, acc[mi][n], 0, 0, 0); }
            __syncthreads();
        }
        epi.apply(acc, row0 + wave * 32, col0, lane);
    }
}

struct Br { float m[4], l[4], o[4]; };
__device__ __forceinline__ void attend_tile(Br& a, const bf16_t* kp, const bf16_t* vb, size_t vstride, const float* qs  , float* ps  , int lane) {
    const unsigned long long vm = __ballot(kp != nullptr);
    if (vm) {
        float s[4] = {0.f, 0.f, 0.f, 0.f};
        if (kp) {
#pragma unroll
            for (int c = 0; c < 8; ++c) { const uint4 raw = *(const uint4*)(kp + c * 8); const unsigned w[4] = {raw.x, raw.y, raw.z, raw.w};
#pragma unroll
                for (int e = 0; e < 4; ++e) { const float k0 = __uint_as_float(w[e] << 16), k1 = __uint_as_float(w[e] & 0xffff0000u); const int d = c * 8 + e * 2;
#pragma unroll
                    for (int h = 0; h < 4; ++h) s[h] += k0 * qs[h * 64 + d] + k1 * qs[h * 64 + d + 1]; } } }
#pragma unroll
        for (int h = 0; h < 4; ++h) { const float sv = kp ? s[h] : -INFINITY; const float mn = fmaxf(a.m[h], wmax(sv)); const float al = a.m[h] == -INFINITY ? 0.f : __expf(a.m[h] - mn);
            const float p = kp ? __expf(sv - mn) : 0.f; a.l[h] = a.l[h] * al + wsum(p); a.o[h] *= al; a.m[h] = mn; ps[h * 64 + lane] = p; }
    }
    __syncthreads();
    if (vm) { for (int k = 0; k < 64; ++k) if ((vm >> k) & 1ull) { const float v = bf2f(vb[(size_t)k * vstride + lane]);
#pragma unroll
            for (int h = 0; h < 4; ++h) a.o[h] += ps[h * 64 + k] * v; } }
    __syncthreads();
}
__device__ __forceinline__ void ph_nsa_naive(const Args& a, char* lds, int vcu, int G) {
    int tid_ = threadIdx.x; asm volatile("" : "+v"(tid_)); asm volatile("" : "+s"(vcu));
    const int wave = tid_ >> 6, lane = tid_ & 63;
    float* qs = (float*)(lds + wave * 7168); float* ps = qs + 256; float* pc = ps + 256; float* psum = pc + 1024;
    const bf16_t* proj = a.proj;
    for (int unit = vcu; unit < NB * 2 * SEQ / 8; unit += G) {
        const int t0 = (unit & 511) * 8, g = (unit >> 9) & 1, b = unit >> 10, t = t0 + wave;
        const size_t row = (size_t)b * SEQ + t; const bf16_t* prow = proj + row * DINP;
        __syncthreads();
#pragma unroll
        for (int h = 0; h < 4; ++h) qs[h * 64 + lane] = bf2f(prow[C_Q + g * 256 + h * 64 + lane]);
        for (int i = lane; i < 256; i += 64) psum[i] = 0.f;
        __syncthreads();
        const bf16_t* kcb = a.kcb + (size_t)(b * 2 + g) * 256 * 64; const bf16_t* vcb = a.vcb + (size_t)(b * 2 + g) * 256 * 64;
        const int cmax = t >= 31 ? (t - 31) >> 4 : -1;
        float sc[4][4]; float mh[4] = {-INFINITY, -INFINITY, -INFINITY, -INFINITY};
#pragma unroll
        for (int ti = 0; ti < 4; ++ti) { const int c = ti * 64 + lane; const bool ok = c <= cmax; float s[4] = {0.f, 0.f, 0.f, 0.f};
            if (ok) { const bf16_t* kp = kcb + (size_t)c * 64; for (int d = 0; d < 64; ++d) { const float kv = bf2f(kp[d]);
#pragma unroll
                    for (int h = 0; h < 4; ++h) s[h] += kv * qs[h * 64 + d]; } }
#pragma unroll
            for (int h = 0; h < 4; ++h) { sc[ti][h] = ok ? s[h] : -INFINITY; mh[h] = fmaxf(mh[h], sc[ti][h]); } }
        float ocmp[4] = {0.f, 0.f, 0.f, 0.f};
        if (cmax >= 0) {
            float lh[4];
#pragma unroll
            for (int h = 0; h < 4; ++h) { mh[h] = wmax(mh[h]); float l = 0.f;
#pragma unroll
                for (int ti = 0; ti < 4; ++ti) l += sc[ti][h] == -INFINITY ? 0.f : __expf(sc[ti][h] - mh[h]);
                lh[h] = wsum(l); }
#pragma unroll
            for (int ti = 0; ti < 4; ++ti) { float tot = 0.f;
#pragma unroll
                for (int h = 0; h < 4; ++h) { const float p = sc[ti][h] == -INFINITY ? 0.f : __expf(sc[ti][h] - mh[h]) / lh[h]; pc[h * 256 + ti * 64 + lane] = p; tot += p; }
                psum[ti * 64 + lane] = tot; }
        }
        __syncthreads();
        if (cmax >= 0) { for (int c = 0; c <= cmax; ++c) { const float v = bf2f(vcb[(size_t)c * 64 + lane]);
#pragma unroll
                for (int h = 0; h < 4; ++h) ocmp[h] += pc[h * 256 + c] * v; } }
        const int cur = t >> 6; float imp = 0.f;
        for (int c = 4 * lane - 1; c <= 4 * lane + 3; ++c) if (c >= 0 && c <= 254) imp += psum[c];
        const bool valid = lane <= cur, forced = lane == 0 || lane == cur || lane == cur - 1;
        const float val = valid ? (forced ? 1e9f : imp) : -1e30f; int rank = 0;
        for (int s2 = 0; s2 < 64; ++s2) { const float v2 = __shfl(val, s2); rank += (v2 > val || (v2 == val && s2 < lane)) ? 1 : 0; }
        const unsigned long long selmask = __ballot(valid && rank < 16);
        Br sb;
#pragma unroll
        for (int h = 0; h < 4; ++h) { sb.m[h] = -INFINITY; sb.l[h] = 0.f; sb.o[h] = 0.f; }
        for (int j = 0; j <= cur; ++j) { const int key = j * 64 + lane; const bf16_t* base = proj + ((size_t)b * SEQ + j * 64) * DINP; const bool on = (selmask >> j) & 1ull;
            attend_tile(sb, (on && key <= t) ? base + (size_t)lane * DINP + C_KS + g * 64 : nullptr, base + C_VS + g * 64, DINP, qs, ps, lane); }
        Br wb;
#pragma unroll
        for (int h = 0; h < 4; ++h) { wb.m[h] = -INFINITY; wb.l[h] = 0.f; wb.o[h] = 0.f; }
        const int wstart = t - 511 > 0 ? t - 511 : 0; const int jlo = (t0 - 511 > 0 ? t0 - 511 : 0) >> 6;
        for (int j = jlo; j <= cur; ++j) { const int key = j * 64 + lane; const bf16_t* base = proj + ((size_t)b * SEQ + j * 64) * DINP;
            attend_tile(wb, (key >= wstart && key <= t) ? base + (size_t)lane * DINP + C_KW + g * 64 : nullptr, base + C_VW + g * 64, DINP, qs, ps, lane); }
#pragma unroll
        for (int h = 0; h < 4; ++h) { const int hh = g * 4 + h; const float g0 = sigmf(bf2f(prow[C_GL + hh * 3 + 0])), g1 = sigmf(bf2f(prow[C_GL + hh * 3 + 1])), g2 = sigmf(bf2f(prow[C_GL + hh * 3 + 2]));
            const float o = g0 * ocmp[h] + g1 * (sb.l[h] > 0.f ? sb.o[h] / sb.l[h] : 0.f) + g2 * (wb.l[h] > 0.f ? wb.o[h] / wb.l[h] : 0.f);
            a.ocat[row * DM + hh * 64 + lane] = f2bf(o); }
    }
}

__device__ __forceinline__ void ph_conv_naive(const Args& a, int l, char* lds, int vcu, int G) {
    int tid_ = threadIdx.x; asm volatile("" : "+v"(tid_)); asm volatile("" : "+s"(vcu));
    const int half = tid_ >> 8, c = tid_ & 255; float* hs = (float*)(lds + half * 63488);
    const float* cw = a.conv_w + (size_t)l * 31 * 256; const float* lg = a.conv_lg + l * 256; const float* lb = a.conv_lb + l * 256;
    float w[31];
#pragma unroll
    for (int k = 0; k < 31; ++k) w[k] = cw[k * 256 + c];
    const float bias = a.conv_b[l * 256 + c];
    for (int unit = vcu; unit < NTOK / 64; unit += G) {
        const int tile = unit * 2 + half, b = tile >> 7, t0 = (tile & 127) * 32;
        __syncthreads();
        for (int i = 0; i < 62; ++i) { const int t = t0 - 30 + i; float v = 0.f;
            if (t >= 0) { const bf16_t* p = a.proj + ((size_t)b * SEQ + t) * DINP + C_CONV; v = bf2f(p[c]) * sigmf(bf2f(p[256 + c])); }
            hs[i * 256 + c] = v; }
        __syncthreads();
        float outv[32];
#pragma unroll
        for (int tt = 0; tt < 32; ++tt) { float s = bias;
#pragma unroll
            for (int k = 0; k < 31; ++k) s += hs[(tt + k) * 256 + c] * w[k];
            outv[tt] = s; }
        __syncthreads();
#pragma unroll
        for (int tt = 0; tt < 32; ++tt) hs[tt * 256 + c] = outv[tt];
        __syncthreads();
        const int wave = c >> 6, lane = c & 63;
        for (int tt = wave; tt < 32; tt += 4) { float v[4], s = 0.f;
#pragma unroll
            for (int i = 0; i < 4; ++i) { v[i] = hs[tt * 256 + lane + 64 * i]; s += v[i]; }
            const float mu = wsum(s) * (1.f / 256.f); float q = 0.f;
#pragma unroll
            for (int i = 0; i < 4; ++i) q += (v[i] - mu) * (v[i] - mu);
            const float rs = rsqrtf(wsum(q) * (1.f / 256.f) + 1e-5f);
#pragma unroll
            for (int i = 0; i < 4; ++i) { const int ch = lane + 64 * i; const float y = (v[i] - mu) * rs * lg[ch] + lb[ch]; a.hconv[((size_t)b * SEQ + t0 + tt) * 256 + ch] = f2bf(siluf(y)); } }
    }
}

__device__ __forceinline__ float ret_lg(int h) { return log1pf(-exp2f(-5.f - (float)h)); }
__device__ __forceinline__ void ph_ret_rot(const Args& a, int vcu, int G) {
    int tid_ = threadIdx.x; asm volatile("" : "+v"(tid_)); asm volatile("" : "+s"(vcu));
    for (size_t idx = (size_t)vcu * NT + tid_; idx < (size_t)NTOK * 128; idx += (size_t)G * NT) {
        const int i = idx & 31, h = (idx >> 5) & 3; const size_t row = idx >> 7; const int pos = row & (SEQ - 1);
        const float co = a.rot[(pos * 32 + i) * 2], si = a.rot[(pos * 32 + i) * 2 + 1];
        const bf16_t* p = a.proj + row * DINP;
        { const float x1 = bf2f(p[C_RQ + h * 64 + i]), x2 = bf2f(p[C_RQ + h * 64 + 32 + i]); a.qr[row * 256 + h * 64 + i] = x1 * co - x2 * si; a.qr[row * 256 + h * 64 + 32 + i] = x1 * si + x2 * co; }
        { const float x1 = bf2f(p[C_RK + h * 64 + i]), x2 = bf2f(p[C_RK + h * 64 + 32 + i]); a.kr[row * 256 + h * 64 + i] = x1 * co - x2 * si; a.kr[row * 256 + h * 64 + 32 + i] = x1 * si + x2 * co; }
    }
}
__device__ __forceinline__ void ph_ret_kv(const Args& a, int vcu, int G) {
    int tid_ = threadIdx.x; asm volatile("" : "+v"(tid_)); asm volatile("" : "+s"(vcu));
    for (int unit = vcu; unit < 512; unit += G) {
        const int u = unit * 2 + (tid_ >> 8), tl = tid_ & 255, c = u & 31, h = (u >> 5) & 3, b = u >> 7; const float lg = ret_lg(h);
        const int dk = tl >> 2, dv0 = (tl & 3) * 16; float s[16];
#pragma unroll
        for (int i = 0; i < 16; ++i) s[i] = 0.f;
        for (int k = 0; k < 128; ++k) { const size_t row = (size_t)b * SEQ + c * 128 + k; const float z = __expf((127.f - (float)k) * lg) * a.kr[row * 256 + h * 64 + dk];
            const bf16_t* vp = a.proj + row * DINP + C_RV + h * 64 + dv0;
#pragma unroll
            for (int i = 0; i < 16; ++i) s[i] += z * bf2f(vp[i]); }
#pragma unroll
        for (int i = 0; i < 16; ++i) a.KV[(size_t)u * 4096 + dk * 64 + dv0 + i] = s[i];
    }
}
__device__ __forceinline__ void ph_ret_scan(const Args& a, int vcu, int G) {
    int tid_ = threadIdx.x; asm volatile("" : "+v"(tid_)); asm volatile("" : "+s"(vcu));
    for (int idx = vcu * NT + tid_; idx < 32 * 4096; idx += G * NT) { const int e = idx & 4095, bh = idx >> 12, h = bh & 3; const float gc = __expf(128.f * ret_lg(h)); float s = 0.f;
        for (int c = 0; c < 32; ++c) { const size_t o = ((size_t)bh * 32 + c) * 4096 + e; a.Sst[o] = s; s = gc * s + a.KV[o]; } }
}
__device__ __forceinline__ void ph_ret_out(const Args& a, int l, char* lds, int vcu, int G) {
    int tid_ = threadIdx.x; asm volatile("" : "+v"(tid_)); asm volatile("" : "+s"(vcu));
    const int sub = tid_ >> 8, tl = tid_ & 255; float* A = (float*)(lds + sub * 32768);
    const float* gn = a.ret_gn + l * 256;
    for (int unit = vcu; unit < 1024; unit += G) {
        const int u = unit * 2 + sub, half = u & 1, c = (u >> 1) & 31, h = (u >> 6) & 3, b = u >> 8; const float lg = ret_lg(h);
        const size_t r0 = (size_t)b * SEQ + c * 128;
        __syncthreads();
        for (int e = tl; e < 64 * 128; e += 256) { const int i = e >> 7, j = e & 127, ig = half * 64 + i; float s = 0.f;
            if (j <= ig) { const float* qp = a.qr + (r0 + ig) * 256 + h * 64; const float* kp = a.kr + (r0 + j) * 256 + h * 64; for (int d = 0; d < 64; ++d) s += qp[d] * kp[d]; s *= __expf((float)(ig - j) * lg); }
            A[i * 128 + j] = s; }
        __syncthreads();
        const int i = tl >> 2, d0 = (tl & 3) * 16, ig = half * 64 + i; float o[16];
#pragma unroll
        for (int x = 0; x < 16; ++x) o[x] = 0.f;
        for (int j = 0; j <= ig; ++j) { const float av = A[i * 128 + j]; const bf16_t* vp = a.proj + (r0 + j) * DINP + C_RV + h * 64 + d0;
#pragma unroll
            for (int x = 0; x < 16; ++x) o[x] += av * bf2f(vp[x]); }
        { const float xi = __expf((float)(ig + 1) * lg); const float* qp = a.qr + (r0 + ig) * 256 + h * 64; const float* Sp = a.Sst + (((size_t)(b * 4 + h) * 32 + c) * 4096);
          float cr[16];
#pragma unroll
          for (int x = 0; x < 16; ++x) cr[x] = 0.f;
          for (int dk = 0; dk < 64; ++dk) { const float q = qp[dk];
#pragma unroll
              for (int x = 0; x < 16; ++x) cr[x] += q * Sp[dk * 64 + d0 + x]; }
#pragma unroll
          for (int x = 0; x < 16; ++x) o[x] += xi * cr[x]; }
        float s = 0.f;
#pragma unroll
        for (int x = 0; x < 16; ++x) s += o[x];
        s += __shfl_xor(s, 1); s += __shfl_xor(s, 2); const float mu = s * (1.f / 64.f);
        float q = 0.f;
#pragma unroll
        for (int x = 0; x < 16; ++x) q += (o[x] - mu) * (o[x] - mu);
        q += __shfl_xor(q, 1); q += __shfl_xor(q, 2); const float rs = rsqrtf(q * (1.f / 64.f) + 1e-5f);
        const bf16_t* gp = a.proj + (r0 + ig) * DINP + C_RG + h * 64 + d0;
#pragma unroll
        for (int x = 0; x < 16; ++x) { const float gt = bf2f(gp[x]); a.ocat[(r0 + ig) * DM + 768 + h * 64 + d0 + x] = f2bf(siluf(gt) * (o[x] - mu) * rs * gn[h * 64 + d0 + x]); }
    }
}

__device__ __forceinline__ void ph_route(const Args& a, int vcu, int G) {
    int tid_ = threadIdx.x; asm volatile("" : "+v"(tid_)); asm volatile("" : "+s"(vcu));
    const int lane = tid_ & 63; const float* g = a.ln_ffn + DM;
    for (int row = vcu * NW + (tid_ >> 6); row < NTOK; row += G * NW) { float lg[8];
#pragma unroll
        for (int e = 0; e < 8; ++e) lg[e] = 0.f;
        for (int k = lane; k < DM; k += 64) { const float xv = a.xres[(size_t)row * DM + k] * g[k];
#pragma unroll
            for (int e = 0; e < 8; ++e) lg[e] += xv * a.router[k * 8 + e]; }
        const float rs = row_rstd(a.ssq, row);
#pragma unroll
        for (int e = 0; e < 8; ++e) lg[e] = wsum(lg[e]) * rs;
        int e1 = 0; float v1 = lg[0];
#pragma unroll
        for (int e = 1; e < 8; ++e) if (lg[e] > v1) { v1 = lg[e]; e1 = e; }
        int e2 = -1; float v2 = -INFINITY;
#pragma unroll
        for (int e = 0; e < 8; ++e) if (e != e1 && lg[e] > v2) { v2 = lg[e]; e2 = e; }
        if (lane == 0) { const float g1 = 1.f / (1.f + __expf(v2 - v1)); a.gate[row * 2] = g1; a.gate[row * 2 + 1] = 1.f - g1;
            const int i1 = atomicAdd(&a.cnt[e1], 1); a.tok_list[e1 * NTOK + i1] = row * 2; const int i2 = atomicAdd(&a.cnt[e2], 1); a.tok_list[e2 * NTOK + i2] = row * 2 + 1; } }
}
__device__ __forceinline__ void ph_route_build(const Args& a, int vcu, int G) {
    int tid_ = threadIdx.x; asm volatile("" : "+v"(tid_)); asm volatile("" : "+s"(vcu));
    for (int idx = vcu * NT + tid_; idx < NEXP * NTOK; idx += G * NT) { const int e = idx >> 15, i = idx & (NTOK - 1);
        int ps = 0; for (int q = 0; q < e; ++q) ps += (a.cnt[q] + 255) & ~255;
        const int ce = a.cnt[e], pe = (ce + 255) & ~255;
        if (i < ce) { const int en = a.tok_list[e * NTOK + i]; a.row_tok[ps + i] = en >> 1; a.slot[en] = ps + i; } else if (i < pe) a.row_tok[ps + i] = -1;
        if (i < pe && (i & 255) == 0) a.tile_exp[(ps + i) >> 8] = e;
        if (idx == 0) { int tot = 0; for (int q = 0; q < 8; ++q) tot += (a.cnt[q] + 255) & ~255; a.meta[0] = tot >> 8; } }
}
__device__ __forceinline__ void ph_final(const Args& a, int vcu, int G) {
    int tid_ = threadIdx.x; asm volatile("" : "+v"(tid_)); asm volatile("" : "+s"(vcu));
    const int lane = tid_ & 63; float* xio = a.xres;
    for (int row = vcu * NW + (tid_ >> 6); row < NTOK; row += G * NW) { const int s1 = a.slot[row * 2], s2 = a.slot[row * 2 + 1]; const float g1 = a.gate[row * 2], g2 = a.gate[row * 2 + 1];
        float v[16]; float ss = 0.f;
#pragma unroll
        for (int i = 0; i < 4; ++i) { const int c = lane * 4 + i * 256; const float4 xv = *(const float4*)(xio + (size_t)row * DM + c);
            const ushort4 p = *(const ushort4*)(a.ysorted + (size_t)s1 * DM + c), q = *(const ushort4*)(a.ysorted + (size_t)s2 * DM + c);
            v[i * 4 + 0] = xv.x + g1 * bf2f(p.x) + g2 * bf2f(q.x); v[i * 4 + 1] = xv.y + g1 * bf2f(p.y) + g2 * bf2f(q.y);
            v[i * 4 + 2] = xv.z + g1 * bf2f(p.z) + g2 * bf2f(q.z); v[i * 4 + 3] = xv.w + g1 * bf2f(p.w) + g2 * bf2f(q.w);
#pragma unroll
            for (int j = 0; j < 4; ++j) ss += v[i * 4 + j] * v[i * 4 + j]; }
        const float rs = rsqrtf(wsum(ss) * (1.f / DM) + 1e-6f);
#pragma unroll
        for (int i = 0; i < 4; ++i) { const int c = lane * 4 + i * 256; const float4 gf = *(const float4*)(a.ln_final + c); float4 o; o.x = v[i * 4] * rs * gf.x; o.y = v[i * 4 + 1] * rs * gf.y; o.z = v[i * 4 + 2] * rs * gf.z; o.w = v[i * 4 + 3] * rs * gf.w;
            *(float4*)(xio + (size_t)row * DM + c) = o; } }
}

__global__ void __launch_bounds__(NT, 2) mega(Args a) {
    extern __shared__ __attribute__((aligned(16))) char lds[];
    volatile LAS unsigned* misc = (volatile LAS unsigned*)((LAS char*)lds + MISC_OFF);
    if (threadIdx.x < 64) misc[threadIdx.x] = 0u;
    __syncthreads();
    XcdBarrier bar = xcd_barrier_post(a.bar, misc);
    const int G = gridDim.x, vcu = blockIdx.x;
#define GRID_BAR() xcd_barrier(bar)

    ph_prologue(a, lds, vcu, G);
    GRID_BAR();
#pragma unroll
    for (int l = 0; l < 2; ++l) {
        ph_gemm(lds, APlain{a.xb, DM}, a.Win + (size_t)l * DINP * DM, DM, EpiIn{a.proj, a.ssq}, SchedPlain{NTOK / 256, DINP / 256}, vcu, G);
        GRID_BAR();
#pragma unroll 1
        for (int kv = 0; kv < 2; ++kv) { const int i = l * 2 + kv;
            ph_gemm(lds, ACmp{a.proj, kv ? C_VC : C_KC}, a.W1b + (size_t)i * 256 * 2048, 2048, EpiSiluBias{a.hc + (size_t)kv * 4096 * 256, a.bias1 + i * 256, 256}, SchedPlain{4096 / 256, 1}, (vcu + G - kv * 16) % G, G); }
        ph_conv_naive(a, l, lds, vcu, G);
        ph_ret_rot(a, vcu, G);
        GRID_BAR();
#pragma unroll 1
        for (int kv = 0; kv < 2; ++kv) { const int i = l * 2 + kv;
            ph_gemm(lds, APlain{a.hc + (size_t)kv * 4096 * 256, 256}, a.W2b + (size_t)i * 256 * 256, 256, EpiStore{kv ? a.vcb : a.kcb, 64, 0, 64}, SchedPlain{4096 / 256, 1}, (vcu + G - kv * 16) % G, G); }
        ph_gemm(lds, APlain{a.hconv, 256}, a.Wpw + (size_t)l * 65536, 256, EpiStore{a.ocat, DM, 512, 256}, SchedPlain{NTOK / 256, 1}, (vcu + G - 32) % G, G);
        ph_ret_kv(a, vcu, G);
        GRID_BAR();
        ph_ret_scan(a, vcu, G);
        GRID_BAR();
        ph_ret_out(a, l, lds, vcu, G);
        ph_nsa_naive(a, lds, vcu, G);
        GRID_BAR();
        ph_gemm(lds, APlain{a.ocat, DM}, a.Wout + (size_t)l * DM * DM, DM, EpiRes{l == 0 ? a.x : a.xres, a.xres, a.xb, a.ssq}, SchedPlain{NTOK / 256, DM / 256}, vcu, G);
        GRID_BAR();
        if (l == 0) {
            ph_gemm(lds, APlain{a.xb, DM}, a.W13, DM, EpiSwiglu{a.hbuf, a.ssq, nullptr}, SchedPlain{NTOK / 256, 2 * DFF / 256}, vcu, G);
            GRID_BAR();
            ph_gemm(lds, APlain{a.hbuf, DFF}, a.W2, DFF, EpiRes{a.xres, a.xres, a.xb, a.ssq}, SchedPlain{NTOK / 256, DM / 256}, vcu, G);
            GRID_BAR();
        }
    }
    ph_route(a, vcu, G);
    GRID_BAR();
    ph_route_build(a, vcu, G);
    GRID_BAR();
    ph_gemm(lds, AGather{a.xb, a.row_tok, DM}, a.Wm13, DM, EpiSwiglu{a.hbuf, a.ssq, a.row_tok}, SchedMoe{a.meta, a.tile_exp, (size_t)2 * DFF * DM, 2 * DFF / 256}, vcu, G);
    GRID_BAR();
    ph_gemm(lds, APlain{a.hbuf, DFF}, a.Wm2, DFF, EpiStore{a.ysorted, DM, 0, DM}, SchedMoe{a.meta, a.tile_exp, (size_t)DM * DFF, DM / 256}, vcu, G);
    GRID_BAR();
    ph_final(a, vcu, G);
}

static inline size_t al256(size_t x) { return (x + 255) & ~(size_t)255; }
extern "C" void kernel_launch(void* const* d_in, const int* in_sizes, int n_in, void* d_out, int out_size, void* d_ws, size_t ws_size, hipStream_t stream) {
    static int grid = 0;
    Args a{};
    const float** ins = (const float**)&a.x;
    for (int i = 0; i < 20; ++i) ins[i] = (const float*)d_in[i];
    a.xres = (float*)d_out;
    char* w = (char*)d_ws; size_t off = 0;
    auto take = [&](size_t bytes) { char* p = w + off; off = al256(off + bytes); return p; };
    a.bar = (unsigned*)take(XCD_BAR_WORDS * 4);
    a.cnt = (int*)take(256);
    a.meta = (int*)take(256);
    const size_t ctl_bytes = off;
    char* regY = w + off;
    a.Wm13 = (bf16_t*)take((size_t)NEXP * 2 * DFF * DM * 2);
    a.Win = (bf16_t*)take((size_t)2 * DINP * DM * 2);
    a.Wout = (bf16_t*)take((size_t)2 * DM * DM * 2);
    a.W13 = (bf16_t*)take((size_t)2 * DFF * DM * 2);
    a.W2 = (bf16_t*)take((size_t)DM * DFF * 2);
    a.xb = (bf16_t*)take((size_t)NTOK * DM * 2);
    a.ysorted = (bf16_t*)regY;
    a.Wm2 = (bf16_t*)take((size_t)NEXP * DM * DFF * 2);
    a.W1b = (bf16_t*)take((size_t)4 * 256 * 2048 * 2);
    a.W2b = (bf16_t*)take((size_t)4 * 256 * 256 * 2);
    a.Wpw = (bf16_t*)take((size_t)2 * 256 * 256 * 2);
    a.bias1 = (float*)take(4 * 256 * 4);
    a.rot = (float*)take((size_t)4096 * 32 * 2 * 4);
    a.ssq = (float*)take((size_t)NTOK * NSLOT * 4);
    a.tok_list = (int*)take((size_t)NEXP * NTOK * 4);
    a.row_tok = (int*)take((size_t)PMAX * 4);
    a.slot = (int*)take((size_t)NTOK * 2 * 4);
    a.tile_exp = (int*)take(1024 * 4);
    a.gate = (float*)take((size_t)NTOK * 2 * 4);
    char* regR = w + off;
    a.proj = (bf16_t*)take((size_t)NTOK * DINP * 2);
    a.ocat = (bf16_t*)take((size_t)NTOK * DM * 2);
    a.hc = (bf16_t*)take((size_t)2 * 4096 * 256 * 2);
    a.kcb = (bf16_t*)take((size_t)4096 * 64 * 2);
    a.vcb = (bf16_t*)take((size_t)4096 * 64 * 2);
    a.hconv = (bf16_t*)take((size_t)NTOK * 256 * 2);
    a.qr = (float*)take((size_t)NTOK * 256 * 4);
    a.kr = (float*)take((size_t)NTOK * 256 * 4);
    a.KV = (float*)take((size_t)1024 * 4096 * 4);
    a.Sst = (float*)take((size_t)1024 * 4096 * 4);
    a.hbuf = (bf16_t*)regR;
    const size_t need = (size_t)(regR - w) + (size_t)PMAX * DFF * 2;
    if (grid == 0) {
        if (need > ws_size || off > ws_size || n_in != 20) { fprintf(stderr, "kernel_launch: workspace too small: need %zu / %zu have %zu\n", need, off, ws_size); grid = -1; return; }
        int dev = 0, cus = 0;
        if (hipGetDevice(&dev) != hipSuccess || hipDeviceGetAttribute(&cus, hipDeviceAttributeMultiprocessorCount, dev) != hipSuccess) { grid = -1; return; }
        if (hipFuncSetAttribute((const void*)mega, hipFuncAttributeMaxDynamicSharedMemorySize, LDS_BYTES) != hipSuccess) { fprintf(stderr, "kernel_launch: hipFuncSetAttribute failed\n"); grid = -1; return; }
        int per_cu = 0;
        if (hipOccupancyMaxActiveBlocksPerMultiprocessor(&per_cu, (const void*)mega, NT, LDS_BYTES) != hipSuccess || per_cu < 1) { fprintf(stderr, "kernel_launch: occupancy query says %d\n", per_cu); }
        (void)hipGetLastError();
        grid = cus;
    }
    if (grid < 0) return;
    (void)hipMemsetAsync(w, 0, ctl_bytes, stream);
    hipLaunchKernelGGL(mega, dim3(grid), dim3(NT), LDS_BYTES, stream, a);
}
```

```cpp
#include <hip/hip_runtime.h>
#include <stdint.h>
#include <stdio.h>

typedef unsigned short bf16_t;
typedef short bf16x8 __attribute__((ext_vector_type(8)));
typedef float f32x4 __attribute__((ext_vector_type(4)));
typedef unsigned u32x4_t __attribute__((ext_vector_type(4)));

constexpr int NTOK = 32768, DM = 1024, NB = 8, SEQ = 4096;
constexpr int DIN = 2840, DINP = 3072, DFF = 2816, NEXP = 8;
constexpr int C_Q = 0, C_KC = 512, C_VC = 640, C_KS = 768, C_VS = 896, C_KW = 1024, C_VW = 1152, C_GL = 1280,
              C_CONV = 1304, C_RQ = 1816, C_RK = 2072, C_RV = 2328, C_RG = 2584;
constexpr int NSLOT = 16;
constexpr int PMAX = 65536 + 8 * 256;
constexpr int NT = 512, NW = 8;
constexpr int LDS_BYTES = 144 * 1024, MISC_OFF = LDS_BYTES - 256;

#define XB_TMO      128
#define XB_XCNT(j)  (256  + 64 * (j))
#define XB_XSUB(j)  (1280 + 64 * (j))
#define XB_XGEN(j)  (2304 + 64 * (j))
#define XB_TOP      3328
#define XB_TOPGEN   3392
#define XCD_BAR_WORDS 3456
#define XB_SPIN_CAP (1u << 20)
#define LAS __attribute__((address_space(3)))
__device__ __forceinline__ unsigned xb_ld(unsigned* p)              { return __hip_atomic_load(p, __ATOMIC_RELAXED, __HIP_MEMORY_SCOPE_AGENT); }
__device__ __forceinline__ unsigned xb_add(unsigned* p, unsigned v) { return __hip_atomic_fetch_add(p, v, __ATOMIC_RELAXED, __HIP_MEMORY_SCOPE_AGENT); }
__device__ __forceinline__ unsigned xb_xcc_id() { return (unsigned)__builtin_amdgcn_s_getreg((3 << 11) | 20) & 0xFu; }
#define XB_SPIN(cond, bar) do { unsigned _sp = 0; while (cond) { __builtin_amdgcn_s_sleep(1); \
    if ((++_sp & 255u) == 0u) { if (xb_ld(&(bar)[XB_TMO])) break; if (_sp > XB_SPIN_CAP) { atomicAdd(&(bar)[XB_TMO], 1u); break; } } } } while (0)
struct XcdBarrier { unsigned* bar; unsigned x; volatile LAS unsigned* st; };
__device__ __forceinline__ XcdBarrier xcd_barrier_post(unsigned* bar, volatile LAS unsigned* st) {
    XcdBarrier b; b.bar = bar; b.x = xb_xcc_id(); b.st = st;
    if (threadIdx.x == 0) (void)xb_add(&bar[XB_XCNT(b.x)], 1u);
    return b;
}
__device__ __forceinline__ void xcd_barrier_complete(unsigned* bar, unsigned x, unsigned& nloc, unsigned& nx) {
    const unsigned G = gridDim.x * gridDim.y * gridDim.z;
    unsigned sum, cnt, mine, sp = 0u;
    for (;;) {
        sum = 0u; cnt = 0u; mine = 0u;
#pragma unroll
        for (unsigned j = 0; j < 16; ++j) { const unsigned c = xb_ld(&bar[XB_XCNT(j)]); sum += c; cnt += (c > 0u) ? 1u : 0u; mine = (j == x) ? c : mine; }
        if (sum == G) break;
        __builtin_amdgcn_s_sleep(1);
        if ((++sp & 255u) == 0u) { if (xb_ld(&bar[XB_TMO])) break; if (sp > XB_SPIN_CAP) { atomicAdd(&bar[XB_TMO], 1u); break; } }
    }
    nloc = mine > 0u ? mine : 1u; nx = cnt > 0u ? cnt : 1u;
}
__device__ __forceinline__ void xcd_barrier(const XcdBarrier& b) {
    asm volatile("s_waitcnt vmcnt(0)" ::: "memory");
    __syncthreads();
    if (threadIdx.x == 0) {
        unsigned* bar = b.bar;
        __builtin_amdgcn_s_waitcnt(0);
        const unsigned bx = xb_xcc_id();
        unsigned nloc = b.st[0], nx = b.st[1];
        if (nloc == 0u) { xcd_barrier_complete(bar, bx, nloc, nx); b.st[0] = nloc; b.st[1] = nx; }
        const unsigned old = xb_add(&bar[XB_XSUB(bx)], 1u);
        const unsigned gen = old / nloc;
        if (old + 1u == (gen + 1u) * nloc) {
            __builtin_amdgcn_fence(__ATOMIC_RELEASE, "agent");
            asm volatile("s_waitcnt vmcnt(0)" ::: "memory");
            const unsigned og = xb_add(&bar[XB_TOP], 1u);
            const unsigned tg = og / nx;
            if (og + 1u == (tg + 1u) * nx) xb_add(&bar[XB_TOPGEN], 1u);
            else XB_SPIN(xb_ld(&bar[XB_TOPGEN]) == tg, bar);
            __builtin_amdgcn_fence(__ATOMIC_ACQUIRE, "agent");
            xb_add(&bar[XB_XGEN(bx)], 1u);
            asm volatile("s_waitcnt vmcnt(0)" ::: "memory");
        } else {
            XB_SPIN(xb_ld(&bar[XB_XGEN(bx)]) == gen, bar);
            __builtin_amdgcn_fence(__ATOMIC_ACQUIRE, "agent");
            asm volatile("s_waitcnt vmcnt(0)" ::: "memory");
        }
    }
    __syncthreads();
}

__device__ __forceinline__ bf16_t f2bf(float f) { unsigned u = __float_as_uint(f); u += 0x7fffu + ((u >> 16) & 1u); return (bf16_t)(u >> 16); }
__device__ __forceinline__ float bf2f(bf16_t h) { return __uint_as_float(((unsigned)h) << 16); }
__device__ __forceinline__ float wsum(float v) {
#pragma unroll
    for (int o = 32; o > 0; o >>= 1) v += __shfl_xor(v, o);
    return v; }
__device__ __forceinline__ float wmax(float v) {
#pragma unroll
    for (int o = 32; o > 0; o >>= 1) v = fmaxf(v, __shfl_xor(v, o));
    return v; }
__device__ __forceinline__ float siluf(float x) { return x / (1.f + __expf(-x)); }
__device__ __forceinline__ float sigmf(float x) { return 1.f / (1.f + __expf(-x)); }
__device__ __forceinline__ float row_rstd(const float* ssq, int row) { float s = 0.f;
#pragma unroll
    for (int i = 0; i < NSLOT; ++i) s += ssq[(size_t)row * NSLOT + i];
    return rsqrtf(s * (1.f / DM) + 1e-6f); }

struct Args {
    const float *x, *ln_attn, *w_in, *cmp_pe, *cmp_w1, *cmp_w2, *conv_w, *conv_b, *conv_lg, *conv_lb, *conv_pw, *ret_gn, *w_out, *ln_ffn, *ffn_w13, *ffn_w2, *router, *moe_w13, *moe_w2, *ln_final;
    float* xres;
    bf16_t *Wm13, *Win, *Wout, *W13, *W2, *xb, *ysorted, *Wm2, *W1b, *W2b, *Wpw;
    float *bias1, *rot, *ssq; int *cnt, *meta, *tok_list, *row_tok, *slot, *tile_exp; float* gate;
    bf16_t *proj, *ocat, *hc, *kcb, *vcb, *hconv; float *qr, *kr, *KV, *Sst; bf16_t* hbuf; bf16_t *vcT, *VsT, *VwT;
    unsigned* bar;
};

struct ConvJob { const float* src; bf16_t* dst; const float* g; int ldsrc, K, Npad, nvalid, mode, pad; };
__device__ __forceinline__ ConvJob get_job(const Args& a, int j) {
    ConvJob c; c.g = nullptr; c.mode = 0; c.pad = 0;
    if (j < 2) { c.src = a.w_in + (size_t)j * DM * DIN; c.dst = a.Win + (size_t)j * DINP * DM; c.g = a.ln_attn + j * DM; c.ldsrc = DIN; c.K = DM; c.Npad = DINP; c.nvalid = DIN; c.mode = 1; }
    else if (j < 4) { const int l = j - 2; c.src = a.w_out + (size_t)l * DM * DM; c.dst = a.Wout + (size_t)l * DM * DM; c.ldsrc = DM; c.K = DM; c.Npad = DM; c.nvalid = DM; }
    else if (j < 6) { const int l = j - 4; c.src = a.conv_pw + (size_t)l * 65536; c.dst = a.Wpw + (size_t)l * 65536; c.ldsrc = 256; c.K = 256; c.Npad = 256; c.nvalid = 256; }
    else if (j < 10) { const int i = j - 6; c.src = a.cmp_w1 + (size_t)i * 2048 * 256; c.dst = a.W1b + (size_t)i * 256 * 2048; c.ldsrc = 256; c.K = 2048; c.Npad = 256; c.nvalid = 256; }
    else if (j < 14) { const int i = j - 10; c.src = a.cmp_w2 + (size_t)i * 256 * 64; c.dst = a.W2b + (size_t)i * 256 * 256; c.ldsrc = 64; c.K = 256; c.Npad = 256; c.nvalid = 64; }
    else if (j == 14) { c.src = a.ffn_w13; c.dst = a.W13; c.g = a.ln_ffn; c.ldsrc = 2 * DFF; c.K = DM; c.Npad = 2 * DFF; c.nvalid = 2 * DFF; c.mode = 2; }
    else if (j == 15) { c.src = a.ffn_w2; c.dst = a.W2; c.ldsrc = DM; c.K = DFF; c.Npad = DM; c.nvalid = DM; }
    else if (j < 24) { const int e = j - 16; c.src = a.moe_w13 + (size_t)e * DM * 2 * DFF; c.dst = a.Wm13 + (size_t)e * 2 * DFF * DM; c.g = a.ln_ffn + DM; c.ldsrc = 2 * DFF; c.K = DM; c.Npad = 2 * DFF; c.nvalid = 2 * DFF; c.mode = 2; }
    else { const int e = j - 24; c.src = a.moe_w2 + (size_t)e * DFF * DM; c.dst = a.Wm2 + (size_t)e * DM * DFF; c.ldsrc = DM; c.K = DFF; c.Npad = DM; c.nvalid = DM; }
    return c;
}
constexpr int NJOBS = 32;
__device__ __forceinline__ void conv_tile(const ConvJob& c, int tile, LAS float* lt  , int tid_) {
    const int ntn = c.Npad / 64, n0 = (tile % ntn) * 64, k0 = (tile / ntn) * 64, tx = tid_ & 63, ty = tid_ >> 6;
    const int n = n0 + tx; int sc; float cs = 1.f;
    if (c.mode == 2) { const int pn = n >> 8, i = n & 255; sc = i < 128 ? 128 * pn + i : DFF + 128 * pn + (i - 128); }
    else { sc = n < c.nvalid ? n : -1; if (c.mode == 1) cs = (n < 512 || (n >= C_RK && n < C_RV)) ? 0.125f : 1.f; }
    for (int r = ty; r < 64; r += NW) { float v = 0.f; if (sc >= 0) { v = c.src[(size_t)(k0 + r) * c.ldsrc + sc] * cs; if (c.g) v *= c.g[k0 + r]; } lt[r * 65 + tx] = v; }
    __syncthreads();
    for (int r = ty; r < 64; r += NW) c.dst[(size_t)(n0 + r) * c.K + k0 + tx] = f2bf(lt[tx * 65 + r]);
    __syncthreads();
}
__device__ __forceinline__ void ph_prologue(const Args& a, LAS char* lds, int vcu, int G) {
    int tid_ = threadIdx.x; asm volatile("" : "+v"(tid_)); asm volatile("" : "+s"(vcu));
    LAS float* lt = (LAS float*)lds; int acc = 0;
    for (int j = 0; j < NJOBS; ++j) { const ConvJob c = get_job(a, j); const int nt = (c.Npad / 64) * (c.K / 64);
        int t0 = vcu - (acc % G); if (t0 < 0) t0 += G;
        for (int t = t0; t < nt; t += G) conv_tile(c, t, lt, tid_);
        acc += nt; }
    for (int u = vcu; u < 16; u += G) { const int i = u >> 2, nl = tid_ & 63, kp = tid_ >> 6, n = (u & 3) * 64 + nl; float s = 0.f;
        const float* pe = a.cmp_pe + (size_t)i * 2048; const float* w1 = a.cmp_w1 + (size_t)i * 2048 * 256;
        for (int k = kp; k < 2048; k += NW) s += pe[k] * w1[(size_t)k * 256 + n];
        lt[kp * 64 + nl] = s; __syncthreads();
        if (kp == 0) { float t = 0.f; for (int q = 0; q < NW; ++q) t += lt[q * 64 + nl]; a.bias1[i * 256 + n] = t; }
        __syncthreads(); }
    for (int idx = vcu * NT + tid_; idx < 4096 * 32; idx += G * NT) { const int pos = idx >> 5, i = idx & 31; const float inv = powf(10000.f, -(float)i / 32.f), ang = (float)pos * inv;
        a.rot[idx * 2] = cosf(ang); a.rot[idx * 2 + 1] = sinf(ang); }
    const int lane = tid_ & 63;
    for (int row = vcu * NW + (tid_ >> 6); row < NTOK; row += G * NW) { float s = 0.f;
        for (int c = lane * 4; c < DM; c += 256) { const float4 v = *(const float4*)(a.x + (size_t)row * DM + c); s += v.x * v.x + v.y * v.y + v.z * v.z + v.w * v.w;
            ushort4 o; o.x = f2bf(v.x); o.y = f2bf(v.y); o.z = f2bf(v.z); o.w = f2bf(v.w); *(ushort4*)(a.xb + (size_t)row * DM + c) = o; }
        s = wsum(s); if (lane < NSLOT) a.ssq[(size_t)row * NSLOT + lane] = lane == 0 ? s : 0.f; }
}

struct APlain { const bf16_t* A; int lda; __device__ __forceinline__ const bf16_t* ptr(int row, int k) const { return A + (size_t)row * lda + k; } };
struct AGather { const bf16_t* A; const int* row_tok; int lda; __device__ __forceinline__ const bf16_t* ptr(int row, int k) const { const int t = row_tok[row]; return t < 0 ? nullptr : A + (size_t)t * lda + k; } };
struct ACmp { const bf16_t* proj; int coloff;
    __device__ __forceinline__ const bf16_t* ptr(int row, int k) const { const int c = row & 255, g = (row >> 8) & 1, b = row >> 9; if (c == 255) return nullptr;
        return proj + (size_t)(b * SEQ + 16 * c + (k >> 6)) * DINP + coloff + g * 64 + (k & 63); } };
struct SchedPlain { int nM, nN; __device__ __forceinline__ int count() const { return nM * nN; }
    __device__ __forceinline__ void get(int u, int& row0, int& col0, size_t& boff) const { row0 = (u / nN) * 256; col0 = (u % nN) * 256; boff = 0; } };
struct SchedMoe { const int* meta; const int* tile_exp; size_t estride; int nN;
    __device__ __forceinline__ int count() const { return meta[0] * nN; }
    __device__ __forceinline__ void get(int u, int& row0, int& col0, size_t& boff) const { row0 = (u / nN) * 256; col0 = (u % nN) * 256; boff = (size_t)tile_exp[row0 >> 8] * estride; } };

struct EpiIn { bf16_t* proj; const float* ssq;
    __device__ __forceinline__ void apply(const f32x4 (&acc)[2][16], int rowb, int col0, int lane) const {
#pragma unroll
        for (int mi = 0; mi < 2; ++mi)
#pragma unroll
            for (int r = 0; r < 4; ++r) { const int row = rowb + mi * 16 + (lane >> 4) * 4 + r; const float rs = row_rstd(ssq, row);
#pragma unroll
                for (int n = 0; n < 16; ++n) proj[(size_t)row * DINP + col0 + n * 16 + (lane & 15)] = f2bf(acc[mi][n][r] * rs); } } };
struct EpiRes { const float* xold; float* xnew; bf16_t* xb; float* ssq;
    __device__ __forceinline__ void apply(const f32x4 (&acc)[2][16], int rowb, int col0, int lane) const {
#pragma unroll
        for (int mi = 0; mi < 2; ++mi)
#pragma unroll
            for (int r = 0; r < 4; ++r) { const int row = rowb + mi * 16 + (lane >> 4) * 4 + r; float s = 0.f;
#pragma unroll
                for (int n = 0; n < 16; ++n) { const size_t o = (size_t)row * DM + col0 + n * 16 + (lane & 15); const float v = xold[o] + acc[mi][n][r]; xnew[o] = v; xb[o] = f2bf(v); s += v * v; }
                s += __shfl_xor(s, 1); s += __shfl_xor(s, 2); s += __shfl_xor(s, 4); s += __shfl_xor(s, 8);
                if ((lane & 15) < 4) ssq[(size_t)row * NSLOT + (col0 >> 8) * 4 + (lane & 15)] = (lane & 15) == 0 ? s : 0.f; } } };
struct EpiSwiglu { bf16_t* h; const float* ssq; const int* row_tok;
    __device__ __forceinline__ void apply(const f32x4 (&acc)[2][16], int rowb, int col0, int lane) const {
#pragma unroll
        for (int mi = 0; mi < 2; ++mi)
#pragma unroll
            for (int r = 0; r < 4; ++r) { const int row = rowb + mi * 16 + (lane >> 4) * 4 + r; const int t = row_tok ? row_tok[row] : row;
                const float rs = t < 0 ? 0.f : row_rstd(ssq, t < 0 ? 0 : t);
#pragma unroll
                for (int n = 0; n < 8; ++n) { const float av = acc[mi][n][r] * rs, bv = acc[mi][n + 8][r] * rs; h[(size_t)row * DFF + (col0 >> 1) + n * 16 + (lane & 15)] = f2bf(siluf(av) * bv); } } } };
struct EpiStore { bf16_t* out; int ldc, coloff, ncols;
    __device__ __forceinline__ void apply(const f32x4 (&acc)[2][16], int rowb, int col0, int lane) const {
#pragma unroll
        for (int mi = 0; mi < 2; ++mi)
#pragma unroll
            for (int r = 0; r < 4; ++r) { const int row = rowb + mi * 16 + (lane >> 4) * 4 + r;
#pragma unroll
                for (int n = 0; n < 16; ++n) { const int c = col0 + n * 16 + (lane & 15); if (c < ncols) out[(size_t)row * ldc + coloff + c] = f2bf(acc[mi][n][r]); } } } };
struct EpiStoreT { bf16_t* out;
    __device__ __forceinline__ void apply(const f32x4 (&acc)[2][16], int rowb, int col0, int lane) const {
#pragma unroll
        for (int mi = 0; mi < 2; ++mi)
#pragma unroll
            for (int r = 0; r < 4; ++r) { const int row = rowb + mi * 16 + (lane >> 4) * 4 + r;
#pragma unroll
                for (int n = 0; n < 4; ++n) { const int c = col0 + n * 16 + (lane & 15); out[(size_t)(row >> 8) * 16384 + c * 256 + (row & 255)] = f2bf(acc[mi][n][r]); } } } };
struct EpiSiluBias { bf16_t* out; const float* bias; int ldc;
    __device__ __forceinline__ void apply(const f32x4 (&acc)[2][16], int rowb, int col0, int lane) const {
#pragma unroll
        for (int mi = 0; mi < 2; ++mi)
#pragma unroll
            for (int r = 0; r < 4; ++r) { const int row = rowb + mi * 16 + (lane >> 4) * 4 + r;
#pragma unroll
                for (int n = 0; n < 16; ++n) { const int c = col0 + n * 16 + (lane & 15); out[(size_t)row * ldc + c] = f2bf(siluf(acc[mi][n][r] + bias[c])); } } } };

template <class AS, class Epi, class Sched>
__device__ __forceinline__ void ph_gemm(LAS char* lds, const AS as, const bf16_t* __restrict__ Bt, const int K, const Epi epi, const Sched sched, int vcu, int G) {
    int tid_ = threadIdx.x; asm volatile("" : "+v"(tid_)); asm volatile("" : "+s"(vcu));
    LAS bf16_t* sA = (LAS bf16_t*)lds; LAS bf16_t* sB = (LAS bf16_t*)(lds + 256 * 40 * 2);
    const int tid = tid_, wave = tid >> 6, lane = tid & 63;
    const int nunits = sched.count();
    for (int u = vcu; u < nunits; u += G) {
        int row0, col0; size_t boff; sched.get(u, row0, col0, boff);
        const bf16_t* Bu = Bt + boff;
        f32x4 acc[2][16];
#pragma unroll
        for (int mi = 0; mi < 2; ++mi)
#pragma unroll
            for (int n = 0; n < 16; ++n) acc[mi][n] = (f32x4){0.f, 0.f, 0.f, 0.f};
#pragma unroll 1
        for (int k0 = 0; k0 < K; k0 += 32) {
#pragma unroll
            for (int i = 0; i < 2; ++i) { const int c = tid + i * NT, r = c >> 2, kc = (c & 3) * 8; const bf16_t* p = as.ptr(row0 + r, k0 + kc);
                uint4 v = make_uint4(0u, 0u, 0u, 0u); if (p) v = *(const uint4*)p; *(LAS u32x4_t*)&sA[r * 40 + kc] = (u32x4_t){v.x, v.y, v.z, v.w}; }
#pragma unroll
            for (int i = 0; i < 2; ++i) { const int c = tid + i * NT, r = c >> 2, kc = (c & 3) * 8;
                *(LAS u32x4_t*)&sB[r * 40 + kc] = *(const u32x4_t*)(Bu + (size_t)(col0 + r) * K + k0 + kc); }
            __syncthreads();
            bf16x8 af[2];
#pragma unroll
            for (int mi = 0; mi < 2; ++mi) af[mi] = *(const LAS bf16x8*)&sA[(wave * 32 + mi * 16 + (lane & 15)) * 40 + (lane >> 4) * 8];
#pragma unroll
            for (int n = 0; n < 16; ++n) { const bf16x8 bfr = *(const LAS bf16x8*)&sB[(n * 16 + (lane & 15)) * 40 + (lane >> 4) * 8];
#pragma unroll
                for (int mi = 0; mi < 2; ++mi) acc[mi][n] = __builtin_amdgcn_mfma_f32_16x16x32_bf16(af[mi], bfr, acc[mi][n], 0, 0, 0); }
            __syncthreads();
        }
        epi.apply(acc, row0 + wave * 32, col0, lane);
    }
}


namespace pg8 {
#define PG8_LAS __attribute__((address_space(3)))
typedef unsigned u32x4 __attribute__((ext_vector_type(4)));
typedef unsigned u32x2 __attribute__((ext_vector_type(2)));
constexpr int BM = 256, BK = 64, HALF = 128, HTB = HALF * BK * 2  , STAGE_BYTES = 8 * HTB, NXCD = 8, WGM = 8;
__host__ __device__ __forceinline__ int lds_byte(int r, int c) { const int st = (r >> 4) * 2 + (c >> 5), rr = r & 15, cc = c & 31, ob = rr * 64 + cc * 2; return st * 1024 + (ob ^ (((ob >> 9) & 1) << 5)); }
__host__ __device__ __forceinline__ void stage_rc(int b, int& R, int& C) { const int st = b / 1024, sb = b % 1024, swz = sb ^ (((sb >> 9) & 1) << 5); R = (st >> 1) * 16 + swz / 64; C = (st & 1) * 32 + (swz % 64) / 2; }
__host__ __device__ __forceinline__ int perm32(int rho) { const int n = rho >> 4, i = rho & 15; return 8 * (i >> 2) + 4 * n + (i & 3); }
struct Unit { int pm, pn; };
struct Gemm { const bf16_t* A; const bf16_t* Bt; int M, N, K; };
struct StaticOrder {
    int nM, nN, nwg, G, c;
    __device__ __forceinline__ void init(int M, int N, int G_, int c_) { nM = M / BM; nN = N / BM; nwg = nM * nN; G = G_; c = c_; }
    __device__ __forceinline__ bool next(int i, Unit& u) const {
        const long L = (long)i * G + c; if (L >= nwg) return false;
        int wgid = (int)L; { const int q = nwg / NXCD, r = nwg % NXCD, xcd = wgid % NXCD, off = wgid / NXCD; wgid = (xcd < r ? xcd * (q + 1) : r * (q + 1) + (xcd - r) * q) + off; }
        const int nig = WGM * nN, gid = wgid / nig, fm = gid * WGM, gsz = (nM - fm) < WGM ? (nM - fm) : WGM;
        u.pm = fm + ((wgid % nig) % gsz); u.pn = (wgid % nig) / gsz; return true;
    }
};
__device__ __forceinline__ unsigned cvt_pk_bf16(float lo, float hi) { unsigned r; asm volatile("v_cvt_pk_bf16_f32 %0, %1, %2" : "=v"(r) : "v"(lo), "v"(hi)); return r; }

template <class Epi, class Sched, bool GATHER>
__device__ __forceinline__ void gemm_phase(PG8_LAS unsigned char* lds, const Gemm g, const Sched& S, const Epi& E, const int* __restrict__ rowmap, const int* __restrict__ tile_exp, const size_t estride) {
    int tid = threadIdx.x; asm volatile("" : "+v"(tid));
    const int wid = __builtin_amdgcn_readfirstlane(tid >> 6), lane = tid & 63, wr = wid >> 2, wc = wid & 3, fr = lane & 15, fq = lane >> 4;
    const int K = g.K, nt = K / BK;
    unsigned voffA[2], voffB[2]; int rA[2];
#pragma unroll
    for (int i = 0; i < 2; ++i) { int R, C; stage_rc(tid * 16 + i * 8192, R, C); const int Rb = (R & ~31) + perm32(R & 31);
        voffA[i] = (unsigned)(R * K + C) * 2u; voffB[i] = (unsigned)(Rb * K + C) * 2u; rA[i] = R; if (GATHER) voffA[i] = (unsigned)C * 2u; }
    const size_t kstep = (size_t)(BK * 2);
    const size_t hstep = (size_t)HALF * K * 2;
    const size_t tstep = 2 * hstep;
    const unsigned ldsw = (unsigned)wid * 1024u;
    const int aoff = lds_byte(wr * 64 + fr, fq * 8), boff = lds_byte(wc * 32 + fr, fq * 8);
#define PG8_SA(b, h) (((b) * 2 + (h)) * HTB)
#define PG8_SB(b, h) ((4 + (b) * 2 + (h)) * HTB)
#define PG8_STAGE(bufoff, gbase, voff) do { _Pragma("unroll") for (int _i = 0; _i < 2; ++_i) \
        __builtin_amdgcn_global_load_lds((const unsigned*)((const char*)(gbase) + (voff)[_i]), (PG8_LAS unsigned*)(lds + (bufoff) + ldsw + _i * 8192), 16, 0, 0); } while (0)
#define PG8_LDA(dst, b, h) do { _Pragma("unroll") for (int m = 0; m < 4; ++m) _Pragma("unroll") for (int k = 0; k < 2; ++k) dst[m][k] = *(const PG8_LAS bf16x8*)(lds + PG8_SA(b, h) + aoff + m * 2048 + k * 1024); } while (0)
#define PG8_LDB(dst, b, h) do { _Pragma("unroll") for (int n = 0; n < 2; ++n) _Pragma("unroll") for (int k = 0; k < 2; ++k) dst[n][k] = *(const PG8_LAS bf16x8*)(lds + PG8_SB(b, h) + boff + n * 2048 + k * 1024); } while (0)
#define PG8_MMA(ai, bj, At, Bt) do { __builtin_amdgcn_s_setprio(1); _Pragma("unroll") for (int m = 0; m < 4; ++m) _Pragma("unroll") for (int n = 0; n < 2; ++n) _Pragma("unroll") for (int k = 0; k < 2; ++k) \
        acc[ai][bj][m][n] = __builtin_amdgcn_mfma_f32_16x16x32_bf16(Bt[n][k], At[m][k], acc[ai][bj][m][n], 0, 0, 0); __builtin_amdgcn_s_setprio(0); } while (0)
#define PG8_WAIT_V(n) asm volatile("s_waitcnt vmcnt(" #n ")" ::: "memory")
#define PG8_WAIT_L(n) asm volatile("s_waitcnt lgkmcnt(" #n ")" ::: "memory")
#define PG8_BAR __builtin_amdgcn_s_barrier()
#define PG8_SCHED __builtin_amdgcn_sched_barrier(0)
    unsigned vgc[2][2], vgn[2][2];
#define PG8_GOFF(dst, pm_) do { if constexpr (GATHER) { _Pragma("unroll") for (int _h = 0; _h < 2; ++_h) _Pragma("unroll") for (int _i = 0; _i < 2; ++_i) { int _t = rowmap[(pm_) * BM + _h * HALF + rA[_i]]; _t = _t < 0 ? 0 : _t; \
        dst[_h][_i] = (unsigned)_t * (unsigned)(K * 2) + voffA[_i]; } } } while (0)
#define PG8_STA(bufoff, gptr, h, arr) do { if constexpr (GATHER) { PG8_STAGE(bufoff, gptr, arr[h]); } else { PG8_STAGE(bufoff, (gptr) + ((h) ? hstep : 0), voffA); } } while (0)
    Unit cur, nxt; int ui = 0;
    if (!S.next(0, cur)) return;
    f32x4 acc[2][2][4][2];
#pragma unroll
    for (int a = 0; a < 2; ++a)
#pragma unroll
        for (int b = 0; b < 2; ++b)
#pragma unroll
            for (int m = 0; m < 4; ++m)
#pragma unroll
                for (int n = 0; n < 2; ++n) acc[a][b][m][n] = (f32x4){0.f, 0.f, 0.f, 0.f};
    bf16x8 At[4][2], B0[2][2], B1[2][2];
    const char* cA = (const char*)g.A + (GATHER ? (size_t)0 : (size_t)cur.pm * tstep);
    const char* cB = (const char*)g.Bt + (tile_exp ? (size_t)tile_exp[cur.pm] * estride * 2 : (size_t)0) + (size_t)cur.pn * tstep;
    PG8_GOFF(vgc, cur.pm);
    PG8_STAGE(PG8_SB(0, 0), cB, voffB); PG8_STAGE(PG8_SB(0, 1), cB + hstep, voffB); PG8_STA(PG8_SA(0, 0), cA, 0, vgc); PG8_STA(PG8_SA(0, 1), cA, 1, vgc);
    if (wr == 1) PG8_BAR;
    PG8_WAIT_V(2); PG8_BAR;
    PG8_STAGE(PG8_SB(1, 0), cB + kstep, voffB); PG8_STA(PG8_SA(1, 0), cA + kstep, 0, vgc); PG8_STAGE(PG8_SB(1, 1), cB + hstep + kstep, voffB);
    PG8_WAIT_V(6); PG8_BAR;
    for (;;) {
        const bool has_next = S.next(ui + 1, nxt);
        const char* nA = has_next ? (const char*)g.A + (GATHER ? (size_t)0 : (size_t)nxt.pm * tstep) : cA;
        const char* nB = has_next ? (const char*)g.Bt + (tile_exp ? (size_t)tile_exp[nxt.pm] * estride * 2 : (size_t)0) + (size_t)nxt.pn * tstep : cB;
        if constexpr (GATHER) { if (has_next) { PG8_GOFF(vgn, nxt.pm); } else {
#pragma unroll
            for (int _h = 0; _h < 2; ++_h)
#pragma unroll
                for (int _i = 0; _i < 2; ++_i) vgn[_h][_i] = vgc[_h][_i]; } }
        for (int t = 0; t < nt; t += 2) {
            const bool last = (t == nt - 2);
            const char* a1 = cA + (size_t)(t + 1) * kstep;
            const char* a2 = last ? nA : cA + (size_t)(t + 2) * kstep; const char* b2 = last ? nB : cB + (size_t)(t + 2) * kstep;
            const char* a3 = a2 + kstep; const char* b3 = b2 + kstep;
            unsigned v2[2][2];
            if constexpr (GATHER) {
#pragma unroll
            for (int _h = 0; _h < 2; ++_h)
#pragma unroll
                for (int _i = 0; _i < 2; ++_i) v2[_h][_i] = last ? vgn[_h][_i] : vgc[_h][_i]; }
            PG8_LDB(B0, 0, 0); PG8_LDB(B1, 0, 1); PG8_SCHED; PG8_LDA(At, 0, 0); PG8_STA(PG8_SA(1, 1), a1, 1, vgc);
            PG8_WAIT_V(8); PG8_WAIT_L(0); PG8_BAR; PG8_MMA(0, 0, At, B0); PG8_MMA(0, 1, At, B1); PG8_BAR; PG8_SCHED;
            PG8_LDA(At, 0, 1); PG8_STAGE(PG8_SB(0, 0), b2, voffB); PG8_STAGE(PG8_SB(0, 1), b2 + hstep, voffB); PG8_STA(PG8_SA(0, 0), a2, 0, v2);
            PG8_WAIT_V(8); PG8_WAIT_L(0); PG8_BAR; PG8_MMA(1, 0, At, B0); PG8_MMA(1, 1, At, B1); PG8_BAR; PG8_SCHED;
            PG8_LDB(B0, 1, 0); PG8_LDB(B1, 1, 1); PG8_SCHED; PG8_LDA(At, 1, 0); PG8_STA(PG8_SA(0, 1), a2, 1, v2);
            PG8_WAIT_V(8); PG8_WAIT_L(0); PG8_BAR; PG8_MMA(0, 0, At, B0); PG8_MMA(0, 1, At, B1); PG8_BAR; PG8_SCHED;
            PG8_LDA(At, 1, 1); PG8_STAGE(PG8_SB(1, 0), b3, voffB); PG8_STAGE(PG8_SB(1, 1), b3 + hstep, voffB); PG8_STA(PG8_SA(1, 0), a3, 0, v2);
            PG8_WAIT_V(8); PG8_WAIT_L(0); PG8_BAR; PG8_MMA(1, 0, At, B0); PG8_MMA(1, 1, At, B1); PG8_BAR; PG8_SCHED;
        }
        if (wr == 0) PG8_BAR;
        E(acc, cur, wr, wc, fr, fq);
        if (!has_next) break;
#pragma unroll
        for (int a = 0; a < 2; ++a)
#pragma unroll
            for (int b = 0; b < 2; ++b)
#pragma unroll
                for (int m = 0; m < 4; ++m)
#pragma unroll
                    for (int n = 0; n < 2; ++n) acc[a][b][m][n] = (f32x4){0.f, 0.f, 0.f, 0.f};
        cur = nxt; cA = nA; cB = nB; ++ui;
        if constexpr (GATHER) {
#pragma unroll
        for (int _h = 0; _h < 2; ++_h)
#pragma unroll
            for (int _i = 0; _i < 2; ++_i) vgc[_h][_i] = vgn[_h][_i]; }
        if (wr == 1) PG8_BAR;
    }
    PG8_WAIT_V(0);
    PG8_BAR;
#undef PG8_SA
#undef PG8_SB
#undef PG8_STAGE
#undef PG8_LDA
#undef PG8_LDB
#undef PG8_MMA
#undef PG8_WAIT_V
#undef PG8_WAIT_L
#undef PG8_BAR
#undef PG8_SCHED
#undef PG8_GOFF
#undef PG8_STA
}

typedef const f32x4 (&AccT)[2][2][4][2];
struct EIn { bf16_t* proj; const float* ssq;
    __device__ __forceinline__ void operator()(AccT acc, const Unit& u, int wr, int wc, int fr, int fq) const {
        const int col0 = u.pn * BM + wc * 32 + 8 * fq;
#pragma unroll
        for (int ai = 0; ai < 2; ++ai)
#pragma unroll
            for (int m = 0; m < 4; ++m) { const int row = u.pm * BM + ai * HALF + wr * 64 + m * 16 + fr; const float rs = row_rstd(ssq, row); bf16_t* rowp = proj + (size_t)row * DINP + col0;
#pragma unroll
                for (int bj = 0; bj < 2; ++bj) { const f32x4 v0 = acc[ai][bj][m][0] * rs, v1 = acc[ai][bj][m][1] * rs; u32x4 w; w.x = cvt_pk_bf16(v0[0], v0[1]); w.y = cvt_pk_bf16(v0[2], v0[3]); w.z = cvt_pk_bf16(v1[0], v1[1]); w.w = cvt_pk_bf16(v1[2], v1[3]);
                    *(u32x4*)(rowp + bj * HALF) = w; } } } };
struct ERes { const float* xold; float* xnew; bf16_t* xb; float* ssq;
    __device__ __forceinline__ void operator()(AccT acc, const Unit& u, int wr, int wc, int fr, int fq) const {
        const int col0 = u.pn * BM + wc * 32 + 8 * fq;
#pragma unroll
        for (int ai = 0; ai < 2; ++ai)
#pragma unroll
            for (int m = 0; m < 4; ++m) { const int row = u.pm * BM + ai * HALF + wr * 64 + m * 16 + fr; const size_t o = (size_t)row * DM + col0; float s = 0.f;
#pragma unroll
                for (int bj = 0; bj < 2; ++bj) { const f32x4 x0 = *(const f32x4*)(xold + o + bj * HALF), x1 = *(const f32x4*)(xold + o + bj * HALF + 4);
                    const f32x4 v0 = x0 + acc[ai][bj][m][0], v1 = x1 + acc[ai][bj][m][1];
                    *(f32x4*)(xnew + o + bj * HALF) = v0; *(f32x4*)(xnew + o + bj * HALF + 4) = v1;
                    u32x4 w; w.x = cvt_pk_bf16(v0[0], v0[1]); w.y = cvt_pk_bf16(v0[2], v0[3]); w.z = cvt_pk_bf16(v1[0], v1[1]); w.w = cvt_pk_bf16(v1[2], v1[3]);
                    *(u32x4*)(xb + o + bj * HALF) = w;
                    s += (v0[0] * v0[0] + v0[1] * v0[1]) + (v0[2] * v0[2] + v0[3] * v0[3]) + (v1[0] * v1[0] + v1[1] * v1[1]) + (v1[2] * v1[2] + v1[3] * v1[3]); }
                s += __shfl_xor(s, 16); s += __shfl_xor(s, 32);
                if (fq == 0) ssq[(size_t)row * NSLOT + u.pn * 4 + wc] = s; } } };
struct ESwiglu { bf16_t* h; const float* ssq; const int* row_tok;
    __device__ __forceinline__ void operator()(AccT acc, const Unit& u, int wr, int wc, int fr, int fq) const {
        const int col0 = u.pn * HALF + wc * 32 + 8 * fq;
#pragma unroll
        for (int ai = 0; ai < 2; ++ai)
#pragma unroll
            for (int m = 0; m < 4; ++m) { const int row = u.pm * BM + ai * HALF + wr * 64 + m * 16 + fr; const int t = row_tok ? row_tok[row] : row; const float rs = t < 0 ? 0.f : row_rstd(ssq, t < 0 ? 0 : t);
                float o[8];
#pragma unroll
                for (int n = 0; n < 2; ++n)
#pragma unroll
                    for (int e = 0; e < 4; ++e) { const float av = acc[ai][0][m][n][e] * rs, bv = acc[ai][1][m][n][e] * rs; o[n * 4 + e] = siluf(av) * bv; }
                u32x4 w; w.x = cvt_pk_bf16(o[0], o[1]); w.y = cvt_pk_bf16(o[2], o[3]); w.z = cvt_pk_bf16(o[4], o[5]); w.w = cvt_pk_bf16(o[6], o[7]);
                *(u32x4*)(h + (size_t)row * DFF + col0) = w; } } };
struct EStore { bf16_t* out; int ldc;
    __device__ __forceinline__ void operator()(AccT acc, const Unit& u, int wr, int wc, int fr, int fq) const {
        const int col0 = u.pn * BM + wc * 32 + 8 * fq;
#pragma unroll
        for (int ai = 0; ai < 2; ++ai)
#pragma unroll
            for (int m = 0; m < 4; ++m) { const int row = u.pm * BM + ai * HALF + wr * 64 + m * 16 + fr; bf16_t* rowp = out + (size_t)row * ldc + col0;
#pragma unroll
                for (int bj = 0; bj < 2; ++bj) { const f32x4 v0 = acc[ai][bj][m][0], v1 = acc[ai][bj][m][1]; u32x4 w; w.x = cvt_pk_bf16(v0[0], v0[1]); w.y = cvt_pk_bf16(v0[2], v0[3]); w.z = cvt_pk_bf16(v1[0], v1[1]); w.w = cvt_pk_bf16(v1[2], v1[3]);
                    *(u32x4*)(rowp + bj * HALF) = w; } } } };
}

namespace nsa {
typedef float f32x16 __attribute__((ext_vector_type(16)));
typedef unsigned u32x4 __attribute__((ext_vector_type(4)));
typedef unsigned u32x2 __attribute__((ext_vector_type(2)));
constexpr int KSTR = 144, VSTR = 136;
constexpr int KT_B = 64 * KSTR, VT_B = 64 * VSTR, BUF_B = KT_B + VT_B;
constexpr int IMP_OFF = 2 * BUF_B  , SELM_OFF = IMP_OFF + 8 * 2048  , WUN_OFF = SELM_OFF + 512;
constexpr float L2E = 1.4426950408889634f;
#define NLAS __attribute__((address_space(3)))
__device__ __forceinline__ unsigned pk2(float lo, float hi) { unsigned r; asm volatile("v_cvt_pk_bf16_f32 %0, %1, %2" : "=v"(r) : "v"(lo), "v"(hi)); return r; }
struct Stage { u32x4 k, v; };
__device__ __forceinline__ void stage_issue(Stage& st, const bf16_t* kg, size_t kstride, const bf16_t* vg, size_t vstride, int tid) {
    const int r = tid >> 3, c = (tid & 7) * 8;
    st.k = *(const u32x4*)(kg + (size_t)r * kstride + c); st.v = *(const u32x4*)(vg + (size_t)r * vstride + c);
}
__device__ __forceinline__ void stage_write(const Stage& st, NLAS char* buf, int tid) {
    const int r = tid >> 3, c = (tid & 7) * 16;
    *(NLAS u32x4*)(buf + r * KSTR + c) = st.k;
    *(NLAS u32x2*)(buf + KT_B + r * VSTR + c) = (u32x2){st.v.x, st.v.y}; *(NLAS u32x2*)(buf + KT_B + r * VSTR + c + 8) = (u32x2){st.v.z, st.v.w};
}
__device__ __forceinline__ void compute_S(NLAS const char* buf, const bf16x8 (&Qf)[4], f32x16& S0, f32x16& S1, int lane) {
    const int kr = lane & 31, hi = lane >> 5;
#pragma unroll
    for (int i = 0; i < 16; ++i) { S0[i] = 0.f; S1[i] = 0.f; }
#pragma unroll
    for (int s = 0; s < 4; ++s) { const bf16x8 a0 = *(NLAS const bf16x8*)(buf + kr * KSTR + s * 32 + hi * 16), a1 = *(NLAS const bf16x8*)(buf + (32 + kr) * KSTR + s * 32 + hi * 16);
        S0 = __builtin_amdgcn_mfma_f32_32x32x16_bf16(a0, Qf[s], S0, 0, 0, 0); S1 = __builtin_amdgcn_mfma_f32_32x32x16_bf16(a1, Qf[s], S1, 0, 0, 0); }
}
__device__ __forceinline__ void mask_S(f32x16& S0, f32x16& S1, int lo, int hi, int lane) {
    const int h4 = (lane >> 5) * 4, lo2 = lo - h4, hi2 = hi - h4;
#pragma unroll
    for (int i = 0; i < 16; ++i) { const int c0 = (i & 3) + 8 * (i >> 2); S0[i] = (c0 >= lo2 && c0 <= hi2) ? S0[i] : -INFINITY; S1[i] = (c0 + 32 >= lo2 && c0 + 32 <= hi2) ? S1[i] : -INFINITY; }
}
__device__ __forceinline__ float max_S(const f32x16& S0, const f32x16& S1) { float m = fmaxf(S0[0], S1[0]);
#pragma unroll
    for (int i = 1; i < 16; ++i) m = fmaxf(m, fmaxf(S0[i], S1[i]));
    return fmaxf(m, __shfl_xor(m, 32)); }
__device__ __forceinline__ float exp_S(f32x16& S0, f32x16& S1, float mL, float sc) { float l = 0.f;
#pragma unroll
    for (int i = 0; i < 16; ++i) { S0[i] = __builtin_amdgcn_exp2f(fmaf(S0[i], L2E, -mL)) * sc; S1[i] = __builtin_amdgcn_exp2f(fmaf(S1[i], L2E, -mL)) * sc; l += S0[i] + S1[i]; }
    return l; }
__device__ __forceinline__ void pack_P(const f32x16& S0, const f32x16& S1, unsigned andm, bf16x8 (&Pf)[4]) {
#pragma unroll
    for (int s2 = 0; s2 < 4; ++s2) { u32x4 w;
#pragma unroll
        for (int q = 0; q < 4; ++q) { const int i = (s2 & 1) * 8 + q * 2; w[q] = (s2 < 2 ? pk2(S0[i], S0[i + 1]) : pk2(S1[i], S1[i + 1])) & andm; }
        Pf[s2] = __builtin_bit_cast(bf16x8, w); }
}
__device__ __forceinline__ void pv(NLAS const char* buf, const bf16x8 (&Pf)[4], f32x16& O0, f32x16& O1, int lane) {
    const int dr = lane & 31, hi = lane >> 5; NLAS const char* vt = buf + KT_B;
#pragma unroll
    for (int s2 = 0; s2 < 4; ++s2) {
        u32x4 w0, w1;
        { const u32x2 x = *(NLAS const u32x2*)(vt + dr * VSTR + (16 * s2 + 4 * hi) * 2), y = *(NLAS const u32x2*)(vt + dr * VSTR + (16 * s2 + 8 + 4 * hi) * 2); w0 = (u32x4){x.x, x.y, y.x, y.y}; }
        { const u32x2 x = *(NLAS const u32x2*)(vt + (32 + dr) * VSTR + (16 * s2 + 4 * hi) * 2), y = *(NLAS const u32x2*)(vt + (32 + dr) * VSTR + (16 * s2 + 8 + 4 * hi) * 2); w1 = (u32x4){x.x, x.y, y.x, y.y}; }
        O0 = __builtin_amdgcn_mfma_f32_32x32x16_bf16(__builtin_bit_cast(bf16x8, w0), Pf[s2], O0, 0, 0, 0);
        O1 = __builtin_amdgcn_mfma_f32_32x32x16_bf16(__builtin_bit_cast(bf16x8, w1), Pf[s2], O1, 0, 0, 0); }
}
__device__ __forceinline__ void online_block(NLAS const char* buf, const bf16x8 (&Qf)[4], f32x16& O0, f32x16& O1, float& m, float& l, bool lane_on, bool use_mask, int lo, int hi, int lane) {
    f32x16 S0, S1; compute_S(buf, Qf, S0, S1, lane);
    if (use_mask) mask_S(S0, S1, lo, hi, lane);
    float mt = max_S(S0, S1); if (!lane_on) mt = -INFINITY;
    const float mn = fmaxf(m, mt), ms = mn == -INFINITY ? 0.f : mn, al = __builtin_amdgcn_exp2f((m - ms) * L2E);
    const float ls = exp_S(S0, S1, ms * L2E, 1.f);
    l = l * al + (lane_on ? ls : 0.f); m = mn;
#pragma unroll
    for (int i = 0; i < 16; ++i) { O0[i] *= al; O1[i] *= al; }
    bf16x8 Pf[4]; pack_P(S0, S1, lane_on ? 0xffffffffu : 0u, Pf);
    pv(buf, Pf, O0, O1, lane);
}
}

__device__ __forceinline__ void ph_nsa(const Args& a, LAS char* lds_, int vcu, int G) {
    using namespace nsa;
    int tid = threadIdx.x; asm volatile("" : "+v"(tid)); asm volatile("" : "+s"(vcu));
    NLAS char* lds = lds_;
    const int w = tid >> 6, lane = tid & 63, hi = lane >> 5, r = lane & 31, tql = r >> 2, hpg = r & 3;
    NLAS float* impw = (NLAS float*)(lds + IMP_OFF + w * 2048);
    NLAS unsigned long long* selm = (NLAS unsigned long long*)(lds + SELM_OFF);
    NLAS unsigned long long* wun = (NLAS unsigned long long*)(lds + WUN_OFF);
    const bf16_t* proj = a.proj;
    for (int it = 0; it * G + vcu < 1024; ++it) {
        const int idx = it * G + vcu, rnd = idx >> 8, k16 = (idx & 255) >> 4, bg = idx & 15;
        const int qb = (rnd == 0) ? 63 - k16 : (rnd == 1) ? 32 + k16 : (rnd == 2) ? 31 - k16 : k16;
        const int b = bg >> 1, g = bg & 1;
        const int tq = 8 * w + tql, t = 64 * qb + tq; const size_t row = (size_t)b * SEQ + t; const bf16_t* prow = proj + row * DINP;
        bf16x8 Qf[4];
#pragma unroll
        for (int s = 0; s < 4; ++s) Qf[s] = *(const bf16x8*)(prow + C_Q + g * 256 + hpg * 64 + 16 * s + 8 * hi);
        f32x16 Oo0, Oo1;
        const int hh = g * 4 + hpg; const float g0 = sigmf(bf2f(prow[C_GL + hh * 3 + 0])), g1 = sigmf(bf2f(prow[C_GL + hh * 3 + 1])), g2 = sigmf(bf2f(prow[C_GL + hh * 3 + 2]));
        Stage st;
        const bf16_t* kcg = a.kcb + (size_t)bg * 256 * 64; const bf16_t* vcg = a.vcT + (size_t)bg * 64 * 256;
        const int nbc = (4 * qb + 3 + 63) >> 6;
        const int cmax = t >= 31 ? (t - 31) >> 4 : -1;
        float mc = -INFINITY, lc = 0.f;
        __syncthreads();
        stage_issue(st, kcg, 64, vcg, 256, tid); stage_write(st, lds, tid); __syncthreads();
        for (int kb = 0; kb < nbc; ++kb) {
            NLAS char* buf = lds + (kb & 1) * BUF_B;
            if (kb + 1 < nbc) stage_issue(st, kcg + (size_t)(kb + 1) * 64 * 64, 64, vcg + (kb + 1) * 64, 256, tid);
            f32x16 S0, S1; compute_S(buf, Qf, S0, S1, lane); mask_S(S0, S1, 0, cmax - 64 * kb, lane);
            const float mt = max_S(S0, S1), mn = fmaxf(mc, mt), ms = mn == -INFINITY ? 0.f : mn, al = __builtin_amdgcn_exp2f((mc - ms) * L2E);
            lc = lc * al + exp_S(S0, S1, ms * L2E, 1.f); mc = mn;
            if (kb + 1 < nbc) stage_write(st, lds + ((kb + 1) & 1) * BUF_B, tid);
            __syncthreads();
        }
        lc += __shfl_xor(lc, 32);
        const float mLc = (mc == -INFINITY ? 0.f : mc) * L2E, ilc = lc > 0.f ? 1.f / lc : 0.f;
        f32x16 Oc0, Oc1, Z0, Z1;
#pragma unroll
        for (int i = 0; i < 16; ++i) { Oc0[i] = 0.f; Oc1[i] = 0.f; Z0[i] = 0.f; Z1[i] = 0.f; }
        stage_issue(st, kcg, 64, vcg, 256, tid); stage_write(st, lds, tid); __syncthreads();
        for (int kb = 0; kb < nbc; ++kb) {
            NLAS char* buf = lds + (kb & 1) * BUF_B;
            if (kb + 1 < nbc) stage_issue(st, kcg + (size_t)(kb + 1) * 64 * 64, 64, vcg + (kb + 1) * 64, 256, tid);
            f32x16 S0, S1; compute_S(buf, Qf, S0, S1, lane); mask_S(S0, S1, 0, cmax - 64 * kb, lane);
            (void)exp_S(S0, S1, mLc, ilc);
            bf16x8 Pf[4]; pack_P(S0, S1, 0xffffffffu, Pf);
            pv(buf, Pf, Oc0, Oc1, lane);
#pragma unroll
            for (int s2 = 0; s2 < 4; ++s2) {
#pragma unroll
                for (int stl = 0; stl < 2; ++stl) { const int sblk = 32 * stl + r; u32x4 wv;
#pragma unroll
                    for (int q = 0; q < 4; ++q) { unsigned x = 0u;
#pragma unroll
                        for (int e = 0; e < 2; ++e) { const int j = q * 2 + e, c = 64 * kb + 16 * s2 + 8 * (j >> 2) + 4 * hi + (j & 3); if (c >= 4 * sblk - 1 && c <= 4 * sblk + 3) x |= (0x3f80u << (16 * e)); }
                        wv[q] = x; }
                    if (stl == 0) Z0 = __builtin_amdgcn_mfma_f32_32x32x16_bf16(Pf[s2], __builtin_bit_cast(bf16x8, wv), Z0, 0, 0, 0);
                    else          Z1 = __builtin_amdgcn_mfma_f32_32x32x16_bf16(Pf[s2], __builtin_bit_cast(bf16x8, wv), Z1, 0, 0, 0); } }
            if (kb + 1 < nbc) stage_write(st, lds + ((kb + 1) & 1) * BUF_B, tid);
            __syncthreads();
        }
#pragma unroll
        for (int i = 0; i < 16; ++i) { Oo0[i] = g0 * Oc0[i]; Oo1[i] = g0 * Oc1[i]; }
#pragma unroll
        for (int q4 = 0; q4 < 4; ++q4) { impw[(2 * q4 + hi) * 64 + r] = (Z0[4 * q4] + Z0[4 * q4 + 1]) + (Z0[4 * q4 + 2] + Z0[4 * q4 + 3]); impw[(2 * q4 + hi) * 64 + 32 + r] = (Z1[4 * q4] + Z1[4 * q4 + 1]) + (Z1[4 * q4 + 2] + Z1[4 * q4 + 3]); }
        __syncthreads();
        unsigned long long wu = 0ull;
        for (int q = 0; q < 8; ++q) { const float imp = impw[q * 64 + lane];
            const bool valid = lane <= qb, forced = lane == 0 || lane == qb || lane == qb - 1; const float val = valid ? (forced ? 1e9f : imp) : -1e30f; int rank = 0;
#pragma unroll
            for (int s2 = 0; s2 < 64; ++s2) { const float v2 = __builtin_bit_cast(float, __builtin_amdgcn_readlane(__builtin_bit_cast(int, val), s2)); rank += (v2 > val || (v2 == val && s2 < lane)) ? 1 : 0; }
            const unsigned long long mk = __ballot(valid && rank < 16); wu |= mk;
            if (lane == 0) selm[8 * w + q] = mk; }
        if (lane == 0) wun[w] = wu;
        __syncthreads();
        unsigned long long um = 0ull;
#pragma unroll
        for (int q = 0; q < 8; ++q) um |= wun[q];
        um = ((unsigned long long)__builtin_amdgcn_readfirstlane((unsigned)(um >> 32)) << 32) | (unsigned)__builtin_amdgcn_readfirstlane((unsigned)um);
        const unsigned long long mq = selm[tq];
        {
            const bf16_t* kg = proj + (size_t)b * SEQ * DINP + C_KS + g * 64; const bf16_t* vg = a.VsT + (size_t)bg * 64 * SEQ;
            f32x16 O0, O1;
#pragma unroll
            for (int i = 0; i < 16; ++i) { O0[i] = 0.f; O1[i] = 0.f; }
            float m = -INFINITY, l = 0.f;
            unsigned long long rem = um; int j = __builtin_ctzll(rem); rem &= rem - 1; int cb = 0;
            stage_issue(st, kg + (size_t)j * 64 * DINP, DINP, vg + j * 64, SEQ, tid); stage_write(st, lds, tid); __syncthreads();
            for (;;) {
                const int jn = rem ? __builtin_ctzll(rem) : -1; if (rem) rem &= rem - 1;
                if (jn >= 0) stage_issue(st, kg + (size_t)jn * 64 * DINP, DINP, vg + jn * 64, SEQ, tid);
                online_block(lds + cb * BUF_B, Qf, O0, O1, m, l, (mq >> j) & 1ull, j == qb, 0, tq, lane);
                if (jn >= 0) stage_write(st, lds + (cb ^ 1) * BUF_B, tid);
                __syncthreads();
                if (jn < 0) break;
                j = jn; cb ^= 1;
            }
            l += __shfl_xor(l, 32); const float sc = l > 0.f ? g1 / l : 0.f;
#pragma unroll
            for (int i = 0; i < 16; ++i) { Oo0[i] += sc * O0[i]; Oo1[i] += sc * O1[i]; }
        }
        {
            const bf16_t* kg = proj + (size_t)b * SEQ * DINP + C_KW + g * 64; const bf16_t* vg = a.VwT + (size_t)bg * 64 * SEQ;
            f32x16 O0, O1;
#pragma unroll
            for (int i = 0; i < 16; ++i) { O0[i] = 0.f; O1[i] = 0.f; }
            float m = -INFINITY, l = 0.f;
            const int jlo = qb - 8 > 0 ? qb - 8 : 0; int cb = 0;
            stage_issue(st, kg + (size_t)jlo * 64 * DINP, DINP, vg + jlo * 64, SEQ, tid); stage_write(st, lds, tid); __syncthreads();
            for (int j = jlo; j <= qb; ++j) {
                if (j < qb) stage_issue(st, kg + (size_t)(j + 1) * 64 * DINP, DINP, vg + (j + 1) * 64, SEQ, tid);
                const bool first = (j == qb - 8), diag = (j == qb);
                online_block(lds + cb * BUF_B, Qf, O0, O1, m, l, true, first || diag, first ? tq + 1 : 0, diag ? tq : 63, lane);
                if (j < qb) stage_write(st, lds + (cb ^ 1) * BUF_B, tid);
                __syncthreads();
                cb ^= 1;
            }
            l += __shfl_xor(l, 32); const float sc = l > 0.f ? g2 / l : 0.f;
#pragma unroll
            for (int i = 0; i < 16; ++i) { Oo0[i] += sc * O0[i]; Oo1[i] += sc * O1[i]; }
        }
        bf16_t* op = a.ocat + row * DM + hh * 64 + 4 * hi;
#pragma unroll
        for (int q4 = 0; q4 < 4; ++q4) { u32x2 w0, w1; w0.x = pk2(Oo0[4 * q4], Oo0[4 * q4 + 1]); w0.y = pk2(Oo0[4 * q4 + 2], Oo0[4 * q4 + 3]); w1.x = pk2(Oo1[4 * q4], Oo1[4 * q4 + 1]); w1.y = pk2(Oo1[4 * q4 + 2], Oo1[4 * q4 + 3]);
            *(u32x2*)(op + 8 * q4) = w0; *(u32x2*)(op + 32 + 8 * q4) = w1; }
    }
}

__device__ __forceinline__ void ph_vtrans(const Args& a, LAS char* lds_, int vcu, int G) {
    int tid = threadIdx.x; asm volatile("" : "+v"(tid)); asm volatile("" : "+s"(vcu));
    LAS bf16_t* tile = (LAS bf16_t*)lds_;
    for (int u = vcu; u < 2 * 16 * 64; u += G) { const int tb = u & 63, bg = (u >> 6) & 15, which = u >> 10, b = bg >> 1, g = bg & 1;
        const bf16_t* src = a.proj + ((size_t)b * SEQ + tb * 64) * DINP + (which ? C_VW : C_VS) + g * 64; bf16_t* dst = (which ? a.VwT : a.VsT) + (size_t)bg * 64 * SEQ + tb * 64;
        const int r = tid >> 3, c = (tid & 7) * 8;
        const uint4 v = *(const uint4*)(src + (size_t)r * DINP + c); const unsigned wv[4] = {v.x, v.y, v.z, v.w};
        __syncthreads();
#pragma unroll
        for (int e = 0; e < 4; ++e) { tile[(c + 2 * e) * 72 + r] = (bf16_t)(wv[e] & 0xffffu); tile[(c + 2 * e + 1) * 72 + r] = (bf16_t)(wv[e] >> 16); }
        __syncthreads();
        *(u32x4_t*)(dst + (size_t)r * SEQ + c) = *(const LAS u32x4_t*)(tile + r * 72 + c);
    }
}

__device__ __forceinline__ void ph_conv_naive(const Args& a, int l, LAS char* lds, int vcu, int G) {
    int tid_ = threadIdx.x; asm volatile("" : "+v"(tid_)); asm volatile("" : "+s"(vcu));
    const int half = tid_ >> 8, c = tid_ & 255; LAS float* hs = (LAS float*)(lds + half * 63488);
    const float* cw = a.conv_w + (size_t)l * 31 * 256; const float* lg = a.conv_lg + l * 256; const float* lb = a.conv_lb + l * 256;
    float w[31];
#pragma unroll
    for (int k = 0; k < 31; ++k) w[k] = cw[k * 256 + c];
    const float bias = a.conv_b[l * 256 + c];
    for (int unit = vcu; unit < NTOK / 64; unit += G) {
        const int tile = unit * 2 + half, b = tile >> 7, t0 = (tile & 127) * 32;
        __syncthreads();
        for (int i = 0; i < 62; ++i) { const int t = t0 - 30 + i; float v = 0.f;
            if (t >= 0) { const bf16_t* p = a.proj + ((size_t)b * SEQ + t) * DINP + C_CONV; v = bf2f(p[c]) * sigmf(bf2f(p[256 + c])); }
            hs[i * 256 + c] = v; }
        __syncthreads();
        float outv[32];
#pragma unroll
        for (int tt = 0; tt < 32; ++tt) { float s = bias;
#pragma unroll
            for (int k = 0; k < 31; ++k) s += hs[(tt + k) * 256 + c] * w[k];
            outv[tt] = s; }
        __syncthreads();
#pragma unroll
        for (int tt = 0; tt < 32; ++tt) hs[tt * 256 + c] = outv[tt];
        __syncthreads();
        const int wave = c >> 6, lane = c & 63;
        for (int tt = wave; tt < 32; tt += 4) { float v[4], s = 0.f;
#pragma unroll
            for (int i = 0; i < 4; ++i) { v[i] = hs[tt * 256 + lane + 64 * i]; s += v[i]; }
            const float mu = wsum(s) * (1.f / 256.f); float q = 0.f;
#pragma unroll
            for (int i = 0; i < 4; ++i) q += (v[i] - mu) * (v[i] - mu);
            const float rs = rsqrtf(wsum(q) * (1.f / 256.f) + 1e-5f);
#pragma unroll
            for (int i = 0; i < 4; ++i) { const int ch = lane + 64 * i; const float y = (v[i] - mu) * rs * lg[ch] + lb[ch]; a.hconv[((size_t)b * SEQ + t0 + tt) * 256 + ch] = f2bf(siluf(y)); } }
    }
}

__device__ __forceinline__ float ret_lg(int h) { return log1pf(-exp2f(-5.f - (float)h)); }
__device__ __forceinline__ void ph_ret_rot(const Args& a, int vcu, int G) {
    int tid_ = threadIdx.x; asm volatile("" : "+v"(tid_)); asm volatile("" : "+s"(vcu));
    for (size_t idx = (size_t)vcu * NT + tid_; idx < (size_t)NTOK * 128; idx += (size_t)G * NT) {
        const int i = idx & 31, h = (idx >> 5) & 3; const size_t row = idx >> 7; const int pos = row & (SEQ - 1);
        const float co = a.rot[(pos * 32 + i) * 2], si = a.rot[(pos * 32 + i) * 2 + 1];
        const bf16_t* p = a.proj + row * DINP;
        { const float x1 = bf2f(p[C_RQ + h * 64 + i]), x2 = bf2f(p[C_RQ + h * 64 + 32 + i]); a.qr[row * 256 + h * 64 + i] = x1 * co - x2 * si; a.qr[row * 256 + h * 64 + 32 + i] = x1 * si + x2 * co; }
        { const float x1 = bf2f(p[C_RK + h * 64 + i]), x2 = bf2f(p[C_RK + h * 64 + 32 + i]); a.kr[row * 256 + h * 64 + i] = x1 * co - x2 * si; a.kr[row * 256 + h * 64 + 32 + i] = x1 * si + x2 * co; }
    }
}
__device__ __forceinline__ void ph_ret_kv(const Args& a, int vcu, int G) {
    int tid_ = threadIdx.x; asm volatile("" : "+v"(tid_)); asm volatile("" : "+s"(vcu));
    for (int unit = vcu; unit < 512; unit += G) {
        const int u = unit * 2 + (tid_ >> 8), tl = tid_ & 255, c = u & 31, h = (u >> 5) & 3, b = u >> 7; const float lg = ret_lg(h);
        const int dk = tl >> 2, dv0 = (tl & 3) * 16; float s[16];
#pragma unroll
        for (int i = 0; i < 16; ++i) s[i] = 0.f;
        for (int k = 0; k < 128; ++k) { const size_t row = (size_t)b * SEQ + c * 128 + k; const float z = __expf((127.f - (float)k) * lg) * a.kr[row * 256 + h * 64 + dk];
            const bf16_t* vp = a.proj + row * DINP + C_RV + h * 64 + dv0;
#pragma unroll
            for (int i = 0; i < 16; ++i) s[i] += z * bf2f(vp[i]); }
#pragma unroll
        for (int i = 0; i < 16; ++i) a.KV[(size_t)u * 4096 + dk * 64 + dv0 + i] = s[i];
    }
}
__device__ __forceinline__ void ph_ret_scan(const Args& a, int vcu, int G) {
    int tid_ = threadIdx.x; asm volatile("" : "+v"(tid_)); asm volatile("" : "+s"(vcu));
    for (int idx = vcu * NT + tid_; idx < 32 * 4096; idx += G * NT) { const int e = idx & 4095, bh = idx >> 12, h = bh & 3; const float gc = __expf(128.f * ret_lg(h)); float s = 0.f;
        for (int c = 0; c < 32; ++c) { const size_t o = ((size_t)bh * 32 + c) * 4096 + e; a.Sst[o] = s; s = gc * s + a.KV[o]; } }
}
__device__ __forceinline__ void ph_ret_out(const Args& a, int l, LAS char* lds, int vcu, int G) {
    int tid_ = threadIdx.x; asm volatile("" : "+v"(tid_)); asm volatile("" : "+s"(vcu));
    const int sub = tid_ >> 8, tl = tid_ & 255; LAS float* A = (LAS float*)(lds + sub * 32768);
    const float* gn = a.ret_gn + l * 256;
    for (int unit = vcu; unit < 1024; unit += G) {
        const int u = unit * 2 + sub, half = u & 1, c = (u >> 1) & 31, h = (u >> 6) & 3, b = u >> 8; const float lg = ret_lg(h);
        const size_t r0 = (size_t)b * SEQ + c * 128;
        __syncthreads();
        for (int e = tl; e < 64 * 128; e += 256) { const int i = e >> 7, j = e & 127, ig = half * 64 + i; float s = 0.f;
            if (j <= ig) { const float* qp = a.qr + (r0 + ig) * 256 + h * 64; const float* kp = a.kr + (r0 + j) * 256 + h * 64; for (int d = 0; d < 64; ++d) s += qp[d] * kp[d]; s *= __expf((float)(ig - j) * lg); }
            A[i * 128 + j] = s; }
        __syncthreads();
        const int i = tl >> 2, d0 = (tl & 3) * 16, ig = half * 64 + i; float o[16];
#pragma unroll
        for (int x = 0; x < 16; ++x) o[x] = 0.f;
        for (int j = 0; j <= ig; ++j) { const float av = A[i * 128 + j]; const bf16_t* vp = a.proj + (r0 + j) * DINP + C_RV + h * 64 + d0;
#pragma unroll
            for (int x = 0; x < 16; ++x) o[x] += av * bf2f(vp[x]); }
        { const float xi = __expf((float)(ig + 1) * lg); const float* qp = a.qr + (r0 + ig) * 256 + h * 64; const float* Sp = a.Sst + (((size_t)(b * 4 + h) * 32 + c) * 4096);
          float cr[16];
#pragma unroll
          for (int x = 0; x < 16; ++x) cr[x] = 0.f;
          for (int dk = 0; dk < 64; ++dk) { const float q = qp[dk];
#pragma unroll
              for (int x = 0; x < 16; ++x) cr[x] += q * Sp[dk * 64 + d0 + x]; }
#pragma unroll
          for (int x = 0; x < 16; ++x) o[x] += xi * cr[x]; }
        float s = 0.f;
#pragma unroll
        for (int x = 0; x < 16; ++x) s += o[x];
        s += __shfl_xor(s, 1); s += __shfl_xor(s, 2); const float mu = s * (1.f / 64.f);
        float q = 0.f;
#pragma unroll
        for (int x = 0; x < 16; ++x) q += (o[x] - mu) * (o[x] - mu);
        q += __shfl_xor(q, 1); q += __shfl_xor(q, 2); const float rs = rsqrtf(q * (1.f / 64.f) + 1e-5f);
        const bf16_t* gp = a.proj + (r0 + ig) * DINP + C_RG + h * 64 + d0;
#pragma unroll
        for (int x = 0; x < 16; ++x) { const float gt = bf2f(gp[x]); a.ocat[(r0 + ig) * DM + 768 + h * 64 + d0 + x] = f2bf(siluf(gt) * (o[x] - mu) * rs * gn[h * 64 + d0 + x]); }
    }
}

__device__ __forceinline__ void ph_route(const Args& a, int vcu, int G) {
    int tid_ = threadIdx.x; asm volatile("" : "+v"(tid_)); asm volatile("" : "+s"(vcu));
    const int lane = tid_ & 63; const float* g = a.ln_ffn + DM;
    for (int row = vcu * NW + (tid_ >> 6); row < NTOK; row += G * NW) { float lg[8];
#pragma unroll
        for (int e = 0; e < 8; ++e) lg[e] = 0.f;
        for (int k = lane; k < DM; k += 64) { const float xv = a.xres[(size_t)row * DM + k] * g[k];
#pragma unroll
            for (int e = 0; e < 8; ++e) lg[e] += xv * a.router[k * 8 + e]; }
        const float rs = row_rstd(a.ssq, row);
#pragma unroll
        for (int e = 0; e < 8; ++e) lg[e] = wsum(lg[e]) * rs;
        int e1 = 0; float v1 = lg[0];
#pragma unroll
        for (int e = 1; e < 8; ++e) if (lg[e] > v1) { v1 = lg[e]; e1 = e; }
        int e2 = -1; float v2 = -INFINITY;
#pragma unroll
        for (int e = 0; e < 8; ++e) if (e != e1 && lg[e] > v2) { v2 = lg[e]; e2 = e; }
        if (lane == 0) { const float g1 = 1.f / (1.f + __expf(v2 - v1)); a.gate[row * 2] = g1; a.gate[row * 2 + 1] = 1.f - g1;
            const int i1 = atomicAdd(&a.cnt[e1], 1); a.tok_list[e1 * NTOK + i1] = row * 2; const int i2 = atomicAdd(&a.cnt[e2], 1); a.tok_list[e2 * NTOK + i2] = row * 2 + 1; } }
}
__device__ __forceinline__ void ph_route_build(const Args& a, int vcu, int G) {
    int tid_ = threadIdx.x; asm volatile("" : "+v"(tid_)); asm volatile("" : "+s"(vcu));
    for (int idx = vcu * NT + tid_; idx < NEXP * NTOK; idx += G * NT) { const int e = idx >> 15, i = idx & (NTOK - 1);
        int ps = 0; for (int q = 0; q < e; ++q) ps += (a.cnt[q] + 255) & ~255;
        const int ce = a.cnt[e], pe = (ce + 255) & ~255;
        if (i < ce) { const int en = a.tok_list[e * NTOK + i]; a.row_tok[ps + i] = en >> 1; a.slot[en] = ps + i; } else if (i < pe) a.row_tok[ps + i] = -1;
        if (i < pe && (i & 255) == 0) a.tile_exp[(ps + i) >> 8] = e;
        if (idx == 0) { int tot = 0; for (int q = 0; q < 8; ++q) tot += (a.cnt[q] + 255) & ~255; a.meta[0] = tot >> 8; } }
}
__device__ __forceinline__ void ph_final(const Args& a, int vcu, int G) {
    int tid_ = threadIdx.x; asm volatile("" : "+v"(tid_)); asm volatile("" : "+s"(vcu));
    const int lane = tid_ & 63; float* xio = a.xres;
    for (int row = vcu * NW + (tid_ >> 6); row < NTOK; row += G * NW) { const int s1 = a.slot[row * 2], s2 = a.slot[row * 2 + 1]; const float g1 = a.gate[row * 2], g2 = a.gate[row * 2 + 1];
        float v[16]; float ss = 0.f;
#pragma unroll
        for (int i = 0; i < 4; ++i) { const int c = lane * 4 + i * 256; const float4 xv = *(const float4*)(xio + (size_t)row * DM + c);
            const ushort4 p = *(const ushort4*)(a.ysorted + (size_t)s1 * DM + c), q = *(const ushort4*)(a.ysorted + (size_t)s2 * DM + c);
            v[i * 4 + 0] = xv.x + g1 * bf2f(p.x) + g2 * bf2f(q.x); v[i * 4 + 1] = xv.y + g1 * bf2f(p.y) + g2 * bf2f(q.y);
            v[i * 4 + 2] = xv.z + g1 * bf2f(p.z) + g2 * bf2f(q.z); v[i * 4 + 3] = xv.w + g1 * bf2f(p.w) + g2 * bf2f(q.w);
#pragma unroll
            for (int j = 0; j < 4; ++j) ss += v[i * 4 + j] * v[i * 4 + j]; }
        const float rs = rsqrtf(wsum(ss) * (1.f / DM) + 1e-6f);
#pragma unroll
        for (int i = 0; i < 4; ++i) { const int c = lane * 4 + i * 256; const float4 gf = *(const float4*)(a.ln_final + c); float4 o; o.x = v[i * 4] * rs * gf.x; o.y = v[i * 4 + 1] * rs * gf.y; o.z = v[i * 4 + 2] * rs * gf.z; o.w = v[i * 4 + 3] * rs * gf.w;
            *(float4*)(xio + (size_t)row * DM + c) = o; } }
}

__global__ void __launch_bounds__(NT, 2) mega(Args a) {
    extern __shared__ __attribute__((aligned(16))) char lds[];
    volatile LAS unsigned* misc = (volatile LAS unsigned*)((LAS char*)lds + MISC_OFF);
    if (threadIdx.x < 64) misc[threadIdx.x] = 0u;
    __syncthreads();
    XcdBarrier bar = xcd_barrier_post(a.bar, misc);
    const int G = gridDim.x, vcu = blockIdx.x;
    LAS char* const lds3 = (LAS char*)lds;
#define GRID_BAR() xcd_barrier(bar)
#define AS4 __attribute__((address_space(4)))
#if defined(__HIP_DEVICE_COMPILE__)
#define LA const AS4 Args* ap_ = (const AS4 Args*)__builtin_amdgcn_kernarg_segment_ptr(); asm volatile("" : "+s"(ap_)); Args A; __builtin_memcpy(&A, ap_, sizeof(Args))
#else
#define LA const Args A = a
#endif

    { LA; ph_prologue(A, lds3, vcu, G); }
    GRID_BAR();
#pragma unroll
    for (int l = 0; l < 2; ++l) {
        { LA; pg8::Gemm g{A.xb, A.Win + (size_t)l * DINP * DM, NTOK, DINP, DM}; pg8::StaticOrder S; S.init(NTOK, DINP, G, vcu);
          pg8::gemm_phase<pg8::EIn, pg8::StaticOrder, false>((PG8_LAS unsigned char*)lds3, g, S, pg8::EIn{A.proj, A.ssq}, nullptr, nullptr, 0); }
        GRID_BAR();
#pragma unroll 1
        for (int kv = 0; kv < 2; ++kv) { const int i = l * 2 + kv;
            { LA; ph_gemm(lds3, ACmp{A.proj, kv ? C_VC : C_KC}, A.W1b + (size_t)i * 256 * 2048, 2048, EpiSiluBias{A.hc + (size_t)kv * 4096 * 256, A.bias1 + i * 256, 256}, SchedPlain{4096 / 256, 1}, (vcu + G - kv * 16) % G, G); } }
        { LA; ph_vtrans(A, lds3, vcu, G); }
        { LA; ph_conv_naive(A, l, lds3, vcu, G); }
        { LA; ph_ret_rot(A, vcu, G); }
        GRID_BAR();
        { LA; ph_gemm(lds3, APlain{A.hc, 256}, A.W2b + (size_t)(l * 2) * 256 * 256, 256, EpiStore{A.kcb, 64, 0, 64}, SchedPlain{4096 / 256, 1}, vcu, G); }
        { LA; ph_gemm(lds3, APlain{A.hc + (size_t)4096 * 256, 256}, A.W2b + (size_t)(l * 2 + 1) * 256 * 256, 256, EpiStoreT{A.vcT}, SchedPlain{4096 / 256, 1}, (vcu + G - 16) % G, G); }
        { LA; ph_gemm(lds3, APlain{A.hconv, 256}, A.Wpw + (size_t)l * 65536, 256, EpiStore{A.ocat, DM, 512, 256}, SchedPlain{NTOK / 256, 1}, (vcu + G - 32) % G, G); }
        { LA; ph_ret_kv(A, vcu, G); }
        GRID_BAR();
        { LA; ph_ret_scan(A, vcu, G); }
        GRID_BAR();
        { LA; ph_ret_out(A, l, lds3, vcu, G); }
        { LA; ph_nsa(A, lds3, vcu, G); }
        GRID_BAR();
        { LA; pg8::Gemm g{A.ocat, A.Wout + (size_t)l * DM * DM, NTOK, DM, DM}; pg8::StaticOrder S; S.init(NTOK, DM, G, vcu);
          pg8::gemm_phase<pg8::ERes, pg8::StaticOrder, false>((PG8_LAS unsigned char*)lds3, g, S, pg8::ERes{l == 0 ? A.x : A.xres, A.xres, A.xb, A.ssq}, nullptr, nullptr, 0); }
        GRID_BAR();
        if (l == 0) {
            { LA; pg8::Gemm g{A.xb, A.W13, NTOK, 2 * DFF, DM}; pg8::StaticOrder S; S.init(NTOK, 2 * DFF, G, vcu);
              pg8::gemm_phase<pg8::ESwiglu, pg8::StaticOrder, false>((PG8_LAS unsigned char*)lds3, g, S, pg8::ESwiglu{A.hbuf, A.ssq, nullptr}, nullptr, nullptr, 0); }
            GRID_BAR();
            { LA; pg8::Gemm g{A.hbuf, A.W2, NTOK, DM, DFF}; pg8::StaticOrder S; S.init(NTOK, DM, G, vcu);
              pg8::gemm_phase<pg8::ERes, pg8::StaticOrder, false>((PG8_LAS unsigned char*)lds3, g, S, pg8::ERes{A.xres, A.xres, A.xb, A.ssq}, nullptr, nullptr, 0); }
            GRID_BAR();
        }
    }
    { LA; ph_route(A, vcu, G); }
    GRID_BAR();
    { LA; ph_route_build(A, vcu, G); }
    GRID_BAR();
    { LA; const int Mm = A.meta[0] * 256; pg8::Gemm g{A.xb, A.Wm13, Mm, 2 * DFF, DM}; pg8::StaticOrder S; S.init(Mm, 2 * DFF, G, vcu);
      pg8::gemm_phase<pg8::ESwiglu, pg8::StaticOrder, true>((PG8_LAS unsigned char*)lds3, g, S, pg8::ESwiglu{A.hbuf, A.ssq, A.row_tok}, A.row_tok, A.tile_exp, (size_t)2 * DFF * DM); }
    GRID_BAR();
    { LA; const int Mm = A.meta[0] * 256; pg8::Gemm g{A.hbuf, A.Wm2, Mm, DM, DFF}; pg8::StaticOrder S; S.init(Mm, DM, G, vcu);
      pg8::gemm_phase<pg8::EStore, pg8::StaticOrder, false>((PG8_LAS unsigned char*)lds3, g, S, pg8::EStore{A.ysorted, DM}, nullptr, A.tile_exp, (size_t)DM * DFF); }
    GRID_BAR();
    { LA; ph_final(A, vcu, G); }
}

static inline size_t al256(size_t x) { return (x + 255) & ~(size_t)255; }
extern "C" void kernel_launch(void* const* d_in, const int* in_sizes, int n_in, void* d_out, int out_size, void* d_ws, size_t ws_size, hipStream_t stream) {
    static int grid = 0;
    Args a{};
    const float** ins = (const float**)&a.x;
    for (int i = 0; i < 20; ++i) ins[i] = (const float*)d_in[i];
    a.xres = (float*)d_out;
    char* w = (char*)d_ws; size_t off = 0;
    auto take = [&](size_t bytes) { char* p = w + off; off = al256(off + bytes); return p; };
    a.bar = (unsigned*)take(XCD_BAR_WORDS * 4);
    a.cnt = (int*)take(256);
    a.meta = (int*)take(256);
    const size_t ctl_bytes = off;
    char* regY = w + off;
    a.Wm13 = (bf16_t*)take((size_t)NEXP * 2 * DFF * DM * 2);
    a.Win = (bf16_t*)take((size_t)2 * DINP * DM * 2);
    a.Wout = (bf16_t*)take((size_t)2 * DM * DM * 2);
    a.W13 = (bf16_t*)take((size_t)2 * DFF * DM * 2);
    a.W2 = (bf16_t*)take((size_t)DM * DFF * 2);
    a.xb = (bf16_t*)take((size_t)NTOK * DM * 2);
    a.ysorted = (bf16_t*)regY;
    a.Wm2 = (bf16_t*)take((size_t)NEXP * DM * DFF * 2);
    a.W1b = (bf16_t*)take((size_t)4 * 256 * 2048 * 2);
    a.W2b = (bf16_t*)take((size_t)4 * 256 * 256 * 2);
    a.Wpw = (bf16_t*)take((size_t)2 * 256 * 256 * 2);
    a.bias1 = (float*)take(4 * 256 * 4);
    a.rot = (float*)take((size_t)4096 * 32 * 2 * 4);
    a.ssq = (float*)take((size_t)NTOK * NSLOT * 4);
    a.tok_list = (int*)take((size_t)NEXP * NTOK * 4);
    a.row_tok = (int*)take((size_t)PMAX * 4);
    a.slot = (int*)take((size_t)NTOK * 2 * 4);
    a.tile_exp = (int*)take(1024 * 4);
    a.gate = (float*)take((size_t)NTOK * 2 * 4);
    char* regR = w + off;
    a.proj = (bf16_t*)take((size_t)NTOK * DINP * 2);
    a.ocat = (bf16_t*)take((size_t)NTOK * DM * 2);
    a.hc = (bf16_t*)take((size_t)2 * 4096 * 256 * 2);
    a.kcb = (bf16_t*)take((size_t)4096 * 64 * 2);
    a.vcb = (bf16_t*)take((size_t)4096 * 64 * 2);
    a.hconv = (bf16_t*)take((size_t)NTOK * 256 * 2);
    a.qr = (float*)take((size_t)NTOK * 256 * 4);
    a.kr = (float*)take((size_t)NTOK * 256 * 4);
    a.KV = (float*)take((size_t)1024 * 4096 * 4);
    a.Sst = (float*)take((size_t)1024 * 4096 * 4);
    a.vcT = (bf16_t*)take((size_t)16 * 64 * 256 * 2);
    a.VsT = (bf16_t*)take((size_t)16 * 64 * SEQ * 2);
    a.VwT = (bf16_t*)take((size_t)16 * 64 * SEQ * 2);
    a.hbuf = (bf16_t*)regR;
    const size_t need = (size_t)(regR - w) + (size_t)PMAX * DFF * 2;
    if (grid == 0) {
        if (need > ws_size || off > ws_size || n_in != 20) { fprintf(stderr, "kernel_launch: workspace too small: need %zu / %zu have %zu\n", need, off, ws_size); grid = -1; return; }
        int dev = 0, cus = 0;
        if (hipGetDevice(&dev) != hipSuccess || hipDeviceGetAttribute(&cus, hipDeviceAttributeMultiprocessorCount, dev) != hipSuccess) { grid = -1; return; }
        if (hipFuncSetAttribute((const void*)mega, hipFuncAttributeMaxDynamicSharedMemorySize, LDS_BYTES) != hipSuccess) { fprintf(stderr, "kernel_launch: hipFuncSetAttribute failed\n"); grid = -1; return; }
        int per_cu = 0;
        if (hipOccupancyMaxActiveBlocksPerMultiprocessor(&per_cu, (const void*)mega, NT, LDS_BYTES) != hipSuccess || per_cu < 1) { fprintf(stderr, "kernel_launch: occupancy query says %d\n", per_cu); }
        (void)hipGetLastError();
        grid = cus;
    }
    if (grid < 0) return;
    (void)hipMemsetAsync(w, 0, ctl_bytes, stream);
    hipLaunchKernelGGL(mega, dim3(grid), dim3(NT), LDS_BYTES, stream, a);
}
```

```cpp
#include <hip/hip_runtime.h>
#include <stdint.h>
#include <stdio.h>

typedef unsigned short bf16_t;
typedef short bf16x8 __attribute__((ext_vector_type(8)));
typedef float f32x4 __attribute__((ext_vector_type(4)));
typedef unsigned u32x4_t __attribute__((ext_vector_type(4)));

constexpr int NTOK = 32768, DM = 1024, NB = 8, SEQ = 4096;
constexpr int DIN = 2840, DINP = 3072, DFF = 2816, NEXP = 8;
constexpr int C_Q = 0, C_KC = 512, C_VC = 640, C_KS = 768, C_VS = 896, C_KW = 1024, C_VW = 1152, C_GL = 1280,
              C_CONV = 1304, C_RQ = 1816, C_RK = 2072, C_RV = 2328, C_RG = 2584;
constexpr int NSLOT = 16;
constexpr int PMAX = 65536 + 8 * 256;
constexpr int NT = 512, NW = 8;
constexpr int LDS_BYTES = 144 * 1024, MISC_OFF = LDS_BYTES - 256;

#define XB_TMO      128
#define XB_XCNT(j)  (256  + 64 * (j))
#define XB_XSUB(j)  (1280 + 64 * (j))
#define XB_XGEN(j)  (2304 + 64 * (j))
#define XB_TOP      3328
#define XB_TOPGEN   3392
#define XCD_BAR_WORDS 3456
#define XB_SPIN_CAP (1u << 20)
#define LAS __attribute__((address_space(3)))
__device__ __forceinline__ unsigned xb_ld(unsigned* p)              { return __hip_atomic_load(p, __ATOMIC_RELAXED, __HIP_MEMORY_SCOPE_AGENT); }
__device__ __forceinline__ unsigned xb_add(unsigned* p, unsigned v) { return __hip_atomic_fetch_add(p, v, __ATOMIC_RELAXED, __HIP_MEMORY_SCOPE_AGENT); }
__device__ __forceinline__ unsigned xb_xcc_id() { return (unsigned)__builtin_amdgcn_s_getreg((3 << 11) | 20) & 0xFu; }
#define XB_SPIN(cond, bar) do { unsigned _sp = 0; while (cond) { __builtin_amdgcn_s_sleep(1); \
    if ((++_sp & 255u) == 0u) { if (xb_ld(&(bar)[XB_TMO])) break; if (_sp > XB_SPIN_CAP) { atomicAdd(&(bar)[XB_TMO], 1u); break; } } } } while (0)
struct XcdBarrier { unsigned* bar; unsigned x; volatile LAS unsigned* st; };
__device__ __forceinline__ XcdBarrier xcd_barrier_post(unsigned* bar, volatile LAS unsigned* st) {
    XcdBarrier b; b.bar = bar; b.x = xb_xcc_id(); b.st = st;
    if (threadIdx.x == 0) (void)xb_add(&bar[XB_XCNT(b.x)], 1u);
    return b;
}
__device__ __forceinline__ void xcd_barrier_complete(unsigned* bar, unsigned x, unsigned& nloc, unsigned& nx) {
    const unsigned G = gridDim.x * gridDim.y * gridDim.z;
    unsigned sum, cnt, mine, sp = 0u;
    for (;;) {
        sum = 0u; cnt = 0u; mine = 0u;
#pragma unroll
        for (unsigned j = 0; j < 16; ++j) { const unsigned c = xb_ld(&bar[XB_XCNT(j)]); sum += c; cnt += (c > 0u) ? 1u : 0u; mine = (j == x) ? c : mine; }
        if (sum == G) break;
        __builtin_amdgcn_s_sleep(1);
        if ((++sp & 255u) == 0u) { if (xb_ld(&bar[XB_TMO])) break; if (sp > XB_SPIN_CAP) { atomicAdd(&bar[XB_TMO], 1u); break; } }
    }
    nloc = mine > 0u ? mine : 1u; nx = cnt > 0u ? cnt : 1u;
}
__device__ __forceinline__ void xcd_barrier(const XcdBarrier& b) {
    asm volatile("s_waitcnt vmcnt(0)" ::: "memory");
    __syncthreads();
    if (threadIdx.x == 0) {
        unsigned* bar = b.bar;
        __builtin_amdgcn_s_waitcnt(0);
        const unsigned bx = xb_xcc_id();
        unsigned nloc = b.st[0], nx = b.st[1];
        if (nloc == 0u) { xcd_barrier_complete(bar, bx, nloc, nx); b.st[0] = nloc; b.st[1] = nx; }
        const unsigned old = xb_add(&bar[XB_XSUB(bx)], 1u);
        const unsigned gen = old / nloc;
        if (old + 1u == (gen + 1u) * nloc) {
            __builtin_amdgcn_fence(__ATOMIC_RELEASE, "agent");
            asm volatile("s_waitcnt vmcnt(0)" ::: "memory");
            const unsigned og = xb_add(&bar[XB_TOP], 1u);
            const unsigned tg = og / nx;
            if (og + 1u == (tg + 1u) * nx) xb_add(&bar[XB_TOPGEN], 1u);
            else XB_SPIN(xb_ld(&bar[XB_TOPGEN]) == tg, bar);
            __builtin_amdgcn_fence(__ATOMIC_ACQUIRE, "agent");
            xb_add(&bar[XB_XGEN(bx)], 1u);
            asm volatile("s_waitcnt vmcnt(0)" ::: "memory");
        } else {
            XB_SPIN(xb_ld(&bar[XB_XGEN(bx)]) == gen, bar);
            __builtin_amdgcn_fence(__ATOMIC_ACQUIRE, "agent");
            asm volatile("s_waitcnt vmcnt(0)" ::: "memory");
        }
    }
    __syncthreads();
}

__device__ __forceinline__ bf16_t f2bf(float f) { unsigned u = __float_as_uint(f); u += 0x7fffu + ((u >> 16) & 1u); return (bf16_t)(u >> 16); }
__device__ __forceinline__ float bf2f(bf16_t h) { return __uint_as_float(((unsigned)h) << 16); }
__device__ __forceinline__ float wsum(float v) {
#pragma unroll
    for (int o = 32; o > 0; o >>= 1) v += __shfl_xor(v, o);
    return v; }
__device__ __forceinline__ float wmax(float v) {
#pragma unroll
    for (int o = 32; o > 0; o >>= 1) v = fmaxf(v, __shfl_xor(v, o));
    return v; }
__device__ __forceinline__ float siluf(float x) { return x / (1.f + __expf(-x)); }
__device__ __forceinline__ float sigmf(float x) { return 1.f / (1.f + __expf(-x)); }
__device__ __forceinline__ float row_rstd(const float* ssq, int row) { float s = 0.f;
#pragma unroll
    for (int i = 0; i < NSLOT; ++i) s += ssq[(size_t)row * NSLOT + i];
    return rsqrtf(s * (1.f / DM) + 1e-6f); }

struct Args {
    const float *x, *ln_attn, *w_in, *cmp_pe, *cmp_w1, *cmp_w2, *conv_w, *conv_b, *conv_lg, *conv_lb, *conv_pw, *ret_gn, *w_out, *ln_ffn, *ffn_w13, *ffn_w2, *router, *moe_w13, *moe_w2, *ln_final;
    float* xres;
    bf16_t *Wm13, *Win, *Wout, *W13, *W2, *xb, *ysorted, *Wm2, *W1b, *W2b, *Wpw;
    float *bias1, *rot, *ssq; int *cnt, *meta, *tok_list, *row_tok, *slot, *tile_exp; float* gate;
    bf16_t *proj, *ocat, *hc, *kcb, *vcb, *hconv; float *qr, *kr, *KV, *Sst; bf16_t* hbuf; bf16_t *vcT, *VsT, *VwT, *qrb, *krb, *KzT, *VrT, *ST;
    unsigned* bar;
};

struct ConvJob { const float* src; bf16_t* dst; const float* g; int ldsrc, K, Npad, nvalid, mode, pad; };
__device__ __forceinline__ ConvJob get_job(const Args& a, int j) {
    ConvJob c; c.g = nullptr; c.mode = 0; c.pad = 0;
    if (j < 2) { c.src = a.w_in + (size_t)j * DM * DIN; c.dst = a.Win + (size_t)j * DINP * DM; c.g = a.ln_attn + j * DM; c.ldsrc = DIN; c.K = DM; c.Npad = DINP; c.nvalid = DIN; c.mode = 1; }
    else if (j < 4) { const int l = j - 2; c.src = a.w_out + (size_t)l * DM * DM; c.dst = a.Wout + (size_t)l * DM * DM; c.ldsrc = DM; c.K = DM; c.Npad = DM; c.nvalid = DM; }
    else if (j < 6) { const int l = j - 4; c.src = a.conv_pw + (size_t)l * 65536; c.dst = a.Wpw + (size_t)l * 65536; c.ldsrc = 256; c.K = 256; c.Npad = 256; c.nvalid = 256; }
    else if (j < 10) { const int i = j - 6; c.src = a.cmp_w1 + (size_t)i * 2048 * 256; c.dst = a.W1b + (size_t)i * 256 * 2048; c.ldsrc = 256; c.K = 2048; c.Npad = 256; c.nvalid = 256; }
    else if (j < 14) { const int i = j - 10; c.src = a.cmp_w2 + (size_t)i * 256 * 64; c.dst = a.W2b + (size_t)i * 256 * 256; c.ldsrc = 64; c.K = 256; c.Npad = 256; c.nvalid = 64; }
    else if (j == 14) { c.src = a.ffn_w13; c.dst = a.W13; c.g = a.ln_ffn; c.ldsrc = 2 * DFF; c.K = DM; c.Npad = 2 * DFF; c.nvalid = 2 * DFF; c.mode = 2; }
    else if (j == 15) { c.src = a.ffn_w2; c.dst = a.W2; c.ldsrc = DM; c.K = DFF; c.Npad = DM; c.nvalid = DM; }
    else if (j < 24) { const int e = j - 16; c.src = a.moe_w13 + (size_t)e * DM * 2 * DFF; c.dst = a.Wm13 + (size_t)e * 2 * DFF * DM; c.g = a.ln_ffn + DM; c.ldsrc = 2 * DFF; c.K = DM; c.Npad = 2 * DFF; c.nvalid = 2 * DFF; c.mode = 2; }
    else { const int e = j - 24; c.src = a.moe_w2 + (size_t)e * DFF * DM; c.dst = a.Wm2 + (size_t)e * DM * DFF; c.ldsrc = DM; c.K = DFF; c.Npad = DM; c.nvalid = DM; }
    return c;
}
constexpr int NJOBS = 32;
__device__ __forceinline__ void conv_tile(const ConvJob& c, int tile, LAS float* lt  , int tid_) {
    const int ntn = c.Npad / 64, n0 = (tile % ntn) * 64, k0 = (tile / ntn) * 64, tx = tid_ & 63, ty = tid_ >> 6;
    const int n = n0 + tx; int sc; float cs = 1.f;
    if (c.mode == 2) { const int pn = n >> 8, i = n & 255; sc = i < 128 ? 128 * pn + i : DFF + 128 * pn + (i - 128); }
    else { sc = n < c.nvalid ? n : -1; if (c.mode == 1) cs = (n < 512 || (n >= C_RK && n < C_RV)) ? 0.125f : 1.f; }
    for (int r = ty; r < 64; r += NW) { float v = 0.f; if (sc >= 0) { v = c.src[(size_t)(k0 + r) * c.ldsrc + sc] * cs; if (c.g) v *= c.g[k0 + r]; } lt[r * 65 + tx] = v; }
    __syncthreads();
    for (int r = ty; r < 64; r += NW) c.dst[(size_t)(n0 + r) * c.K + k0 + tx] = f2bf(lt[tx * 65 + r]);
    __syncthreads();
}
__device__ __forceinline__ void ph_prologue(const Args& a, LAS char* lds, int vcu, int G) {
    int tid_ = threadIdx.x; asm volatile("" : "+v"(tid_)); asm volatile("" : "+s"(vcu));
    LAS float* lt = (LAS float*)lds; int acc = 0;
    for (int j = 0; j < NJOBS; ++j) { const ConvJob c = get_job(a, j); const int nt = (c.Npad / 64) * (c.K / 64);
        int t0 = vcu - (acc % G); if (t0 < 0) t0 += G;
        for (int t = t0; t < nt; t += G) conv_tile(c, t, lt, tid_);
        acc += nt; }
    for (int u = vcu; u < 16; u += G) { const int i = u >> 2, nl = tid_ & 63, kp = tid_ >> 6, n = (u & 3) * 64 + nl; float s = 0.f;
        const float* pe = a.cmp_pe + (size_t)i * 2048; const float* w1 = a.cmp_w1 + (size_t)i * 2048 * 256;
        for (int k = kp; k < 2048; k += NW) s += pe[k] * w1[(size_t)k * 256 + n];
        lt[kp * 64 + nl] = s; __syncthreads();
        if (kp == 0) { float t = 0.f; for (int q = 0; q < NW; ++q) t += lt[q * 64 + nl]; a.bias1[i * 256 + n] = t; }
        __syncthreads(); }
    for (int idx = vcu * NT + tid_; idx < 4096 * 32; idx += G * NT) { const int pos = idx >> 5, i = idx & 31; const float inv = powf(10000.f, -(float)i / 32.f), ang = (float)pos * inv;
        a.rot[idx * 2] = cosf(ang); a.rot[idx * 2 + 1] = sinf(ang); }
    const int lane = tid_ & 63;
    for (int row = vcu * NW + (tid_ >> 6); row < NTOK; row += G * NW) { float s = 0.f;
        for (int c = lane * 4; c < DM; c += 256) { const float4 v = *(const float4*)(a.x + (size_t)row * DM + c); s += v.x * v.x + v.y * v.y + v.z * v.z + v.w * v.w;
            ushort4 o; o.x = f2bf(v.x); o.y = f2bf(v.y); o.z = f2bf(v.z); o.w = f2bf(v.w); *(ushort4*)(a.xb + (size_t)row * DM + c) = o; }
        s = wsum(s); if (lane < NSLOT) a.ssq[(size_t)row * NSLOT + lane] = lane == 0 ? s : 0.f; }
}

struct APlain { const bf16_t* A; int lda; __device__ __forceinline__ const bf16_t* ptr(int row, int k) const { return A + (size_t)row * lda + k; } };
struct AGather { const bf16_t* A; const int* row_tok; int lda; __device__ __forceinline__ const bf16_t* ptr(int row, int k) const { const int t = row_tok[row]; return t < 0 ? nullptr : A + (size_t)t * lda + k; } };
struct ACmp { const bf16_t* proj; int coloff;
    __device__ __forceinline__ const bf16_t* ptr(int row, int k) const { const int c = row & 255, g = (row >> 8) & 1, b = row >> 9; if (c == 255) return nullptr;
        return proj + (size_t)(b * SEQ + 16 * c + (k >> 6)) * DINP + coloff + g * 64 + (k & 63); } };
struct SchedPlain { int nM, nN; __device__ __forceinline__ int count() const { return nM * nN; }
    __device__ __forceinline__ void get(int u, int& row0, int& col0, size_t& boff) const { row0 = (u / nN) * 256; col0 = (u % nN) * 256; boff = 0; } };
struct SchedMoe { const int* meta; const int* tile_exp; size_t estride; int nN;
    __device__ __forceinline__ int count() const { return meta[0] * nN; }
    __device__ __forceinline__ void get(int u, int& row0, int& col0, size_t& boff) const { row0 = (u / nN) * 256; col0 = (u % nN) * 256; boff = (size_t)tile_exp[row0 >> 8] * estride; } };

struct EpiIn { bf16_t* proj; const float* ssq;
    __device__ __forceinline__ void apply(const f32x4 (&acc)[2][16], int rowb, int col0, int lane) const {
#pragma unroll
        for (int mi = 0; mi < 2; ++mi)
#pragma unroll
            for (int r = 0; r < 4; ++r) { const int row = rowb + mi * 16 + (lane >> 4) * 4 + r; const float rs = row_rstd(ssq, row);
#pragma unroll
                for (int n = 0; n < 16; ++n) proj[(size_t)row * DINP + col0 + n * 16 + (lane & 15)] = f2bf(acc[mi][n][r] * rs); } } };
struct EpiRes { const float* xold; float* xnew; bf16_t* xb; float* ssq;
    __device__ __forceinline__ void apply(const f32x4 (&acc)[2][16], int rowb, int col0, int lane) const {
#pragma unroll
        for (int mi = 0; mi < 2; ++mi)
#pragma unroll
            for (int r = 0; r < 4; ++r) { const int row = rowb + mi * 16 + (lane >> 4) * 4 + r; float s = 0.f;
#pragma unroll
                for (int n = 0; n < 16; ++n) { const size_t o = (size_t)row * DM + col0 + n * 16 + (lane & 15); const float v = xold[o] + acc[mi][n][r]; xnew[o] = v; xb[o] = f2bf(v); s += v * v; }
                s += __shfl_xor(s, 1); s += __shfl_xor(s, 2); s += __shfl_xor(s, 4); s += __shfl_xor(s, 8);
                if ((lane & 15) < 4) ssq[(size_t)row * NSLOT + (col0 >> 8) * 4 + (lane & 15)] = (lane & 15) == 0 ? s : 0.f; } } };
struct EpiSwiglu { bf16_t* h; const float* ssq; const int* row_tok;
    __device__ __forceinline__ void apply(const f32x4 (&acc)[2][16], int rowb, int col0, int lane) const {
#pragma unroll
        for (int mi = 0; mi < 2; ++mi)
#pragma unroll
            for (int r = 0; r < 4; ++r) { const int row = rowb + mi * 16 + (lane >> 4) * 4 + r; const int t = row_tok ? row_tok[row] : row;
                const float rs = t < 0 ? 0.f : row_rstd(ssq, t < 0 ? 0 : t);
#pragma unroll
                for (int n = 0; n < 8; ++n) { const float av = acc[mi][n][r] * rs, bv = acc[mi][n + 8][r] * rs; h[(size_t)row * DFF + (col0 >> 1) + n * 16 + (lane & 15)] = f2bf(siluf(av) * bv); } } } };
struct EpiStore { bf16_t* out; int ldc, coloff, ncols;
    __device__ __forceinline__ void apply(const f32x4 (&acc)[2][16], int rowb, int col0, int lane) const {
#pragma unroll
        for (int mi = 0; mi < 2; ++mi)
#pragma unroll
            for (int r = 0; r < 4; ++r) { const int row = rowb + mi * 16 + (lane >> 4) * 4 + r;
#pragma unroll
                for (int n = 0; n < 16; ++n) { const int c = col0 + n * 16 + (lane & 15); if (c < ncols) out[(size_t)row * ldc + coloff + c] = f2bf(acc[mi][n][r]); } } } };
struct EpiStoreT { bf16_t* out;
    __device__ __forceinline__ void apply(const f32x4 (&acc)[2][16], int rowb, int col0, int lane) const {
#pragma unroll
        for (int mi = 0; mi < 2; ++mi)
#pragma unroll
            for (int r = 0; r < 4; ++r) { const int row = rowb + mi * 16 + (lane >> 4) * 4 + r;
#pragma unroll
                for (int n = 0; n < 4; ++n) { const int c = col0 + n * 16 + (lane & 15); out[(size_t)(row >> 8) * 16384 + c * 256 + (row & 255)] = f2bf(acc[mi][n][r]); } } } };
struct EpiSiluBias { bf16_t* out; const float* bias; int ldc;
    __device__ __forceinline__ void apply(const f32x4 (&acc)[2][16], int rowb, int col0, int lane) const {
#pragma unroll
        for (int mi = 0; mi < 2; ++mi)
#pragma unroll
            for (int r = 0; r < 4; ++r) { const int row = rowb + mi * 16 + (lane >> 4) * 4 + r;
#pragma unroll
                for (int n = 0; n < 16; ++n) { const int c = col0 + n * 16 + (lane & 15); out[(size_t)row * ldc + c] = f2bf(siluf(acc[mi][n][r] + bias[c])); } } } };

template <class AS, class Epi, class Sched>
__device__ __forceinline__ void ph_gemm(LAS char* lds, const AS as, const bf16_t* __restrict__ Bt, const int K, const Epi epi, const Sched sched, int vcu, int G) {
    int tid_ = threadIdx.x; asm volatile("" : "+v"(tid_)); asm volatile("" : "+s"(vcu));
    LAS bf16_t* sA = (LAS bf16_t*)lds; LAS bf16_t* sB = (LAS bf16_t*)(lds + 256 * 40 * 2);
    const int tid = tid_, wave = tid >> 6, lane = tid & 63;
    const int nunits = sched.count();
    for (int u = vcu; u < nunits; u += G) {
        int row0, col0; size_t boff; sched.get(u, row0, col0, boff);
        const bf16_t* Bu = Bt + boff;
        f32x4 acc[2][16];
#pragma unroll
        for (int mi = 0; mi < 2; ++mi)
#pragma unroll
            for (int n = 0; n < 16; ++n) acc[mi][n] = (f32x4){0.f, 0.f, 0.f, 0.f};
#pragma unroll 1
        for (int k0 = 0; k0 < K; k0 += 32) {
#pragma unroll
            for (int i = 0; i < 2; ++i) { const int c = tid + i * NT, r = c >> 2, kc = (c & 3) * 8; const bf16_t* p = as.ptr(row0 + r, k0 + kc);
                uint4 v = make_uint4(0u, 0u, 0u, 0u); if (p) v = *(const uint4*)p; *(LAS u32x4_t*)&sA[r * 40 + kc] = (u32x4_t){v.x, v.y, v.z, v.w}; }
#pragma unroll
            for (int i = 0; i < 2; ++i) { const int c = tid + i * NT, r = c >> 2, kc = (c & 3) * 8;
                *(LAS u32x4_t*)&sB[r * 40 + kc] = *(const u32x4_t*)(Bu + (size_t)(col0 + r) * K + k0 + kc); }
            __syncthreads();
            bf16x8 af[2];
#pragma unroll
            for (int mi = 0; mi < 2; ++mi) af[mi] = *(const LAS bf16x8*)&sA[(wave * 32 + mi * 16 + (lane & 15)) * 40 + (lane >> 4) * 8];
#pragma unroll
            for (int n = 0; n < 16; ++n) { const bf16x8 bfr = *(const LAS bf16x8*)&sB[(n * 16 + (lane & 15)) * 40 + (lane >> 4) * 8];
#pragma unroll
                for (int mi = 0; mi < 2; ++mi) acc[mi][n] = __builtin_amdgcn_mfma_f32_16x16x32_bf16(af[mi], bfr, acc[mi][n], 0, 0, 0); }
            __syncthreads();
        }
        epi.apply(acc, row0 + wave * 32, col0, lane);
    }
}


namespace pg8 {
#define PG8_LAS __attribute__((address_space(3)))
typedef unsigned u32x4 __attribute__((ext_vector_type(4)));
typedef unsigned u32x2 __attribute__((ext_vector_type(2)));
constexpr int BM = 256, BK = 64, HALF = 128, HTB = HALF * BK * 2  , STAGE_BYTES = 8 * HTB, NXCD = 8, WGM = 8;
__host__ __device__ __forceinline__ int lds_byte(int r, int c) { const int st = (r >> 4) * 2 + (c >> 5), rr = r & 15, cc = c & 31, ob = rr * 64 + cc * 2; return st * 1024 + (ob ^ (((ob >> 9) & 1) << 5)); }
__host__ __device__ __forceinline__ void stage_rc(int b, int& R, int& C) { const int st = b / 1024, sb = b % 1024, swz = sb ^ (((sb >> 9) & 1) << 5); R = (st >> 1) * 16 + swz / 64; C = (st & 1) * 32 + (swz % 64) / 2; }
__host__ __device__ __forceinline__ int perm32(int rho) { const int n = rho >> 4, i = rho & 15; return 8 * (i >> 2) + 4 * n + (i & 3); }
struct Unit { int pm, pn; };
struct Gemm { const bf16_t* A; const bf16_t* Bt; int M, N, K; };
struct StaticOrder {
    int nM, nN, nwg, G, c;
    __device__ __forceinline__ void init(int M, int N, int G_, int c_) { nM = M / BM; nN = N / BM; nwg = nM * nN; G = G_; c = c_; }
    __device__ __forceinline__ bool next(int i, Unit& u) const {
        const long L = (long)i * G + c; if (L >= nwg) return false;
        int wgid = (int)L; { const int q = nwg / NXCD, r = nwg % NXCD, xcd = wgid % NXCD, off = wgid / NXCD; wgid = (xcd < r ? xcd * (q + 1) : r * (q + 1) + (xcd - r) * q) + off; }
        const int nig = WGM * nN, gid = wgid / nig, fm = gid * WGM, gsz = (nM - fm) < WGM ? (nM - fm) : WGM;
        u.pm = fm + ((wgid % nig) % gsz); u.pn = (wgid % nig) / gsz; return true;
    }
};
__device__ __forceinline__ unsigned cvt_pk_bf16(float lo, float hi) { unsigned r; asm volatile("v_cvt_pk_bf16_f32 %0, %1, %2" : "=v"(r) : "v"(lo), "v"(hi)); return r; }

template <class Epi, class Sched, bool GATHER>
__device__ __forceinline__ void gemm_phase(PG8_LAS unsigned char* lds, const Gemm g, const Sched& S, const Epi& E, const int* __restrict__ rowmap, const int* __restrict__ tile_exp, const size_t estride) {
    int tid = threadIdx.x; asm volatile("" : "+v"(tid));
    const int wid = __builtin_amdgcn_readfirstlane(tid >> 6), lane = tid & 63, wr = wid >> 2, wc = wid & 3, fr = lane & 15, fq = lane >> 4;
    const int K = g.K, nt = K / BK;
    unsigned voffA[2], voffB[2]; int rA[2];
#pragma unroll
    for (int i = 0; i < 2; ++i) { int R, C; stage_rc(tid * 16 + i * 8192, R, C); const int Rb = (R & ~31) + perm32(R & 31);
        voffA[i] = (unsigned)(R * K + C) * 2u; voffB[i] = (unsigned)(Rb * K + C) * 2u; rA[i] = R; if (GATHER) voffA[i] = (unsigned)C * 2u; }
    const size_t kstep = (size_t)(BK * 2);
    const size_t hstep = (size_t)HALF * K * 2;
    const size_t tstep = 2 * hstep;
    const unsigned ldsw = (unsigned)wid * 1024u;
    const int aoff = lds_byte(wr * 64 + fr, fq * 8), boff = lds_byte(wc * 32 + fr, fq * 8);
#define PG8_SA(b, h) (((b) * 2 + (h)) * HTB)
#define PG8_SB(b, h) ((4 + (b) * 2 + (h)) * HTB)
#define PG8_STAGE(bufoff, gbase, voff) do { _Pragma("unroll") for (int _i = 0; _i < 2; ++_i) \
        __builtin_amdgcn_global_load_lds((const unsigned*)((const char*)(gbase) + (voff)[_i]), (PG8_LAS unsigned*)(lds + (bufoff) + ldsw + _i * 8192), 16, 0, 0); } while (0)
#define PG8_LDA(dst, b, h) do { _Pragma("unroll") for (int m = 0; m < 4; ++m) _Pragma("unroll") for (int k = 0; k < 2; ++k) dst[m][k] = *(const PG8_LAS bf16x8*)(lds + PG8_SA(b, h) + aoff + m * 2048 + k * 1024); } while (0)
#define PG8_LDB(dst, b, h) do { _Pragma("unroll") for (int n = 0; n < 2; ++n) _Pragma("unroll") for (int k = 0; k < 2; ++k) dst[n][k] = *(const PG8_LAS bf16x8*)(lds + PG8_SB(b, h) + boff + n * 2048 + k * 1024); } while (0)
#define PG8_MMA(ai, bj, At, Bt) do { __builtin_amdgcn_s_setprio(1); _Pragma("unroll") for (int m = 0; m < 4; ++m) _Pragma("unroll") for (int n = 0; n < 2; ++n) _Pragma("unroll") for (int k = 0; k < 2; ++k) \
        acc[ai][bj][m][n] = __builtin_amdgcn_mfma_f32_16x16x32_bf16(Bt[n][k], At[m][k], acc[ai][bj][m][n], 0, 0, 0); __builtin_amdgcn_s_setprio(0); } while (0)
#define PG8_WAIT_V(n) asm volatile("s_waitcnt vmcnt(" #n ")" ::: "memory")
#define PG8_WAIT_L(n) asm volatile("s_waitcnt lgkmcnt(" #n ")" ::: "memory")
#define PG8_BAR __builtin_amdgcn_s_barrier()
#define PG8_SCHED __builtin_amdgcn_sched_barrier(0)
    unsigned vgc[2][2], vgn[2][2];
#define PG8_GOFF(dst, pm_) do { if constexpr (GATHER) { _Pragma("unroll") for (int _h = 0; _h < 2; ++_h) _Pragma("unroll") for (int _i = 0; _i < 2; ++_i) { int _t = rowmap[(pm_) * BM + _h * HALF + rA[_i]]; _t = _t < 0 ? 0 : _t; \
        dst[_h][_i] = (unsigned)_t * (unsigned)(K * 2) + voffA[_i]; } } } while (0)
#define PG8_STA(bufoff, gptr, h, arr) do { if constexpr (GATHER) { PG8_STAGE(bufoff, gptr, arr[h]); } else { PG8_STAGE(bufoff, (gptr) + ((h) ? hstep : 0), voffA); } } while (0)
    Unit cur, nxt; int ui = 0;
    if (!S.next(0, cur)) return;
    f32x4 acc[2][2][4][2];
#pragma unroll
    for (int a = 0; a < 2; ++a)
#pragma unroll
        for (int b = 0; b < 2; ++b)
#pragma unroll
            for (int m = 0; m < 4; ++m)
#pragma unroll
                for (int n = 0; n < 2; ++n) acc[a][b][m][n] = (f32x4){0.f, 0.f, 0.f, 0.f};
    bf16x8 At[4][2], B0[2][2], B1[2][2];
    const char* cA = (const char*)g.A + (GATHER ? (size_t)0 : (size_t)cur.pm * tstep);
    const char* cB = (const char*)g.Bt + (tile_exp ? (size_t)tile_exp[cur.pm] * estride * 2 : (size_t)0) + (size_t)cur.pn * tstep;
    PG8_GOFF(vgc, cur.pm);
    PG8_STAGE(PG8_SB(0, 0), cB, voffB); PG8_STAGE(PG8_SB(0, 1), cB + hstep, voffB); PG8_STA(PG8_SA(0, 0), cA, 0, vgc); PG8_STA(PG8_SA(0, 1), cA, 1, vgc);
    if (wr == 1) PG8_BAR;
    PG8_WAIT_V(2); PG8_BAR;
    PG8_STAGE(PG8_SB(1, 0), cB + kstep, voffB); PG8_STA(PG8_SA(1, 0), cA + kstep, 0, vgc); PG8_STAGE(PG8_SB(1, 1), cB + hstep + kstep, voffB);
    PG8_WAIT_V(6); PG8_BAR;
    for (;;) {
        const bool has_next = S.next(ui + 1, nxt);
        const char* nA = has_next ? (const char*)g.A + (GATHER ? (size_t)0 : (size_t)nxt.pm * tstep) : cA;
        const char* nB = has_next ? (const char*)g.Bt + (tile_exp ? (size_t)tile_exp[nxt.pm] * estride * 2 : (size_t)0) + (size_t)nxt.pn * tstep : cB;
        if constexpr (GATHER) { if (has_next) { PG8_GOFF(vgn, nxt.pm); } else {
#pragma unroll
            for (int _h = 0; _h < 2; ++_h)
#pragma unroll
                for (int _i = 0; _i < 2; ++_i) vgn[_h][_i] = vgc[_h][_i]; } }
        for (int t = 0; t < nt; t += 2) {
            const bool last = (t == nt - 2);
            const char* a1 = cA + (size_t)(t + 1) * kstep;
            const char* a2 = last ? nA : cA + (size_t)(t + 2) * kstep; const char* b2 = last ? nB : cB + (size_t)(t + 2) * kstep;
            const char* a3 = a2 + kstep; const char* b3 = b2 + kstep;
            unsigned v2[2][2];
            if constexpr (GATHER) {
#pragma unroll
            for (int _h = 0; _h < 2; ++_h)
#pragma unroll
                for (int _i = 0; _i < 2; ++_i) v2[_h][_i] = last ? vgn[_h][_i] : vgc[_h][_i]; }
            PG8_LDB(B0, 0, 0); PG8_LDB(B1, 0, 1); PG8_SCHED; PG8_LDA(At, 0, 0); PG8_STA(PG8_SA(1, 1), a1, 1, vgc);
            PG8_WAIT_V(8); PG8_WAIT_L(0); PG8_BAR; PG8_MMA(0, 0, At, B0); PG8_MMA(0, 1, At, B1); PG8_BAR; PG8_SCHED;
            PG8_LDA(At, 0, 1); PG8_STAGE(PG8_SB(0, 0), b2, voffB); PG8_STAGE(PG8_SB(0, 1), b2 + hstep, voffB); PG8_STA(PG8_SA(0, 0), a2, 0, v2);
            PG8_WAIT_V(8); PG8_WAIT_L(0); PG8_BAR; PG8_MMA(1, 0, At, B0); PG8_MMA(1, 1, At, B1); PG8_BAR; PG8_SCHED;
            PG8_LDB(B0, 1, 0); PG8_LDB(B1, 1, 1); PG8_SCHED; PG8_LDA(At, 1, 0); PG8_STA(PG8_SA(0, 1), a2, 1, v2);
            PG8_WAIT_V(8); PG8_WAIT_L(0); PG8_BAR; PG8_MMA(0, 0, At, B0); PG8_MMA(0, 1, At, B1); PG8_BAR; PG8_SCHED;
            PG8_LDA(At, 1, 1); PG8_STAGE(PG8_SB(1, 0), b3, voffB); PG8_STAGE(PG8_SB(1, 1), b3 + hstep, voffB); PG8_STA(PG8_SA(1, 0), a3, 0, v2);
            PG8_WAIT_V(8); PG8_WAIT_L(0); PG8_BAR; PG8_MMA(1, 0, At, B0); PG8_MMA(1, 1, At, B1); PG8_BAR; PG8_SCHED;
        }
        if (wr == 0) PG8_BAR;
        E(acc, cur, wr, wc, fr, fq);
        if (!has_next) break;
#pragma unroll
        for (int a = 0; a < 2; ++a)
#pragma unroll
            for (int b = 0; b < 2; ++b)
#pragma unroll
                for (int m = 0; m < 4; ++m)
#pragma unroll
                    for (int n = 0; n < 2; ++n) acc[a][b][m][n] = (f32x4){0.f, 0.f, 0.f, 0.f};
        cur = nxt; cA = nA; cB = nB; ++ui;
        if constexpr (GATHER) {
#pragma unroll
        for (int _h = 0; _h < 2; ++_h)
#pragma unroll
            for (int _i = 0; _i < 2; ++_i) vgc[_h][_i] = vgn[_h][_i]; }
        if (wr == 1) PG8_BAR;
    }
    PG8_WAIT_V(0);
    PG8_BAR;
#undef PG8_SA
#undef PG8_SB
#undef PG8_STAGE
#undef PG8_LDA
#undef PG8_LDB
#undef PG8_MMA
#undef PG8_WAIT_V
#undef PG8_WAIT_L
#undef PG8_BAR
#undef PG8_SCHED
#undef PG8_GOFF
#undef PG8_STA
}

typedef const f32x4 (&AccT)[2][2][4][2];
struct EIn { bf16_t* proj; const float* ssq;
    __device__ __forceinline__ void operator()(AccT acc, const Unit& u, int wr, int wc, int fr, int fq) const {
        const int col0 = u.pn * BM + wc * 32 + 8 * fq;
#pragma unroll
        for (int ai = 0; ai < 2; ++ai)
#pragma unroll
            for (int m = 0; m < 4; ++m) { const int row = u.pm * BM + ai * HALF + wr * 64 + m * 16 + fr; const float rs = row_rstd(ssq, row); bf16_t* rowp = proj + (size_t)row * DINP + col0;
#pragma unroll
                for (int bj = 0; bj < 2; ++bj) { const f32x4 v0 = acc[ai][bj][m][0] * rs, v1 = acc[ai][bj][m][1] * rs; u32x4 w; w.x = cvt_pk_bf16(v0[0], v0[1]); w.y = cvt_pk_bf16(v0[2], v0[3]); w.z = cvt_pk_bf16(v1[0], v1[1]); w.w = cvt_pk_bf16(v1[2], v1[3]);
                    *(u32x4*)(rowp + bj * HALF) = w; } } } };
struct ERes { const float* xold; float* xnew; bf16_t* xb; float* ssq;
    __device__ __forceinline__ void operator()(AccT acc, const Unit& u, int wr, int wc, int fr, int fq) const {
        const int col0 = u.pn * BM + wc * 32 + 8 * fq;
#pragma unroll
        for (int ai = 0; ai < 2; ++ai)
#pragma unroll
            for (int m = 0; m < 4; ++m) { const int row = u.pm * BM + ai * HALF + wr * 64 + m * 16 + fr; const size_t o = (size_t)row * DM + col0; float s = 0.f;
#pragma unroll
                for (int bj = 0; bj < 2; ++bj) { const f32x4 x0 = *(const f32x4*)(xold + o + bj * HALF), x1 = *(const f32x4*)(xold + o + bj * HALF + 4);
                    const f32x4 v0 = x0 + acc[ai][bj][m][0], v1 = x1 + acc[ai][bj][m][1];
                    *(f32x4*)(xnew + o + bj * HALF) = v0; *(f32x4*)(xnew + o + bj * HALF + 4) = v1;
                    u32x4 w; w.x = cvt_pk_bf16(v0[0], v0[1]); w.y = cvt_pk_bf16(v0[2], v0[3]); w.z = cvt_pk_bf16(v1[0], v1[1]); w.w = cvt_pk_bf16(v1[2], v1[3]);
                    *(u32x4*)(xb + o + bj * HALF) = w;
                    s += (v0[0] * v0[0] + v0[1] * v0[1]) + (v0[2] * v0[2] + v0[3] * v0[3]) + (v1[0] * v1[0] + v1[1] * v1[1]) + (v1[2] * v1[2] + v1[3] * v1[3]); }
                s += __shfl_xor(s, 16); s += __shfl_xor(s, 32);
                if (fq == 0) ssq[(size_t)row * NSLOT + u.pn * 4 + wc] = s; } } };
struct ESwiglu { bf16_t* h; const float* ssq; const int* row_tok;
    __device__ __forceinline__ void operator()(AccT acc, const Unit& u, int wr, int wc, int fr, int fq) const {
        const int col0 = u.pn * HALF + wc * 32 + 8 * fq;
#pragma unroll
        for (int ai = 0; ai < 2; ++ai)
#pragma unroll
            for (int m = 0; m < 4; ++m) { const int row = u.pm * BM + ai * HALF + wr * 64 + m * 16 + fr; const int t = row_tok ? row_tok[row] : row; const float rs = t < 0 ? 0.f : row_rstd(ssq, t < 0 ? 0 : t);
                float o[8];
#pragma unroll
                for (int n = 0; n < 2; ++n)
#pragma unroll
                    for (int e = 0; e < 4; ++e) { const float av = acc[ai][0][m][n][e] * rs, bv = acc[ai][1][m][n][e] * rs; o[n * 4 + e] = siluf(av) * bv; }
                u32x4 w; w.x = cvt_pk_bf16(o[0], o[1]); w.y = cvt_pk_bf16(o[2], o[3]); w.z = cvt_pk_bf16(o[4], o[5]); w.w = cvt_pk_bf16(o[6], o[7]);
                *(u32x4*)(h + (size_t)row * DFF + col0) = w; } } };
struct EStore { bf16_t* out; int ldc;
    __device__ __forceinline__ void operator()(AccT acc, const Unit& u, int wr, int wc, int fr, int fq) const {
        const int col0 = u.pn * BM + wc * 32 + 8 * fq;
#pragma unroll
        for (int ai = 0; ai < 2; ++ai)
#pragma unroll
            for (int m = 0; m < 4; ++m) { const int row = u.pm * BM + ai * HALF + wr * 64 + m * 16 + fr; bf16_t* rowp = out + (size_t)row * ldc + col0;
#pragma unroll
                for (int bj = 0; bj < 2; ++bj) { const f32x4 v0 = acc[ai][bj][m][0], v1 = acc[ai][bj][m][1]; u32x4 w; w.x = cvt_pk_bf16(v0[0], v0[1]); w.y = cvt_pk_bf16(v0[2], v0[3]); w.z = cvt_pk_bf16(v1[0], v1[1]); w.w = cvt_pk_bf16(v1[2], v1[3]);
                    *(u32x4*)(rowp + bj * HALF) = w; } } } };
}

namespace nsa {
typedef float f32x16 __attribute__((ext_vector_type(16)));
typedef unsigned u32x4 __attribute__((ext_vector_type(4)));
typedef unsigned u32x2 __attribute__((ext_vector_type(2)));
constexpr int KSTR = 144, VSTR = 136;
constexpr int KT_B = 64 * KSTR, VT_B = 64 * VSTR, BUF_B = KT_B + VT_B;
constexpr int IMP_OFF = 2 * BUF_B  , SELM_OFF = IMP_OFF + 8 * 2048  , WUN_OFF = SELM_OFF + 512;
constexpr float L2E = 1.4426950408889634f;
#define NLAS __attribute__((address_space(3)))
__device__ __forceinline__ unsigned pk2(float lo, float hi) { unsigned r; asm volatile("v_cvt_pk_bf16_f32 %0, %1, %2" : "=v"(r) : "v"(lo), "v"(hi)); return r; }
struct Stage { u32x4 k, v; };
__device__ __forceinline__ void stage_issue(Stage& st, const bf16_t* kg, size_t kstride, const bf16_t* vg, size_t vstride, int tid) {
    const int r = tid >> 3, c = (tid & 7) * 8;
    st.k = *(const u32x4*)(kg + (size_t)r * kstride + c); st.v = *(const u32x4*)(vg + (size_t)r * vstride + c);
}
__device__ __forceinline__ void stage_write(const Stage& st, NLAS char* buf, int tid) {
    const int r = tid >> 3, c = (tid & 7) * 16;
    *(NLAS u32x4*)(buf + r * KSTR + c) = st.k;
    *(NLAS u32x2*)(buf + KT_B + r * VSTR + c) = (u32x2){st.v.x, st.v.y}; *(NLAS u32x2*)(buf + KT_B + r * VSTR + c + 8) = (u32x2){st.v.z, st.v.w};
}
__device__ __forceinline__ void compute_S(NLAS const char* buf, const bf16x8 (&Qf)[4], f32x16& S0, f32x16& S1, int lane) {
    const int kr = lane & 31, hi = lane >> 5;
#pragma unroll
    for (int i = 0; i < 16; ++i) { S0[i] = 0.f; S1[i] = 0.f; }
#pragma unroll
    for (int s = 0; s < 4; ++s) { const bf16x8 a0 = *(NLAS const bf16x8*)(buf + kr * KSTR + s * 32 + hi * 16), a1 = *(NLAS const bf16x8*)(buf + (32 + kr) * KSTR + s * 32 + hi * 16);
        S0 = __builtin_amdgcn_mfma_f32_32x32x16_bf16(a0, Qf[s], S0, 0, 0, 0); S1 = __builtin_amdgcn_mfma_f32_32x32x16_bf16(a1, Qf[s], S1, 0, 0, 0); }
}
__device__ __forceinline__ void mask_S(f32x16& S0, f32x16& S1, int lo, int hi, int lane) {
    const int h4 = (lane >> 5) * 4, lo2 = lo - h4, hi2 = hi - h4;
#pragma unroll
    for (int i = 0; i < 16; ++i) { const int c0 = (i & 3) + 8 * (i >> 2); S0[i] = (c0 >= lo2 && c0 <= hi2) ? S0[i] : -INFINITY; S1[i] = (c0 + 32 >= lo2 && c0 + 32 <= hi2) ? S1[i] : -INFINITY; }
}
__device__ __forceinline__ float max_S(const f32x16& S0, const f32x16& S1) { float m = fmaxf(S0[0], S1[0]);
#pragma unroll
    for (int i = 1; i < 16; ++i) m = fmaxf(m, fmaxf(S0[i], S1[i]));
    return fmaxf(m, __shfl_xor(m, 32)); }
__device__ __forceinline__ float exp_S(f32x16& S0, f32x16& S1, float mL, float sc) { float l = 0.f;
#pragma unroll
    for (int i = 0; i < 16; ++i) { S0[i] = __builtin_amdgcn_exp2f(fmaf(S0[i], L2E, -mL)) * sc; S1[i] = __builtin_amdgcn_exp2f(fmaf(S1[i], L2E, -mL)) * sc; l += S0[i] + S1[i]; }
    return l; }
__device__ __forceinline__ void pack_P(const f32x16& S0, const f32x16& S1, unsigned andm, bf16x8 (&Pf)[4]) {
#pragma unroll
    for (int s2 = 0; s2 < 4; ++s2) { u32x4 w;
#pragma unroll
        for (int q = 0; q < 4; ++q) { const int i = (s2 & 1) * 8 + q * 2; w[q] = (s2 < 2 ? pk2(S0[i], S0[i + 1]) : pk2(S1[i], S1[i + 1])) & andm; }
        Pf[s2] = __builtin_bit_cast(bf16x8, w); }
}
__device__ __forceinline__ void pv(NLAS const char* buf, const bf16x8 (&Pf)[4], f32x16& O0, f32x16& O1, int lane) {
    const int dr = lane & 31, hi = lane >> 5; NLAS const char* vt = buf + KT_B;
#pragma unroll
    for (int s2 = 0; s2 < 4; ++s2) {
        u32x4 w0, w1;
        { const u32x2 x = *(NLAS const u32x2*)(vt + dr * VSTR + (16 * s2 + 4 * hi) * 2), y = *(NLAS const u32x2*)(vt + dr * VSTR + (16 * s2 + 8 + 4 * hi) * 2); w0 = (u32x4){x.x, x.y, y.x, y.y}; }
        { const u32x2 x = *(NLAS const u32x2*)(vt + (32 + dr) * VSTR + (16 * s2 + 4 * hi) * 2), y = *(NLAS const u32x2*)(vt + (32 + dr) * VSTR + (16 * s2 + 8 + 4 * hi) * 2); w1 = (u32x4){x.x, x.y, y.x, y.y}; }
        O0 = __builtin_amdgcn_mfma_f32_32x32x16_bf16(__builtin_bit_cast(bf16x8, w0), Pf[s2], O0, 0, 0, 0);
        O1 = __builtin_amdgcn_mfma_f32_32x32x16_bf16(__builtin_bit_cast(bf16x8, w1), Pf[s2], O1, 0, 0, 0); }
}
__device__ __forceinline__ void online_block(NLAS const char* buf, const bf16x8 (&Qf)[4], f32x16& O0, f32x16& O1, float& m, float& l, bool lane_on, bool use_mask, int lo, int hi, int lane) {
    f32x16 S0, S1; compute_S(buf, Qf, S0, S1, lane);
    if (use_mask) mask_S(S0, S1, lo, hi, lane);
    float mt = max_S(S0, S1); if (!lane_on) mt = -INFINITY;
    const float mn = fmaxf(m, mt), ms = mn == -INFINITY ? 0.f : mn, al = __builtin_amdgcn_exp2f((m - ms) * L2E);
    const float ls = exp_S(S0, S1, ms * L2E, 1.f);
    l = l * al + (lane_on ? ls : 0.f); m = mn;
#pragma unroll
    for (int i = 0; i < 16; ++i) { O0[i] *= al; O1[i] *= al; }
    bf16x8 Pf[4]; pack_P(S0, S1, lane_on ? 0xffffffffu : 0u, Pf);
    pv(buf, Pf, O0, O1, lane);
}
}

__device__ __forceinline__ void ph_nsa(const Args& a, LAS char* lds_, int vcu, int G) {
    using namespace nsa;
    int tid = threadIdx.x; asm volatile("" : "+v"(tid)); asm volatile("" : "+s"(vcu));
    NLAS char* lds = lds_;
    const int w = tid >> 6, lane = tid & 63, hi = lane >> 5, r = lane & 31, tql = r >> 2, hpg = r & 3;
    NLAS float* impw = (NLAS float*)(lds + IMP_OFF + w * 2048);
    NLAS unsigned long long* selm = (NLAS unsigned long long*)(lds + SELM_OFF);
    NLAS unsigned long long* wun = (NLAS unsigned long long*)(lds + WUN_OFF);
    const bf16_t* proj = a.proj;
    for (int it = 0; it * G + vcu < 1024; ++it) {
        const int idx = it * G + vcu, rnd = idx >> 8, k16 = (idx & 255) >> 4, bg = idx & 15;
        const int qb = (rnd == 0) ? 63 - k16 : (rnd == 1) ? 32 + k16 : (rnd == 2) ? 31 - k16 : k16;
        const int b = bg >> 1, g = bg & 1;
        const int tq = 8 * w + tql, t = 64 * qb + tq; const size_t row = (size_t)b * SEQ + t; const bf16_t* prow = proj + row * DINP;
        bf16x8 Qf[4];
#pragma unroll
        for (int s = 0; s < 4; ++s) Qf[s] = *(const bf16x8*)(prow + C_Q + g * 256 + hpg * 64 + 16 * s + 8 * hi);
        f32x16 Oo0, Oo1;
        const int hh = g * 4 + hpg; const float g0 = sigmf(bf2f(prow[C_GL + hh * 3 + 0])), g1 = sigmf(bf2f(prow[C_GL + hh * 3 + 1])), g2 = sigmf(bf2f(prow[C_GL + hh * 3 + 2]));
        Stage st;
        const bf16_t* kcg = a.kcb + (size_t)bg * 256 * 64; const bf16_t* vcg = a.vcT + (size_t)bg * 64 * 256;
        const int nbc = (4 * qb + 3 + 63) >> 6;
        const int cmax = t >= 31 ? (t - 31) >> 4 : -1;
        float mc = -INFINITY, lc = 0.f;
        __syncthreads();
        stage_issue(st, kcg, 64, vcg, 256, tid); stage_write(st, lds, tid); __syncthreads();
        for (int kb = 0; kb < nbc; ++kb) {
            NLAS char* buf = lds + (kb & 1) * BUF_B;
            if (kb + 1 < nbc) stage_issue(st, kcg + (size_t)(kb + 1) * 64 * 64, 64, vcg + (kb + 1) * 64, 256, tid);
            f32x16 S0, S1; compute_S(buf, Qf, S0, S1, lane); mask_S(S0, S1, 0, cmax - 64 * kb, lane);
            const float mt = max_S(S0, S1), mn = fmaxf(mc, mt), ms = mn == -INFINITY ? 0.f : mn, al = __builtin_amdgcn_exp2f((mc - ms) * L2E);
            lc = lc * al + exp_S(S0, S1, ms * L2E, 1.f); mc = mn;
            if (kb + 1 < nbc) stage_write(st, lds + ((kb + 1) & 1) * BUF_B, tid);
            __syncthreads();
        }
        lc += __shfl_xor(lc, 32);
        const float mLc = (mc == -INFINITY ? 0.f : mc) * L2E, ilc = lc > 0.f ? 1.f / lc : 0.f;
        f32x16 Oc0, Oc1, Z0, Z1;
#pragma unroll
        for (int i = 0; i < 16; ++i) { Oc0[i] = 0.f; Oc1[i] = 0.f; Z0[i] = 0.f; Z1[i] = 0.f; }
        stage_issue(st, kcg, 64, vcg, 256, tid); stage_write(st, lds, tid); __syncthreads();
        for (int kb = 0; kb < nbc; ++kb) {
            NLAS char* buf = lds + (kb & 1) * BUF_B;
            if (kb + 1 < nbc) stage_issue(st, kcg + (size_t)(kb + 1) * 64 * 64, 64, vcg + (kb + 1) * 64, 256, tid);
            f32x16 S0, S1; compute_S(buf, Qf, S0, S1, lane); mask_S(S0, S1, 0, cmax - 64 * kb, lane);
            (void)exp_S(S0, S1, mLc, ilc);
            bf16x8 Pf[4]; pack_P(S0, S1, 0xffffffffu, Pf);
            pv(buf, Pf, Oc0, Oc1, lane);
#pragma unroll
            for (int s2 = 0; s2 < 4; ++s2) {
#pragma unroll
                for (int stl = 0; stl < 2; ++stl) { const int sblk = 32 * stl + r; u32x4 wv;
#pragma unroll
                    for (int q = 0; q < 4; ++q) { unsigned x = 0u;
#pragma unroll
                        for (int e = 0; e < 2; ++e) { const int j = q * 2 + e, c = 64 * kb + 16 * s2 + 8 * (j >> 2) + 4 * hi + (j & 3); if (c >= 4 * sblk - 1 && c <= 4 * sblk + 3) x |= (0x3f80u << (16 * e)); }
                        wv[q] = x; }
                    if (stl == 0) Z0 = __builtin_amdgcn_mfma_f32_32x32x16_bf16(Pf[s2], __builtin_bit_cast(bf16x8, wv), Z0, 0, 0, 0);
                    else          Z1 = __builtin_amdgcn_mfma_f32_32x32x16_bf16(Pf[s2], __builtin_bit_cast(bf16x8, wv), Z1, 0, 0, 0); } }
            if (kb + 1 < nbc) stage_write(st, lds + ((kb + 1) & 1) * BUF_B, tid);
            __syncthreads();
        }
#pragma unroll
        for (int i = 0; i < 16; ++i) { Oo0[i] = g0 * Oc0[i]; Oo1[i] = g0 * Oc1[i]; }
#pragma unroll
        for (int q4 = 0; q4 < 4; ++q4) { impw[(2 * q4 + hi) * 64 + r] = (Z0[4 * q4] + Z0[4 * q4 + 1]) + (Z0[4 * q4 + 2] + Z0[4 * q4 + 3]); impw[(2 * q4 + hi) * 64 + 32 + r] = (Z1[4 * q4] + Z1[4 * q4 + 1]) + (Z1[4 * q4 + 2] + Z1[4 * q4 + 3]); }
        __syncthreads();
        unsigned long long wu = 0ull;
        for (int q = 0; q < 8; ++q) { const float imp = impw[q * 64 + lane];
            const bool valid = lane <= qb, forced = lane == 0 || lane == qb || lane == qb - 1; const float val = valid ? (forced ? 1e9f : imp) : -1e30f; int rank = 0;
#pragma unroll
            for (int s2 = 0; s2 < 64; ++s2) { const float v2 = __builtin_bit_cast(float, __builtin_amdgcn_readlane(__builtin_bit_cast(int, val), s2)); rank += (v2 > val || (v2 == val && s2 < lane)) ? 1 : 0; }
            const unsigned long long mk = __ballot(valid && rank < 16); wu |= mk;
            if (lane == 0) selm[8 * w + q] = mk; }
        if (lane == 0) wun[w] = wu;
        __syncthreads();
        unsigned long long um = 0ull;
#pragma unroll
        for (int q = 0; q < 8; ++q) um |= wun[q];
        um = ((unsigned long long)__builtin_amdgcn_readfirstlane((unsigned)(um >> 32)) << 32) | (unsigned)__builtin_amdgcn_readfirstlane((unsigned)um);
        const unsigned long long mq = selm[tq];
        {
            const bf16_t* kg = proj + (size_t)b * SEQ * DINP + C_KS + g * 64; const bf16_t* vg = a.VsT + (size_t)bg * 64 * SEQ;
            f32x16 O0, O1;
#pragma unroll
            for (int i = 0; i < 16; ++i) { O0[i] = 0.f; O1[i] = 0.f; }
            float m = -INFINITY, l = 0.f;
            unsigned long long rem = um; int j = __builtin_ctzll(rem); rem &= rem - 1; int cb = 0;
            stage_issue(st, kg + (size_t)j * 64 * DINP, DINP, vg + j * 64, SEQ, tid); stage_write(st, lds, tid); __syncthreads();
            for (;;) {
                const int jn = rem ? __builtin_ctzll(rem) : -1; if (rem) rem &= rem - 1;
                if (jn >= 0) stage_issue(st, kg + (size_t)jn * 64 * DINP, DINP, vg + jn * 64, SEQ, tid);
                online_block(lds + cb * BUF_B, Qf, O0, O1, m, l, (mq >> j) & 1ull, j == qb, 0, tq, lane);
                if (jn >= 0) stage_write(st, lds + (cb ^ 1) * BUF_B, tid);
                __syncthreads();
                if (jn < 0) break;
                j = jn; cb ^= 1;
            }
            l += __shfl_xor(l, 32); const float sc = l > 0.f ? g1 / l : 0.f;
#pragma unroll
            for (int i = 0; i < 16; ++i) { Oo0[i] += sc * O0[i]; Oo1[i] += sc * O1[i]; }
        }
        {
            const bf16_t* kg = proj + (size_t)b * SEQ * DINP + C_KW + g * 64; const bf16_t* vg = a.VwT + (size_t)bg * 64 * SEQ;
            f32x16 O0, O1;
#pragma unroll
            for (int i = 0; i < 16; ++i) { O0[i] = 0.f; O1[i] = 0.f; }
            float m = -INFINITY, l = 0.f;
            const int jlo = qb - 8 > 0 ? qb - 8 : 0; int cb = 0;
            stage_issue(st, kg + (size_t)jlo * 64 * DINP, DINP, vg + jlo * 64, SEQ, tid); stage_write(st, lds, tid); __syncthreads();
            for (int j = jlo; j <= qb; ++j) {
                if (j < qb) stage_issue(st, kg + (size_t)(j + 1) * 64 * DINP, DINP, vg + (j + 1) * 64, SEQ, tid);
                const bool first = (j == qb - 8), diag = (j == qb);
                online_block(lds + cb * BUF_B, Qf, O0, O1, m, l, true, first || diag, first ? tq + 1 : 0, diag ? tq : 63, lane);
                if (j < qb) stage_write(st, lds + (cb ^ 1) * BUF_B, tid);
                __syncthreads();
                cb ^= 1;
            }
            l += __shfl_xor(l, 32); const float sc = l > 0.f ? g2 / l : 0.f;
#pragma unroll
            for (int i = 0; i < 16; ++i) { Oo0[i] += sc * O0[i]; Oo1[i] += sc * O1[i]; }
        }
        bf16_t* op = a.ocat + row * DM + hh * 64 + 4 * hi;
#pragma unroll
        for (int q4 = 0; q4 < 4; ++q4) { u32x2 w0, w1; w0.x = pk2(Oo0[4 * q4], Oo0[4 * q4 + 1]); w0.y = pk2(Oo0[4 * q4 + 2], Oo0[4 * q4 + 3]); w1.x = pk2(Oo1[4 * q4], Oo1[4 * q4 + 1]); w1.y = pk2(Oo1[4 * q4 + 2], Oo1[4 * q4 + 3]);
            *(u32x2*)(op + 8 * q4) = w0; *(u32x2*)(op + 32 + 8 * q4) = w1; }
    }
}

__device__ __forceinline__ void ph_vtrans(const Args& a, LAS char* lds_, int vcu, int G) {
    int tid = threadIdx.x; asm volatile("" : "+v"(tid)); asm volatile("" : "+s"(vcu));
    LAS bf16_t* tile = (LAS bf16_t*)lds_;
    for (int u = vcu; u < 2 * 16 * 64; u += G) { const int tb = u & 63, bg = (u >> 6) & 15, which = u >> 10, b = bg >> 1, g = bg & 1;
        const bf16_t* src = a.proj + ((size_t)b * SEQ + tb * 64) * DINP + (which ? C_VW : C_VS) + g * 64; bf16_t* dst = (which ? a.VwT : a.VsT) + (size_t)bg * 64 * SEQ + tb * 64;
        const int r = tid >> 3, c = (tid & 7) * 8;
        const uint4 v = *(const uint4*)(src + (size_t)r * DINP + c); const unsigned wv[4] = {v.x, v.y, v.z, v.w};
        __syncthreads();
#pragma unroll
        for (int e = 0; e < 4; ++e) { tile[(c + 2 * e) * 72 + r] = (bf16_t)(wv[e] & 0xffffu); tile[(c + 2 * e + 1) * 72 + r] = (bf16_t)(wv[e] >> 16); }
        __syncthreads();
        *(u32x4_t*)(dst + (size_t)r * SEQ + c) = *(const LAS u32x4_t*)(tile + r * 72 + c);
    }
}

__device__ __forceinline__ void ph_conv_naive(const Args& a, int l, LAS char* lds, int vcu, int G) {
    int tid_ = threadIdx.x; asm volatile("" : "+v"(tid_)); asm volatile("" : "+s"(vcu));
    const int half = tid_ >> 8, c = tid_ & 255; LAS float* hs = (LAS float*)(lds + half * 63488);
    const float* cw = a.conv_w + (size_t)l * 31 * 256; const float* lg = a.conv_lg + l * 256; const float* lb = a.conv_lb + l * 256;
    float w[31];
#pragma unroll
    for (int k = 0; k < 31; ++k) w[k] = cw[k * 256 + c];
    const float bias = a.conv_b[l * 256 + c];
    for (int unit = vcu; unit < NTOK / 64; unit += G) {
        const int tile = unit * 2 + half, b = tile >> 7, t0 = (tile & 127) * 32;
        __syncthreads();
        for (int i = 0; i < 62; ++i) { const int t = t0 - 30 + i; float v = 0.f;
            if (t >= 0) { const bf16_t* p = a.proj + ((size_t)b * SEQ + t) * DINP + C_CONV; v = bf2f(p[c]) * sigmf(bf2f(p[256 + c])); }
            hs[i * 256 + c] = v; }
        __syncthreads();
        float outv[32];
#pragma unroll
        for (int tt = 0; tt < 32; ++tt) { float s = bias;
#pragma unroll
            for (int k = 0; k < 31; ++k) s += hs[(tt + k) * 256 + c] * w[k];
            outv[tt] = s; }
        __syncthreads();
#pragma unroll
        for (int tt = 0; tt < 32; ++tt) hs[tt * 256 + c] = outv[tt];
        __syncthreads();
        const int wave = c >> 6, lane = c & 63;
        for (int tt = wave; tt < 32; tt += 4) { float v[4], s = 0.f;
#pragma unroll
            for (int i = 0; i < 4; ++i) { v[i] = hs[tt * 256 + lane + 64 * i]; s += v[i]; }
            const float mu = wsum(s) * (1.f / 256.f); float q = 0.f;
#pragma unroll
            for (int i = 0; i < 4; ++i) q += (v[i] - mu) * (v[i] - mu);
            const float rs = rsqrtf(wsum(q) * (1.f / 256.f) + 1e-5f);
#pragma unroll
            for (int i = 0; i < 4; ++i) { const int ch = lane + 64 * i; const float y = (v[i] - mu) * rs * lg[ch] + lb[ch]; a.hconv[((size_t)b * SEQ + t0 + tt) * 256 + ch] = f2bf(siluf(y)); } }
    }
}


namespace ret {
using nsa::f32x16; using nsa::u32x4; using nsa::u32x2; using nsa::pk2;
__device__ __forceinline__ float lg2g(int h) { return log2f(1.f - exp2f(-5.f - (float)h)); }
}
__device__ __forceinline__ void ph_ret_prep(const Args& a, LAS char* lds, int vcu, int G) {
    int tid = threadIdx.x; asm volatile("" : "+v"(tid)); asm volatile("" : "+s"(vcu));
    LAS bf16_t* tK = (LAS bf16_t*)lds; LAS bf16_t* tV = (LAS bf16_t*)(lds + 256 * 72 * 2);
    for (int u = vcu; u < NB * 64; u += G) { const int b = u >> 6, tb = u & 63;
        __syncthreads();
#pragma unroll
        for (int it = 0; it < 2; ++it) { const int item = tid + NT * it, tok = item >> 4, h = (item >> 2) & 3, ch = item & 3; const int pos = tb * 64 + tok; const size_t row = (size_t)b * SEQ + pos;
            const bf16_t* p = a.proj + row * DINP; const int c0 = h * 64 + 8 * ch;
            const u32x4_t ql = *(const u32x4_t*)(p + C_RQ + c0), qh = *(const u32x4_t*)(p + C_RQ + c0 + 32), kl = *(const u32x4_t*)(p + C_RK + c0), kh = *(const u32x4_t*)(p + C_RK + c0 + 32);
            const u32x4_t vl = *(const u32x4_t*)(p + C_RV + c0), vh = *(const u32x4_t*)(p + C_RV + c0 + 32);
            const float* cs = a.rot + ((size_t)pos * 32 + 8 * ch) * 2; float co[8], si[8];
#pragma unroll
            for (int e = 0; e < 4; ++e) { const f32x4 t4 = *(const f32x4*)(cs + 4 * e); co[2 * e] = t4[0]; si[2 * e] = t4[1]; co[2 * e + 1] = t4[2]; si[2 * e + 1] = t4[3]; }
            const float zeta = exp2f((float)(127 - (pos & 127)) * ret::lg2g(h));
            u32x4_t oql, oqh, okl, okh;
#pragma unroll
            for (int e2 = 0; e2 < 4; ++e2) { float r1[2], r2[2], k1[2], k2[2];
#pragma unroll
                for (int e1 = 0; e1 < 2; ++e1) { const int e = e2 * 2 + e1; const float x1 = __uint_as_float(e1 ? (ql[e2] & 0xffff0000u) : (ql[e2] << 16)), x2 = __uint_as_float(e1 ? (qh[e2] & 0xffff0000u) : (qh[e2] << 16));
                    const float y1 = __uint_as_float(e1 ? (kl[e2] & 0xffff0000u) : (kl[e2] << 16)), y2 = __uint_as_float(e1 ? (kh[e2] & 0xffff0000u) : (kh[e2] << 16));
                    r1[e1] = x1 * co[e] - x2 * si[e]; r2[e1] = x1 * si[e] + x2 * co[e]; k1[e1] = y1 * co[e] - y2 * si[e]; k2[e1] = y1 * si[e] + y2 * co[e];
                    tK[(c0 + e) * 72 + tok] = f2bf(k1[e1] * zeta); tK[(c0 + 32 + e) * 72 + tok] = f2bf(k2[e1] * zeta);
                    tV[(c0 + e) * 72 + tok] = (bf16_t)(e1 ? (vl[e2] >> 16) : (vl[e2] & 0xffffu)); tV[(c0 + 32 + e) * 72 + tok] = (bf16_t)(e1 ? (vh[e2] >> 16) : (vh[e2] & 0xffffu)); }
                oql[e2] = nsa::pk2(r1[0], r1[1]); oqh[e2] = nsa::pk2(r2[0], r2[1]); okl[e2] = nsa::pk2(k1[0], k1[1]); okh[e2] = nsa::pk2(k2[0], k2[1]); }
            *(u32x4_t*)(a.qrb + row * 256 + c0) = oql; *(u32x4_t*)(a.qrb + row * 256 + c0 + 32) = oqh; *(u32x4_t*)(a.krb + row * 256 + c0) = okl; *(u32x4_t*)(a.krb + row * 256 + c0 + 32) = okh; }
        __syncthreads();
#pragma unroll
        for (int it = 0; it < 4; ++it) { const int q = tid + NT * it, ri = q >> 3, cc = (q & 7) * 8; const size_t o = ((size_t)b * 256 + ri) * SEQ + tb * 64 + cc;
            *(u32x4_t*)(a.KzT + o) = *(const LAS u32x4_t*)(tK + ri * 72 + cc); *(u32x4_t*)(a.VrT + o) = *(const LAS u32x4_t*)(tV + ri * 72 + cc); }
    }
}
__device__ __forceinline__ void ph_ret_state(const Args& a, int vcu, int G) {
    using namespace ret;
    int tid = threadIdx.x; asm volatile("" : "+v"(tid)); asm volatile("" : "+s"(vcu));
    const int w = tid >> 6, lane = tid & 63, hi = lane >> 5, r = lane & 31;
    if (w >= 4) return;
    for (int u = vcu; u < 32; u += G) { const int h = u & 3, et = w >> 1, dt = w & 1; const float gc = exp2f(128.f * lg2g(h));
        const bf16_t* va = a.VrT + ((size_t)u * 64 + 32 * et + r) * SEQ + 8 * hi; const bf16_t* kb = a.KzT + ((size_t)u * 64 + 32 * dt + r) * SEQ + 8 * hi;
        f32x16 S;
#pragma unroll
        for (int i = 0; i < 16; ++i) S[i] = 0.f;
        bf16x8 A[8], B[8];
#pragma unroll
        for (int s2 = 0; s2 < 8; ++s2) { A[s2] = *(const bf16x8*)(va + 16 * s2); B[s2] = *(const bf16x8*)(kb + 16 * s2); }
        for (int c = 0; c < 32; ++c) {
            bf16_t* sp = a.ST + (((size_t)u * 32 + c) * 64 + 32 * et + 4 * hi) * 64 + 32 * dt + r;
#pragma unroll
            for (int i = 0; i < 16; ++i) sp[((i & 3) + 8 * (i >> 2)) * 64] = f2bf(S[i]);
            f32x16 KV;
#pragma unroll
            for (int i = 0; i < 16; ++i) KV[i] = 0.f;
            bf16x8 An[8], Bn[8]; const int cn = c < 31 ? c + 1 : c;
#pragma unroll
            for (int s2 = 0; s2 < 8; ++s2) { An[s2] = *(const bf16x8*)(va + cn * 128 + 16 * s2); Bn[s2] = *(const bf16x8*)(kb + cn * 128 + 16 * s2); }
#pragma unroll
            for (int s2 = 0; s2 < 8; ++s2) KV = __builtin_amdgcn_mfma_f32_32x32x16_bf16(A[s2], B[s2], KV, 0, 0, 0);
#pragma unroll
            for (int i = 0; i < 16; ++i) S[i] = gc * S[i] + KV[i];
#pragma unroll
            for (int s2 = 0; s2 < 8; ++s2) { A[s2] = An[s2]; B[s2] = Bn[s2]; }
        }
    }
}
__device__ __forceinline__ void ph_ret_out(const Args& a, int l, int vcu, int G) {
    using namespace ret;
    int tid = threadIdx.x; asm volatile("" : "+v"(tid)); asm volatile("" : "+s"(vcu));
    const int w = tid >> 6, lane = tid & 63, hi = lane >> 5, r = lane & 31, h = w >> 1, qh = w & 1;
    const float lg = lg2g(h); const float* gn = a.ret_gn + l * 256 + h * 64;
    for (int u = vcu; u < NB * 32; u += G) { const int b = u >> 5, c = u & 31, bh = b * 4 + h;
        const bf16_t* stp = a.ST + ((size_t)bh * 32 + c) * 4096; const bf16_t* vt = a.VrT + (size_t)bh * 64 * SEQ + c * 128;
#pragma unroll 1
        for (int qt = 0; qt < 2; ++qt) { const int q = 2 * qh + qt; const size_t row = (size_t)b * SEQ + c * 128 + 32 * q + r;
            bf16x8 Qf[4];
#pragma unroll
            for (int s = 0; s < 4; ++s) Qf[s] = *(const bf16x8*)(a.qrb + row * 256 + h * 64 + 16 * s + 8 * hi);
            f32x16 O0, O1;
#pragma unroll
            for (int i = 0; i < 16; ++i) { O0[i] = 0.f; O1[i] = 0.f; }
#pragma unroll
            for (int s = 0; s < 4; ++s) { const bf16x8 a0 = *(const bf16x8*)(stp + r * 64 + 16 * s + 8 * hi), a1 = *(const bf16x8*)(stp + (32 + r) * 64 + 16 * s + 8 * hi);
                O0 = __builtin_amdgcn_mfma_f32_32x32x16_bf16(a0, Qf[s], O0, 0, 0, 0); O1 = __builtin_amdgcn_mfma_f32_32x32x16_bf16(a1, Qf[s], O1, 0, 0, 0); }
            const float xi = exp2f((float)(32 * q + r + 1) * lg);
#pragma unroll
            for (int i = 0; i < 16; ++i) { O0[i] *= xi; O1[i] *= xi; }
            for (int kt = 0; kt <= q; ++kt) { const size_t krow = (size_t)b * SEQ + c * 128 + 32 * kt + r;
                f32x16 S;
#pragma unroll
                for (int i = 0; i < 16; ++i) S[i] = 0.f;
#pragma unroll
                for (int s = 0; s < 4; ++s) { const bf16x8 ka = *(const bf16x8*)(a.krb + krow * 256 + h * 64 + 16 * s + 8 * hi); S = __builtin_amdgcn_mfma_f32_32x32x16_bf16(ka, Qf[s], S, 0, 0, 0); }
                const int dbase = 32 * (q - kt) + r - 4 * hi;
#pragma unroll
                for (int i = 0; i < 16; ++i) { const int dl = dbase - ((i & 3) + 8 * (i >> 2)); S[i] = dl >= 0 ? S[i] * exp2f((float)dl * lg) : 0.f; }
#pragma unroll
                for (int s2 = 0; s2 < 2; ++s2) { u32x4 pw;
#pragma unroll
                    for (int x = 0; x < 4; ++x) pw[x] = pk2(S[8 * s2 + 2 * x], S[8 * s2 + 2 * x + 1]);
                    const bf16x8 Pf = __builtin_bit_cast(bf16x8, pw);
                    const bf16_t* v0 = vt + (size_t)r * SEQ + 32 * kt + 16 * s2 + 4 * hi; const bf16_t* v1 = v0 + (size_t)32 * SEQ;
                    const u32x2 x0 = *(const u32x2*)v0, y0 = *(const u32x2*)(v0 + 8), x1 = *(const u32x2*)v1, y1 = *(const u32x2*)(v1 + 8);
                    O0 = __builtin_amdgcn_mfma_f32_32x32x16_bf16(__builtin_bit_cast(bf16x8, (u32x4){x0.x, x0.y, y0.x, y0.y}), Pf, O0, 0, 0, 0);
                    O1 = __builtin_amdgcn_mfma_f32_32x32x16_bf16(__builtin_bit_cast(bf16x8, (u32x4){x1.x, x1.y, y1.x, y1.y}), Pf, O1, 0, 0, 0); }
            }
            float sm = 0.f;
#pragma unroll
            for (int i = 0; i < 16; ++i) sm += O0[i] + O1[i];
            sm += __shfl_xor(sm, 32); const float mu = sm * (1.f / 64.f); float vq = 0.f;
#pragma unroll
            for (int i = 0; i < 16; ++i) { const float d0 = O0[i] - mu, d1 = O1[i] - mu; vq += d0 * d0 + d1 * d1; }
            vq += __shfl_xor(vq, 32); const float rs = rsqrtf(vq * (1.f / 64.f) + 1e-5f);
            const bf16_t* gp = a.proj + row * DINP + C_RG + h * 64 + 4 * hi; bf16_t* op = a.ocat + row * DM + 768 + h * 64 + 4 * hi;
#pragma unroll
            for (int q4 = 0; q4 < 4; ++q4) {
#pragma unroll
                for (int et = 0; et < 2; ++et) { const int e0 = 32 * et + 8 * q4; const u32x2 gt = *(const u32x2*)(gp + e0); const f32x4 gg = *(const f32x4*)(gn + e0 + 4 * hi);
                    float o[4];
#pragma unroll
                    for (int x = 0; x < 4; ++x) { const float ov = et ? O1[4 * q4 + x] : O0[4 * q4 + x]; const unsigned gw = x < 2 ? gt.x : gt.y; const float gv = __uint_as_float((x & 1) ? (gw & 0xffff0000u) : (gw << 16));
                        o[x] = siluf(gv) * (ov - mu) * rs * gg[x]; }
                    u32x2 ow; ow.x = pk2(o[0], o[1]); ow.y = pk2(o[2], o[3]); *(u32x2*)(op + e0) = ow; } }
        }
    }
}

__device__ __forceinline__ void ph_route(const Args& a, int vcu, int G) {
    int tid_ = threadIdx.x; asm volatile("" : "+v"(tid_)); asm volatile("" : "+s"(vcu));
    const int lane = tid_ & 63; const float* g = a.ln_ffn + DM;
    for (int row = vcu * NW + (tid_ >> 6); row < NTOK; row += G * NW) { float lg[8];
#pragma unroll
        for (int e = 0; e < 8; ++e) lg[e] = 0.f;
        for (int k = lane; k < DM; k += 64) { const float xv = a.xres[(size_t)row * DM + k] * g[k];
#pragma unroll
            for (int e = 0; e < 8; ++e) lg[e] += xv * a.router[k * 8 + e]; }
        const float rs = row_rstd(a.ssq, row);
#pragma unroll
        for (int e = 0; e < 8; ++e) lg[e] = wsum(lg[e]) * rs;
        int e1 = 0; float v1 = lg[0];
#pragma unroll
        for (int e = 1; e < 8; ++e) if (lg[e] > v1) { v1 = lg[e]; e1 = e; }
        int e2 = -1; float v2 = -INFINITY;
#pragma unroll
        for (int e = 0; e < 8; ++e) if (e != e1 && lg[e] > v2) { v2 = lg[e]; e2 = e; }
        if (lane == 0) { const float g1 = 1.f / (1.f + __expf(v2 - v1)); a.gate[row * 2] = g1; a.gate[row * 2 + 1] = 1.f - g1;
            const int i1 = atomicAdd(&a.cnt[e1], 1); a.tok_list[e1 * NTOK + i1] = row * 2; const int i2 = atomicAdd(&a.cnt[e2], 1); a.tok_list[e2 * NTOK + i2] = row * 2 + 1; } }
}
__device__ __forceinline__ void ph_route_build(const Args& a, int vcu, int G) {
    int tid_ = threadIdx.x; asm volatile("" : "+v"(tid_)); asm volatile("" : "+s"(vcu));
    for (int idx = vcu * NT + tid_; idx < NEXP * NTOK; idx += G * NT) { const int e = idx >> 15, i = idx & (NTOK - 1);
        int ps = 0; for (int q = 0; q < e; ++q) ps += (a.cnt[q] + 255) & ~255;
        const int ce = a.cnt[e], pe = (ce + 255) & ~255;
        if (i < ce) { const int en = a.tok_list[e * NTOK + i]; a.row_tok[ps + i] = en >> 1; a.slot[en] = ps + i; } else if (i < pe) a.row_tok[ps + i] = -1;
        if (i < pe && (i & 255) == 0) a.tile_exp[(ps + i) >> 8] = e;
        if (idx == 0) { int tot = 0; for (int q = 0; q < 8; ++q) tot += (a.cnt[q] + 255) & ~255; a.meta[0] = tot >> 8; } }
}
__device__ __forceinline__ void ph_final(const Args& a, int vcu, int G) {
    int tid_ = threadIdx.x; asm volatile("" : "+v"(tid_)); asm volatile("" : "+s"(vcu));
    const int lane = tid_ & 63; float* xio = a.xres;
    for (int row = vcu * NW + (tid_ >> 6); row < NTOK; row += G * NW) { const int s1 = a.slot[row * 2], s2 = a.slot[row * 2 + 1]; const float g1 = a.gate[row * 2], g2 = a.gate[row * 2 + 1];
        float v[16]; float ss = 0.f;
#pragma unroll
        for (int i = 0; i < 4; ++i) { const int c = lane * 4 + i * 256; const float4 xv = *(const float4*)(xio + (size_t)row * DM + c);
            const ushort4 p = *(const ushort4*)(a.ysorted + (size_t)s1 * DM + c), q = *(const ushort4*)(a.ysorted + (size_t)s2 * DM + c);
            v[i * 4 + 0] = xv.x + g1 * bf2f(p.x) + g2 * bf2f(q.x); v[i * 4 + 1] = xv.y + g1 * bf2f(p.y) + g2 * bf2f(q.y);
            v[i * 4 + 2] = xv.z + g1 * bf2f(p.z) + g2 * bf2f(q.z); v[i * 4 + 3] = xv.w + g1 * bf2f(p.w) + g2 * bf2f(q.w);
#pragma unroll
            for (int j = 0; j < 4; ++j) ss += v[i * 4 + j] * v[i * 4 + j]; }
        const float rs = rsqrtf(wsum(ss) * (1.f / DM) + 1e-6f);
#pragma unroll
        for (int i = 0; i < 4; ++i) { const int c = lane * 4 + i * 256; const float4 gf = *(const float4*)(a.ln_final + c); float4 o; o.x = v[i * 4] * rs * gf.x; o.y = v[i * 4 + 1] * rs * gf.y; o.z = v[i * 4 + 2] * rs * gf.z; o.w = v[i * 4 + 3] * rs * gf.w;
            *(float4*)(xio + (size_t)row * DM + c) = o; } }
}

__global__ void __launch_bounds__(NT, 2) mega(Args a) {
    extern __shared__ __attribute__((aligned(16))) char lds[];
    volatile LAS unsigned* misc = (volatile LAS unsigned*)((LAS char*)lds + MISC_OFF);
    if (threadIdx.x < 64) misc[threadIdx.x] = 0u;
    __syncthreads();
    XcdBarrier bar = xcd_barrier_post(a.bar, misc);
    const int G = gridDim.x, vcu = blockIdx.x;
    LAS char* const lds3 = (LAS char*)lds;
#define GRID_BAR() xcd_barrier(bar)
#define AS4 __attribute__((address_space(4)))
#if defined(__HIP_DEVICE_COMPILE__)
#define LA const AS4 Args* ap_ = (const AS4 Args*)__builtin_amdgcn_kernarg_segment_ptr(); asm volatile("" : "+s"(ap_)); Args A; __builtin_memcpy(&A, ap_, sizeof(Args))
#else
#define LA const Args A = a
#endif

    { LA; ph_prologue(A, lds3, vcu, G); }
    GRID_BAR();
#pragma unroll
    for (int l = 0; l < 2; ++l) {
        { LA; pg8::Gemm g{A.xb, A.Win + (size_t)l * DINP * DM, NTOK, DINP, DM}; pg8::StaticOrder S; S.init(NTOK, DINP, G, vcu);
          pg8::gemm_phase<pg8::EIn, pg8::StaticOrder, false>((PG8_LAS unsigned char*)lds3, g, S, pg8::EIn{A.proj, A.ssq}, nullptr, nullptr, 0); }
        GRID_BAR();
#pragma unroll 1
        for (int kv = 0; kv < 2; ++kv) { const int i = l * 2 + kv;
            { LA; ph_gemm(lds3, ACmp{A.proj, kv ? C_VC : C_KC}, A.W1b + (size_t)i * 256 * 2048, 2048, EpiSiluBias{A.hc + (size_t)kv * 4096 * 256, A.bias1 + i * 256, 256}, SchedPlain{4096 / 256, 1}, (vcu + G - kv * 16) % G, G); } }
        { LA; ph_vtrans(A, lds3, vcu, G); }
        { LA; ph_conv_naive(A, l, lds3, vcu, G); }
        { LA; ph_ret_prep(A, lds3, vcu, G); }
        GRID_BAR();
        { LA; ph_gemm(lds3, APlain{A.hc, 256}, A.W2b + (size_t)(l * 2) * 256 * 256, 256, EpiStore{A.kcb, 64, 0, 64}, SchedPlain{4096 / 256, 1}, vcu, G); }
        { LA; ph_gemm(lds3, APlain{A.hc + (size_t)4096 * 256, 256}, A.W2b + (size_t)(l * 2 + 1) * 256 * 256, 256, EpiStoreT{A.vcT}, SchedPlain{4096 / 256, 1}, (vcu + G - 16) % G, G); }
        { LA; ph_gemm(lds3, APlain{A.hconv, 256}, A.Wpw + (size_t)l * 65536, 256, EpiStore{A.ocat, DM, 512, 256}, SchedPlain{NTOK / 256, 1}, (vcu + G - 32) % G, G); }
        { LA; ph_ret_state(A, (vcu + G - 64) % G, G); }
        GRID_BAR();
        { LA; ph_ret_out(A, l, vcu, G); }
        { LA; ph_nsa(A, lds3, vcu, G); }
        GRID_BAR();
        { LA; pg8::Gemm g{A.ocat, A.Wout + (size_t)l * DM * DM, NTOK, DM, DM}; pg8::StaticOrder S; S.init(NTOK, DM, G, vcu);
          pg8::gemm_phase<pg8::ERes, pg8::StaticOrder, false>((PG8_LAS unsigned char*)lds3, g, S, pg8::ERes{l == 0 ? A.x : A.xres, A.xres, A.xb, A.ssq}, nullptr, nullptr, 0); }
        GRID_BAR();
        if (l == 0) {
            { LA; pg8::Gemm g{A.xb, A.W13, NTOK, 2 * DFF, DM}; pg8::StaticOrder S; S.init(NTOK, 2 * DFF, G, vcu);
              pg8::gemm_phase<pg8::ESwiglu, pg8::StaticOrder, false>((PG8_LAS unsigned char*)lds3, g, S, pg8::ESwiglu{A.hbuf, A.ssq, nullptr}, nullptr, nullptr, 0); }
            GRID_BAR();
            { LA; pg8::Gemm g{A.hbuf, A.W2, NTOK, DM, DFF}; pg8::StaticOrder S; S.init(NTOK, DM, G, vcu);
              pg8::gemm_phase<pg8::ERes, pg8::StaticOrder, false>((PG8_LAS unsigned char*)lds3, g, S, pg8::ERes{A.xres, A.xres, A.xb, A.ssq}, nullptr, nullptr, 0); }
            GRID_BAR();
        }
    }
    { LA; ph_route(A, vcu, G); }
    GRID_BAR();
    { LA; ph_route_build(A, vcu, G); }
    GRID_BAR();
    { LA; const int Mm = A.meta[0] * 256; pg8::Gemm g{A.xb, A.Wm13, Mm, 2 * DFF, DM}; pg8::StaticOrder S; S.init(Mm, 2 * DFF, G, vcu);
      pg8::gemm_phase<pg8::ESwiglu, pg8::StaticOrder, true>((PG8_LAS unsigned char*)lds3, g, S, pg8::ESwiglu{A.hbuf, A.ssq, A.row_tok}, A.row_tok, A.tile_exp, (size_t)2 * DFF * DM); }
    GRID_BAR();
    { LA; const int Mm = A.meta[0] * 256; pg8::Gemm g{A.hbuf, A.Wm2, Mm, DM, DFF}; pg8::StaticOrder S; S.init(Mm, DM, G, vcu);
      pg8::gemm_phase<pg8::EStore, pg8::StaticOrder, false>((PG8_LAS unsigned char*)lds3, g, S, pg8::EStore{A.ysorted, DM}, nullptr, A.tile_exp, (size_t)DM * DFF); }
    GRID_BAR();
    { LA; ph_final(A, vcu, G); }
}

static inline size_t al256(size_t x) { return (x + 255) & ~(size_t)255; }
extern "C" void kernel_launch(void* const* d_in, const int* in_sizes, int n_in, void* d_out, int out_size, void* d_ws, size_t ws_size, hipStream_t stream) {
    static int grid = 0;
    Args a{};
    const float** ins = (const float**)&a.x;
    for (int i = 0; i < 20; ++i) ins[i] = (const float*)d_in[i];
    a.xres = (float*)d_out;
    char* w = (char*)d_ws; size_t off = 0;
    auto take = [&](size_t bytes) { char* p = w + off; off = al256(off + bytes); return p; };
    a.bar = (unsigned*)take(XCD_BAR_WORDS * 4);
    a.cnt = (int*)take(256);
    a.meta = (int*)take(256);
    const size_t ctl_bytes = off;
    char* regY = w + off;
    a.Wm13 = (bf16_t*)take((size_t)NEXP * 2 * DFF * DM * 2);
    a.Win = (bf16_t*)take((size_t)2 * DINP * DM * 2);
    a.Wout = (bf16_t*)take((size_t)2 * DM * DM * 2);
    a.W13 = (bf16_t*)take((size_t)2 * DFF * DM * 2);
    a.W2 = (bf16_t*)take((size_t)DM * DFF * 2);
    a.xb = (bf16_t*)take((size_t)NTOK * DM * 2);
    a.ysorted = (bf16_t*)regY;
    a.Wm2 = (bf16_t*)take((size_t)NEXP * DM * DFF * 2);
    a.W1b = (bf16_t*)take((size_t)4 * 256 * 2048 * 2);
    a.W2b = (bf16_t*)take((size_t)4 * 256 * 256 * 2);
    a.Wpw = (bf16_t*)take((size_t)2 * 256 * 256 * 2);
    a.bias1 = (float*)take(4 * 256 * 4);
    a.rot = (float*)take((size_t)4096 * 32 * 2 * 4);
    a.ssq = (float*)take((size_t)NTOK * NSLOT * 4);
    a.tok_list = (int*)take((size_t)NEXP * NTOK * 4);
    a.row_tok = (int*)take((size_t)PMAX * 4);
    a.slot = (int*)take((size_t)NTOK * 2 * 4);
    a.tile_exp = (int*)take(1024 * 4);
    a.gate = (float*)take((size_t)NTOK * 2 * 4);
    char* regR = w + off;
    a.proj = (bf16_t*)take((size_t)NTOK * DINP * 2);
    a.ocat = (bf16_t*)take((size_t)NTOK * DM * 2);
    a.hc = (bf16_t*)take((size_t)2 * 4096 * 256 * 2);
    a.kcb = (bf16_t*)take((size_t)4096 * 64 * 2);
    a.vcb = (bf16_t*)take((size_t)4096 * 64 * 2);
    a.hconv = (bf16_t*)take((size_t)NTOK * 256 * 2);
    a.qr = (float*)take((size_t)NTOK * 256 * 4);
    a.kr = (float*)take((size_t)NTOK * 256 * 4);
    a.KV = (float*)take((size_t)1024 * 4096 * 4);
    a.Sst = (float*)take((size_t)1024 * 4096 * 4);
    a.vcT = (bf16_t*)take((size_t)16 * 64 * 256 * 2);
    a.VsT = (bf16_t*)take((size_t)16 * 64 * SEQ * 2);
    a.VwT = (bf16_t*)take((size_t)16 * 64 * SEQ * 2);
    a.qrb = (bf16_t*)take((size_t)NTOK * 256 * 2);
    a.krb = (bf16_t*)take((size_t)NTOK * 256 * 2);
    a.KzT = (bf16_t*)take((size_t)32 * 64 * SEQ * 2);
    a.VrT = (bf16_t*)take((size_t)32 * 64 * SEQ * 2);
    a.ST = (bf16_t*)take((size_t)32 * 32 * 4096 * 2);
    a.hbuf = (bf16_t*)regR;
    const size_t need = (size_t)(regR - w) + (size_t)PMAX * DFF * 2;
    if (grid == 0) {
        if (need > ws_size || off > ws_size || n_in != 20) { fprintf(stderr, "kernel_launch: workspace too small: need %zu / %zu have %zu\n", need, off, ws_size); grid = -1; return; }
        int dev = 0, cus = 0;
        if (hipGetDevice(&dev) != hipSuccess || hipDeviceGetAttribute(&cus, hipDeviceAttributeMultiprocessorCount, dev) != hipSuccess) { grid = -1; return; }
        if (hipFuncSetAttribute((const void*)mega, hipFuncAttributeMaxDynamicSharedMemorySize, LDS_BYTES) != hipSuccess) { fprintf(stderr, "kernel_launch: hipFuncSetAttribute failed\n"); grid = -1; return; }
        int per_cu = 0;
        if (hipOccupancyMaxActiveBlocksPerMultiprocessor(&per_cu, (const void*)mega, NT, LDS_BYTES) != hipSuccess || per_cu < 1) { fprintf(stderr, "kernel_launch: occupancy query says %d\n", per_cu); }
        (void)hipGetLastError();
        grid = cus;
    }
    if (grid < 0) return;
    (void)hipMemsetAsync(w, 0, ctl_bytes, stream);
    hipLaunchKernelGGL(mega, dim3(grid), dim3(NT), LDS_BYTES, stream, a);
}
```

```cpp
#include <hip/hip_runtime.h>
#include <stdint.h>
#include <stdio.h>

typedef unsigned short bf16_t;
typedef short bf16x8 __attribute__((ext_vector_type(8)));
typedef float f32x4 __attribute__((ext_vector_type(4)));
typedef unsigned u32x4_t __attribute__((ext_vector_type(4)));

constexpr int NTOK = 32768, DM = 1024, NB = 8, SEQ = 4096;
constexpr int DIN = 2840, DINP = 3072, DFF = 2816, NEXP = 8;
constexpr int C_Q = 0, C_KC = 512, C_VC = 640, C_KS = 768, C_VS = 896, C_KW = 1024, C_VW = 1152, C_GL = 1280,
              C_CONV = 1304, C_RQ = 1816, C_RK = 2072, C_RV = 2328, C_RG = 2584;
constexpr int NSLOT = 16;
constexpr int PMAX = 65536 + 8 * 256;
constexpr int NT = 512, NW = 8;
constexpr int LDS_BYTES = 144 * 1024, MISC_OFF = LDS_BYTES - 256;

#define XB_TMO      128
#define XB_XCNT(j)  (256  + 64 * (j))
#define XB_XSUB(j)  (1280 + 64 * (j))
#define XB_XGEN(j)  (2304 + 64 * (j))
#define XB_TOP      3328
#define XB_TOPGEN   3392
#define XCD_BAR_WORDS 3456
#define XB_SPIN_CAP (1u << 20)
#define LAS __attribute__((address_space(3)))
__device__ __forceinline__ unsigned xb_ld(unsigned* p)              { return __hip_atomic_load(p, __ATOMIC_RELAXED, __HIP_MEMORY_SCOPE_AGENT); }
__device__ __forceinline__ unsigned xb_add(unsigned* p, unsigned v) { return __hip_atomic_fetch_add(p, v, __ATOMIC_RELAXED, __HIP_MEMORY_SCOPE_AGENT); }
__device__ __forceinline__ unsigned xb_xcc_id() { return (unsigned)__builtin_amdgcn_s_getreg((3 << 11) | 20) & 0xFu; }
#define XB_SPIN(cond, bar) do { unsigned _sp = 0; while (cond) { __builtin_amdgcn_s_sleep(1); \
    if ((++_sp & 255u) == 0u) { if (xb_ld(&(bar)[XB_TMO])) break; if (_sp > XB_SPIN_CAP) { atomicAdd(&(bar)[XB_TMO], 1u); break; } } } } while (0)
struct XcdBarrier { unsigned* bar; unsigned x; volatile LAS unsigned* st; };
__device__ __forceinline__ XcdBarrier xcd_barrier_post(unsigned* bar, volatile LAS unsigned* st) {
    XcdBarrier b; b.bar = bar; b.x = xb_xcc_id(); b.st = st;
    if (threadIdx.x == 0) (void)xb_add(&bar[XB_XCNT(b.x)], 1u);
    return b;
}
__device__ __forceinline__ void xcd_barrier_complete(unsigned* bar, unsigned x, unsigned& nloc, unsigned& nx) {
    const unsigned G = gridDim.x * gridDim.y * gridDim.z;
    unsigned sum, cnt, mine, sp = 0u;
    for (;;) {
        sum = 0u; cnt = 0u; mine = 0u;
#pragma unroll
        for (unsigned j = 0; j < 16; ++j) { const unsigned c = xb_ld(&bar[XB_XCNT(j)]); sum += c; cnt += (c > 0u) ? 1u : 0u; mine = (j == x) ? c : mine; }
        if (sum == G) break;
        __builtin_amdgcn_s_sleep(1);
        if ((++sp & 255u) == 0u) { if (xb_ld(&bar[XB_TMO])) break; if (sp > XB_SPIN_CAP) { atomicAdd(&bar[XB_TMO], 1u); break; } }
    }
    nloc = mine > 0u ? mine : 1u; nx = cnt > 0u ? cnt : 1u;
}
__device__ __forceinline__ void xcd_barrier(const XcdBarrier& b) {
    asm volatile("s_waitcnt vmcnt(0)" ::: "memory");
    __syncthreads();
    if (threadIdx.x == 0) {
        unsigned* bar = b.bar;
        __builtin_amdgcn_s_waitcnt(0);
        const unsigned bx = xb_xcc_id();
        unsigned nloc = b.st[0], nx = b.st[1];
        if (nloc == 0u) { xcd_barrier_complete(bar, bx, nloc, nx); b.st[0] = nloc; b.st[1] = nx; }
        const unsigned old = xb_add(&bar[XB_XSUB(bx)], 1u);
        const unsigned gen = old / nloc;
        if (old + 1u == (gen + 1u) * nloc) {
            __builtin_amdgcn_fence(__ATOMIC_RELEASE, "agent");
            asm volatile("s_waitcnt vmcnt(0)" ::: "memory");
            const unsigned og = xb_add(&bar[XB_TOP], 1u);
            const unsigned tg = og / nx;
            if (og + 1u == (tg + 1u) * nx) xb_add(&bar[XB_TOPGEN], 1u);
            else XB_SPIN(xb_ld(&bar[XB_TOPGEN]) == tg, bar);
            __builtin_amdgcn_fence(__ATOMIC_ACQUIRE, "agent");
            xb_add(&bar[XB_XGEN(bx)], 1u);
            asm volatile("s_waitcnt vmcnt(0)" ::: "memory");
        } else {
            XB_SPIN(xb_ld(&bar[XB_XGEN(bx)]) == gen, bar);
            __builtin_amdgcn_fence(__ATOMIC_ACQUIRE, "agent");
            asm volatile("s_waitcnt vmcnt(0)" ::: "memory");
        }
    }
    __syncthreads();
}

__device__ __forceinline__ bf16_t f2bf(float f) { unsigned u = __float_as_uint(f); u += 0x7fffu + ((u >> 16) & 1u); return (bf16_t)(u >> 16); }
__device__ __forceinline__ unsigned pk2bf(float lo, float hi) { unsigned r; asm volatile("v_cvt_pk_bf16_f32 %0, %1, %2" : "=v"(r) : "v"(lo), "v"(hi)); return r; }
__device__ __forceinline__ float bf2f(bf16_t h) { return __uint_as_float(((unsigned)h) << 16); }
__device__ __forceinline__ float wsum(float v) {
#pragma unroll
    for (int o = 32; o > 0; o >>= 1) v += __shfl_xor(v, o);
    return v; }
__device__ __forceinline__ float wmax(float v) {
#pragma unroll
    for (int o = 32; o > 0; o >>= 1) v = fmaxf(v, __shfl_xor(v, o));
    return v; }
__device__ __forceinline__ float siluf(float x) { return x / (1.f + __expf(-x)); }
__device__ __forceinline__ float sigmf(float x) { return 1.f / (1.f + __expf(-x)); }
__device__ __forceinline__ float row_rstd(const float* ssq, int row) { float s = 0.f;
#pragma unroll
    for (int i = 0; i < NSLOT; ++i) s += ssq[(size_t)row * NSLOT + i];
    return rsqrtf(s * (1.f / DM) + 1e-6f); }

struct Args {
    const float *x, *ln_attn, *w_in, *cmp_pe, *cmp_w1, *cmp_w2, *conv_w, *conv_b, *conv_lg, *conv_lb, *conv_pw, *ret_gn, *w_out, *ln_ffn, *ffn_w13, *ffn_w2, *router, *moe_w13, *moe_w2, *ln_final;
    float* xres;
    bf16_t *Wm13, *Win, *Wout, *W13, *W2, *xb, *ysorted, *Wm2, *W1b, *W2b, *Wpw;
    float *bias1, *rot, *ssq; int *cnt, *meta, *tok_list, *row_tok, *slot, *tile_exp; float* gate;
    bf16_t *proj, *ocat, *hc, *kcb, *vcb, *hconv; float *qr, *kr, *KV, *Sst; bf16_t* hbuf; bf16_t *vcT, *VsT, *VwT, *qrb, *krb, *KzT, *VrT, *ST;
    unsigned* bar;
};

struct ConvJob { const float* src; bf16_t* dst; const float* g; int ldsrc, K, Npad, nvalid, mode, pad; };
__device__ __forceinline__ ConvJob get_job(const Args& a, int j) {
    ConvJob c; c.g = nullptr; c.mode = 0; c.pad = 0;
    if (j < 2) { c.src = a.w_in + (size_t)j * DM * DIN; c.dst = a.Win + (size_t)j * DINP * DM; c.g = a.ln_attn + j * DM; c.ldsrc = DIN; c.K = DM; c.Npad = DINP; c.nvalid = DIN; c.mode = 1; }
    else if (j < 4) { const int l = j - 2; c.src = a.w_out + (size_t)l * DM * DM; c.dst = a.Wout + (size_t)l * DM * DM; c.ldsrc = DM; c.K = DM; c.Npad = DM; c.nvalid = DM; }
    else if (j < 6) { const int l = j - 4; c.src = a.conv_pw + (size_t)l * 65536; c.dst = a.Wpw + (size_t)l * 65536; c.ldsrc = 256; c.K = 256; c.Npad = 256; c.nvalid = 256; }
    else if (j < 10) { const int i = j - 6; c.src = a.cmp_w1 + (size_t)i * 2048 * 256; c.dst = a.W1b + (size_t)i * 256 * 2048; c.ldsrc = 256; c.K = 2048; c.Npad = 256; c.nvalid = 256; }
    else if (j < 14) { const int i = j - 10; c.src = a.cmp_w2 + (size_t)i * 256 * 64; c.dst = a.W2b + (size_t)i * 256 * 256; c.ldsrc = 64; c.K = 256; c.Npad = 256; c.nvalid = 64; }
    else if (j == 14) { c.src = a.ffn_w13; c.dst = a.W13; c.g = a.ln_ffn; c.ldsrc = 2 * DFF; c.K = DM; c.Npad = 2 * DFF; c.nvalid = 2 * DFF; c.mode = 2; }
    else if (j == 15) { c.src = a.ffn_w2; c.dst = a.W2; c.ldsrc = DM; c.K = DFF; c.Npad = DM; c.nvalid = DM; }
    else if (j < 24) { const int e = j - 16; c.src = a.moe_w13 + (size_t)e * DM * 2 * DFF; c.dst = a.Wm13 + (size_t)e * 2 * DFF * DM; c.g = a.ln_ffn + DM; c.ldsrc = 2 * DFF; c.K = DM; c.Npad = 2 * DFF; c.nvalid = 2 * DFF; c.mode = 2; }
    else { const int e = j - 24; c.src = a.moe_w2 + (size_t)e * DFF * DM; c.dst = a.Wm2 + (size_t)e * DM * DFF; c.ldsrc = DM; c.K = DFF; c.Npad = DM; c.nvalid = DM; }
    return c;
}
constexpr int NJOBS = 32;
__device__ __forceinline__ void conv_super(const ConvJob& c, int st, LAS float* lt, int tid_) {
    const int nsn = c.Npad / 256, n0 = (st % nsn) * 256, k0 = (st / nsn) * 64, lane = tid_ & 63, wv = tid_ >> 6;
    float v[32];
#pragma unroll
    for (int q = 0; q < 4; ++q) { const int n = n0 + q * 64 + lane; int sc;
        if (c.mode == 2) { const int pn = n >> 8, i = n & 255; sc = i < 128 ? 128 * pn + i : DFF + 128 * pn + (i - 128); } else sc = n < c.nvalid ? n : -1;
#pragma unroll
        for (int i = 0; i < 8; ++i) v[q * 8 + i] = sc >= 0 ? c.src[(size_t)(k0 + wv + 8 * i) * c.ldsrc + sc] : 0.f; }
#pragma unroll
    for (int q = 0; q < 4; ++q)
#pragma unroll
        for (int i = 0; i < 8; ++i) lt[(wv + 8 * i) * 257 + q * 64 + lane] = v[q * 8 + i];
    __syncthreads();
    const int nl = tid_ >> 3, ch = tid_ & 7;
    float gs[8];
#pragma unroll
    for (int e = 0; e < 8; ++e) gs[e] = c.g ? c.g[k0 + 8 * ch + e] : 1.f;
#pragma unroll
    for (int q = 0; q < 4; ++q) { const int n = n0 + q * 64 + nl; const float cs = (c.mode == 1 && (n < 512 || (n >= C_RK && n < C_RV))) ? 0.125f : 1.f; float x[8];
#pragma unroll
        for (int e = 0; e < 8; ++e) x[e] = lt[(8 * ch + e) * 257 + q * 64 + nl] * gs[e] * cs;
        u32x4_t w; w.x = pk2bf(x[0], x[1]); w.y = pk2bf(x[2], x[3]); w.z = pk2bf(x[4], x[5]); w.w = pk2bf(x[6], x[7]);
        *(u32x4_t*)(c.dst + (size_t)n * c.K + k0 + 8 * ch) = w; }
    __syncthreads();
}
__device__ __forceinline__ void ph_prologue(const Args& a, LAS char* lds, int vcu, int G) {
    int tid_ = threadIdx.x; asm volatile("" : "+v"(tid_)); asm volatile("" : "+s"(vcu));
    LAS float* lt = (LAS float*)lds; int acc = 0;
    for (int j = 0; j < NJOBS; ++j) { const ConvJob c = get_job(a, j); const int nt = (c.Npad / 256) * (c.K / 64);
        int t0 = vcu - (acc % G); if (t0 < 0) t0 += G;
        for (int t = t0; t < nt; t += G) conv_super(c, t, lt, tid_);
        acc += nt; }
    for (int u = vcu; u < 16; u += G) { const int i = u >> 2, nl = tid_ & 63, kp = tid_ >> 6, n = (u & 3) * 64 + nl; float s = 0.f;
        const float* pe = a.cmp_pe + (size_t)i * 2048; const float* w1 = a.cmp_w1 + (size_t)i * 2048 * 256;
        for (int k = kp; k < 2048; k += NW) s += pe[k] * w1[(size_t)k * 256 + n];
        lt[kp * 64 + nl] = s; __syncthreads();
        if (kp == 0) { float t = 0.f; for (int q = 0; q < NW; ++q) t += lt[q * 64 + nl]; a.bias1[i * 256 + n] = t; }
        __syncthreads(); }
    for (int idx = vcu * NT + tid_; idx < 4096 * 32; idx += G * NT) { const int pos = idx >> 5, i = idx & 31; const float inv = powf(10000.f, -(float)i / 32.f), ang = (float)pos * inv;
        a.rot[idx * 2] = cosf(ang); a.rot[idx * 2 + 1] = sinf(ang); }
    const int lane = tid_ & 63;
    for (int row = vcu * NW + (tid_ >> 6); row < NTOK; row += G * NW) { float s = 0.f;
        for (int c = lane * 4; c < DM; c += 256) { const float4 v = *(const float4*)(a.x + (size_t)row * DM + c); s += v.x * v.x + v.y * v.y + v.z * v.z + v.w * v.w;
            ushort4 o; o.x = f2bf(v.x); o.y = f2bf(v.y); o.z = f2bf(v.z); o.w = f2bf(v.w); *(ushort4*)(a.xb + (size_t)row * DM + c) = o; }
        s = wsum(s); if (lane < NSLOT) a.ssq[(size_t)row * NSLOT + lane] = lane == 0 ? s : 0.f; }
}

struct APlain { const bf16_t* A; int lda; __device__ __forceinline__ const bf16_t* ptr(int row, int k) const { return A + (size_t)row * lda + k; } };
struct AGather { const bf16_t* A; const int* row_tok; int lda; __device__ __forceinline__ const bf16_t* ptr(int row, int k) const { const int t = row_tok[row]; return t < 0 ? nullptr : A + (size_t)t * lda + k; } };
struct ACmp { const bf16_t* proj; int coloff;
    __device__ __forceinline__ const bf16_t* ptr(int row, int k) const { const int c = row & 255, g = (row >> 8) & 1, b = row >> 9; if (c == 255) return nullptr;
        return proj + (size_t)(b * SEQ + 16 * c + (k >> 6)) * DINP + coloff + g * 64 + (k & 63); } };
struct SchedPlain { int nM, nN; __device__ __forceinline__ int count() const { return nM * nN; }
    __device__ __forceinline__ void get(int u, int& row0, int& col0, size_t& boff) const { row0 = (u / nN) * 256; col0 = (u % nN) * 256; boff = 0; } };
struct SchedMoe { const int* meta; const int* tile_exp; size_t estride; int nN;
    __device__ __forceinline__ int count() const { return meta[0] * nN; }
    __device__ __forceinline__ void get(int u, int& row0, int& col0, size_t& boff) const { row0 = (u / nN) * 256; col0 = (u % nN) * 256; boff = (size_t)tile_exp[row0 >> 8] * estride; } };

struct EpiIn { bf16_t* proj; const float* ssq;
    __device__ __forceinline__ void apply(const f32x4 (&acc)[2][16], int rowb, int col0, int lane) const {
#pragma unroll
        for (int mi = 0; mi < 2; ++mi)
#pragma unroll
            for (int r = 0; r < 4; ++r) { const int row = rowb + mi * 16 + (lane >> 4) * 4 + r; const float rs = row_rstd(ssq, row);
#pragma unroll
                for (int n = 0; n < 16; ++n) proj[(size_t)row * DINP + col0 + n * 16 + (lane & 15)] = f2bf(acc[mi][n][r] * rs); } } };
struct EpiRes { const float* xold; float* xnew; bf16_t* xb; float* ssq;
    __device__ __forceinline__ void apply(const f32x4 (&acc)[2][16], int rowb, int col0, int lane) const {
#pragma unroll
        for (int mi = 0; mi < 2; ++mi)
#pragma unroll
            for (int r = 0; r < 4; ++r) { const int row = rowb + mi * 16 + (lane >> 4) * 4 + r; float s = 0.f;
#pragma unroll
                for (int n = 0; n < 16; ++n) { const size_t o = (size_t)row * DM + col0 + n * 16 + (lane & 15); const float v = xold[o] + acc[mi][n][r]; xnew[o] = v; xb[o] = f2bf(v); s += v * v; }
                s += __shfl_xor(s, 1); s += __shfl_xor(s, 2); s += __shfl_xor(s, 4); s += __shfl_xor(s, 8);
                if ((lane & 15) < 4) ssq[(size_t)row * NSLOT + (col0 >> 8) * 4 + (lane & 15)] = (lane & 15) == 0 ? s : 0.f; } } };
struct EpiSwiglu { bf16_t* h; const float* ssq; const int* row_tok;
    __device__ __forceinline__ void apply(const f32x4 (&acc)[2][16], int rowb, int col0, int lane) const {
#pragma unroll
        for (int mi = 0; mi < 2; ++mi)
#pragma unroll
            for (int r = 0; r < 4; ++r) { const int row = rowb + mi * 16 + (lane >> 4) * 4 + r; const int t = row_tok ? row_tok[row] : row;
                const float rs = t < 0 ? 0.f : row_rstd(ssq, t < 0 ? 0 : t);
#pragma unroll
                for (int n = 0; n < 8; ++n) { const float av = acc[mi][n][r] * rs, bv = acc[mi][n + 8][r] * rs; h[(size_t)row * DFF + (col0 >> 1) + n * 16 + (lane & 15)] = f2bf(siluf(av) * bv); } } } };
struct EpiStore { bf16_t* out; int ldc, coloff, ncols;
    __device__ __forceinline__ void apply(const f32x4 (&acc)[2][16], int rowb, int col0, int lane) const {
#pragma unroll
        for (int mi = 0; mi < 2; ++mi)
#pragma unroll
            for (int r = 0; r < 4; ++r) { const int row = rowb + mi * 16 + (lane >> 4) * 4 + r;
#pragma unroll
                for (int n = 0; n < 16; ++n) { const int c = col0 + n * 16 + (lane & 15); if (c < ncols) out[(size_t)row * ldc + coloff + c] = f2bf(acc[mi][n][r]); } } } };
struct EpiStoreT { bf16_t* out;
    __device__ __forceinline__ void apply(const f32x4 (&acc)[2][16], int rowb, int col0, int lane) const {
#pragma unroll
        for (int mi = 0; mi < 2; ++mi)
#pragma unroll
            for (int r = 0; r < 4; ++r) { const int row = rowb + mi * 16 + (lane >> 4) * 4 + r;
#pragma unroll
                for (int n = 0; n < 4; ++n) { const int c = col0 + n * 16 + (lane & 15); out[(size_t)(row >> 8) * 16384 + c * 256 + (row & 255)] = f2bf(acc[mi][n][r]); } } } };
struct EpiSiluBias { bf16_t* out; const float* bias; int ldc;
    __device__ __forceinline__ void apply(const f32x4 (&acc)[2][16], int rowb, int col0, int lane) const {
#pragma unroll
        for (int mi = 0; mi < 2; ++mi)
#pragma unroll
            for (int r = 0; r < 4; ++r) { const int row = rowb + mi * 16 + (lane >> 4) * 4 + r;
#pragma unroll
                for (int n = 0; n < 16; ++n) { const int c = col0 + n * 16 + (lane & 15); out[(size_t)row * ldc + c] = f2bf(siluf(acc[mi][n][r] + bias[c])); } } } };

template <class AS, class Epi, class Sched>
__device__ __forceinline__ void ph_gemm(LAS char* lds, const AS as, const bf16_t* __restrict__ Bt, const int K, const Epi epi, const Sched sched, int vcu, int G) {
    int tid_ = threadIdx.x; asm volatile("" : "+v"(tid_)); asm volatile("" : "+s"(vcu));
    LAS bf16_t* sA = (LAS bf16_t*)lds; LAS bf16_t* sB = (LAS bf16_t*)(lds + 256 * 40 * 2);
    const int tid = tid_, wave = tid >> 6, lane = tid & 63;
    const int nunits = sched.count();
    for (int u = vcu; u < nunits; u += G) {
        int row0, col0; size_t boff; sched.get(u, row0, col0, boff);
        const bf16_t* Bu = Bt + boff;
        f32x4 acc[2][16];
#pragma unroll
        for (int mi = 0; mi < 2; ++mi)
#pragma unroll
            for (int n = 0; n < 16; ++n) acc[mi][n] = (f32x4){0.f, 0.f, 0.f, 0.f};
#pragma unroll 1
        for (int k0 = 0; k0 < K; k0 += 32) {
#pragma unroll
            for (int i = 0; i < 2; ++i) { const int c = tid + i * NT, r = c >> 2, kc = (c & 3) * 8; const bf16_t* p = as.ptr(row0 + r, k0 + kc);
                uint4 v = make_uint4(0u, 0u, 0u, 0u); if (p) v = *(const uint4*)p; *(LAS u32x4_t*)&sA[r * 40 + kc] = (u32x4_t){v.x, v.y, v.z, v.w}; }
#pragma unroll
            for (int i = 0; i < 2; ++i) { const int c = tid + i * NT, r = c >> 2, kc = (c & 3) * 8;
                *(LAS u32x4_t*)&sB[r * 40 + kc] = *(const u32x4_t*)(Bu + (size_t)(col0 + r) * K + k0 + kc); }
            __syncthreads();
            bf16x8 af[2];
#pragma unroll
            for (int mi = 0; mi < 2; ++mi) af[mi] = *(const LAS bf16x8*)&sA[(wave * 32 + mi * 16 + (lane & 15)) * 40 + (lane >> 4) * 8];
#pragma unroll
            for (int n = 0; n < 16; ++n) { const bf16x8 bfr = *(const LAS bf16x8*)&sB[(n * 16 + (lane & 15)) * 40 + (lane >> 4) * 8];
#pragma unroll
                for (int mi = 0; mi < 2; ++mi) acc[mi][n] = __builtin_amdgcn_mfma_f32_16x16x32_bf16(af[mi], bfr, acc[mi][n], 0, 0, 0); }
            __syncthreads();
        }
        epi.apply(acc, row0 + wave * 32, col0, lane);
    }
}


namespace pg8 {
#define PG8_LAS __attribute__((address_space(3)))
typedef unsigned u32x4 __attribute__((ext_vector_type(4)));
typedef unsigned u32x2 __attribute__((ext_vector_type(2)));
constexpr int BM = 256, BK = 64, HALF = 128, HTB = HALF * BK * 2  , STAGE_BYTES = 8 * HTB, NXCD = 8, WGM = 8;
__host__ __device__ __forceinline__ int lds_byte(int r, int c) { const int st = (r >> 4) * 2 + (c >> 5), rr = r & 15, cc = c & 31, ob = rr * 64 + cc * 2; return st * 1024 + (ob ^ (((ob >> 9) & 1) << 5)); }
__host__ __device__ __forceinline__ void stage_rc(int b, int& R, int& C) { const int st = b / 1024, sb = b % 1024, swz = sb ^ (((sb >> 9) & 1) << 5); R = (st >> 1) * 16 + swz / 64; C = (st & 1) * 32 + (swz % 64) / 2; }
__host__ __device__ __forceinline__ int perm32(int rho) { const int n = rho >> 4, i = rho & 15; return 8 * (i >> 2) + 4 * n + (i & 3); }
struct Unit { int pm, pn; };
struct Gemm { const bf16_t* A; const bf16_t* Bt; int M, N, K; };
struct StaticOrder {
    int nM, nN, nwg, G, c;
    __device__ __forceinline__ void init(int M, int N, int G_, int c_) { nM = M / BM; nN = N / BM; nwg = nM * nN; G = G_; c = c_; }
    __device__ __forceinline__ bool next(int i, Unit& u) const {
        const long L = (long)i * G + c; if (L >= nwg) return false;
        int wgid = (int)L; { const int q = nwg / NXCD, r = nwg % NXCD, xcd = wgid % NXCD, off = wgid / NXCD; wgid = (xcd < r ? xcd * (q + 1) : r * (q + 1) + (xcd - r) * q) + off; }
        const int nig = WGM * nN, gid = wgid / nig, fm = gid * WGM, gsz = (nM - fm) < WGM ? (nM - fm) : WGM;
        u.pm = fm + ((wgid % nig) % gsz); u.pn = (wgid % nig) / gsz; return true;
    }
};
__device__ __forceinline__ unsigned cvt_pk_bf16(float lo, float hi) { unsigned r; asm volatile("v_cvt_pk_bf16_f32 %0, %1, %2" : "=v"(r) : "v"(lo), "v"(hi)); return r; }

template <class Epi, class Sched, int AMODE>
__device__ __forceinline__ void gemm_phase(PG8_LAS unsigned char* lds, const Gemm g, const Sched& S, const Epi& E, const int* __restrict__ rowmap, const int* __restrict__ tile_exp, const size_t estride) {
    constexpr bool GATHER = AMODE != 0;
    int tid = threadIdx.x; asm volatile("" : "+v"(tid));
    const int wid = __builtin_amdgcn_readfirstlane(tid >> 6), lane = tid & 63, wr = wid >> 2, wc = wid & 3, fr = lane & 15, fq = lane >> 4;
    const int K = g.K, nt = K / BK;
    unsigned voffA[2], voffB[2]; int rA[2];
#pragma unroll
    for (int i = 0; i < 2; ++i) { int R, C; stage_rc(tid * 16 + i * 8192, R, C); const int Rb = (R & ~31) + perm32(R & 31);
        voffA[i] = (unsigned)(R * K + C) * 2u; voffB[i] = (unsigned)(Rb * K + C) * 2u; rA[i] = R; if (GATHER) voffA[i] = (unsigned)C * 2u; }
    const size_t kstep = (size_t)(BK * 2);
    const size_t kstepA = AMODE == 2 ? (size_t)DINP * 2 : kstep;
    const size_t hstep = (size_t)HALF * K * 2;
    const size_t tstep = 2 * hstep;
    const unsigned ldsw = (unsigned)wid * 1024u;
    const int aoff = lds_byte(wr * 64 + fr, fq * 8), boff = lds_byte(wc * 32 + fr, fq * 8);
#define PG8_SA(b, h) (((b) * 2 + (h)) * HTB)
#define PG8_SB(b, h) ((4 + (b) * 2 + (h)) * HTB)
#define PG8_STAGE(bufoff, gbase, voff) do { _Pragma("unroll") for (int _i = 0; _i < 2; ++_i) \
        __builtin_amdgcn_global_load_lds((const unsigned*)((const char*)(gbase) + (voff)[_i]), (PG8_LAS unsigned*)(lds + (bufoff) + ldsw + _i * 8192), 16, 0, 0); } while (0)
#define PG8_LDA(dst, b, h) do { _Pragma("unroll") for (int m = 0; m < 4; ++m) _Pragma("unroll") for (int k = 0; k < 2; ++k) dst[m][k] = *(const PG8_LAS bf16x8*)(lds + PG8_SA(b, h) + aoff + m * 2048 + k * 1024); } while (0)
#define PG8_LDB(dst, b, h) do { _Pragma("unroll") for (int n = 0; n < 2; ++n) _Pragma("unroll") for (int k = 0; k < 2; ++k) dst[n][k] = *(const PG8_LAS bf16x8*)(lds + PG8_SB(b, h) + boff + n * 2048 + k * 1024); } while (0)
#define PG8_MMA(ai, bj, At, Bt) do { __builtin_amdgcn_s_setprio(1); _Pragma("unroll") for (int m = 0; m < 4; ++m) _Pragma("unroll") for (int n = 0; n < 2; ++n) _Pragma("unroll") for (int k = 0; k < 2; ++k) \
        acc[ai][bj][m][n] = __builtin_amdgcn_mfma_f32_16x16x32_bf16(Bt[n][k], At[m][k], acc[ai][bj][m][n], 0, 0, 0); __builtin_amdgcn_s_setprio(0); } while (0)
#define PG8_WAIT_V(n) asm volatile("s_waitcnt vmcnt(" #n ")" ::: "memory")
#define PG8_WAIT_L(n) asm volatile("s_waitcnt lgkmcnt(" #n ")" ::: "memory")
#define PG8_BAR __builtin_amdgcn_s_barrier()
#define PG8_SCHED __builtin_amdgcn_sched_barrier(0)
    unsigned vgc[2][2], vgn[2][2];
#define PG8_GOFF(dst, pm_) do { if constexpr (AMODE == 1) { _Pragma("unroll") for (int _h = 0; _h < 2; ++_h) _Pragma("unroll") for (int _i = 0; _i < 2; ++_i) { int _t = rowmap[(pm_) * BM + _h * HALF + rA[_i]]; _t = _t < 0 ? 0 : _t; \
        dst[_h][_i] = (unsigned)_t * (unsigned)(K * 2) + voffA[_i]; } } \
      else if constexpr (AMODE == 2) { _Pragma("unroll") for (int _h = 0; _h < 2; ++_h) _Pragma("unroll") for (int _i = 0; _i < 2; ++_i) { const int _r = (pm_) * BM + _h * HALF + rA[_i]; int _c = _r & 255; _c = _c > 254 ? 254 : _c; \
        dst[_h][_i] = (unsigned)(((_r >> 9) * SEQ + 16 * _c) * DINP + (int)estride + ((_r >> 8) & 1) * 64) * 2u + voffA[_i]; } } } while (0)
#define PG8_STA(bufoff, gptr, h, arr) do { if constexpr (GATHER) { PG8_STAGE(bufoff, gptr, arr[h]); } else { PG8_STAGE(bufoff, (gptr) + ((h) ? hstep : 0), voffA); } } while (0)
    Unit cur, nxt; int ui = 0;
    if (!S.next(0, cur)) return;
    f32x4 acc[2][2][4][2];
#pragma unroll
    for (int a = 0; a < 2; ++a)
#pragma unroll
        for (int b = 0; b < 2; ++b)
#pragma unroll
            for (int m = 0; m < 4; ++m)
#pragma unroll
                for (int n = 0; n < 2; ++n) acc[a][b][m][n] = (f32x4){0.f, 0.f, 0.f, 0.f};
    bf16x8 At[4][2], B0[2][2], B1[2][2];
    const char* cA = (const char*)g.A + (GATHER ? (size_t)0 : (size_t)cur.pm * tstep);
    const char* cB = (const char*)g.Bt + (tile_exp ? (size_t)tile_exp[cur.pm] * estride * 2 : (size_t)0) + (size_t)cur.pn * tstep;
    PG8_GOFF(vgc, cur.pm);
    PG8_STAGE(PG8_SB(0, 0), cB, voffB); PG8_STAGE(PG8_SB(0, 1), cB + hstep, voffB); PG8_STA(PG8_SA(0, 0), cA, 0, vgc); PG8_STA(PG8_SA(0, 1), cA, 1, vgc);
    if (wr == 1) PG8_BAR;
    PG8_WAIT_V(2); PG8_BAR;
    PG8_STAGE(PG8_SB(1, 0), cB + kstep, voffB); PG8_STA(PG8_SA(1, 0), cA + kstepA, 0, vgc); PG8_STAGE(PG8_SB(1, 1), cB + hstep + kstep, voffB);
    PG8_WAIT_V(6); PG8_BAR;
    for (;;) {
        const bool has_next = S.next(ui + 1, nxt);
        const char* nA = has_next ? (const char*)g.A + (GATHER ? (size_t)0 : (size_t)nxt.pm * tstep) : cA;
        const char* nB = has_next ? (const char*)g.Bt + (tile_exp ? (size_t)tile_exp[nxt.pm] * estride * 2 : (size_t)0) + (size_t)nxt.pn * tstep : cB;
        if constexpr (GATHER) { if (has_next) { PG8_GOFF(vgn, nxt.pm); } else {
#pragma unroll
            for (int _h = 0; _h < 2; ++_h)
#pragma unroll
                for (int _i = 0; _i < 2; ++_i) vgn[_h][_i] = vgc[_h][_i]; } }
        for (int t = 0; t < nt; t += 2) {
            const bool last = (t == nt - 2);
            const char* a1 = cA + (size_t)(t + 1) * kstepA;
            const char* a2 = last ? nA : cA + (size_t)(t + 2) * kstepA; const char* b2 = last ? nB : cB + (size_t)(t + 2) * kstep;
            const char* a3 = a2 + kstepA; const char* b3 = b2 + kstep;
            unsigned v2[2][2];
            if constexpr (GATHER) {
#pragma unroll
            for (int _h = 0; _h < 2; ++_h)
#pragma unroll
                for (int _i = 0; _i < 2; ++_i) v2[_h][_i] = last ? vgn[_h][_i] : vgc[_h][_i]; }
            PG8_LDB(B0, 0, 0); PG8_LDB(B1, 0, 1); PG8_SCHED; PG8_LDA(At, 0, 0); PG8_STA(PG8_SA(1, 1), a1, 1, vgc);
            PG8_WAIT_V(8); PG8_WAIT_L(0); PG8_BAR; PG8_MMA(0, 0, At, B0); PG8_MMA(0, 1, At, B1); PG8_BAR; PG8_SCHED;
            PG8_LDA(At, 0, 1); PG8_STAGE(PG8_SB(0, 0), b2, voffB); PG8_STAGE(PG8_SB(0, 1), b2 + hstep, voffB); PG8_STA(PG8_SA(0, 0), a2, 0, v2);
            PG8_WAIT_V(8); PG8_WAIT_L(0); PG8_BAR; PG8_MMA(1, 0, At, B0); PG8_MMA(1, 1, At, B1); PG8_BAR; PG8_SCHED;
            PG8_LDB(B0, 1, 0); PG8_LDB(B1, 1, 1); PG8_SCHED; PG8_LDA(At, 1, 0); PG8_STA(PG8_SA(0, 1), a2, 1, v2);
            PG8_WAIT_V(8); PG8_WAIT_L(0); PG8_BAR; PG8_MMA(0, 0, At, B0); PG8_MMA(0, 1, At, B1); PG8_BAR; PG8_SCHED;
            PG8_LDA(At, 1, 1); PG8_STAGE(PG8_SB(1, 0), b3, voffB); PG8_STAGE(PG8_SB(1, 1), b3 + hstep, voffB); PG8_STA(PG8_SA(1, 0), a3, 0, v2);
            PG8_WAIT_V(8); PG8_WAIT_L(0); PG8_BAR; PG8_MMA(1, 0, At, B0); PG8_MMA(1, 1, At, B1); PG8_BAR; PG8_SCHED;
        }
        if (wr == 0) PG8_BAR;
        E(acc, cur, wr, wc, fr, fq);
        if (!has_next) break;
#pragma unroll
        for (int a = 0; a < 2; ++a)
#pragma unroll
            for (int b = 0; b < 2; ++b)
#pragma unroll
                for (int m = 0; m < 4; ++m)
#pragma unroll
                    for (int n = 0; n < 2; ++n) acc[a][b][m][n] = (f32x4){0.f, 0.f, 0.f, 0.f};
        cur = nxt; cA = nA; cB = nB; ++ui;
        if constexpr (GATHER) {
#pragma unroll
        for (int _h = 0; _h < 2; ++_h)
#pragma unroll
            for (int _i = 0; _i < 2; ++_i) vgc[_h][_i] = vgn[_h][_i]; }
        if (wr == 1) PG8_BAR;
    }
    PG8_WAIT_V(0);
    PG8_BAR;
#undef PG8_SA
#undef PG8_SB
#undef PG8_STAGE
#undef PG8_LDA
#undef PG8_LDB
#undef PG8_MMA
#undef PG8_WAIT_V
#undef PG8_WAIT_L
#undef PG8_BAR
#undef PG8_SCHED
#undef PG8_GOFF
#undef PG8_STA
}

typedef const f32x4 (&AccT)[2][2][4][2];
struct EIn { bf16_t* proj; const float* ssq;
    __device__ __forceinline__ void operator()(AccT acc, const Unit& u, int wr, int wc, int fr, int fq) const {
        const int col0 = u.pn * BM + wc * 32 + 8 * fq;
#pragma unroll
        for (int ai = 0; ai < 2; ++ai)
#pragma unroll
            for (int m = 0; m < 4; ++m) { const int row = u.pm * BM + ai * HALF + wr * 64 + m * 16 + fr; const float rs = row_rstd(ssq, row); bf16_t* rowp = proj + (size_t)row * DINP + col0;
#pragma unroll
                for (int bj = 0; bj < 2; ++bj) { const f32x4 v0 = acc[ai][bj][m][0] * rs, v1 = acc[ai][bj][m][1] * rs; u32x4 w; w.x = cvt_pk_bf16(v0[0], v0[1]); w.y = cvt_pk_bf16(v0[2], v0[3]); w.z = cvt_pk_bf16(v1[0], v1[1]); w.w = cvt_pk_bf16(v1[2], v1[3]);
                    *(u32x4*)(rowp + bj * HALF) = w; } } } };
struct ERes { const float* xold; float* xnew; bf16_t* xb; float* ssq;
    __device__ __forceinline__ void operator()(AccT acc, const Unit& u, int wr, int wc, int fr, int fq) const {
        const int col0 = u.pn * BM + wc * 32 + 8 * fq;
#pragma unroll
        for (int ai = 0; ai < 2; ++ai)
#pragma unroll
            for (int m = 0; m < 4; ++m) { const int row = u.pm * BM + ai * HALF + wr * 64 + m * 16 + fr; const size_t o = (size_t)row * DM + col0; float s = 0.f;
#pragma unroll
                for (int bj = 0; bj < 2; ++bj) { const f32x4 x0 = *(const f32x4*)(xold + o + bj * HALF), x1 = *(const f32x4*)(xold + o + bj * HALF + 4);
                    const f32x4 v0 = x0 + acc[ai][bj][m][0], v1 = x1 + acc[ai][bj][m][1];
                    *(f32x4*)(xnew + o + bj * HALF) = v0; *(f32x4*)(xnew + o + bj * HALF + 4) = v1;
                    u32x4 w; w.x = cvt_pk_bf16(v0[0], v0[1]); w.y = cvt_pk_bf16(v0[2], v0[3]); w.z = cvt_pk_bf16(v1[0], v1[1]); w.w = cvt_pk_bf16(v1[2], v1[3]);
                    *(u32x4*)(xb + o + bj * HALF) = w;
                    s += (v0[0] * v0[0] + v0[1] * v0[1]) + (v0[2] * v0[2] + v0[3] * v0[3]) + (v1[0] * v1[0] + v1[1] * v1[1]) + (v1[2] * v1[2] + v1[3] * v1[3]); }
                s += __shfl_xor(s, 16); s += __shfl_xor(s, 32);
                if (fq == 0) ssq[(size_t)row * NSLOT + u.pn * 4 + wc] = s; } } };
struct ESwiglu { bf16_t* h; const float* ssq; const int* row_tok;
    __device__ __forceinline__ void operator()(AccT acc, const Unit& u, int wr, int wc, int fr, int fq) const {
        const int col0 = u.pn * HALF + wc * 32 + 8 * fq;
#pragma unroll
        for (int ai = 0; ai < 2; ++ai)
#pragma unroll
            for (int m = 0; m < 4; ++m) { const int row = u.pm * BM + ai * HALF + wr * 64 + m * 16 + fr; const int t = row_tok ? row_tok[row] : row; const float rs = t < 0 ? 0.f : row_rstd(ssq, t < 0 ? 0 : t);
                float o[8];
#pragma unroll
                for (int n = 0; n < 2; ++n)
#pragma unroll
                    for (int e = 0; e < 4; ++e) { const float av = acc[ai][0][m][n][e] * rs, bv = acc[ai][1][m][n][e] * rs; o[n * 4 + e] = siluf(av) * bv; }
                u32x4 w; w.x = cvt_pk_bf16(o[0], o[1]); w.y = cvt_pk_bf16(o[2], o[3]); w.z = cvt_pk_bf16(o[4], o[5]); w.w = cvt_pk_bf16(o[6], o[7]);
                *(u32x4*)(h + (size_t)row * DFF + col0) = w; } } };
struct ESiluBias { bf16_t* out; const float* bias;
    __device__ __forceinline__ void operator()(AccT acc, const Unit& u, int wr, int wc, int fr, int fq) const {
        const int col0 = u.pn * BM + wc * 32 + 8 * fq;
#pragma unroll
        for (int ai = 0; ai < 2; ++ai)
#pragma unroll
            for (int m = 0; m < 4; ++m) { const int row = u.pm * BM + ai * HALF + wr * 64 + m * 16 + fr; bf16_t* rowp = out + (size_t)row * 256 + col0;
#pragma unroll
                for (int bj = 0; bj < 2; ++bj) { const f32x4 b0 = *(const f32x4*)(bias + col0 + bj * HALF), b1 = *(const f32x4*)(bias + col0 + bj * HALF + 4); const f32x4 v0 = acc[ai][bj][m][0] + b0, v1 = acc[ai][bj][m][1] + b1;
                    u32x4 w; w.x = cvt_pk_bf16(siluf(v0[0]), siluf(v0[1])); w.y = cvt_pk_bf16(siluf(v0[2]), siluf(v0[3])); w.z = cvt_pk_bf16(siluf(v1[0]), siluf(v1[1])); w.w = cvt_pk_bf16(siluf(v1[2]), siluf(v1[3]));
                    *(u32x4*)(rowp + bj * HALF) = w; } } } };
struct EKc { bf16_t* out; int transposed, pad;
    __device__ __forceinline__ void operator()(AccT acc, const Unit& u, int wr, int wc, int fr, int fq) const {
        if (wc >= 2) return;
        const int col0 = wc * 32 + 8 * fq;
#pragma unroll
        for (int ai = 0; ai < 2; ++ai)
#pragma unroll
            for (int m = 0; m < 4; ++m) { const int row = u.pm * BM + ai * HALF + wr * 64 + m * 16 + fr; const f32x4 v0 = acc[ai][0][m][0], v1 = acc[ai][0][m][1];
                if (!transposed) { u32x4 w; w.x = cvt_pk_bf16(v0[0], v0[1]); w.y = cvt_pk_bf16(v0[2], v0[3]); w.z = cvt_pk_bf16(v1[0], v1[1]); w.w = cvt_pk_bf16(v1[2], v1[3]); *(u32x4*)(out + (size_t)row * 64 + col0) = w; }
                else { bf16_t* o = out + (size_t)(row >> 8) * 16384 + (size_t)col0 * 256 + (row & 255);
#pragma unroll
                    for (int x = 0; x < 4; ++x) { o[x * 256] = f2bf(v0[x]); o[(4 + x) * 256] = f2bf(v1[x]); } } } } };
struct EStore { bf16_t* out; int ldc;
    __device__ __forceinline__ void operator()(AccT acc, const Unit& u, int wr, int wc, int fr, int fq) const {
        const int col0 = u.pn * BM + wc * 32 + 8 * fq;
#pragma unroll
        for (int ai = 0; ai < 2; ++ai)
#pragma unroll
            for (int m = 0; m < 4; ++m) { const int row = u.pm * BM + ai * HALF + wr * 64 + m * 16 + fr; bf16_t* rowp = out + (size_t)row * ldc + col0;
#pragma unroll
                for (int bj = 0; bj < 2; ++bj) { const f32x4 v0 = acc[ai][bj][m][0], v1 = acc[ai][bj][m][1]; u32x4 w; w.x = cvt_pk_bf16(v0[0], v0[1]); w.y = cvt_pk_bf16(v0[2], v0[3]); w.z = cvt_pk_bf16(v1[0], v1[1]); w.w = cvt_pk_bf16(v1[2], v1[3]);
                    *(u32x4*)(rowp + bj * HALF) = w; } } } };
}

namespace nsa {
typedef float f32x16 __attribute__((ext_vector_type(16)));
typedef unsigned u32x4 __attribute__((ext_vector_type(4)));
typedef unsigned u32x2 __attribute__((ext_vector_type(2)));
constexpr int KSTR = 144, VSTR = 136;
constexpr int KT_B = 64 * KSTR, VT_B = 64 * VSTR, BUF_B = KT_B + VT_B;
constexpr int IMP_OFF = 2 * BUF_B  , SELM_OFF = IMP_OFF + 8 * 2048  , WUN_OFF = SELM_OFF + 512;
constexpr float L2E = 1.4426950408889634f;
#define NLAS __attribute__((address_space(3)))
__device__ __forceinline__ unsigned pk2(float lo, float hi) { unsigned r; asm volatile("v_cvt_pk_bf16_f32 %0, %1, %2" : "=v"(r) : "v"(lo), "v"(hi)); return r; }
struct Stage { u32x4 k, v; };
__device__ __forceinline__ void stage_issue(Stage& st, const bf16_t* kg, size_t kstride, const bf16_t* vg, size_t vstride, int tid) {
    const int r = tid >> 3, c = (tid & 7) * 8;
    st.k = *(const u32x4*)(kg + (size_t)r * kstride + c); st.v = *(const u32x4*)(vg + (size_t)r * vstride + c);
}
__device__ __forceinline__ void stage_write(const Stage& st, NLAS char* buf, int tid) {
    const int r = tid >> 3, c = (tid & 7) * 16;
    *(NLAS u32x4*)(buf + r * KSTR + c) = st.k;
    *(NLAS u32x2*)(buf + KT_B + r * VSTR + c) = (u32x2){st.v.x, st.v.y}; *(NLAS u32x2*)(buf + KT_B + r * VSTR + c + 8) = (u32x2){st.v.z, st.v.w};
}
__device__ __forceinline__ void compute_S(NLAS const char* buf, const bf16x8 (&Qf)[4], f32x16& S0, f32x16& S1, int lane) {
    const int kr = lane & 31, hi = lane >> 5;
#pragma unroll
    for (int i = 0; i < 16; ++i) { S0[i] = 0.f; S1[i] = 0.f; }
#pragma unroll
    for (int s = 0; s < 4; ++s) { const bf16x8 a0 = *(NLAS const bf16x8*)(buf + kr * KSTR + s * 32 + hi * 16), a1 = *(NLAS const bf16x8*)(buf + (32 + kr) * KSTR + s * 32 + hi * 16);
        S0 = __builtin_amdgcn_mfma_f32_32x32x16_bf16(a0, Qf[s], S0, 0, 0, 0); S1 = __builtin_amdgcn_mfma_f32_32x32x16_bf16(a1, Qf[s], S1, 0, 0, 0); }
}
__device__ __forceinline__ void mask_S(f32x16& S0, f32x16& S1, int lo, int hi, int lane) {
    const int h4 = (lane >> 5) * 4, lo2 = lo - h4, hi2 = hi - h4;
#pragma unroll
    for (int i = 0; i < 16; ++i) { const int c0 = (i & 3) + 8 * (i >> 2); S0[i] = (c0 >= lo2 && c0 <= hi2) ? S0[i] : -INFINITY; S1[i] = (c0 + 32 >= lo2 && c0 + 32 <= hi2) ? S1[i] : -INFINITY; }
}
__device__ __forceinline__ float max_S(const f32x16& S0, const f32x16& S1) { float m = fmaxf(S0[0], S1[0]);
#pragma unroll
    for (int i = 1; i < 16; ++i) m = fmaxf(m, fmaxf(S0[i], S1[i]));
    return fmaxf(m, __shfl_xor(m, 32)); }
__device__ __forceinline__ float exp_S(f32x16& S0, f32x16& S1, float mL, float sc) { float l = 0.f;
#pragma unroll
    for (int i = 0; i < 16; ++i) { S0[i] = __builtin_amdgcn_exp2f(fmaf(S0[i], L2E, -mL)) * sc; S1[i] = __builtin_amdgcn_exp2f(fmaf(S1[i], L2E, -mL)) * sc; l += S0[i] + S1[i]; }
    return l; }
__device__ __forceinline__ void pack_P(const f32x16& S0, const f32x16& S1, unsigned andm, bf16x8 (&Pf)[4]) {
#pragma unroll
    for (int s2 = 0; s2 < 4; ++s2) { u32x4 w;
#pragma unroll
        for (int q = 0; q < 4; ++q) { const int i = (s2 & 1) * 8 + q * 2; w[q] = (s2 < 2 ? pk2(S0[i], S0[i + 1]) : pk2(S1[i], S1[i + 1])) & andm; }
        Pf[s2] = __builtin_bit_cast(bf16x8, w); }
}
__device__ __forceinline__ void pv(NLAS const char* buf, const bf16x8 (&Pf)[4], f32x16& O0, f32x16& O1, int lane) {
    const int dr = lane & 31, hi = lane >> 5; NLAS const char* vt = buf + KT_B;
#pragma unroll
    for (int s2 = 0; s2 < 4; ++s2) {
        u32x4 w0, w1;
        { const u32x2 x = *(NLAS const u32x2*)(vt + dr * VSTR + (16 * s2 + 4 * hi) * 2), y = *(NLAS const u32x2*)(vt + dr * VSTR + (16 * s2 + 8 + 4 * hi) * 2); w0 = (u32x4){x.x, x.y, y.x, y.y}; }
        { const u32x2 x = *(NLAS const u32x2*)(vt + (32 + dr) * VSTR + (16 * s2 + 4 * hi) * 2), y = *(NLAS const u32x2*)(vt + (32 + dr) * VSTR + (16 * s2 + 8 + 4 * hi) * 2); w1 = (u32x4){x.x, x.y, y.x, y.y}; }
        O0 = __builtin_amdgcn_mfma_f32_32x32x16_bf16(__builtin_bit_cast(bf16x8, w0), Pf[s2], O0, 0, 0, 0);
        O1 = __builtin_amdgcn_mfma_f32_32x32x16_bf16(__builtin_bit_cast(bf16x8, w1), Pf[s2], O1, 0, 0, 0); }
}
__device__ __forceinline__ void online_block(NLAS const char* buf, const bf16x8 (&Qf)[4], f32x16& O0, f32x16& O1, float& m, float& l, bool lane_on, bool use_mask, int lo, int hi, int lane) {
    f32x16 S0, S1; compute_S(buf, Qf, S0, S1, lane);
    if (use_mask) mask_S(S0, S1, lo, hi, lane);
    float mt = max_S(S0, S1); if (!lane_on) mt = -INFINITY;
    const float mn = fmaxf(m, mt), ms = mn == -INFINITY ? 0.f : mn, al = __builtin_amdgcn_exp2f((m - ms) * L2E);
    const float ls = exp_S(S0, S1, ms * L2E, 1.f);
    l = l * al + (lane_on ? ls : 0.f); m = mn;
#pragma unroll
    for (int i = 0; i < 16; ++i) { O0[i] *= al; O1[i] *= al; }
    bf16x8 Pf[4]; pack_P(S0, S1, lane_on ? 0xffffffffu : 0u, Pf);
    pv(buf, Pf, O0, O1, lane);
}
}

__device__ __forceinline__ void ph_nsa(const Args& a, LAS char* lds_, int vcu, int G) {
    using namespace nsa;
    int tid = threadIdx.x; asm volatile("" : "+v"(tid)); asm volatile("" : "+s"(vcu));
    NLAS char* lds = lds_;
    const int w = tid >> 6, lane = tid & 63, hi = lane >> 5, r = lane & 31, tql = r >> 2, hpg = r & 3;
    NLAS float* impw = (NLAS float*)(lds + IMP_OFF + w * 2048);
    NLAS unsigned long long* selm = (NLAS unsigned long long*)(lds + SELM_OFF);
    NLAS unsigned long long* wun = (NLAS unsigned long long*)(lds + WUN_OFF);
    const bf16_t* proj = a.proj;
    for (int it = 0; it * G + vcu < 1024; ++it) {
        const int idx = it * G + vcu, rnd = idx >> 8, k16 = (idx & 255) >> 4, bg = idx & 15;
        const int qb = (rnd == 0) ? 63 - k16 : (rnd == 1) ? 32 + k16 : (rnd == 2) ? 31 - k16 : k16;
        const int b = bg >> 1, g = bg & 1;
        const int tq = 8 * w + tql, t = 64 * qb + tq; const size_t row = (size_t)b * SEQ + t; const bf16_t* prow = proj + row * DINP;
        bf16x8 Qf[4];
#pragma unroll
        for (int s = 0; s < 4; ++s) Qf[s] = *(const bf16x8*)(prow + C_Q + g * 256 + hpg * 64 + 16 * s + 8 * hi);
        f32x16 Oo0, Oo1;
        const int hh = g * 4 + hpg; const float g0 = sigmf(bf2f(prow[C_GL + hh * 3 + 0])), g1 = sigmf(bf2f(prow[C_GL + hh * 3 + 1])), g2 = sigmf(bf2f(prow[C_GL + hh * 3 + 2]));
        Stage st;
        const bf16_t* kcg = a.kcb + (size_t)bg * 256 * 64; const bf16_t* vcg = a.vcT + (size_t)bg * 64 * 256;
        const int nbc = (4 * qb + 3 + 63) >> 6;
        const int cmax = t >= 31 ? (t - 31) >> 4 : -1;
        float mc = -INFINITY, lc = 0.f;
        __syncthreads();
        stage_issue(st, kcg, 64, vcg, 256, tid); stage_write(st, lds, tid); __syncthreads();
        for (int kb = 0; kb < nbc; ++kb) {
            NLAS char* buf = lds + (kb & 1) * BUF_B;
            if (kb + 1 < nbc) stage_issue(st, kcg + (size_t)(kb + 1) * 64 * 64, 64, vcg + (kb + 1) * 64, 256, tid);
            f32x16 S0, S1; compute_S(buf, Qf, S0, S1, lane); mask_S(S0, S1, 0, cmax - 64 * kb, lane);
            const float mt = max_S(S0, S1), mn = fmaxf(mc, mt), ms = mn == -INFINITY ? 0.f : mn, al = __builtin_amdgcn_exp2f((mc - ms) * L2E);
            lc = lc * al + exp_S(S0, S1, ms * L2E, 1.f); mc = mn;
            if (kb + 1 < nbc) stage_write(st, lds + ((kb + 1) & 1) * BUF_B, tid);
            __syncthreads();
        }
        lc += __shfl_xor(lc, 32);
        const float mLc = (mc == -INFINITY ? 0.f : mc) * L2E, ilc = lc > 0.f ? 1.f / lc : 0.f;
        f32x16 Oc0, Oc1, Z0, Z1;
#pragma unroll
        for (int i = 0; i < 16; ++i) { Oc0[i] = 0.f; Oc1[i] = 0.f; Z0[i] = 0.f; Z1[i] = 0.f; }
        stage_issue(st, kcg, 64, vcg, 256, tid); stage_write(st, lds, tid); __syncthreads();
        for (int kb = 0; kb < nbc; ++kb) {
            NLAS char* buf = lds + (kb & 1) * BUF_B;
            if (kb + 1 < nbc) stage_issue(st, kcg + (size_t)(kb + 1) * 64 * 64, 64, vcg + (kb + 1) * 64, 256, tid);
            f32x16 S0, S1; compute_S(buf, Qf, S0, S1, lane); mask_S(S0, S1, 0, cmax - 64 * kb, lane);
            (void)exp_S(S0, S1, mLc, ilc);
            bf16x8 Pf[4]; pack_P(S0, S1, 0xffffffffu, Pf);
            pv(buf, Pf, Oc0, Oc1, lane);
#pragma unroll
            for (int s2 = 0; s2 < 4; ++s2) {
#pragma unroll
                for (int stl = 0; stl < 2; ++stl) { const int sblk = 32 * stl + r; u32x4 wv;
#pragma unroll
                    for (int q = 0; q < 4; ++q) { unsigned x = 0u;
#pragma unroll
                        for (int e = 0; e < 2; ++e) { const int j = q * 2 + e, c = 64 * kb + 16 * s2 + 8 * (j >> 2) + 4 * hi + (j & 3); if (c >= 4 * sblk - 1 && c <= 4 * sblk + 3) x |= (0x3f80u << (16 * e)); }
                        wv[q] = x; }
                    if (stl == 0) Z0 = __builtin_amdgcn_mfma_f32_32x32x16_bf16(Pf[s2], __builtin_bit_cast(bf16x8, wv), Z0, 0, 0, 0);
                    else          Z1 = __builtin_amdgcn_mfma_f32_32x32x16_bf16(Pf[s2], __builtin_bit_cast(bf16x8, wv), Z1, 0, 0, 0); } }
            if (kb + 1 < nbc) stage_write(st, lds + ((kb + 1) & 1) * BUF_B, tid);
            __syncthreads();
        }
#pragma unroll
        for (int i = 0; i < 16; ++i) { Oo0[i] = g0 * Oc0[i]; Oo1[i] = g0 * Oc1[i]; }
#pragma unroll
        for (int q4 = 0; q4 < 4; ++q4) { impw[(2 * q4 + hi) * 64 + r] = (Z0[4 * q4] + Z0[4 * q4 + 1]) + (Z0[4 * q4 + 2] + Z0[4 * q4 + 3]); impw[(2 * q4 + hi) * 64 + 32 + r] = (Z1[4 * q4] + Z1[4 * q4 + 1]) + (Z1[4 * q4 + 2] + Z1[4 * q4 + 3]); }
        __syncthreads();
        unsigned long long wu = 0ull;
        for (int q = 0; q < 8; ++q) { const float imp = impw[q * 64 + lane];
            const bool valid = lane <= qb, forced = lane == 0 || lane == qb || lane == qb - 1; const float val = valid ? (forced ? 1e9f : imp) : -1e30f; int rank = 0;
#pragma unroll
            for (int s2 = 0; s2 < 64; ++s2) { const float v2 = __builtin_bit_cast(float, __builtin_amdgcn_readlane(__builtin_bit_cast(int, val), s2)); rank += (v2 > val || (v2 == val && s2 < lane)) ? 1 : 0; }
            const unsigned long long mk = __ballot(valid && rank < 16); wu |= mk;
            if (lane == 0) selm[8 * w + q] = mk; }
        if (lane == 0) wun[w] = wu;
        __syncthreads();
        unsigned long long um = 0ull;
#pragma unroll
        for (int q = 0; q < 8; ++q) um |= wun[q];
        um = ((unsigned long long)__builtin_amdgcn_readfirstlane((unsigned)(um >> 32)) << 32) | (unsigned)__builtin_amdgcn_readfirstlane((unsigned)um);
        const unsigned long long mq = selm[tq];
        {
            const bf16_t* kg = proj + (size_t)b * SEQ * DINP + C_KS + g * 64; const bf16_t* vg = a.VsT + (size_t)bg * 64 * SEQ;
            f32x16 O0, O1;
#pragma unroll
            for (int i = 0; i < 16; ++i) { O0[i] = 0.f; O1[i] = 0.f; }
            float m = -INFINITY, l = 0.f;
            unsigned long long rem = um; int j = __builtin_ctzll(rem); rem &= rem - 1; int cb = 0;
            stage_issue(st, kg + (size_t)j * 64 * DINP, DINP, vg + j * 64, SEQ, tid); stage_write(st, lds, tid); __syncthreads();
            for (;;) {
                const int jn = rem ? __builtin_ctzll(rem) : -1; if (rem) rem &= rem - 1;
                if (jn >= 0) stage_issue(st, kg + (size_t)jn * 64 * DINP, DINP, vg + jn * 64, SEQ, tid);
                online_block(lds + cb * BUF_B, Qf, O0, O1, m, l, (mq >> j) & 1ull, j == qb, 0, tq, lane);
                if (jn >= 0) stage_write(st, lds + (cb ^ 1) * BUF_B, tid);
                __syncthreads();
                if (jn < 0) break;
                j = jn; cb ^= 1;
            }
            l += __shfl_xor(l, 32); const float sc = l > 0.f ? g1 / l : 0.f;
#pragma unroll
            for (int i = 0; i < 16; ++i) { Oo0[i] += sc * O0[i]; Oo1[i] += sc * O1[i]; }
        }
        {
            const bf16_t* kg = proj + (size_t)b * SEQ * DINP + C_KW + g * 64; const bf16_t* vg = a.VwT + (size_t)bg * 64 * SEQ;
            f32x16 O0, O1;
#pragma unroll
            for (int i = 0; i < 16; ++i) { O0[i] = 0.f; O1[i] = 0.f; }
            float m = -INFINITY, l = 0.f;
            const int jlo = qb - 8 > 0 ? qb - 8 : 0; int cb = 0;
            stage_issue(st, kg + (size_t)jlo * 64 * DINP, DINP, vg + jlo * 64, SEQ, tid); stage_write(st, lds, tid); __syncthreads();
            for (int j = jlo; j <= qb; ++j) {
                if (j < qb) stage_issue(st, kg + (size_t)(j + 1) * 64 * DINP, DINP, vg + (j + 1) * 64, SEQ, tid);
                const bool first = (j == qb - 8), diag = (j == qb);
                online_block(lds + cb * BUF_B, Qf, O0, O1, m, l, true, first || diag, first ? tq + 1 : 0, diag ? tq : 63, lane);
                if (j < qb) stage_write(st, lds + (cb ^ 1) * BUF_B, tid);
                __syncthreads();
                cb ^= 1;
            }
            l += __shfl_xor(l, 32); const float sc = l > 0.f ? g2 / l : 0.f;
#pragma unroll
            for (int i = 0; i < 16; ++i) { Oo0[i] += sc * O0[i]; Oo1[i] += sc * O1[i]; }
        }
        bf16_t* op = a.ocat + row * DM + hh * 64 + 4 * hi;
#pragma unroll
        for (int q4 = 0; q4 < 4; ++q4) { u32x2 w0, w1; w0.x = pk2(Oo0[4 * q4], Oo0[4 * q4 + 1]); w0.y = pk2(Oo0[4 * q4 + 2], Oo0[4 * q4 + 3]); w1.x = pk2(Oo1[4 * q4], Oo1[4 * q4 + 1]); w1.y = pk2(Oo1[4 * q4 + 2], Oo1[4 * q4 + 3]);
            *(u32x2*)(op + 8 * q4) = w0; *(u32x2*)(op + 32 + 8 * q4) = w1; }
    }
}

__device__ __forceinline__ void ph_vtrans(const Args& a, LAS char* lds_, int vcu, int G) {
    int tid = threadIdx.x; asm volatile("" : "+v"(tid)); asm volatile("" : "+s"(vcu));
    LAS bf16_t* tile = (LAS bf16_t*)lds_;
    for (int u = vcu; u < 2 * 16 * 64; u += G) { const int tb = u & 63, bg = (u >> 6) & 15, which = u >> 10, b = bg >> 1, g = bg & 1;
        const bf16_t* src = a.proj + ((size_t)b * SEQ + tb * 64) * DINP + (which ? C_VW : C_VS) + g * 64; bf16_t* dst = (which ? a.VwT : a.VsT) + (size_t)bg * 64 * SEQ + tb * 64;
        const int r = tid >> 3, c = (tid & 7) * 8;
        const uint4 v = *(const uint4*)(src + (size_t)r * DINP + c); const unsigned wv[4] = {v.x, v.y, v.z, v.w};
        __syncthreads();
#pragma unroll
        for (int e = 0; e < 4; ++e) { tile[(c + 2 * e) * 72 + r] = (bf16_t)(wv[e] & 0xffffu); tile[(c + 2 * e + 1) * 72 + r] = (bf16_t)(wv[e] >> 16); }
        __syncthreads();
        *(u32x4_t*)(dst + (size_t)r * SEQ + c) = *(const LAS u32x4_t*)(tile + r * 72 + c);
    }
}

__device__ __forceinline__ void ph_conv_naive(const Args& a, int l, LAS char* lds, int vcu, int G) {
    int tid_ = threadIdx.x; asm volatile("" : "+v"(tid_)); asm volatile("" : "+s"(vcu));
    const int half = tid_ >> 8, c = tid_ & 255; LAS float* hs = (LAS float*)(lds + half * 63488);
    const float* cw = a.conv_w + (size_t)l * 31 * 256; const float* lg = a.conv_lg + l * 256; const float* lb = a.conv_lb + l * 256;
    float w[31];
#pragma unroll
    for (int k = 0; k < 31; ++k) w[k] = cw[k * 256 + c];
    const float bias = a.conv_b[l * 256 + c];
    for (int unit = vcu; unit < NTOK / 64; unit += G) {
        const int tile = unit * 2 + half, b = tile >> 7, t0 = (tile & 127) * 32;
        __syncthreads();
        for (int i = 0; i < 62; ++i) { const int t = t0 - 30 + i; float v = 0.f;
            if (t >= 0) { const bf16_t* p = a.proj + ((size_t)b * SEQ + t) * DINP + C_CONV; v = bf2f(p[c]) * sigmf(bf2f(p[256 + c])); }
            hs[i * 256 + c] = v; }
        __syncthreads();
        float outv[32];
#pragma unroll
        for (int tt = 0; tt < 32; ++tt) { float s = bias;
#pragma unroll
            for (int k = 0; k < 31; ++k) s += hs[(tt + k) * 256 + c] * w[k];
            outv[tt] = s; }
        __syncthreads();
#pragma unroll
        for (int tt = 0; tt < 32; ++tt) hs[tt * 256 + c] = outv[tt];
        __syncthreads();
        const int wave = c >> 6, lane = c & 63;
        for (int tt = wave; tt < 32; tt += 4) { float v[4], s = 0.f;
#pragma unroll
            for (int i = 0; i < 4; ++i) { v[i] = hs[tt * 256 + lane + 64 * i]; s += v[i]; }
            const float mu = wsum(s) * (1.f / 256.f); float q = 0.f;
#pragma unroll
            for (int i = 0; i < 4; ++i) q += (v[i] - mu) * (v[i] - mu);
            const float rs = rsqrtf(wsum(q) * (1.f / 256.f) + 1e-5f);
#pragma unroll
            for (int i = 0; i < 4; ++i) { const int ch = lane + 64 * i; const float y = (v[i] - mu) * rs * lg[ch] + lb[ch]; a.hconv[((size_t)b * SEQ + t0 + tt) * 256 + ch] = f2bf(siluf(y)); } }
    }
}


namespace ret {
using nsa::f32x16; using nsa::u32x4; using nsa::u32x2; using nsa::pk2;
__device__ __forceinline__ float lg2g(int h) { return log2f(1.f - exp2f(-5.f - (float)h)); }
}
__device__ __forceinline__ void ph_ret_prep(const Args& a, LAS char* lds, int vcu, int G) {
    int tid = threadIdx.x; asm volatile("" : "+v"(tid)); asm volatile("" : "+s"(vcu));
    LAS bf16_t* tK = (LAS bf16_t*)lds; LAS bf16_t* tV = (LAS bf16_t*)(lds + 256 * 72 * 2);
    for (int u = vcu; u < NB * 64; u += G) { const int b = u >> 6, tb = u & 63;
        __syncthreads();
#pragma unroll
        for (int it = 0; it < 2; ++it) { const int item = tid + NT * it, tok = item >> 4, h = (item >> 2) & 3, ch = item & 3; const int pos = tb * 64 + tok; const size_t row = (size_t)b * SEQ + pos;
            const bf16_t* p = a.proj + row * DINP; const int c0 = h * 64 + 8 * ch;
            const u32x4_t ql = *(const u32x4_t*)(p + C_RQ + c0), qh = *(const u32x4_t*)(p + C_RQ + c0 + 32), kl = *(const u32x4_t*)(p + C_RK + c0), kh = *(const u32x4_t*)(p + C_RK + c0 + 32);
            const u32x4_t vl = *(const u32x4_t*)(p + C_RV + c0), vh = *(const u32x4_t*)(p + C_RV + c0 + 32);
            const float* cs = a.rot + ((size_t)pos * 32 + 8 * ch) * 2; float co[8], si[8];
#pragma unroll
            for (int e = 0; e < 4; ++e) { const f32x4 t4 = *(const f32x4*)(cs + 4 * e); co[2 * e] = t4[0]; si[2 * e] = t4[1]; co[2 * e + 1] = t4[2]; si[2 * e + 1] = t4[3]; }
            const float zeta = exp2f((float)(127 - (pos & 127)) * ret::lg2g(h));
            u32x4_t oql, oqh, okl, okh;
#pragma unroll
            for (int e2 = 0; e2 < 4; ++e2) { float r1[2], r2[2], k1[2], k2[2];
#pragma unroll
                for (int e1 = 0; e1 < 2; ++e1) { const int e = e2 * 2 + e1; const float x1 = __uint_as_float(e1 ? (ql[e2] & 0xffff0000u) : (ql[e2] << 16)), x2 = __uint_as_float(e1 ? (qh[e2] & 0xffff0000u) : (qh[e2] << 16));
                    const float y1 = __uint_as_float(e1 ? (kl[e2] & 0xffff0000u) : (kl[e2] << 16)), y2 = __uint_as_float(e1 ? (kh[e2] & 0xffff0000u) : (kh[e2] << 16));
                    r1[e1] = x1 * co[e] - x2 * si[e]; r2[e1] = x1 * si[e] + x2 * co[e]; k1[e1] = y1 * co[e] - y2 * si[e]; k2[e1] = y1 * si[e] + y2 * co[e];
                    tK[(c0 + e) * 72 + tok] = f2bf(k1[e1] * zeta); tK[(c0 + 32 + e) * 72 + tok] = f2bf(k2[e1] * zeta);
                    tV[(c0 + e) * 72 + tok] = (bf16_t)(e1 ? (vl[e2] >> 16) : (vl[e2] & 0xffffu)); tV[(c0 + 32 + e) * 72 + tok] = (bf16_t)(e1 ? (vh[e2] >> 16) : (vh[e2] & 0xffffu)); }
                oql[e2] = nsa::pk2(r1[0], r1[1]); oqh[e2] = nsa::pk2(r2[0], r2[1]); okl[e2] = nsa::pk2(k1[0], k1[1]); okh[e2] = nsa::pk2(k2[0], k2[1]); }
            *(u32x4_t*)(a.qrb + row * 256 + c0) = oql; *(u32x4_t*)(a.qrb + row * 256 + c0 + 32) = oqh; *(u32x4_t*)(a.krb + row * 256 + c0) = okl; *(u32x4_t*)(a.krb + row * 256 + c0 + 32) = okh; }
        __syncthreads();
#pragma unroll
        for (int it = 0; it < 4; ++it) { const int q = tid + NT * it, ri = q >> 3, cc = (q & 7) * 8; const size_t o = ((size_t)b * 256 + ri) * SEQ + tb * 64 + cc;
            *(u32x4_t*)(a.KzT + o) = *(const LAS u32x4_t*)(tK + ri * 72 + cc); *(u32x4_t*)(a.VrT + o) = *(const LAS u32x4_t*)(tV + ri * 72 + cc); }
    }
}
__device__ __forceinline__ void ph_ret_state(const Args& a, int vcu, int G) {
    using namespace ret;
    int tid = threadIdx.x; asm volatile("" : "+v"(tid)); asm volatile("" : "+s"(vcu));
    const int w = tid >> 6, lane = tid & 63, hi = lane >> 5, r = lane & 31;
    if (w >= 4) return;
    for (int u = vcu; u < 32; u += G) { const int h = u & 3, et = w >> 1, dt = w & 1; const float gc = exp2f(128.f * lg2g(h));
        const bf16_t* va = a.VrT + ((size_t)u * 64 + 32 * et + r) * SEQ + 8 * hi; const bf16_t* kb = a.KzT + ((size_t)u * 64 + 32 * dt + r) * SEQ + 8 * hi;
        f32x16 S;
#pragma unroll
        for (int i = 0; i < 16; ++i) S[i] = 0.f;
        bf16x8 A[8], B[8];
#pragma unroll
        for (int s2 = 0; s2 < 8; ++s2) { A[s2] = *(const bf16x8*)(va + 16 * s2); B[s2] = *(const bf16x8*)(kb + 16 * s2); }
        for (int c = 0; c < 32; ++c) {
            bf16_t* sp = a.ST + (((size_t)u * 32 + c) * 64 + 32 * et + 4 * hi) * 64 + 32 * dt + r;
#pragma unroll
            for (int i = 0; i < 16; ++i) sp[((i & 3) + 8 * (i >> 2)) * 64] = f2bf(S[i]);
            f32x16 KV;
#pragma unroll
            for (int i = 0; i < 16; ++i) KV[i] = 0.f;
            bf16x8 An[8], Bn[8]; const int cn = c < 31 ? c + 1 : c;
#pragma unroll
            for (int s2 = 0; s2 < 8; ++s2) { An[s2] = *(const bf16x8*)(va + cn * 128 + 16 * s2); Bn[s2] = *(const bf16x8*)(kb + cn * 128 + 16 * s2); }
#pragma unroll
            for (int s2 = 0; s2 < 8; ++s2) KV = __builtin_amdgcn_mfma_f32_32x32x16_bf16(A[s2], B[s2], KV, 0, 0, 0);
#pragma unroll
            for (int i = 0; i < 16; ++i) S[i] = gc * S[i] + KV[i];
#pragma unroll
            for (int s2 = 0; s2 < 8; ++s2) { A[s2] = An[s2]; B[s2] = Bn[s2]; }
        }
    }
}
__device__ __forceinline__ void ph_ret_out(const Args& a, int l, int vcu, int G) {
    using namespace ret;
    int tid = threadIdx.x; asm volatile("" : "+v"(tid)); asm volatile("" : "+s"(vcu));
    const int w = tid >> 6, lane = tid & 63, hi = lane >> 5, r = lane & 31, h = w >> 1, qh = w & 1;
    const float lg = lg2g(h); const float* gn = a.ret_gn + l * 256 + h * 64;
    for (int u = vcu; u < NB * 32; u += G) { const int b = u >> 5, c = u & 31, bh = b * 4 + h;
        const bf16_t* stp = a.ST + ((size_t)bh * 32 + c) * 4096; const bf16_t* vt = a.VrT + (size_t)bh * 64 * SEQ + c * 128;
#pragma unroll 1
        for (int qt = 0; qt < 2; ++qt) { const int q = 2 * qh + qt; const size_t row = (size_t)b * SEQ + c * 128 + 32 * q + r;
            bf16x8 Qf[4];
#pragma unroll
            for (int s = 0; s < 4; ++s) Qf[s] = *(const bf16x8*)(a.qrb + row * 256 + h * 64 + 16 * s + 8 * hi);
            f32x16 O0, O1;
#pragma unroll
            for (int i = 0; i < 16; ++i) { O0[i] = 0.f; O1[i] = 0.f; }
#pragma unroll
            for (int s = 0; s < 4; ++s) { const bf16x8 a0 = *(const bf16x8*)(stp + r * 64 + 16 * s + 8 * hi), a1 = *(const bf16x8*)(stp + (32 + r) * 64 + 16 * s + 8 * hi);
                O0 = __builtin_amdgcn_mfma_f32_32x32x16_bf16(a0, Qf[s], O0, 0, 0, 0); O1 = __builtin_amdgcn_mfma_f32_32x32x16_bf16(a1, Qf[s], O1, 0, 0, 0); }
            const float xi = exp2f((float)(32 * q + r + 1) * lg);
#pragma unroll
            for (int i = 0; i < 16; ++i) { O0[i] *= xi; O1[i] *= xi; }
            for (int kt = 0; kt <= q; ++kt) { const size_t krow = (size_t)b * SEQ + c * 128 + 32 * kt + r;
                f32x16 S;
#pragma unroll
                for (int i = 0; i < 16; ++i) S[i] = 0.f;
#pragma unroll
                for (int s = 0; s < 4; ++s) { const bf16x8 ka = *(const bf16x8*)(a.krb + krow * 256 + h * 64 + 16 * s + 8 * hi); S = __builtin_amdgcn_mfma_f32_32x32x16_bf16(ka, Qf[s], S, 0, 0, 0); }
                const int dbase = 32 * (q - kt) + r - 4 * hi;
#pragma unroll
                for (int i = 0; i < 16; ++i) { const int dl = dbase - ((i & 3) + 8 * (i >> 2)); S[i] = dl >= 0 ? S[i] * exp2f((float)dl * lg) : 0.f; }
#pragma unroll
                for (int s2 = 0; s2 < 2; ++s2) { u32x4 pw;
#pragma unroll
                    for (int x = 0; x < 4; ++x) pw[x] = pk2(S[8 * s2 + 2 * x], S[8 * s2 + 2 * x + 1]);
                    const bf16x8 Pf = __builtin_bit_cast(bf16x8, pw);
                    const bf16_t* v0 = vt + (size_t)r * SEQ + 32 * kt + 16 * s2 + 4 * hi; const bf16_t* v1 = v0 + (size_t)32 * SEQ;
                    const u32x2 x0 = *(const u32x2*)v0, y0 = *(const u32x2*)(v0 + 8), x1 = *(const u32x2*)v1, y1 = *(const u32x2*)(v1 + 8);
                    O0 = __builtin_amdgcn_mfma_f32_32x32x16_bf16(__builtin_bit_cast(bf16x8, (u32x4){x0.x, x0.y, y0.x, y0.y}), Pf, O0, 0, 0, 0);
                    O1 = __builtin_amdgcn_mfma_f32_32x32x16_bf16(__builtin_bit_cast(bf16x8, (u32x4){x1.x, x1.y, y1.x, y1.y}), Pf, O1, 0, 0, 0); }
            }
            float sm = 0.f;
#pragma unroll
            for (int i = 0; i < 16; ++i) sm += O0[i] + O1[i];
            sm += __shfl_xor(sm, 32); const float mu = sm * (1.f / 64.f); float vq = 0.f;
#pragma unroll
            for (int i = 0; i < 16; ++i) { const float d0 = O0[i] - mu, d1 = O1[i] - mu; vq += d0 * d0 + d1 * d1; }
            vq += __shfl_xor(vq, 32); const float rs = rsqrtf(vq * (1.f / 64.f) + 1e-5f);
            const bf16_t* gp = a.proj + row * DINP + C_RG + h * 64 + 4 * hi; bf16_t* op = a.ocat + row * DM + 768 + h * 64 + 4 * hi;
#pragma unroll
            for (int q4 = 0; q4 < 4; ++q4) {
#pragma unroll
                for (int et = 0; et < 2; ++et) { const int e0 = 32 * et + 8 * q4; const u32x2 gt = *(const u32x2*)(gp + e0); const f32x4 gg = *(const f32x4*)(gn + e0 + 4 * hi);
                    float o[4];
#pragma unroll
                    for (int x = 0; x < 4; ++x) { const float ov = et ? O1[4 * q4 + x] : O0[4 * q4 + x]; const unsigned gw = x < 2 ? gt.x : gt.y; const float gv = __uint_as_float((x & 1) ? (gw & 0xffff0000u) : (gw << 16));
                        o[x] = siluf(gv) * (ov - mu) * rs * gg[x]; }
                    u32x2 ow; ow.x = pk2(o[0], o[1]); ow.y = pk2(o[2], o[3]); *(u32x2*)(op + e0) = ow; } }
        }
    }
}

__device__ __forceinline__ void ph_route(const Args& a, LAS char* lds, int vcu, int G) {
    int tid_ = threadIdx.x; asm volatile("" : "+v"(tid_)); asm volatile("" : "+s"(vcu));
    const int lane = tid_ & 63; const float* g = a.ln_ffn + DM; LAS float* gr = (LAS float*)lds;
    __syncthreads();
    for (int q = tid_; q < DM * 8; q += NT) gr[q] = a.router[q] * g[q >> 3];
    __syncthreads();
    for (int row = vcu * NW + (tid_ >> 6); row < NTOK; row += G * NW) { float lg[8];
#pragma unroll
        for (int e = 0; e < 8; ++e) lg[e] = 0.f;
        f32x4 xv[4];
#pragma unroll
        for (int i = 0; i < 4; ++i) xv[i] = *(const f32x4*)(a.xres + (size_t)row * DM + lane * 4 + 256 * i);
#pragma unroll
        for (int i = 0; i < 4; ++i)
#pragma unroll
            for (int jj = 0; jj < 4; ++jj) { const int k = lane * 4 + 256 * i + jj; const f32x4 r0 = *(const LAS f32x4*)(gr + k * 8), r1 = *(const LAS f32x4*)(gr + k * 8 + 4); const float x = xv[i][jj];
                lg[0] += x * r0[0]; lg[1] += x * r0[1]; lg[2] += x * r0[2]; lg[3] += x * r0[3]; lg[4] += x * r1[0]; lg[5] += x * r1[1]; lg[6] += x * r1[2]; lg[7] += x * r1[3]; }
        const float rs = row_rstd(a.ssq, row);
#pragma unroll
        for (int e = 0; e < 8; ++e) lg[e] = wsum(lg[e]) * rs;
        int e1 = 0; float v1 = lg[0];
#pragma unroll
        for (int e = 1; e < 8; ++e) if (lg[e] > v1) { v1 = lg[e]; e1 = e; }
        int e2 = -1; float v2 = -INFINITY;
#pragma unroll
        for (int e = 0; e < 8; ++e) if (e != e1 && lg[e] > v2) { v2 = lg[e]; e2 = e; }
        if (lane == 0) { const float g1 = 1.f / (1.f + __expf(v2 - v1)); a.gate[row * 2] = g1; a.gate[row * 2 + 1] = 1.f - g1;
            const int i1 = atomicAdd(&a.cnt[e1], 1); a.tok_list[e1 * NTOK + i1] = row * 2; const int i2 = atomicAdd(&a.cnt[e2], 1); a.tok_list[e2 * NTOK + i2] = row * 2 + 1; } }
}
__device__ __forceinline__ void ph_route_build(const Args& a, int vcu, int G) {
    int tid_ = threadIdx.x; asm volatile("" : "+v"(tid_)); asm volatile("" : "+s"(vcu));
    for (int idx = vcu * NT + tid_; idx < NEXP * NTOK; idx += G * NT) { const int e = idx >> 15, i = idx & (NTOK - 1);
        int ps = 0; for (int q = 0; q < e; ++q) ps += (a.cnt[q] + 255) & ~255;
        const int ce = a.cnt[e], pe = (ce + 255) & ~255;
        if (i < ce) { const int en = a.tok_list[e * NTOK + i]; a.row_tok[ps + i] = en >> 1; a.slot[en] = ps + i; } else if (i < pe) a.row_tok[ps + i] = -1;
        if (i < pe && (i & 255) == 0) a.tile_exp[(ps + i) >> 8] = e;
        if (idx == 0) { int tot = 0; for (int q = 0; q < 8; ++q) tot += (a.cnt[q] + 255) & ~255; a.meta[0] = tot >> 8; } }
}
__device__ __forceinline__ void ph_final(const Args& a, int vcu, int G) {
    int tid_ = threadIdx.x; asm volatile("" : "+v"(tid_)); asm volatile("" : "+s"(vcu));
    const int lane = tid_ & 63; float* xio = a.xres;
    for (int row = vcu * NW + (tid_ >> 6); row < NTOK; row += G * NW) { const int s1 = a.slot[row * 2], s2 = a.slot[row * 2 + 1]; const float g1 = a.gate[row * 2], g2 = a.gate[row * 2 + 1];
        float v[16]; float ss = 0.f;
#pragma unroll
        for (int i = 0; i < 4; ++i) { const int c = lane * 4 + i * 256; const float4 xv = *(const float4*)(xio + (size_t)row * DM + c);
            const ushort4 p = *(const ushort4*)(a.ysorted + (size_t)s1 * DM + c), q = *(const ushort4*)(a.ysorted + (size_t)s2 * DM + c);
            v[i * 4 + 0] = xv.x + g1 * bf2f(p.x) + g2 * bf2f(q.x); v[i * 4 + 1] = xv.y + g1 * bf2f(p.y) + g2 * bf2f(q.y);
            v[i * 4 + 2] = xv.z + g1 * bf2f(p.z) + g2 * bf2f(q.z); v[i * 4 + 3] = xv.w + g1 * bf2f(p.w) + g2 * bf2f(q.w);
#pragma unroll
            for (int j = 0; j < 4; ++j) ss += v[i * 4 + j] * v[i * 4 + j]; }
        const float rs = rsqrtf(wsum(ss) * (1.f / DM) + 1e-6f);
#pragma unroll
        for (int i = 0; i < 4; ++i) { const int c = lane * 4 + i * 256; const float4 gf = *(const float4*)(a.ln_final + c); float4 o; o.x = v[i * 4] * rs * gf.x; o.y = v[i * 4 + 1] * rs * gf.y; o.z = v[i * 4 + 2] * rs * gf.z; o.w = v[i * 4 + 3] * rs * gf.w;
            *(float4*)(xio + (size_t)row * DM + c) = o; } }
}

__global__ void __launch_bounds__(NT, 2) mega(Args a) {
    extern __shared__ __attribute__((aligned(16))) char lds[];
    volatile LAS unsigned* misc = (volatile LAS unsigned*)((LAS char*)lds + MISC_OFF);
    if (threadIdx.x < 64) misc[threadIdx.x] = 0u;
    __syncthreads();
    XcdBarrier bar = xcd_barrier_post(a.bar, misc);
    const int G = gridDim.x, vcu = blockIdx.x;
    LAS char* const lds3 = (LAS char*)lds;
#ifndef REP_PRO
#define REP_PRO 1
#endif
#ifndef REP_GEMM
#define REP_GEMM 1
#endif
#ifndef REP_NSA
#define REP_NSA 1
#endif
#ifndef REP_X
#define REP_X 1
#endif
#define GRID_BAR() xcd_barrier(bar)
#define AS4 __attribute__((address_space(4)))
#if defined(__HIP_DEVICE_COMPILE__)
#define LA const AS4 Args* ap_ = (const AS4 Args*)__builtin_amdgcn_kernarg_segment_ptr(); asm volatile("" : "+s"(ap_)); Args A; __builtin_memcpy(&A, ap_, sizeof(Args))
#else
#define LA const Args A = a
#endif

    { LA; ph_prologue(A, lds3, vcu, G); }
    GRID_BAR();
#pragma unroll
    for (int l = 0; l < 2; ++l) {
        for (int rep = 0; rep < REP_GEMM; ++rep) { LA; pg8::Gemm g{A.xb, A.Win + (size_t)l * DINP * DM, NTOK, DINP, DM}; pg8::StaticOrder S; S.init(NTOK, DINP, G, vcu);
          pg8::gemm_phase<pg8::EIn, pg8::StaticOrder, 0>((PG8_LAS unsigned char*)lds3, g, S, pg8::EIn{A.proj, A.ssq}, nullptr, nullptr, 0); }
        GRID_BAR();
#pragma unroll 1
        for (int rep = 0; rep < REP_X; ++rep) {
#pragma unroll 1
        for (int kv = 0; kv < 2; ++kv) { const int i = l * 2 + kv;
            { LA; pg8::Gemm g{A.proj, A.W1b + (size_t)i * 256 * 2048, 4096, 256, 2048}; pg8::StaticOrder S; S.init(4096, 256, G, (vcu + G - kv * 16) % G);
              pg8::gemm_phase<pg8::ESiluBias, pg8::StaticOrder, 2>((PG8_LAS unsigned char*)lds3, g, S, pg8::ESiluBias{A.hc + (size_t)kv * 4096 * 256, A.bias1 + i * 256}, nullptr, nullptr, (size_t)(kv ? C_VC : C_KC)); } }
        { LA; ph_vtrans(A, lds3, vcu, G); }
        { LA; ph_conv_naive(A, l, lds3, vcu, G); }
        { LA; ph_ret_prep(A, lds3, vcu, G); }
        }
        GRID_BAR();
#pragma unroll 1
        for (int rep = 0; rep < REP_X; ++rep) {
        { LA; pg8::Gemm g{A.hc, A.W2b + (size_t)(l * 2) * 256 * 256, 4096, 256, 256}; pg8::StaticOrder S; S.init(4096, 256, G, vcu);
          pg8::gemm_phase<pg8::EKc, pg8::StaticOrder, 0>((PG8_LAS unsigned char*)lds3, g, S, pg8::EKc{A.kcb, 0, 0}, nullptr, nullptr, 0); }
        { LA; pg8::Gemm g{A.hc + (size_t)4096 * 256, A.W2b + (size_t)(l * 2 + 1) * 256 * 256, 4096, 256, 256}; pg8::StaticOrder S; S.init(4096, 256, G, (vcu + G - 16) % G);
          pg8::gemm_phase<pg8::EKc, pg8::StaticOrder, 0>((PG8_LAS unsigned char*)lds3, g, S, pg8::EKc{A.vcT, 1, 0}, nullptr, nullptr, 0); }
        { LA; pg8::Gemm g{A.hconv, A.Wpw + (size_t)l * 65536, NTOK, 256, 256}; pg8::StaticOrder S; S.init(NTOK, 256, G, (vcu + G - 32) % G);
          pg8::gemm_phase<pg8::EStore, pg8::StaticOrder, 0>((PG8_LAS unsigned char*)lds3, g, S, pg8::EStore{A.ocat + 512, DM}, nullptr, nullptr, 0); }
        { LA; ph_ret_state(A, (vcu + G - 64) % G, G); }
        }
        GRID_BAR();
        { LA; ph_ret_out(A, l, vcu, G); }
        for (int rep = 0; rep < REP_NSA; ++rep) { LA; ph_nsa(A, lds3, vcu, G); }
        GRID_BAR();
        { LA; pg8::Gemm g{A.ocat, A.Wout + (size_t)l * DM * DM, NTOK, DM, DM}; pg8::StaticOrder S; S.init(NTOK, DM, G, vcu);
          pg8::gemm_phase<pg8::ERes, pg8::StaticOrder, 0>((PG8_LAS unsigned char*)lds3, g, S, pg8::ERes{l == 0 ? A.x : A.xres, A.xres, A.xb, A.ssq}, nullptr, nullptr, 0); }
        GRID_BAR();
        if (l == 0) {
            for (int rep = 0; rep < REP_GEMM; ++rep) { LA; pg8::Gemm g{A.xb, A.W13, NTOK, 2 * DFF, DM}; pg8::StaticOrder S; S.init(NTOK, 2 * DFF, G, vcu);
              pg8::gemm_phase<pg8::ESwiglu, pg8::StaticOrder, 0>((PG8_LAS unsigned char*)lds3, g, S, pg8::ESwiglu{A.hbuf, A.ssq, nullptr}, nullptr, nullptr, 0); }
            GRID_BAR();
            { LA; pg8::Gemm g{A.hbuf, A.W2, NTOK, DM, DFF}; pg8::StaticOrder S; S.init(NTOK, DM, G, vcu);
              pg8::gemm_phase<pg8::ERes, pg8::StaticOrder, 0>((PG8_LAS unsigned char*)lds3, g, S, pg8::ERes{A.xres, A.xres, A.xb, A.ssq}, nullptr, nullptr, 0); }
            GRID_BAR();
        }
    }
    { LA; ph_route(A, lds3, vcu, G); }
    GRID_BAR();
    { LA; ph_route_build(A, vcu, G); }
    GRID_BAR();
    for (int rep = 0; rep < REP_GEMM; ++rep) { LA; const int Mm = A.meta[0] * 256; pg8::Gemm g{A.xb, A.Wm13, Mm, 2 * DFF, DM}; pg8::StaticOrder S; S.init(Mm, 2 * DFF, G, vcu);
      pg8::gemm_phase<pg8::ESwiglu, pg8::StaticOrder, 1>((PG8_LAS unsigned char*)lds3, g, S, pg8::ESwiglu{A.hbuf, A.ssq, A.row_tok}, A.row_tok, A.tile_exp, (size_t)2 * DFF * DM); }
    GRID_BAR();
    for (int rep = 0; rep < REP_GEMM; ++rep) { LA; const int Mm = A.meta[0] * 256; pg8::Gemm g{A.hbuf, A.Wm2, Mm, DM, DFF}; pg8::StaticOrder S; S.init(Mm, DM, G, vcu);
      pg8::gemm_phase<pg8::EStore, pg8::StaticOrder, 0>((PG8_LAS unsigned char*)lds3, g, S, pg8::EStore{A.ysorted, DM}, nullptr, A.tile_exp, (size_t)DM * DFF); }
    GRID_BAR();
    { LA; ph_final(A, vcu, G); }
}

static inline size_t al256(size_t x) { return (x + 255) & ~(size_t)255; }
extern "C" void kernel_launch(void* const* d_in, const int* in_sizes, int n_in, void* d_out, int out_size, void* d_ws, size_t ws_size, hipStream_t stream) {
    static int grid = 0;
    Args a{};
    const float** ins = (const float**)&a.x;
    for (int i = 0; i < 20; ++i) ins[i] = (const float*)d_in[i];
    a.xres = (float*)d_out;
    char* w = (char*)d_ws; size_t off = 0;
    auto take = [&](size_t bytes) { char* p = w + off; off = al256(off + bytes); return p; };
    a.bar = (unsigned*)take(XCD_BAR_WORDS * 4);
    a.cnt = (int*)take(256);
    a.meta = (int*)take(256);
    const size_t ctl_bytes = off;
    char* regY = w + off;
    a.Wm13 = (bf16_t*)take((size_t)NEXP * 2 * DFF * DM * 2);
    a.Win = (bf16_t*)take((size_t)2 * DINP * DM * 2);
    a.Wout = (bf16_t*)take((size_t)2 * DM * DM * 2);
    a.W13 = (bf16_t*)take((size_t)2 * DFF * DM * 2);
    a.W2 = (bf16_t*)take((size_t)DM * DFF * 2);
    a.xb = (bf16_t*)take((size_t)NTOK * DM * 2);
    a.ysorted = (bf16_t*)regY;
    a.Wm2 = (bf16_t*)take((size_t)NEXP * DM * DFF * 2);
    a.W1b = (bf16_t*)take((size_t)4 * 256 * 2048 * 2);
    a.W2b = (bf16_t*)take((size_t)4 * 256 * 256 * 2);
    a.Wpw = (bf16_t*)take((size_t)2 * 256 * 256 * 2);
    a.bias1 = (float*)take(4 * 256 * 4);
    a.rot = (float*)take((size_t)4096 * 32 * 2 * 4);
    a.ssq = (float*)take((size_t)NTOK * NSLOT * 4);
    a.tok_list = (int*)take((size_t)NEXP * NTOK * 4);
    a.row_tok = (int*)take((size_t)PMAX * 4);
    a.slot = (int*)take((size_t)NTOK * 2 * 4);
    a.tile_exp = (int*)take(1024 * 4);
    a.gate = (float*)take((size_t)NTOK * 2 * 4);
    char* regR = w + off;
    a.proj = (bf16_t*)take((size_t)NTOK * DINP * 2);
    a.ocat = (bf16_t*)take((size_t)NTOK * DM * 2);
    a.hc = (bf16_t*)take((size_t)2 * 4096 * 256 * 2);
    a.kcb = (bf16_t*)take((size_t)4096 * 64 * 2);
    a.vcb = (bf16_t*)take((size_t)4096 * 64 * 2);
    a.hconv = (bf16_t*)take((size_t)NTOK * 256 * 2);
    a.qr = (float*)take((size_t)NTOK * 256 * 4);
    a.kr = (float*)take((size_t)NTOK * 256 * 4);
    a.KV = (float*)take((size_t)1024 * 4096 * 4);
    a.Sst = (float*)take((size_t)1024 * 4096 * 4);
    a.vcT = (bf16_t*)take((size_t)16 * 64 * 256 * 2);
    a.VsT = (bf16_t*)take((size_t)16 * 64 * SEQ * 2);
    a.VwT = (bf16_t*)take((size_t)16 * 64 * SEQ * 2);
    a.qrb = (bf16_t*)take((size_t)NTOK * 256 * 2);
    a.krb = (bf16_t*)take((size_t)NTOK * 256 * 2);
    a.KzT = (bf16_t*)take((size_t)32 * 64 * SEQ * 2);
    a.VrT = (bf16_t*)take((size_t)32 * 64 * SEQ * 2);
    a.ST = (bf16_t*)take((size_t)32 * 32 * 4096 * 2);
    a.hbuf = (bf16_t*)regR;
    const size_t need = (size_t)(regR - w) + (size_t)PMAX * DFF * 2;
    if (grid == 0) {
        if (need > ws_size || off > ws_size || n_in != 20) { fprintf(stderr, "kernel_launch: workspace too small: need %zu / %zu have %zu\n", need, off, ws_size); grid = -1; return; }
        int dev = 0, cus = 0;
        if (hipGetDevice(&dev) != hipSuccess || hipDeviceGetAttribute(&cus, hipDeviceAttributeMultiprocessorCount, dev) != hipSuccess) { grid = -1; return; }
        if (hipFuncSetAttribute((const void*)mega, hipFuncAttributeMaxDynamicSharedMemorySize, LDS_BYTES) != hipSuccess) { fprintf(stderr, "kernel_launch: hipFuncSetAttribute failed\n"); grid = -1; return; }
        int per_cu = 0;
        if (hipOccupancyMaxActiveBlocksPerMultiprocessor(&per_cu, (const void*)mega, NT, LDS_BYTES) != hipSuccess || per_cu < 1) { fprintf(stderr, "kernel_launch: occupancy query says %d\n", per_cu); }
        (void)hipGetLastError();
        grid = cus;
    }
    if (grid < 0) return;
    (void)hipMemsetAsync(w, 0, ctl_bytes, stream);
    hipLaunchKernelGGL(mega, dim3(grid), dim3(NT), LDS_BYTES, stream, a);
}
```

```cpp
#include <hip/hip_runtime.h>
#include <stdint.h>
#include <stdio.h>

typedef unsigned short bf16_t;
typedef short bf16x8 __attribute__((ext_vector_type(8)));
typedef float f32x4 __attribute__((ext_vector_type(4)));
typedef unsigned u32x4_t __attribute__((ext_vector_type(4)));

constexpr int NTOK = 32768, DM = 1024, NB = 8, SEQ = 4096;
constexpr int DIN = 2840, DINP = 3072, DFF = 2816, NEXP = 8;
constexpr int C_Q = 0, C_KC = 512, C_VC = 640, C_KS = 768, C_VS = 896, C_KW = 1024, C_VW = 1152, C_GL = 1280,
              C_CONV = 1304, C_RQ = 1816, C_RK = 2072, C_RV = 2328, C_RG = 2584;
constexpr int NSLOT = 16;
constexpr int PMAX = 65536 + 8 * 256;
constexpr int NT = 512, NW = 8;
constexpr int LDS_BYTES = 144 * 1024, MISC_OFF = LDS_BYTES - 256;

#define XB_TMO      128
#define XB_XCNT(j)  (256  + 64 * (j))
#define XB_XSUB(j)  (1280 + 64 * (j))
#define XB_XGEN(j)  (2304 + 64 * (j))
#define XB_TOP      3328
#define XB_TOPGEN   3392
#define XCD_BAR_WORDS 3456
#define XB_SPIN_CAP (1u << 20)
#define LAS __attribute__((address_space(3)))
__device__ __forceinline__ unsigned xb_ld(unsigned* p)              { return __hip_atomic_load(p, __ATOMIC_RELAXED, __HIP_MEMORY_SCOPE_AGENT); }
__device__ __forceinline__ unsigned xb_add(unsigned* p, unsigned v) { return __hip_atomic_fetch_add(p, v, __ATOMIC_RELAXED, __HIP_MEMORY_SCOPE_AGENT); }
__device__ __forceinline__ unsigned xb_xcc_id() { return (unsigned)__builtin_amdgcn_s_getreg((3 << 11) | 20) & 0xFu; }
#define XB_SPIN(cond, bar) do { unsigned _sp = 0; while (cond) { __builtin_amdgcn_s_sleep(1); \
    if ((++_sp & 255u) == 0u) { if (xb_ld(&(bar)[XB_TMO])) break; if (_sp > XB_SPIN_CAP) { atomicAdd(&(bar)[XB_TMO], 1u); break; } } } } while (0)
struct XcdBarrier { unsigned* bar; unsigned x; volatile LAS unsigned* st; };
__device__ __forceinline__ XcdBarrier xcd_barrier_post(unsigned* bar, volatile LAS unsigned* st) {
    XcdBarrier b; b.bar = bar; b.x = xb_xcc_id(); b.st = st;
    if (threadIdx.x == 0) (void)xb_add(&bar[XB_XCNT(b.x)], 1u);
    return b;
}
__device__ __forceinline__ void xcd_barrier_complete(unsigned* bar, unsigned x, unsigned& nloc, unsigned& nx) {
    const unsigned G = gridDim.x * gridDim.y * gridDim.z;
    unsigned sum, cnt, mine, sp = 0u;
    for (;;) {
        sum = 0u; cnt = 0u; mine = 0u;
#pragma unroll
        for (unsigned j = 0; j < 16; ++j) { const unsigned c = xb_ld(&bar[XB_XCNT(j)]); sum += c; cnt += (c > 0u) ? 1u : 0u; mine = (j == x) ? c : mine; }
        if (sum == G) break;
        __builtin_amdgcn_s_sleep(1);
        if ((++sp & 255u) == 0u) { if (xb_ld(&bar[XB_TMO])) break; if (sp > XB_SPIN_CAP) { atomicAdd(&bar[XB_TMO], 1u); break; } }
    }
    nloc = mine > 0u ? mine : 1u; nx = cnt > 0u ? cnt : 1u;
}
__device__ __forceinline__ void xcd_barrier(const XcdBarrier& b) {
    asm volatile("s_waitcnt vmcnt(0)" ::: "memory");
    __syncthreads();
    if (threadIdx.x == 0) {
        unsigned* bar = b.bar;
        __builtin_amdgcn_s_waitcnt(0);
        const unsigned bx = xb_xcc_id();
        unsigned nloc = b.st[0], nx = b.st[1];
        if (nloc == 0u) { xcd_barrier_complete(bar, bx, nloc, nx); b.st[0] = nloc; b.st[1] = nx; }
        const unsigned old = xb_add(&bar[XB_XSUB(bx)], 1u);
        const unsigned gen = old / nloc;
        if (old + 1u == (gen + 1u) * nloc) {
            __builtin_amdgcn_fence(__ATOMIC_RELEASE, "agent");
            asm volatile("s_waitcnt vmcnt(0)" ::: "memory");
            const unsigned og = xb_add(&bar[XB_TOP], 1u);
            const unsigned tg = og / nx;
            if (og + 1u == (tg + 1u) * nx) xb_add(&bar[XB_TOPGEN], 1u);
            else XB_SPIN(xb_ld(&bar[XB_TOPGEN]) == tg, bar);
            __builtin_amdgcn_fence(__ATOMIC_ACQUIRE, "agent");
            xb_add(&bar[XB_XGEN(bx)], 1u);
            asm volatile("s_waitcnt vmcnt(0)" ::: "memory");
        } else {
            XB_SPIN(xb_ld(&bar[XB_XGEN(bx)]) == gen, bar);
            __builtin_amdgcn_fence(__ATOMIC_ACQUIRE, "agent");
            asm volatile("s_waitcnt vmcnt(0)" ::: "memory");
        }
    }
    __syncthreads();
}

__device__ __forceinline__ bf16_t f2bf(float f) { unsigned u = __float_as_uint(f); u += 0x7fffu + ((u >> 16) & 1u); return (bf16_t)(u >> 16); }
__device__ __forceinline__ unsigned pk2bf(float lo, float hi) { unsigned r; asm volatile("v_cvt_pk_bf16_f32 %0, %1, %2" : "=v"(r) : "v"(lo), "v"(hi)); return r; }
__device__ __forceinline__ float bf2f(bf16_t h) { return __uint_as_float(((unsigned)h) << 16); }
__device__ __forceinline__ float wsum(float v) {
#pragma unroll
    for (int o = 32; o > 0; o >>= 1) v += __shfl_xor(v, o);
    return v; }
__device__ __forceinline__ float wmax(float v) {
#pragma unroll
    for (int o = 32; o > 0; o >>= 1) v = fmaxf(v, __shfl_xor(v, o));
    return v; }
__device__ __forceinline__ float siluf(float x) { return x / (1.f + __expf(-x)); }
__device__ __forceinline__ float sigmf(float x) { return 1.f / (1.f + __expf(-x)); }
__device__ __forceinline__ float row_rstd(const float* ssq, int row) { const f32x4* p = (const f32x4*)(ssq + (size_t)row * NSLOT); const f32x4 a = p[0], b = p[1], c = p[2], d = p[3];
    const f32x4 t = (a + b) + (c + d); return rsqrtf(((t[0] + t[1]) + (t[2] + t[3])) * (1.f / DM) + 1e-6f); }

struct Args {
    const float *x, *ln_attn, *w_in, *cmp_pe, *cmp_w1, *cmp_w2, *conv_w, *conv_b, *conv_lg, *conv_lb, *conv_pw, *ret_gn, *w_out, *ln_ffn, *ffn_w13, *ffn_w2, *router, *moe_w13, *moe_w2, *ln_final;
    float* xres;
    bf16_t *Wm13, *Win, *Wout, *W13, *W2, *xb, *ysorted, *Wm2, *W1b, *W2b, *Wpw;
    float *bias1, *rot, *ssq; int *cnt, *meta, *tok_list, *row_tok, *slot, *tile_exp; float* gate;
    bf16_t *proj, *ocat, *hc, *kcb, *vcb, *hconv; float *qr, *kr, *KV, *Sst; bf16_t* hbuf; bf16_t *vcT, *VsT, *VwT, *qrb, *krb, *KzT, *VrT, *ST;
    unsigned* bar;
};

struct ConvJob { const float* src; bf16_t* dst; const float* g; int ldsrc, K, Npad, nvalid, mode, pad; };
__device__ __forceinline__ ConvJob get_job(const Args& a, int j) {
    ConvJob c; c.g = nullptr; c.mode = 0; c.pad = 0;
    if (j < 2) { c.src = a.w_in + (size_t)j * DM * DIN; c.dst = a.Win + (size_t)j * DINP * DM; c.g = a.ln_attn + j * DM; c.ldsrc = DIN; c.K = DM; c.Npad = DINP; c.nvalid = DIN; c.mode = 1; }
    else if (j < 4) { const int l = j - 2; c.src = a.w_out + (size_t)l * DM * DM; c.dst = a.Wout + (size_t)l * DM * DM; c.ldsrc = DM; c.K = DM; c.Npad = DM; c.nvalid = DM; }
    else if (j < 6) { const int l = j - 4; c.src = a.conv_pw + (size_t)l * 65536; c.dst = a.Wpw + (size_t)l * 65536; c.ldsrc = 256; c.K = 256; c.Npad = 256; c.nvalid = 256; }
    else if (j < 10) { const int i = j - 6; c.src = a.cmp_w1 + (size_t)i * 2048 * 256; c.dst = a.W1b + (size_t)i * 256 * 2048; c.ldsrc = 256; c.K = 2048; c.Npad = 256; c.nvalid = 256; }
    else if (j < 14) { const int i = j - 10; c.src = a.cmp_w2 + (size_t)i * 256 * 64; c.dst = a.W2b + (size_t)i * 256 * 256; c.ldsrc = 64; c.K = 256; c.Npad = 256; c.nvalid = 64; }
    else if (j == 14) { c.src = a.ffn_w13; c.dst = a.W13; c.g = a.ln_ffn; c.ldsrc = 2 * DFF; c.K = DM; c.Npad = 2 * DFF; c.nvalid = 2 * DFF; c.mode = 2; }
    else if (j == 15) { c.src = a.ffn_w2; c.dst = a.W2; c.ldsrc = DM; c.K = DFF; c.Npad = DM; c.nvalid = DM; }
    else if (j < 24) { const int e = j - 16; c.src = a.moe_w13 + (size_t)e * DM * 2 * DFF; c.dst = a.Wm13 + (size_t)e * 2 * DFF * DM; c.g = a.ln_ffn + DM; c.ldsrc = 2 * DFF; c.K = DM; c.Npad = 2 * DFF; c.nvalid = 2 * DFF; c.mode = 2; }
    else { const int e = j - 24; c.src = a.moe_w2 + (size_t)e * DFF * DM; c.dst = a.Wm2 + (size_t)e * DM * DFF; c.ldsrc = DM; c.K = DFF; c.Npad = DM; c.nvalid = DM; }
    return c;
}
constexpr int NJOBS = 32;
__device__ __forceinline__ void conv_super(const ConvJob& c, int st, LAS float* lt, int tid_) {
    const int nsn = c.Npad / 256, n0 = (st % nsn) * 256, k0 = (st / nsn) * 64, lane = tid_ & 63, wv = tid_ >> 6;
    float v[32];
#pragma unroll
    for (int q = 0; q < 4; ++q) { const int n = n0 + q * 64 + lane; int sc;
        if (c.mode == 2) { const int pn = n >> 8, i = n & 255; sc = i < 128 ? 128 * pn + i : DFF + 128 * pn + (i - 128); } else sc = n < c.nvalid ? n : -1;
#pragma unroll
        for (int i = 0; i < 8; ++i) v[q * 8 + i] = sc >= 0 ? c.src[(size_t)(k0 + wv + 8 * i) * c.ldsrc + sc] : 0.f; }
#pragma unroll
    for (int q = 0; q < 4; ++q)
#pragma unroll
        for (int i = 0; i < 8; ++i) lt[(wv + 8 * i) * 257 + q * 64 + lane] = v[q * 8 + i];
    __syncthreads();
    const int nl = tid_ >> 3, ch = tid_ & 7;
    float gs[8];
#pragma unroll
    for (int e = 0; e < 8; ++e) gs[e] = c.g ? c.g[k0 + 8 * ch + e] : 1.f;
#pragma unroll
    for (int q = 0; q < 4; ++q) { const int n = n0 + q * 64 + nl; const float cs = (c.mode == 1 && (n < 512 || (n >= C_RK && n < C_RV))) ? 0.125f : 1.f; float x[8];
#pragma unroll
        for (int e = 0; e < 8; ++e) x[e] = lt[(8 * ch + e) * 257 + q * 64 + nl] * gs[e] * cs;
        u32x4_t w; w.x = pk2bf(x[0], x[1]); w.y = pk2bf(x[2], x[3]); w.z = pk2bf(x[4], x[5]); w.w = pk2bf(x[6], x[7]);
        *(u32x4_t*)(c.dst + (size_t)n * c.K + k0 + 8 * ch) = w; }
    __syncthreads();
}
__device__ __forceinline__ void ph_prologue(const Args& a, LAS char* lds, int vcu, int G) {
    int tid_ = threadIdx.x; asm volatile("" : "+v"(tid_)); asm volatile("" : "+s"(vcu));
    LAS float* lt = (LAS float*)lds; int acc = 0;
    for (int j = 0; j < NJOBS; ++j) { const ConvJob c = get_job(a, j); const int nt = (c.Npad / 256) * (c.K / 64);
        int t0 = vcu - (acc % G); if (t0 < 0) t0 += G;
        for (int t = t0; t < nt; t += G) conv_super(c, t, lt, tid_);
        acc += nt; }
    for (int u = vcu; u < 16; u += G) { const int i = u >> 2, nl = tid_ & 63, kp = tid_ >> 6, n = (u & 3) * 64 + nl; float s = 0.f;
        const float* pe = a.cmp_pe + (size_t)i * 2048; const float* w1 = a.cmp_w1 + (size_t)i * 2048 * 256;
        for (int k = kp; k < 2048; k += NW) s += pe[k] * w1[(size_t)k * 256 + n];
        lt[kp * 64 + nl] = s; __syncthreads();
        if (kp == 0) { float t = 0.f; for (int q = 0; q < NW; ++q) t += lt[q * 64 + nl]; a.bias1[i * 256 + n] = t; }
        __syncthreads(); }
    for (int idx = vcu * NT + tid_; idx < 4096 * 32; idx += G * NT) { const int pos = idx >> 5, i = idx & 31; const float inv = powf(10000.f, -(float)i / 32.f), ang = (float)pos * inv;
        a.rot[idx * 2] = cosf(ang); a.rot[idx * 2 + 1] = sinf(ang); }
    const int lane = tid_ & 63;
    for (int row = vcu * NW + (tid_ >> 6); row < NTOK; row += G * NW) { float s = 0.f;
        for (int c = lane * 4; c < DM; c += 256) { const float4 v = *(const float4*)(a.x + (size_t)row * DM + c); s += v.x * v.x + v.y * v.y + v.z * v.z + v.w * v.w;
            ushort4 o; o.x = f2bf(v.x); o.y = f2bf(v.y); o.z = f2bf(v.z); o.w = f2bf(v.w); *(ushort4*)(a.xb + (size_t)row * DM + c) = o; }
        s = wsum(s); if (lane < NSLOT) a.ssq[(size_t)row * NSLOT + lane] = lane == 0 ? s : 0.f; }
}

struct APlain { const bf16_t* A; int lda; __device__ __forceinline__ const bf16_t* ptr(int row, int k) const { return A + (size_t)row * lda + k; } };
struct AGather { const bf16_t* A; const int* row_tok; int lda; __device__ __forceinline__ const bf16_t* ptr(int row, int k) const { const int t = row_tok[row]; return t < 0 ? nullptr : A + (size_t)t * lda + k; } };
struct ACmp { const bf16_t* proj; int coloff;
    __device__ __forceinline__ const bf16_t* ptr(int row, int k) const { const int c = row & 255, g = (row >> 8) & 1, b = row >> 9; if (c == 255) return nullptr;
        return proj + (size_t)(b * SEQ + 16 * c + (k >> 6)) * DINP + coloff + g * 64 + (k & 63); } };
struct SchedPlain { int nM, nN; __device__ __forceinline__ int count() const { return nM * nN; }
    __device__ __forceinline__ void get(int u, int& row0, int& col0, size_t& boff) const { row0 = (u / nN) * 256; col0 = (u % nN) * 256; boff = 0; } };
struct SchedMoe { const int* meta; const int* tile_exp; size_t estride; int nN;
    __device__ __forceinline__ int count() const { return meta[0] * nN; }
    __device__ __forceinline__ void get(int u, int& row0, int& col0, size_t& boff) const { row0 = (u / nN) * 256; col0 = (u % nN) * 256; boff = (size_t)tile_exp[row0 >> 8] * estride; } };

struct EpiIn { bf16_t* proj; const float* ssq;
    __device__ __forceinline__ void apply(const f32x4 (&acc)[2][16], int rowb, int col0, int lane) const {
#pragma unroll
        for (int mi = 0; mi < 2; ++mi)
#pragma unroll
            for (int r = 0; r < 4; ++r) { const int row = rowb + mi * 16 + (lane >> 4) * 4 + r; const float rs = row_rstd(ssq, row);
#pragma unroll
                for (int n = 0; n < 16; ++n) proj[(size_t)row * DINP + col0 + n * 16 + (lane & 15)] = f2bf(acc[mi][n][r] * rs); } } };
struct EpiRes { const float* xold; float* xnew; bf16_t* xb; float* ssq;
    __device__ __forceinline__ void apply(const f32x4 (&acc)[2][16], int rowb, int col0, int lane) const {
#pragma unroll
        for (int mi = 0; mi < 2; ++mi)
#pragma unroll
            for (int r = 0; r < 4; ++r) { const int row = rowb + mi * 16 + (lane >> 4) * 4 + r; float s = 0.f;
#pragma unroll
                for (int n = 0; n < 16; ++n) { const size_t o = (size_t)row * DM + col0 + n * 16 + (lane & 15); const float v = xold[o] + acc[mi][n][r]; xnew[o] = v; xb[o] = f2bf(v); s += v * v; }
                s += __shfl_xor(s, 1); s += __shfl_xor(s, 2); s += __shfl_xor(s, 4); s += __shfl_xor(s, 8);
                if ((lane & 15) < 4) ssq[(size_t)row * NSLOT + (col0 >> 8) * 4 + (lane & 15)] = (lane & 15) == 0 ? s : 0.f; } } };
struct EpiSwiglu { bf16_t* h; const float* ssq; const int* row_tok;
    __device__ __forceinline__ void apply(const f32x4 (&acc)[2][16], int rowb, int col0, int lane) const {
#pragma unroll
        for (int mi = 0; mi < 2; ++mi)
#pragma unroll
            for (int r = 0; r < 4; ++r) { const int row = rowb + mi * 16 + (lane >> 4) * 4 + r; const int t = row_tok ? row_tok[row] : row;
                const float rs = t < 0 ? 0.f : row_rstd(ssq, t < 0 ? 0 : t);
#pragma unroll
                for (int n = 0; n < 8; ++n) { const float av = acc[mi][n][r] * rs, bv = acc[mi][n + 8][r] * rs; h[(size_t)row * DFF + (col0 >> 1) + n * 16 + (lane & 15)] = f2bf(siluf(av) * bv); } } } };
struct EpiStore { bf16_t* out; int ldc, coloff, ncols;
    __device__ __forceinline__ void apply(const f32x4 (&acc)[2][16], int rowb, int col0, int lane) const {
#pragma unroll
        for (int mi = 0; mi < 2; ++mi)
#pragma unroll
            for (int r = 0; r < 4; ++r) { const int row = rowb + mi * 16 + (lane >> 4) * 4 + r;
#pragma unroll
                for (int n = 0; n < 16; ++n) { const int c = col0 + n * 16 + (lane & 15); if (c < ncols) out[(size_t)row * ldc + coloff + c] = f2bf(acc[mi][n][r]); } } } };
struct EpiStoreT { bf16_t* out;
    __device__ __forceinline__ void apply(const f32x4 (&acc)[2][16], int rowb, int col0, int lane) const {
#pragma unroll
        for (int mi = 0; mi < 2; ++mi)
#pragma unroll
            for (int r = 0; r < 4; ++r) { const int row = rowb + mi * 16 + (lane >> 4) * 4 + r;
#pragma unroll
                for (int n = 0; n < 4; ++n) { const int c = col0 + n * 16 + (lane & 15); out[(size_t)(row >> 8) * 16384 + c * 256 + (row & 255)] = f2bf(acc[mi][n][r]); } } } };
struct EpiSiluBias { bf16_t* out; const float* bias; int ldc;
    __device__ __forceinline__ void apply(const f32x4 (&acc)[2][16], int rowb, int col0, int lane) const {
#pragma unroll
        for (int mi = 0; mi < 2; ++mi)
#pragma unroll
            for (int r = 0; r < 4; ++r) { const int row = rowb + mi * 16 + (lane >> 4) * 4 + r;
#pragma unroll
                for (int n = 0; n < 16; ++n) { const int c = col0 + n * 16 + (lane & 15); out[(size_t)row * ldc + c] = f2bf(siluf(acc[mi][n][r] + bias[c])); } } } };

template <class AS, class Epi, class Sched>
__device__ __forceinline__ void ph_gemm(LAS char* lds, const AS as, const bf16_t* __restrict__ Bt, const int K, const Epi epi, const Sched sched, int vcu, int G) {
    int tid_ = threadIdx.x; asm volatile("" : "+v"(tid_)); asm volatile("" : "+s"(vcu));
    LAS bf16_t* sA = (LAS bf16_t*)lds; LAS bf16_t* sB = (LAS bf16_t*)(lds + 256 * 40 * 2);
    const int tid = tid_, wave = tid >> 6, lane = tid & 63;
    const int nunits = sched.count();
    for (int u = vcu; u < nunits; u += G) {
        int row0, col0; size_t boff; sched.get(u, row0, col0, boff);
        const bf16_t* Bu = Bt + boff;
        f32x4 acc[2][16];
#pragma unroll
        for (int mi = 0; mi < 2; ++mi)
#pragma unroll
            for (int n = 0; n < 16; ++n) acc[mi][n] = (f32x4){0.f, 0.f, 0.f, 0.f};
#pragma unroll 1
        for (int k0 = 0; k0 < K; k0 += 32) {
#pragma unroll
            for (int i = 0; i < 2; ++i) { const int c = tid + i * NT, r = c >> 2, kc = (c & 3) * 8; const bf16_t* p = as.ptr(row0 + r, k0 + kc);
                uint4 v = make_uint4(0u, 0u, 0u, 0u); if (p) v = *(const uint4*)p; *(LAS u32x4_t*)&sA[r * 40 + kc] = (u32x4_t){v.x, v.y, v.z, v.w}; }
#pragma unroll
            for (int i = 0; i < 2; ++i) { const int c = tid + i * NT, r = c >> 2, kc = (c & 3) * 8;
                *(LAS u32x4_t*)&sB[r * 40 + kc] = *(const u32x4_t*)(Bu + (size_t)(col0 + r) * K + k0 + kc); }
            __syncthreads();
            bf16x8 af[2];
#pragma unroll
            for (int mi = 0; mi < 2; ++mi) af[mi] = *(const LAS bf16x8*)&sA[(wave * 32 + mi * 16 + (lane & 15)) * 40 + (lane >> 4) * 8];
#pragma unroll
            for (int n = 0; n < 16; ++n) { const bf16x8 bfr = *(const LAS bf16x8*)&sB[(n * 16 + (lane & 15)) * 40 + (lane >> 4) * 8];
#pragma unroll
                for (int mi = 0; mi < 2; ++mi) acc[mi][n] = __builtin_amdgcn_mfma_f32_16x16x32_bf16(af[mi], bfr, acc[mi][n], 0, 0, 0); }
            __syncthreads();
        }
        epi.apply(acc, row0 + wave * 32, col0, lane);
    }
}


namespace pg8 {
#define PG8_LAS __attribute__((address_space(3)))
typedef unsigned u32x4 __attribute__((ext_vector_type(4)));
typedef unsigned u32x2 __attribute__((ext_vector_type(2)));
constexpr int BM = 256, BK = 64, HALF = 128, HTB = HALF * BK * 2  , STAGE_BYTES = 8 * HTB, NXCD = 8, WGM = 8;
__host__ __device__ __forceinline__ int lds_byte(int r, int c) { const int st = (r >> 4) * 2 + (c >> 5), rr = r & 15, cc = c & 31, ob = rr * 64 + cc * 2; return st * 1024 + (ob ^ (((ob >> 9) & 1) << 5)); }
__host__ __device__ __forceinline__ void stage_rc(int b, int& R, int& C) { const int st = b / 1024, sb = b % 1024, swz = sb ^ (((sb >> 9) & 1) << 5); R = (st >> 1) * 16 + swz / 64; C = (st & 1) * 32 + (swz % 64) / 2; }
__host__ __device__ __forceinline__ int perm32(int rho) { const int n = rho >> 4, i = rho & 15; return 8 * (i >> 2) + 4 * n + (i & 3); }
struct Unit { int pm, pn; };
struct Gemm { const bf16_t* A; const bf16_t* Bt; int M, N, K; };
struct StaticOrder {
    int nM, nN, nwg, G, c;
    __device__ __forceinline__ void init(int M, int N, int G_, int c_) { nM = M / BM; nN = N / BM; nwg = nM * nN; G = G_; c = c_; }
    __device__ __forceinline__ bool next(int i, Unit& u) const {
        const long L = (long)i * G + c; if (L >= nwg) return false;
        int wgid = (int)L; { const int q = nwg / NXCD, r = nwg % NXCD, xcd = wgid % NXCD, off = wgid / NXCD; wgid = (xcd < r ? xcd * (q + 1) : r * (q + 1) + (xcd - r) * q) + off; }
        const int nig = WGM * nN, gid = wgid / nig, fm = gid * WGM, gsz = (nM - fm) < WGM ? (nM - fm) : WGM;
        u.pm = fm + ((wgid % nig) % gsz); u.pn = (wgid % nig) / gsz; return true;
    }
};
__device__ __forceinline__ unsigned cvt_pk_bf16(float lo, float hi) { unsigned r; asm volatile("v_cvt_pk_bf16_f32 %0, %1, %2" : "=v"(r) : "v"(lo), "v"(hi)); return r; }

template <class Epi, class Sched, int AMODE>
__device__ __forceinline__ void gemm_phase(PG8_LAS unsigned char* lds, const Gemm g, const Sched& S, const Epi& E, const int* __restrict__ rowmap, const int* __restrict__ tile_exp, const size_t estride) {
    constexpr bool GATHER = AMODE != 0;
    int tid = threadIdx.x; asm volatile("" : "+v"(tid));
    const int wid = __builtin_amdgcn_readfirstlane(tid >> 6), lane = tid & 63, wr = wid >> 2, wc = wid & 3, fr = lane & 15, fq = lane >> 4;
    const int K = g.K, nt = K / BK;
    unsigned voffA[2], voffB[2]; int rA[2];
#pragma unroll
    for (int i = 0; i < 2; ++i) { int R, C; stage_rc(tid * 16 + i * 8192, R, C); const int Rb = (R & ~31) + perm32(R & 31);
        voffA[i] = (unsigned)(R * K + C) * 2u; voffB[i] = (unsigned)(Rb * K + C) * 2u; rA[i] = R; if (GATHER) voffA[i] = (unsigned)C * 2u; }
    const size_t kstep = (size_t)(BK * 2);
    const size_t kstepA = AMODE == 2 ? (size_t)DINP * 2 : kstep;
    const size_t hstep = (size_t)HALF * K * 2;
    const size_t tstep = 2 * hstep;
    const unsigned ldsw = (unsigned)wid * 1024u;
    const int aoff = lds_byte(wr * 64 + fr, fq * 8), boff = lds_byte(wc * 32 + fr, fq * 8);
#define PG8_SA(b, h) (((b) * 2 + (h)) * HTB)
#define PG8_SB(b, h) ((4 + (b) * 2 + (h)) * HTB)
#define PG8_STAGE(bufoff, gbase, voff) do { _Pragma("unroll") for (int _i = 0; _i < 2; ++_i) \
        __builtin_amdgcn_global_load_lds((const unsigned*)((const char*)(gbase) + (voff)[_i]), (PG8_LAS unsigned*)(lds + (bufoff) + ldsw + _i * 8192), 16, 0, 0); } while (0)
#define PG8_LDA(dst, b, h) do { _Pragma("unroll") for (int m = 0; m < 4; ++m) _Pragma("unroll") for (int k = 0; k < 2; ++k) dst[m][k] = *(const PG8_LAS bf16x8*)(lds + PG8_SA(b, h) + aoff + m * 2048 + k * 1024); } while (0)
#define PG8_LDB(dst, b, h) do { _Pragma("unroll") for (int n = 0; n < 2; ++n) _Pragma("unroll") for (int k = 0; k < 2; ++k) dst[n][k] = *(const PG8_LAS bf16x8*)(lds + PG8_SB(b, h) + boff + n * 2048 + k * 1024); } while (0)
#define PG8_MMA(ai, bj, At, Bt) do { __builtin_amdgcn_s_setprio(1); _Pragma("unroll") for (int m = 0; m < 4; ++m) _Pragma("unroll") for (int n = 0; n < 2; ++n) _Pragma("unroll") for (int k = 0; k < 2; ++k) \
        acc[ai][bj][m][n] = __builtin_amdgcn_mfma_f32_16x16x32_bf16(Bt[n][k], At[m][k], acc[ai][bj][m][n], 0, 0, 0); __builtin_amdgcn_s_setprio(0); } while (0)
#define PG8_WAIT_V(n) asm volatile("s_waitcnt vmcnt(" #n ")" ::: "memory")
#define PG8_WAIT_L(n) asm volatile("s_waitcnt lgkmcnt(" #n ")" ::: "memory")
#define PG8_BAR __builtin_amdgcn_s_barrier()
#define PG8_SCHED __builtin_amdgcn_sched_barrier(0)
    unsigned vgc[2][2], vgn[2][2];
#define PG8_GOFF(dst, pm_) do { if constexpr (AMODE == 1) { _Pragma("unroll") for (int _h = 0; _h < 2; ++_h) _Pragma("unroll") for (int _i = 0; _i < 2; ++_i) { int _t = rowmap[(pm_) * BM + _h * HALF + rA[_i]]; _t = _t < 0 ? 0 : _t; \
        dst[_h][_i] = (unsigned)_t * (unsigned)(K * 2) + voffA[_i]; } } \
      else if constexpr (AMODE == 2) { _Pragma("unroll") for (int _h = 0; _h < 2; ++_h) _Pragma("unroll") for (int _i = 0; _i < 2; ++_i) { const int _r = (pm_) * BM + _h * HALF + rA[_i]; int _c = _r & 255; _c = _c > 254 ? 254 : _c; \
        dst[_h][_i] = (unsigned)(((_r >> 9) * SEQ + 16 * _c) * DINP + (int)estride + ((_r >> 8) & 1) * 64) * 2u + voffA[_i]; } } } while (0)
#define PG8_STA(bufoff, gptr, h, arr) do { if constexpr (GATHER) { PG8_STAGE(bufoff, gptr, arr[h]); } else { PG8_STAGE(bufoff, (gptr) + ((h) ? hstep : 0), voffA); } } while (0)
    Unit cur, nxt; int ui = 0;
    if (!S.next(0, cur)) return;
    f32x4 acc[2][2][4][2];
#pragma unroll
    for (int a = 0; a < 2; ++a)
#pragma unroll
        for (int b = 0; b < 2; ++b)
#pragma unroll
            for (int m = 0; m < 4; ++m)
#pragma unroll
                for (int n = 0; n < 2; ++n) acc[a][b][m][n] = (f32x4){0.f, 0.f, 0.f, 0.f};
    bf16x8 At[4][2], B0[2][2], B1[2][2];
    const char* cA = (const char*)g.A + (GATHER ? (size_t)0 : (size_t)cur.pm * tstep);
    const char* cB = (const char*)g.Bt + (tile_exp ? (size_t)tile_exp[cur.pm] * estride * 2 : (size_t)0) + (size_t)cur.pn * tstep;
    PG8_GOFF(vgc, cur.pm);
    PG8_STAGE(PG8_SB(0, 0), cB, voffB); PG8_STAGE(PG8_SB(0, 1), cB + hstep, voffB); PG8_STA(PG8_SA(0, 0), cA, 0, vgc); PG8_STA(PG8_SA(0, 1), cA, 1, vgc);
    if (wr == 1) PG8_BAR;
    PG8_WAIT_V(2); PG8_BAR;
    PG8_STAGE(PG8_SB(1, 0), cB + kstep, voffB); PG8_STA(PG8_SA(1, 0), cA + kstepA, 0, vgc); PG8_STAGE(PG8_SB(1, 1), cB + hstep + kstep, voffB);
    PG8_WAIT_V(6); PG8_BAR;
    for (;;) {
        const bool has_next = S.next(ui + 1, nxt);
        const char* nA = has_next ? (const char*)g.A + (GATHER ? (size_t)0 : (size_t)nxt.pm * tstep) : cA;
        const char* nB = has_next ? (const char*)g.Bt + (tile_exp ? (size_t)tile_exp[nxt.pm] * estride * 2 : (size_t)0) + (size_t)nxt.pn * tstep : cB;
        if constexpr (GATHER) { if (has_next) { PG8_GOFF(vgn, nxt.pm); } else {
#pragma unroll
            for (int _h = 0; _h < 2; ++_h)
#pragma unroll
                for (int _i = 0; _i < 2; ++_i) vgn[_h][_i] = vgc[_h][_i]; } }
        for (int t = 0; t < nt; t += 2) {
            const bool last = (t == nt - 2);
            const char* a1 = cA + (size_t)(t + 1) * kstepA;
            const char* a2 = last ? nA : cA + (size_t)(t + 2) * kstepA; const char* b2 = last ? nB : cB + (size_t)(t + 2) * kstep;
            const char* a3 = a2 + kstepA; const char* b3 = b2 + kstep;
            unsigned v2[2][2];
            if constexpr (GATHER) {
#pragma unroll
            for (int _h = 0; _h < 2; ++_h)
#pragma unroll
                for (int _i = 0; _i < 2; ++_i) v2[_h][_i] = last ? vgn[_h][_i] : vgc[_h][_i]; }
            PG8_LDB(B0, 0, 0); PG8_LDB(B1, 0, 1); PG8_SCHED; PG8_LDA(At, 0, 0); PG8_STA(PG8_SA(1, 1), a1, 1, vgc);
            PG8_WAIT_V(8); PG8_WAIT_L(0); PG8_BAR; PG8_MMA(0, 0, At, B0); PG8_MMA(0, 1, At, B1); PG8_BAR; PG8_SCHED;
            PG8_LDA(At, 0, 1); PG8_STAGE(PG8_SB(0, 0), b2, voffB); PG8_STAGE(PG8_SB(0, 1), b2 + hstep, voffB); PG8_STA(PG8_SA(0, 0), a2, 0, v2);
            PG8_WAIT_V(8); PG8_WAIT_L(0); PG8_BAR; PG8_MMA(1, 0, At, B0); PG8_MMA(1, 1, At, B1); PG8_BAR; PG8_SCHED;
            PG8_LDB(B0, 1, 0); PG8_LDB(B1, 1, 1); PG8_SCHED; PG8_LDA(At, 1, 0); PG8_STA(PG8_SA(0, 1), a2, 1, v2);
            PG8_WAIT_V(8); PG8_WAIT_L(0); PG8_BAR; PG8_MMA(0, 0, At, B0); PG8_MMA(0, 1, At, B1); PG8_BAR; PG8_SCHED;
            PG8_LDA(At, 1, 1); PG8_STAGE(PG8_SB(1, 0), b3, voffB); PG8_STAGE(PG8_SB(1, 1), b3 + hstep, voffB); PG8_STA(PG8_SA(1, 0), a3, 0, v2);
            PG8_WAIT_V(8); PG8_WAIT_L(0); PG8_BAR; PG8_MMA(1, 0, At, B0); PG8_MMA(1, 1, At, B1); PG8_BAR; PG8_SCHED;
        }
        if (wr == 0) PG8_BAR;
        E(acc, cur, wr, wc, fr, fq);
        if (!has_next) break;
#pragma unroll
        for (int a = 0; a < 2; ++a)
#pragma unroll
            for (int b = 0; b < 2; ++b)
#pragma unroll
                for (int m = 0; m < 4; ++m)
#pragma unroll
                    for (int n = 0; n < 2; ++n) acc[a][b][m][n] = (f32x4){0.f, 0.f, 0.f, 0.f};
        cur = nxt; cA = nA; cB = nB; ++ui;
        if constexpr (GATHER) {
#pragma unroll
        for (int _h = 0; _h < 2; ++_h)
#pragma unroll
            for (int _i = 0; _i < 2; ++_i) vgc[_h][_i] = vgn[_h][_i]; }
        if (wr == 1) PG8_BAR;
    }
    PG8_WAIT_V(0);
    PG8_BAR;
#undef PG8_SA
#undef PG8_SB
#undef PG8_STAGE
#undef PG8_LDA
#undef PG8_LDB
#undef PG8_MMA
#undef PG8_WAIT_V
#undef PG8_WAIT_L
#undef PG8_BAR
#undef PG8_SCHED
#undef PG8_GOFF
#undef PG8_STA
}

typedef const f32x4 (&AccT)[2][2][4][2];
struct EIn { bf16_t* proj; const float* ssq;
    __device__ __forceinline__ void operator()(AccT acc, const Unit& u, int wr, int wc, int fr, int fq) const {
        const int col0 = u.pn * BM + wc * 32 + 8 * fq;
#pragma unroll
        for (int ai = 0; ai < 2; ++ai)
#pragma unroll
            for (int m = 0; m < 4; ++m) { const int row = u.pm * BM + ai * HALF + wr * 64 + m * 16 + fr; const float rs = row_rstd(ssq, row); bf16_t* rowp = proj + (size_t)row * DINP + col0;
#pragma unroll
                for (int bj = 0; bj < 2; ++bj) { const f32x4 v0 = acc[ai][bj][m][0] * rs, v1 = acc[ai][bj][m][1] * rs; u32x4 w; w.x = cvt_pk_bf16(v0[0], v0[1]); w.y = cvt_pk_bf16(v0[2], v0[3]); w.z = cvt_pk_bf16(v1[0], v1[1]); w.w = cvt_pk_bf16(v1[2], v1[3]);
                    *(u32x4*)(rowp + bj * HALF) = w; } } } };
struct ERes { const float* xold; float* xnew; bf16_t* xb; float* ssq;
    __device__ __forceinline__ void operator()(AccT acc, const Unit& u, int wr, int wc, int fr, int fq) const {
        const int col0 = u.pn * BM + wc * 32 + 8 * fq;
#pragma unroll
        for (int ai = 0; ai < 2; ++ai)
#pragma unroll
            for (int m = 0; m < 4; ++m) { const int row = u.pm * BM + ai * HALF + wr * 64 + m * 16 + fr; const size_t o = (size_t)row * DM + col0; float s = 0.f;
#pragma unroll
                for (int bj = 0; bj < 2; ++bj) { const f32x4 x0 = *(const f32x4*)(xold + o + bj * HALF), x1 = *(const f32x4*)(xold + o + bj * HALF + 4);
                    const f32x4 v0 = x0 + acc[ai][bj][m][0], v1 = x1 + acc[ai][bj][m][1];
                    *(f32x4*)(xnew + o + bj * HALF) = v0; *(f32x4*)(xnew + o + bj * HALF + 4) = v1;
                    u32x4 w; w.x = cvt_pk_bf16(v0[0], v0[1]); w.y = cvt_pk_bf16(v0[2], v0[3]); w.z = cvt_pk_bf16(v1[0], v1[1]); w.w = cvt_pk_bf16(v1[2], v1[3]);
                    *(u32x4*)(xb + o + bj * HALF) = w;
                    s += (v0[0] * v0[0] + v0[1] * v0[1]) + (v0[2] * v0[2] + v0[3] * v0[3]) + (v1[0] * v1[0] + v1[1] * v1[1]) + (v1[2] * v1[2] + v1[3] * v1[3]); }
                s += __shfl_xor(s, 16); s += __shfl_xor(s, 32);
                if (fq == 0) ssq[(size_t)row * NSLOT + u.pn * 4 + wc] = s; } } };
struct ESwiglu { bf16_t* h; const float* ssq; const int* row_tok;
    __device__ __forceinline__ void operator()(AccT acc, const Unit& u, int wr, int wc, int fr, int fq) const {
        const int col0 = u.pn * HALF + wc * 32 + 8 * fq;
#pragma unroll
        for (int ai = 0; ai < 2; ++ai)
#pragma unroll
            for (int m = 0; m < 4; ++m) { const int row = u.pm * BM + ai * HALF + wr * 64 + m * 16 + fr; const int t = row_tok ? row_tok[row] : row; const float rs = t < 0 ? 0.f : row_rstd(ssq, t < 0 ? 0 : t);
                float o[8];
#pragma unroll
                for (int n = 0; n < 2; ++n)
#pragma unroll
                    for (int e = 0; e < 4; ++e) { const float av = acc[ai][0][m][n][e] * rs, bv = acc[ai][1][m][n][e] * rs; o[n * 4 + e] = siluf(av) * bv; }
                u32x4 w; w.x = cvt_pk_bf16(o[0], o[1]); w.y = cvt_pk_bf16(o[2], o[3]); w.z = cvt_pk_bf16(o[4], o[5]); w.w = cvt_pk_bf16(o[6], o[7]);
                *(u32x4*)(h + (size_t)row * DFF + col0) = w; } } };
struct ESiluBias { bf16_t* out; const float* bias;
    __device__ __forceinline__ void operator()(AccT acc, const Unit& u, int wr, int wc, int fr, int fq) const {
        const int col0 = u.pn * BM + wc * 32 + 8 * fq;
#pragma unroll
        for (int ai = 0; ai < 2; ++ai)
#pragma unroll
            for (int m = 0; m < 4; ++m) { const int row = u.pm * BM + ai * HALF + wr * 64 + m * 16 + fr; bf16_t* rowp = out + (size_t)row * 256 + col0;
#pragma unroll
                for (int bj = 0; bj < 2; ++bj) { const f32x4 b0 = *(const f32x4*)(bias + col0 + bj * HALF), b1 = *(const f32x4*)(bias + col0 + bj * HALF + 4); const f32x4 v0 = acc[ai][bj][m][0] + b0, v1 = acc[ai][bj][m][1] + b1;
                    u32x4 w; w.x = cvt_pk_bf16(siluf(v0[0]), siluf(v0[1])); w.y = cvt_pk_bf16(siluf(v0[2]), siluf(v0[3])); w.z = cvt_pk_bf16(siluf(v1[0]), siluf(v1[1])); w.w = cvt_pk_bf16(siluf(v1[2]), siluf(v1[3]));
                    *(u32x4*)(rowp + bj * HALF) = w; } } } };
struct EKc { bf16_t* out; int transposed, pad;
    __device__ __forceinline__ void operator()(AccT acc, const Unit& u, int wr, int wc, int fr, int fq) const {
        if (wc >= 2) return;
        const int col0 = wc * 32 + 8 * fq;
#pragma unroll
        for (int ai = 0; ai < 2; ++ai)
#pragma unroll
            for (int m = 0; m < 4; ++m) { const int row = u.pm * BM + ai * HALF + wr * 64 + m * 16 + fr; const f32x4 v0 = acc[ai][0][m][0], v1 = acc[ai][0][m][1];
                if (!transposed) { u32x4 w; w.x = cvt_pk_bf16(v0[0], v0[1]); w.y = cvt_pk_bf16(v0[2], v0[3]); w.z = cvt_pk_bf16(v1[0], v1[1]); w.w = cvt_pk_bf16(v1[2], v1[3]); *(u32x4*)(out + (size_t)row * 64 + col0) = w; }
                else { bf16_t* o = out + (size_t)(row >> 8) * 16384 + (size_t)col0 * 256 + (row & 255);
#pragma unroll
                    for (int x = 0; x < 4; ++x) { o[x * 256] = f2bf(v0[x]); o[(4 + x) * 256] = f2bf(v1[x]); } } } } };
struct EStore { bf16_t* out; int ldc;
    __device__ __forceinline__ void operator()(AccT acc, const Unit& u, int wr, int wc, int fr, int fq) const {
        const int col0 = u.pn * BM + wc * 32 + 8 * fq;
#pragma unroll
        for (int ai = 0; ai < 2; ++ai)
#pragma unroll
            for (int m = 0; m < 4; ++m) { const int row = u.pm * BM + ai * HALF + wr * 64 + m * 16 + fr; bf16_t* rowp = out + (size_t)row * ldc + col0;
#pragma unroll
                for (int bj = 0; bj < 2; ++bj) { const f32x4 v0 = acc[ai][bj][m][0], v1 = acc[ai][bj][m][1]; u32x4 w; w.x = cvt_pk_bf16(v0[0], v0[1]); w.y = cvt_pk_bf16(v0[2], v0[3]); w.z = cvt_pk_bf16(v1[0], v1[1]); w.w = cvt_pk_bf16(v1[2], v1[3]);
                    *(u32x4*)(rowp + bj * HALF) = w; } } } };
}

#ifndef NSA_REP_SEL
#define NSA_REP_SEL 1
#endif
#ifndef NSA_REP_WIN
#define NSA_REP_WIN 1
#endif
namespace nsa {
typedef float f32x16 __attribute__((ext_vector_type(16)));
typedef unsigned u32x4 __attribute__((ext_vector_type(4)));
typedef unsigned u32x2 __attribute__((ext_vector_type(2)));
constexpr int KSTR = 144, VSTR = 144;
constexpr int KT_B = 64 * KSTR, VT_B = 64 * VSTR, BUF_B = KT_B + VT_B;
constexpr int IMP_OFF = 2 * BUF_B  , SELM_OFF = IMP_OFF + 8 * 2048  , WUN_OFF = SELM_OFF + 512;
constexpr float L2E = 1.4426950408889634f;
#define NLAS __attribute__((address_space(3)))
__device__ __forceinline__ unsigned pk2(float lo, float hi) { unsigned r; asm volatile("v_cvt_pk_bf16_f32 %0, %1, %2" : "=v"(r) : "v"(lo), "v"(hi)); return r; }
struct Stage { u32x4 k, v; };
__device__ __forceinline__ void stage_issue(Stage& st, const bf16_t* kg, size_t kstride, const bf16_t* vg, size_t vstride, int tid) {
    const int r = tid >> 3, c = (tid & 7) * 8;
    st.k = *(const u32x4*)(kg + (size_t)r * kstride + c); st.v = *(const u32x4*)(vg + (size_t)r * vstride + c);
}
__device__ __forceinline__ void stage_write(const Stage& st, NLAS char* buf, int tid) {
    const int r = tid >> 3, c = (tid & 7) * 16;
    *(NLAS u32x4*)(buf + r * KSTR + c) = st.k;
    { const int cc = tid & 7, vo = KT_B + r * VSTR + (cc >> 1) * 32 + (cc & 1) * 8;
      *(NLAS u32x2*)(buf + vo) = (u32x2){st.v.x, st.v.y}; *(NLAS u32x2*)(buf + vo + 16) = (u32x2){st.v.z, st.v.w}; }
}
__device__ __forceinline__ void compute_S(NLAS const char* buf, const bf16x8 (&Qf)[4], f32x16& S0, f32x16& S1, int lane) {
    const int kr = lane & 31, hi = lane >> 5;
#pragma unroll
    for (int i = 0; i < 16; ++i) { S0[i] = 0.f; S1[i] = 0.f; }
    bf16x8 af[8];
#pragma unroll
    for (int s = 0; s < 4; ++s) { af[2 * s] = *(NLAS const bf16x8*)(buf + kr * KSTR + s * 32 + hi * 16); af[2 * s + 1] = *(NLAS const bf16x8*)(buf + (32 + kr) * KSTR + s * 32 + hi * 16); }
    __builtin_amdgcn_sched_barrier(0);
#pragma unroll
    for (int s = 0; s < 4; ++s) { S0 = __builtin_amdgcn_mfma_f32_32x32x16_bf16(af[2 * s], Qf[s], S0, 0, 0, 0); S1 = __builtin_amdgcn_mfma_f32_32x32x16_bf16(af[2 * s + 1], Qf[s], S1, 0, 0, 0); }
}
__device__ __forceinline__ void mask_S(f32x16& S0, f32x16& S1, int lo, int hi, int lane) {
    const int h4 = (lane >> 5) * 4, lo2 = lo - h4, hi2 = hi - h4;
#pragma unroll
    for (int i = 0; i < 16; ++i) { const int c0 = (i & 3) + 8 * (i >> 2); S0[i] = (c0 >= lo2 && c0 <= hi2) ? S0[i] : -INFINITY; S1[i] = (c0 + 32 >= lo2 && c0 + 32 <= hi2) ? S1[i] : -INFINITY; }
}
__device__ __forceinline__ float max3f(float a, float b, float c) { float r; asm("v_max3_f32 %0, %1, %2, %3" : "=v"(r) : "v"(a), "v"(b), "v"(c)); return r; }
__device__ __forceinline__ float max_S(const f32x16& S0, const f32x16& S1) { float m = max3f(S0[0], S1[0], S0[1]);
    m = max3f(m, S1[1], S0[2]); m = max3f(m, S1[2], S0[3]); m = max3f(m, S1[3], S0[4]); m = max3f(m, S1[4], S0[5]); m = max3f(m, S1[5], S0[6]); m = max3f(m, S1[6], S0[7]); m = max3f(m, S1[7], S0[8]);
    m = max3f(m, S1[8], S0[9]); m = max3f(m, S1[9], S0[10]); m = max3f(m, S1[10], S0[11]); m = max3f(m, S1[11], S0[12]); m = max3f(m, S1[12], S0[13]); m = max3f(m, S1[13], S0[14]); m = max3f(m, S1[14], S0[15]);
    float o = __shfl_xor(m, 32); return max3f(m, S1[15], o); }
__device__ __forceinline__ float exp_S(f32x16& S0, f32x16& S1, float mL) { float l0 = 0.f, l1 = 0.f;
#pragma unroll
    for (int i = 0; i < 16; ++i) { S0[i] = __builtin_amdgcn_exp2f(fmaf(S0[i], L2E, -mL)); S1[i] = __builtin_amdgcn_exp2f(fmaf(S1[i], L2E, -mL)); l0 += S0[i]; l1 += S1[i]; }
    return l0 + l1; }
__device__ __forceinline__ void pack_P(const f32x16& S0, const f32x16& S1, unsigned andm, bf16x8 (&Pf)[4]) {
#pragma unroll
    for (int s2 = 0; s2 < 4; ++s2) { u32x4 w;
#pragma unroll
        for (int q = 0; q < 4; ++q) { const int i = (s2 & 1) * 8 + q * 2; w[q] = (s2 < 2 ? pk2(S0[i], S0[i + 1]) : pk2(S1[i], S1[i + 1])) & andm; }
        Pf[s2] = __builtin_bit_cast(bf16x8, w); }
}
__device__ __forceinline__ void pv(NLAS const char* buf, const bf16x8 (&Pf)[4], f32x16& O0, f32x16& O1, int lane) {
    const int dr = lane & 31, hi = lane >> 5; NLAS const char* vt = buf + KT_B;
    bf16x8 vf[8];
#pragma unroll
    for (int s2 = 0; s2 < 4; ++s2) { vf[2 * s2] = *(NLAS const bf16x8*)(vt + dr * VSTR + (16 * s2 + 8 * hi) * 2); vf[2 * s2 + 1] = *(NLAS const bf16x8*)(vt + (32 + dr) * VSTR + (16 * s2 + 8 * hi) * 2); }
    __builtin_amdgcn_sched_barrier(0);
#pragma unroll
    for (int s2 = 0; s2 < 4; ++s2) { O0 = __builtin_amdgcn_mfma_f32_32x32x16_bf16(vf[2 * s2], Pf[s2], O0, 0, 0, 0); O1 = __builtin_amdgcn_mfma_f32_32x32x16_bf16(vf[2 * s2 + 1], Pf[s2], O1, 0, 0, 0); }
}
__device__ __forceinline__ void online_block(NLAS const char* buf, const bf16x8 (&Qf)[4], f32x16& O0, f32x16& O1, float& m, float& l, bool lane_on, bool use_mask, int lo, int hi, int lane) {
    f32x16 S0, S1; compute_S(buf, Qf, S0, S1, lane);
    if (use_mask) mask_S(S0, S1, lo, hi, lane);
    float mt = max_S(S0, S1); if (!lane_on) mt = -INFINITY;
    const float mn = max3f(m, mt, mt), ms = mn == -INFINITY ? 0.f : mn;
    const float ls = exp_S(S0, S1, ms * L2E);
    if (__any(mn != m)) { const float al = __builtin_amdgcn_exp2f((m - ms) * L2E); l *= al;
#pragma unroll
        for (int i = 0; i < 16; ++i) { O0[i] *= al; O1[i] *= al; } }
    l += (lane_on ? ls : 0.f); m = mn;
    bf16x8 Pf[4]; pack_P(S0, S1, lane_on ? 0xffffffffu : 0u, Pf);
    pv(buf, Pf, O0, O1, lane);
}

struct BitIter { unsigned long long rem; __device__ __forceinline__ int next() { if (!rem) return -1; const int j = __builtin_ctzll(rem); rem &= rem - 1; return j; } };
struct RangeIter { int cur, end; __device__ __forceinline__ int next() { return cur <= end ? cur++ : -1; } };
struct SelPar { unsigned long long mq; int qb, tq;
    __device__ __forceinline__ void get(int j, bool& on, bool& um, int& lo, int& hi) const { on = (mq >> j) & 1ull; um = (j == qb); lo = 0; hi = tq; } };
struct WinPar { int qb, tq;
    __device__ __forceinline__ void get(int j, bool& on, bool& um, int& lo, int& hi) const { const bool first = (j == qb - 8), diag = (j == qb); on = true; um = first || diag; lo = first ? tq + 1 : 0; hi = diag ? tq : 63; } };
template <class It, class Par>
__device__ __forceinline__ void run_blocks(It it, const Par par, const bf16_t* kg, const bf16_t* vg, NLAS char* lds, const bf16x8 (&Qf)[4], f32x16& O0, f32x16& O1, float& m, float& l, int tid, int lane) {
    int j0 = it.next(), j1 = it.next();
    Stage sa, sb;
    stage_issue(sa, kg + (size_t)j0 * 64 * DINP, DINP, vg + j0 * 64, SEQ, tid);
    if (j1 >= 0) stage_issue(sb, kg + (size_t)j1 * 64 * DINP, DINP, vg + j1 * 64, SEQ, tid);
    stage_write(sa, lds, tid); __syncthreads();
    for (;;) {
        const int j2 = it.next();
        if (j2 >= 0) stage_issue(sa, kg + (size_t)j2 * 64 * DINP, DINP, vg + j2 * 64, SEQ, tid);
        { bool on, um; int lo, hi; par.get(j0, on, um, lo, hi); if (__any(on)) online_block(lds, Qf, O0, O1, m, l, on, um, lo, hi, lane); }
        if (j1 >= 0) stage_write(sb, lds + BUF_B, tid);
        __syncthreads();
        if (j1 < 0) break;
        const int j3 = it.next();
        if (j3 >= 0) stage_issue(sb, kg + (size_t)j3 * 64 * DINP, DINP, vg + j3 * 64, SEQ, tid);
        { bool on, um; int lo, hi; par.get(j1, on, um, lo, hi); if (__any(on)) online_block(lds + BUF_B, Qf, O0, O1, m, l, on, um, lo, hi, lane); }
        if (j2 >= 0) stage_write(sa, lds, tid);
        __syncthreads();
        if (j2 < 0) break;
        j0 = j2; j1 = j3;
    }
}
}

__device__ __forceinline__ void ph_nsa(const Args& a, LAS char* lds_, int vcu, int G) {
    using namespace nsa;
    int tid = threadIdx.x; asm volatile("" : "+v"(tid)); asm volatile("" : "+s"(vcu));
    NLAS char* lds = lds_;
    const int w = __builtin_amdgcn_readfirstlane(tid >> 6), lane = tid & 63, hi = lane >> 5, r = lane & 31, tql = r >> 2, hpg = r & 3;
    NLAS float* impw = (NLAS float*)(lds + IMP_OFF + w * 2048);
    NLAS unsigned long long* selm = (NLAS unsigned long long*)(lds + SELM_OFF);
    NLAS unsigned long long* wun = (NLAS unsigned long long*)(lds + WUN_OFF);
    const bf16_t* proj = a.proj;
    for (int it = 0; it * G + vcu < 1024; ++it) {
        asm volatile("" : "+v"(tid));
        const int idx = it * G + vcu, rnd = idx >> 8, k16 = (idx & 255) >> 4, bg = idx & 15;
        const int qb = (rnd == 0) ? 63 - k16 : (rnd == 1) ? 32 + k16 : (rnd == 2) ? 31 - k16 : k16;
        const int b = bg >> 1, g = bg & 1;
        const int tq = 8 * w + tql, t = 64 * qb + tq; const size_t row = (size_t)b * SEQ + t; const bf16_t* prow = proj + row * DINP;
        bf16x8 Qf[4];
#pragma unroll
        for (int s = 0; s < 4; ++s) Qf[s] = *(const bf16x8*)(prow + C_Q + g * 256 + hpg * 64 + 16 * s + 8 * hi);
        f32x16 Oo0, Oo1;
        const int hh = g * 4 + hpg; const float g0 = sigmf(bf2f(prow[C_GL + hh * 3 + 0])), g1 = sigmf(bf2f(prow[C_GL + hh * 3 + 1])), g2 = sigmf(bf2f(prow[C_GL + hh * 3 + 2]));
        Stage st;
        const bf16_t* kcg = a.kcb + (size_t)bg * 256 * 64; const bf16_t* vcg = a.vcT + (size_t)bg * 64 * 256;
        const int nbc = (4 * qb + 3 + 63) >> 6;
        const int cmax = t >= 31 ? (t - 31) >> 4 : -1;
        float mc = -INFINITY, lc = 0.f;
        __syncthreads();
        stage_issue(st, kcg, 64, vcg, 256, tid); stage_write(st, lds, tid); __syncthreads();
        for (int kb = 0; kb < nbc; ++kb) {
            NLAS char* buf = lds + (kb & 1) * BUF_B;
            if (kb + 1 < nbc) stage_issue(st, kcg + (size_t)(kb + 1) * 64 * 64, 64, vcg + (kb + 1) * 64, 256, tid);
            f32x16 S0, S1; compute_S(buf, Qf, S0, S1, lane); mask_S(S0, S1, 0, cmax - 64 * kb, lane);
            const float mt = max_S(S0, S1), mn = max3f(mc, mt, mt), ms = mn == -INFINITY ? 0.f : mn, al = __builtin_amdgcn_exp2f((mc - ms) * L2E);
            lc = lc * al + exp_S(S0, S1, ms * L2E); mc = mn;
            if (kb + 1 < nbc) stage_write(st, lds + ((kb + 1) & 1) * BUF_B, tid);
            __syncthreads();
        }
        lc += __shfl_xor(lc, 32);
        const float mLc = (mc == -INFINITY ? 0.f : mc) * L2E, ilc = lc > 0.f ? 1.f / lc : 0.f;
        f32x16 Oc0, Oc1, Z0, Z1;
#pragma unroll
        for (int i = 0; i < 16; ++i) { Oc0[i] = 0.f; Oc1[i] = 0.f; Z0[i] = 0.f; Z1[i] = 0.f; }
        stage_issue(st, kcg, 64, vcg, 256, tid); stage_write(st, lds, tid); __syncthreads();
        for (int kb = 0; kb < nbc; ++kb) {
            NLAS char* buf = lds + (kb & 1) * BUF_B;
            if (kb + 1 < nbc) stage_issue(st, kcg + (size_t)(kb + 1) * 64 * 64, 64, vcg + (kb + 1) * 64, 256, tid);
            f32x16 S0, S1; compute_S(buf, Qf, S0, S1, lane); mask_S(S0, S1, 0, cmax - 64 * kb, lane);
            (void)exp_S(S0, S1, mLc);
#pragma unroll
            for (int i = 0; i < 16; ++i) { S0[i] *= ilc; S1[i] *= ilc; }
            bf16x8 Pf[4]; pack_P(S0, S1, 0xffffffffu, Pf);
            pv(buf, Pf, Oc0, Oc1, lane);
#pragma unroll
            for (int s2 = 0; s2 < 4; ++s2) {
#pragma unroll
                for (int stl = 0; stl < 2; ++stl) { const int sblk = 32 * stl + r; u32x4 wv;
#pragma unroll
                    for (int q = 0; q < 4; ++q) { unsigned x = 0u;
#pragma unroll
                        for (int e = 0; e < 2; ++e) { const int j = q * 2 + e, c = 64 * kb + 16 * s2 + 8 * (j >> 2) + 4 * hi + (j & 3); if (c >= 4 * sblk - 1 && c <= 4 * sblk + 3) x |= (0x3f80u << (16 * e)); }
                        wv[q] = x; }
                    if (stl == 0) Z0 = __builtin_amdgcn_mfma_f32_32x32x16_bf16(Pf[s2], __builtin_bit_cast(bf16x8, wv), Z0, 0, 0, 0);
                    else          Z1 = __builtin_amdgcn_mfma_f32_32x32x16_bf16(Pf[s2], __builtin_bit_cast(bf16x8, wv), Z1, 0, 0, 0); } }
            if (kb + 1 < nbc) stage_write(st, lds + ((kb + 1) & 1) * BUF_B, tid);
            __syncthreads();
        }
#pragma unroll
        for (int i = 0; i < 16; ++i) { Oo0[i] = g0 * Oc0[i]; Oo1[i] = g0 * Oc1[i]; }
#pragma unroll
        for (int q4 = 0; q4 < 4; ++q4) { impw[(2 * q4 + hi) * 64 + r] = (Z0[4 * q4] + Z0[4 * q4 + 1]) + (Z0[4 * q4 + 2] + Z0[4 * q4 + 3]); impw[(2 * q4 + hi) * 64 + 32 + r] = (Z1[4 * q4] + Z1[4 * q4 + 1]) + (Z1[4 * q4 + 2] + Z1[4 * q4 + 3]); }
        __syncthreads();
        unsigned long long wu = 0ull;
        for (int q = 0; q < 8; ++q) { const float imp = impw[q * 64 + lane];
            const bool valid = lane <= qb, forced = lane == 0 || lane == qb || lane == qb - 1; const float val = valid ? (forced ? 1e9f : imp) : -1e30f; int rank = 0;
#pragma unroll
            for (int s2 = 0; s2 < 64; ++s2) { const float v2 = __builtin_bit_cast(float, __builtin_amdgcn_readlane(__builtin_bit_cast(int, val), s2)); rank += (v2 > val || (v2 == val && s2 < lane)) ? 1 : 0; }
            const unsigned long long mk = __ballot(valid && rank < 16); wu |= mk;
            if (lane == 0) selm[8 * w + q] = mk; }
        if (lane == 0) wun[w] = wu;
        __syncthreads();
        unsigned long long um = 0ull;
#pragma unroll
        for (int q = 0; q < 8; ++q) um |= wun[q];
        um = ((unsigned long long)__builtin_amdgcn_readfirstlane((unsigned)(um >> 32)) << 32) | (unsigned)__builtin_amdgcn_readfirstlane((unsigned)um);
        const unsigned long long mq = selm[tq];
        {
            const bf16_t* kg = proj + (size_t)b * SEQ * DINP + C_KS + g * 64; const bf16_t* vg = a.VsT + (size_t)bg * 64 * SEQ;
            f32x16 O0, O1;
#pragma unroll
            for (int i = 0; i < 16; ++i) { O0[i] = 0.f; O1[i] = 0.f; }
            float m = -INFINITY, l = 0.f;
            for (int rep = 0; rep < NSA_REP_SEL; ++rep) {
#pragma unroll
            for (int i = 0; i < 16; ++i) { O0[i] = 0.f; O1[i] = 0.f; }
            m = -INFINITY; l = 0.f;
            run_blocks(BitIter{um}, SelPar{mq, qb, tq}, kg, vg, lds, Qf, O0, O1, m, l, tid, lane); }
            l += __shfl_xor(l, 32); const float sc = l > 0.f ? g1 / l : 0.f;
#pragma unroll
            for (int i = 0; i < 16; ++i) { Oo0[i] += sc * O0[i]; Oo1[i] += sc * O1[i]; }
        }
        {
            const bf16_t* kg = proj + (size_t)b * SEQ * DINP + C_KW + g * 64; const bf16_t* vg = a.VwT + (size_t)bg * 64 * SEQ;
            f32x16 O0, O1;
#pragma unroll
            for (int i = 0; i < 16; ++i) { O0[i] = 0.f; O1[i] = 0.f; }
            float m = -INFINITY, l = 0.f;
            for (int rep = 0; rep < NSA_REP_WIN; ++rep) {
#pragma unroll
            for (int i = 0; i < 16; ++i) { O0[i] = 0.f; O1[i] = 0.f; }
            m = -INFINITY; l = 0.f;
            run_blocks(RangeIter{qb - 8 > 0 ? qb - 8 : 0, qb}, WinPar{qb, tq}, kg, vg, lds, Qf, O0, O1, m, l, tid, lane); }
            l += __shfl_xor(l, 32); const float sc = l > 0.f ? g2 / l : 0.f;
#pragma unroll
            for (int i = 0; i < 16; ++i) { Oo0[i] += sc * O0[i]; Oo1[i] += sc * O1[i]; }
        }
        bf16_t* op = a.ocat + row * DM + hh * 64 + 4 * hi;
#pragma unroll
        for (int q4 = 0; q4 < 4; ++q4) { u32x2 w0, w1; w0.x = pk2(Oo0[4 * q4], Oo0[4 * q4 + 1]); w0.y = pk2(Oo0[4 * q4 + 2], Oo0[4 * q4 + 3]); w1.x = pk2(Oo1[4 * q4], Oo1[4 * q4 + 1]); w1.y = pk2(Oo1[4 * q4 + 2], Oo1[4 * q4 + 3]);
            *(u32x2*)(op + 8 * q4) = w0; *(u32x2*)(op + 32 + 8 * q4) = w1; }
    }
}

__device__ __forceinline__ void ph_vtrans(const Args& a, LAS char* lds_, int vcu, int G) {
    int tid = threadIdx.x; asm volatile("" : "+v"(tid)); asm volatile("" : "+s"(vcu));
    LAS bf16_t* tile = (LAS bf16_t*)lds_;
    for (int u = vcu; u < 2 * 16 * 64; u += G) { const int tb = u & 63, bg = (u >> 6) & 15, which = u >> 10, b = bg >> 1, g = bg & 1;
        const bf16_t* src = a.proj + ((size_t)b * SEQ + tb * 64) * DINP + (which ? C_VW : C_VS) + g * 64; bf16_t* dst = (which ? a.VwT : a.VsT) + (size_t)bg * 64 * SEQ + tb * 64;
        const int r = tid >> 3, c = (tid & 7) * 8;
        const uint4 v = *(const uint4*)(src + (size_t)r * DINP + c); const unsigned wv[4] = {v.x, v.y, v.z, v.w};
        __syncthreads();
#pragma unroll
        for (int e = 0; e < 4; ++e) { tile[(c + 2 * e) * 72 + r] = (bf16_t)(wv[e] & 0xffffu); tile[(c + 2 * e + 1) * 72 + r] = (bf16_t)(wv[e] >> 16); }
        __syncthreads();
        *(u32x4_t*)(dst + (size_t)r * SEQ + c) = *(const LAS u32x4_t*)(tile + r * 72 + c);
    }
}

__device__ __forceinline__ void ph_conv_naive(const Args& a, int l, LAS char* lds, int vcu, int G) {
    int tid_ = threadIdx.x; asm volatile("" : "+v"(tid_)); asm volatile("" : "+s"(vcu));
    const int half = tid_ >> 8, c = tid_ & 255; LAS float* hs = (LAS float*)(lds + half * 63488);
    const float* cw = a.conv_w + (size_t)l * 31 * 256; const float* lg = a.conv_lg + l * 256; const float* lb = a.conv_lb + l * 256;
    float w[31];
#pragma unroll
    for (int k = 0; k < 31; ++k) w[k] = cw[k * 256 + c];
    const float bias = a.conv_b[l * 256 + c];
    for (int unit = vcu; unit < NTOK / 64; unit += G) {
        const int tile = unit * 2 + half, b = tile >> 7, t0 = (tile & 127) * 32;
        __syncthreads();
        for (int i = 0; i < 62; ++i) { const int t = t0 - 30 + i; float v = 0.f;
            if (t >= 0) { const bf16_t* p = a.proj + ((size_t)b * SEQ + t) * DINP + C_CONV; v = bf2f(p[c]) * sigmf(bf2f(p[256 + c])); }
            hs[i * 256 + c] = v; }
        __syncthreads();
        float outv[32];
#pragma unroll
        for (int tt = 0; tt < 32; ++tt) { float s = bias;
#pragma unroll
            for (int k = 0; k < 31; ++k) s += hs[(tt + k) * 256 + c] * w[k];
            outv[tt] = s; }
        __syncthreads();
#pragma unroll
        for (int tt = 0; tt < 32; ++tt) hs[tt * 256 + c] = outv[tt];
        __syncthreads();
        const int wave = c >> 6, lane = c & 63;
        for (int tt = wave; tt < 32; tt += 4) { float v[4], s = 0.f;
#pragma unroll
            for (int i = 0; i < 4; ++i) { v[i] = hs[tt * 256 + lane + 64 * i]; s += v[i]; }
            const float mu = wsum(s) * (1.f / 256.f); float q = 0.f;
#pragma unroll
            for (int i = 0; i < 4; ++i) q += (v[i] - mu) * (v[i] - mu);
            const float rs = rsqrtf(wsum(q) * (1.f / 256.f) + 1e-5f);
#pragma unroll
            for (int i = 0; i < 4; ++i) { const int ch = lane + 64 * i; const float y = (v[i] - mu) * rs * lg[ch] + lb[ch]; a.hconv[((size_t)b * SEQ + t0 + tt) * 256 + ch] = f2bf(siluf(y)); } }
    }
}


namespace ret {
using nsa::f32x16; using nsa::u32x4; using nsa::u32x2; using nsa::pk2;
__device__ __forceinline__ float lg2g(int h) { return log2f(1.f - exp2f(-5.f - (float)h)); }
}
__device__ __forceinline__ void ph_ret_prep(const Args& a, LAS char* lds, int vcu, int G) {
    int tid = threadIdx.x; asm volatile("" : "+v"(tid)); asm volatile("" : "+s"(vcu));
    LAS bf16_t* tK = (LAS bf16_t*)lds; LAS bf16_t* tV = (LAS bf16_t*)(lds + 256 * 72 * 2);
    for (int u = vcu; u < NB * 64; u += G) { const int b = u >> 6, tb = u & 63;
        __syncthreads();
#pragma unroll
        for (int it = 0; it < 2; ++it) { const int item = tid + NT * it, tok = item >> 4, h = (item >> 2) & 3, ch = item & 3; const int pos = tb * 64 + tok; const size_t row = (size_t)b * SEQ + pos;
            const bf16_t* p = a.proj + row * DINP; const int c0 = h * 64 + 8 * ch;
            const u32x4_t ql = *(const u32x4_t*)(p + C_RQ + c0), qh = *(const u32x4_t*)(p + C_RQ + c0 + 32), kl = *(const u32x4_t*)(p + C_RK + c0), kh = *(const u32x4_t*)(p + C_RK + c0 + 32);
            const u32x4_t vl = *(const u32x4_t*)(p + C_RV + c0), vh = *(const u32x4_t*)(p + C_RV + c0 + 32);
            const float* cs = a.rot + ((size_t)pos * 32 + 8 * ch) * 2; float co[8], si[8];
#pragma unroll
            for (int e = 0; e < 4; ++e) { const f32x4 t4 = *(const f32x4*)(cs + 4 * e); co[2 * e] = t4[0]; si[2 * e] = t4[1]; co[2 * e + 1] = t4[2]; si[2 * e + 1] = t4[3]; }
            const float zeta = exp2f((float)(127 - (pos & 127)) * ret::lg2g(h));
            u32x4_t oql, oqh, okl, okh;
#pragma unroll
            for (int e2 = 0; e2 < 4; ++e2) { float r1[2], r2[2], k1[2], k2[2];
#pragma unroll
                for (int e1 = 0; e1 < 2; ++e1) { const int e = e2 * 2 + e1; const float x1 = __uint_as_float(e1 ? (ql[e2] & 0xffff0000u) : (ql[e2] << 16)), x2 = __uint_as_float(e1 ? (qh[e2] & 0xffff0000u) : (qh[e2] << 16));
                    const float y1 = __uint_as_float(e1 ? (kl[e2] & 0xffff0000u) : (kl[e2] << 16)), y2 = __uint_as_float(e1 ? (kh[e2] & 0xffff0000u) : (kh[e2] << 16));
                    r1[e1] = x1 * co[e] - x2 * si[e]; r2[e1] = x1 * si[e] + x2 * co[e]; k1[e1] = y1 * co[e] - y2 * si[e]; k2[e1] = y1 * si[e] + y2 * co[e];
                    tK[(c0 + e) * 72 + tok] = f2bf(k1[e1] * zeta); tK[(c0 + 32 + e) * 72 + tok] = f2bf(k2[e1] * zeta);
                    tV[(c0 + e) * 72 + tok] = (bf16_t)(e1 ? (vl[e2] >> 16) : (vl[e2] & 0xffffu)); tV[(c0 + 32 + e) * 72 + tok] = (bf16_t)(e1 ? (vh[e2] >> 16) : (vh[e2] & 0xffffu)); }
                oql[e2] = nsa::pk2(r1[0], r1[1]); oqh[e2] = nsa::pk2(r2[0], r2[1]); okl[e2] = nsa::pk2(k1[0], k1[1]); okh[e2] = nsa::pk2(k2[0], k2[1]); }
            *(u32x4_t*)(a.qrb + row * 256 + c0) = oql; *(u32x4_t*)(a.qrb + row * 256 + c0 + 32) = oqh; *(u32x4_t*)(a.krb + row * 256 + c0) = okl; *(u32x4_t*)(a.krb + row * 256 + c0 + 32) = okh; }
        __syncthreads();
#pragma unroll
        for (int it = 0; it < 4; ++it) { const int q = tid + NT * it, ri = q >> 3, cc = (q & 7) * 8; const size_t o = ((size_t)b * 256 + ri) * SEQ + tb * 64 + cc;
            *(u32x4_t*)(a.KzT + o) = *(const LAS u32x4_t*)(tK + ri * 72 + cc); *(u32x4_t*)(a.VrT + o) = *(const LAS u32x4_t*)(tV + ri * 72 + cc); }
    }
}
__device__ __forceinline__ void ph_ret_state(const Args& a, int vcu, int G) {
    using namespace ret;
    int tid = threadIdx.x; asm volatile("" : "+v"(tid)); asm volatile("" : "+s"(vcu));
    const int w = tid >> 6, lane = tid & 63, hi = lane >> 5, r = lane & 31;
    if (w >= 4) return;
    for (int u = vcu; u < 32; u += G) { const int h = u & 3, et = w >> 1, dt = w & 1; const float gc = exp2f(128.f * lg2g(h));
        const bf16_t* va = a.VrT + ((size_t)u * 64 + 32 * et + r) * SEQ + 8 * hi; const bf16_t* kb = a.KzT + ((size_t)u * 64 + 32 * dt + r) * SEQ + 8 * hi;
        f32x16 S;
#pragma unroll
        for (int i = 0; i < 16; ++i) S[i] = 0.f;
        bf16x8 A[8], B[8];
#pragma unroll
        for (int s2 = 0; s2 < 8; ++s2) { A[s2] = *(const bf16x8*)(va + 16 * s2); B[s2] = *(const bf16x8*)(kb + 16 * s2); }
        for (int c = 0; c < 32; ++c) {
            bf16_t* sp = a.ST + (((size_t)u * 32 + c) * 64 + 32 * et + 4 * hi) * 64 + 32 * dt + r;
#pragma unroll
            for (int i = 0; i < 16; ++i) sp[((i & 3) + 8 * (i >> 2)) * 64] = f2bf(S[i]);
            f32x16 KV;
#pragma unroll
            for (int i = 0; i < 16; ++i) KV[i] = 0.f;
            bf16x8 An[8], Bn[8]; const int cn = c < 31 ? c + 1 : c;
#pragma unroll
            for (int s2 = 0; s2 < 8; ++s2) { An[s2] = *(const bf16x8*)(va + cn * 128 + 16 * s2); Bn[s2] = *(const bf16x8*)(kb + cn * 128 + 16 * s2); }
#pragma unroll
            for (int s2 = 0; s2 < 8; ++s2) KV = __builtin_amdgcn_mfma_f32_32x32x16_bf16(A[s2], B[s2], KV, 0, 0, 0);
#pragma unroll
            for (int i = 0; i < 16; ++i) S[i] = gc * S[i] + KV[i];
#pragma unroll
            for (int s2 = 0; s2 < 8; ++s2) { A[s2] = An[s2]; B[s2] = Bn[s2]; }
        }
    }
}
__device__ __forceinline__ void ph_ret_out(const Args& a, int l, int vcu, int G) {
    using namespace ret;
    int tid = threadIdx.x; asm volatile("" : "+v"(tid)); asm volatile("" : "+s"(vcu));
    const int w = tid >> 6, lane = tid & 63, hi = lane >> 5, r = lane & 31, h = w >> 1, qh = w & 1;
    const float lg = lg2g(h); const float* gn = a.ret_gn + l * 256 + h * 64;
    for (int u = vcu; u < NB * 32; u += G) { const int b = u >> 5, c = u & 31, bh = b * 4 + h;
        const bf16_t* stp = a.ST + ((size_t)bh * 32 + c) * 4096; const bf16_t* vt = a.VrT + (size_t)bh * 64 * SEQ + c * 128;
#pragma unroll 1
        for (int qt = 0; qt < 2; ++qt) { const int q = 2 * qh + qt; const size_t row = (size_t)b * SEQ + c * 128 + 32 * q + r;
            bf16x8 Qf[4];
#pragma unroll
            for (int s = 0; s < 4; ++s) Qf[s] = *(const bf16x8*)(a.qrb + row * 256 + h * 64 + 16 * s + 8 * hi);
            f32x16 O0, O1;
#pragma unroll
            for (int i = 0; i < 16; ++i) { O0[i] = 0.f; O1[i] = 0.f; }
#pragma unroll
            for (int s = 0; s < 4; ++s) { const bf16x8 a0 = *(const bf16x8*)(stp + r * 64 + 16 * s + 8 * hi), a1 = *(const bf16x8*)(stp + (32 + r) * 64 + 16 * s + 8 * hi);
                O0 = __builtin_amdgcn_mfma_f32_32x32x16_bf16(a0, Qf[s], O0, 0, 0, 0); O1 = __builtin_amdgcn_mfma_f32_32x32x16_bf16(a1, Qf[s], O1, 0, 0, 0); }
            const float xi = exp2f((float)(32 * q + r + 1) * lg);
#pragma unroll
            for (int i = 0; i < 16; ++i) { O0[i] *= xi; O1[i] *= xi; }
            for (int kt = 0; kt <= q; ++kt) { const size_t krow = (size_t)b * SEQ + c * 128 + 32 * kt + r;
                f32x16 S;
#pragma unroll
                for (int i = 0; i < 16; ++i) S[i] = 0.f;
#pragma unroll
                for (int s = 0; s < 4; ++s) { const bf16x8 ka = *(const bf16x8*)(a.krb + krow * 256 + h * 64 + 16 * s + 8 * hi); S = __builtin_amdgcn_mfma_f32_32x32x16_bf16(ka, Qf[s], S, 0, 0, 0); }
                const int dbase = 32 * (q - kt) + r - 4 * hi;
#pragma unroll
                for (int i = 0; i < 16; ++i) { const int dl = dbase - ((i & 3) + 8 * (i >> 2)); S[i] = dl >= 0 ? S[i] * exp2f((float)dl * lg) : 0.f; }
#pragma unroll
                for (int s2 = 0; s2 < 2; ++s2) { u32x4 pw;
#pragma unroll
                    for (int x = 0; x < 4; ++x) pw[x] = pk2(S[8 * s2 + 2 * x], S[8 * s2 + 2 * x + 1]);
                    const bf16x8 Pf = __builtin_bit_cast(bf16x8, pw);
                    const bf16_t* v0 = vt + (size_t)r * SEQ + 32 * kt + 16 * s2 + 4 * hi; const bf16_t* v1 = v0 + (size_t)32 * SEQ;
                    const u32x2 x0 = *(const u32x2*)v0, y0 = *(const u32x2*)(v0 + 8), x1 = *(const u32x2*)v1, y1 = *(const u32x2*)(v1 + 8);
                    O0 = __builtin_amdgcn_mfma_f32_32x32x16_bf16(__builtin_bit_cast(bf16x8, (u32x4){x0.x, x0.y, y0.x, y0.y}), Pf, O0, 0, 0, 0);
                    O1 = __builtin_amdgcn_mfma_f32_32x32x16_bf16(__builtin_bit_cast(bf16x8, (u32x4){x1.x, x1.y, y1.x, y1.y}), Pf, O1, 0, 0, 0); }
            }
            float sm = 0.f;
#pragma unroll
            for (int i = 0; i < 16; ++i) sm += O0[i] + O1[i];
            sm += __shfl_xor(sm, 32); const float mu = sm * (1.f / 64.f); float vq = 0.f;
#pragma unroll
            for (int i = 0; i < 16; ++i) { const float d0 = O0[i] - mu, d1 = O1[i] - mu; vq += d0 * d0 + d1 * d1; }
            vq += __shfl_xor(vq, 32); const float rs = rsqrtf(vq * (1.f / 64.f) + 1e-5f);
            const bf16_t* gp = a.proj + row * DINP + C_RG + h * 64 + 4 * hi; bf16_t* op = a.ocat + row * DM + 768 + h * 64 + 4 * hi;
#pragma unroll
            for (int q4 = 0; q4 < 4; ++q4) {
#pragma unroll
                for (int et = 0; et < 2; ++et) { const int e0 = 32 * et + 8 * q4; const u32x2 gt = *(const u32x2*)(gp + e0); const f32x4 gg = *(const f32x4*)(gn + e0 + 4 * hi);
                    float o[4];
#pragma unroll
                    for (int x = 0; x < 4; ++x) { const float ov = et ? O1[4 * q4 + x] : O0[4 * q4 + x]; const unsigned gw = x < 2 ? gt.x : gt.y; const float gv = __uint_as_float((x & 1) ? (gw & 0xffff0000u) : (gw << 16));
                        o[x] = siluf(gv) * (ov - mu) * rs * gg[x]; }
                    u32x2 ow; ow.x = pk2(o[0], o[1]); ow.y = pk2(o[2], o[3]); *(u32x2*)(op + e0) = ow; } }
        }
    }
}

__device__ __forceinline__ void ph_route(const Args& a, LAS char* lds, int vcu, int G) {
    int tid_ = threadIdx.x; asm volatile("" : "+v"(tid_)); asm volatile("" : "+s"(vcu));
    const int lane = tid_ & 63; const float* g = a.ln_ffn + DM; LAS float* gr = (LAS float*)lds;
    __syncthreads();
    for (int q = tid_; q < DM * 8; q += NT) gr[q] = a.router[q] * g[q >> 3];
    __syncthreads();
    for (int row = vcu * NW + (tid_ >> 6); row < NTOK; row += G * NW) { float lg[8];
#pragma unroll
        for (int e = 0; e < 8; ++e) lg[e] = 0.f;
        f32x4 xv[4];
#pragma unroll
        for (int i = 0; i < 4; ++i) xv[i] = *(const f32x4*)(a.xres + (size_t)row * DM + lane * 4 + 256 * i);
#pragma unroll
        for (int i = 0; i < 4; ++i)
#pragma unroll
            for (int jj = 0; jj < 4; ++jj) { const int k = lane * 4 + 256 * i + jj; const f32x4 r0 = *(const LAS f32x4*)(gr + k * 8), r1 = *(const LAS f32x4*)(gr + k * 8 + 4); const float x = xv[i][jj];
                lg[0] += x * r0[0]; lg[1] += x * r0[1]; lg[2] += x * r0[2]; lg[3] += x * r0[3]; lg[4] += x * r1[0]; lg[5] += x * r1[1]; lg[6] += x * r1[2]; lg[7] += x * r1[3]; }
        const float rs = row_rstd(a.ssq, row);
#pragma unroll
        for (int e = 0; e < 8; ++e) lg[e] = wsum(lg[e]) * rs;
        int e1 = 0; float v1 = lg[0];
#pragma unroll
        for (int e = 1; e < 8; ++e) if (lg[e] > v1) { v1 = lg[e]; e1 = e; }
        int e2 = -1; float v2 = -INFINITY;
#pragma unroll
        for (int e = 0; e < 8; ++e) if (e != e1 && lg[e] > v2) { v2 = lg[e]; e2 = e; }
        if (lane == 0) { const float g1 = 1.f / (1.f + __expf(v2 - v1)); a.gate[row * 2] = g1; a.gate[row * 2 + 1] = 1.f - g1;
            const int i1 = atomicAdd(&a.cnt[e1], 1); a.tok_list[e1 * NTOK + i1] = row * 2; const int i2 = atomicAdd(&a.cnt[e2], 1); a.tok_list[e2 * NTOK + i2] = row * 2 + 1; } }
}
__device__ __forceinline__ void ph_route_build(const Args& a, int vcu, int G) {
    int tid_ = threadIdx.x; asm volatile("" : "+v"(tid_)); asm volatile("" : "+s"(vcu));
    for (int idx = vcu * NT + tid_; idx < NEXP * NTOK; idx += G * NT) { const int e = idx >> 15, i = idx & (NTOK - 1);
        int ps = 0; for (int q = 0; q < e; ++q) ps += (a.cnt[q] + 255) & ~255;
        const int ce = a.cnt[e], pe = (ce + 255) & ~255;
        if (i < ce) { const int en = a.tok_list[e * NTOK + i]; a.row_tok[ps + i] = en >> 1; a.slot[en] = ps + i; } else if (i < pe) a.row_tok[ps + i] = -1;
        if (i < pe && (i & 255) == 0) a.tile_exp[(ps + i) >> 8] = e;
        if (idx == 0) { int tot = 0; for (int q = 0; q < 8; ++q) tot += (a.cnt[q] + 255) & ~255; a.meta[0] = tot >> 8; } }
}
__device__ __forceinline__ void ph_final(const Args& a, int vcu, int G) {
    int tid_ = threadIdx.x; asm volatile("" : "+v"(tid_)); asm volatile("" : "+s"(vcu));
    const int lane = tid_ & 63; float* xio = a.xres;
    for (int row = vcu * NW + (tid_ >> 6); row < NTOK; row += G * NW) { const int s1 = a.slot[row * 2], s2 = a.slot[row * 2 + 1]; const float g1 = a.gate[row * 2], g2 = a.gate[row * 2 + 1];
        float v[16]; float ss = 0.f;
#pragma unroll
        for (int i = 0; i < 4; ++i) { const int c = lane * 4 + i * 256; const float4 xv = *(const float4*)(xio + (size_t)row * DM + c);
            const ushort4 p = *(const ushort4*)(a.ysorted + (size_t)s1 * DM + c), q = *(const ushort4*)(a.ysorted + (size_t)s2 * DM + c);
            v[i * 4 + 0] = xv.x + g1 * bf2f(p.x) + g2 * bf2f(q.x); v[i * 4 + 1] = xv.y + g1 * bf2f(p.y) + g2 * bf2f(q.y);
            v[i * 4 + 2] = xv.z + g1 * bf2f(p.z) + g2 * bf2f(q.z); v[i * 4 + 3] = xv.w + g1 * bf2f(p.w) + g2 * bf2f(q.w);
#pragma unroll
            for (int j = 0; j < 4; ++j) ss += v[i * 4 + j] * v[i * 4 + j]; }
        const float rs = rsqrtf(wsum(ss) * (1.f / DM) + 1e-6f);
#pragma unroll
        for (int i = 0; i < 4; ++i) { const int c = lane * 4 + i * 256; const float4 gf = *(const float4*)(a.ln_final + c); float4 o; o.x = v[i * 4] * rs * gf.x; o.y = v[i * 4 + 1] * rs * gf.y; o.z = v[i * 4 + 2] * rs * gf.z; o.w = v[i * 4 + 3] * rs * gf.w;
            *(float4*)(xio + (size_t)row * DM + c) = o; } }
}

__global__ void __launch_bounds__(NT, 2) mega(Args a) {
    extern __shared__ __attribute__((aligned(16))) char lds[];
    volatile LAS unsigned* misc = (volatile LAS unsigned*)((LAS char*)lds + MISC_OFF);
    if (threadIdx.x < 64) misc[threadIdx.x] = 0u;
    __syncthreads();
    XcdBarrier bar = xcd_barrier_post(a.bar, misc);
    const int G = gridDim.x, vcu = blockIdx.x;
    LAS char* const lds3 = (LAS char*)lds;
#ifndef REP_PRO
#define REP_PRO 1
#endif
#ifndef REP_GEMM
#define REP_GEMM 1
#endif
#ifndef REP_NSA
#define REP_NSA 1
#endif
#ifndef REP_X
#define REP_X 1
#endif
#define GRID_BAR() xcd_barrier(bar)
#define AS4 __attribute__((address_space(4)))
#if defined(__HIP_DEVICE_COMPILE__)
#define LA const AS4 Args* ap_ = (const AS4 Args*)__builtin_amdgcn_kernarg_segment_ptr(); asm volatile("" : "+s"(ap_)); Args A; __builtin_memcpy(&A, ap_, sizeof(Args))
#else
#define LA const Args A = a
#endif

    { LA; ph_prologue(A, lds3, vcu, G); }
    GRID_BAR();
#pragma unroll
    for (int l = 0; l < 2; ++l) {
        for (int rep = 0; rep < REP_GEMM; ++rep) { LA; pg8::Gemm g{A.xb, A.Win + (size_t)l * DINP * DM, NTOK, DINP, DM}; pg8::StaticOrder S; S.init(NTOK, DINP, G, vcu);
          pg8::gemm_phase<pg8::EIn, pg8::StaticOrder, 0>((PG8_LAS unsigned char*)lds3, g, S, pg8::EIn{A.proj, A.ssq}, nullptr, nullptr, 0); }
        GRID_BAR();
#pragma unroll 1
        for (int rep = 0; rep < REP_X; ++rep) {
#pragma unroll 1
        for (int kv = 0; kv < 2; ++kv) { const int i = l * 2 + kv;
            { LA; pg8::Gemm g{A.proj, A.W1b + (size_t)i * 256 * 2048, 4096, 256, 2048}; pg8::StaticOrder S; S.init(4096, 256, G, (vcu + G - kv * 16) % G);
              pg8::gemm_phase<pg8::ESiluBias, pg8::StaticOrder, 2>((PG8_LAS unsigned char*)lds3, g, S, pg8::ESiluBias{A.hc + (size_t)kv * 4096 * 256, A.bias1 + i * 256}, nullptr, nullptr, (size_t)(kv ? C_VC : C_KC)); } }
        { LA; ph_vtrans(A, lds3, vcu, G); }
        { LA; ph_conv_naive(A, l, lds3, vcu, G); }
        { LA; ph_ret_prep(A, lds3, vcu, G); }
        }
        GRID_BAR();
#pragma unroll 1
        for (int rep = 0; rep < REP_X; ++rep) {
        { LA; pg8::Gemm g{A.hc, A.W2b + (size_t)(l * 2) * 256 * 256, 4096, 256, 256}; pg8::StaticOrder S; S.init(4096, 256, G, vcu);
          pg8::gemm_phase<pg8::EKc, pg8::StaticOrder, 0>((PG8_LAS unsigned char*)lds3, g, S, pg8::EKc{A.kcb, 0, 0}, nullptr, nullptr, 0); }
        { LA; pg8::Gemm g{A.hc + (size_t)4096 * 256, A.W2b + (size_t)(l * 2 + 1) * 256 * 256, 4096, 256, 256}; pg8::StaticOrder S; S.init(4096, 256, G, (vcu + G - 16) % G);
          pg8::gemm_phase<pg8::EKc, pg8::StaticOrder, 0>((PG8_LAS unsigned char*)lds3, g, S, pg8::EKc{A.vcT, 1, 0}, nullptr, nullptr, 0); }
        { LA; pg8::Gemm g{A.hconv, A.Wpw + (size_t)l * 65536, NTOK, 256, 256}; pg8::StaticOrder S; S.init(NTOK, 256, G, (vcu + G - 32) % G);
          pg8::gemm_phase<pg8::EStore, pg8::StaticOrder, 0>((PG8_LAS unsigned char*)lds3, g, S, pg8::EStore{A.ocat + 512, DM}, nullptr, nullptr, 0); }
        { LA; ph_ret_state(A, (vcu + G - 64) % G, G); }
        }
        GRID_BAR();
        { LA; ph_ret_out(A, l, vcu, G); }
        for (int rep = 0; rep < REP_NSA; ++rep) { LA; ph_nsa(A, lds3, vcu, G); }
        GRID_BAR();
        { LA; pg8::Gemm g{A.ocat, A.Wout + (size_t)l * DM * DM, NTOK, DM, DM}; pg8::StaticOrder S; S.init(NTOK, DM, G, vcu);
          pg8::gemm_phase<pg8::ERes, pg8::StaticOrder, 0>((PG8_LAS unsigned char*)lds3, g, S, pg8::ERes{l == 0 ? A.x : A.xres, A.xres, A.xb, A.ssq}, nullptr, nullptr, 0); }
        GRID_BAR();
        if (l == 0) {
            for (int rep = 0; rep < REP_GEMM; ++rep) { LA; pg8::Gemm g{A.xb, A.W13, NTOK, 2 * DFF, DM}; pg8::StaticOrder S; S.init(NTOK, 2 * DFF, G, vcu);
              pg8::gemm_phase<pg8::ESwiglu, pg8::StaticOrder, 0>((PG8_LAS unsigned char*)lds3, g, S, pg8::ESwiglu{A.hbuf, A.ssq, nullptr}, nullptr, nullptr, 0); }
            GRID_BAR();
            { LA; pg8::Gemm g{A.hbuf, A.W2, NTOK, DM, DFF}; pg8::StaticOrder S; S.init(NTOK, DM, G, vcu);
              pg8::gemm_phase<pg8::ERes, pg8::StaticOrder, 0>((PG8_LAS unsigned char*)lds3, g, S, pg8::ERes{A.xres, A.xres, A.xb, A.ssq}, nullptr, nullptr, 0); }
            GRID_BAR();
        }
    }
    { LA; ph_route(A, lds3, vcu, G); }
    GRID_BAR();
    { LA; ph_route_build(A, vcu, G); }
    GRID_BAR();
    for (int rep = 0; rep < REP_GEMM; ++rep) { LA; const int Mm = A.meta[0] * 256; pg8::Gemm g{A.xb, A.Wm13, Mm, 2 * DFF, DM}; pg8::StaticOrder S; S.init(Mm, 2 * DFF, G, vcu);
      pg8::gemm_phase<pg8::ESwiglu, pg8::StaticOrder, 1>((PG8_LAS unsigned char*)lds3, g, S, pg8::ESwiglu{A.hbuf, A.ssq, A.row_tok}, A.row_tok, A.tile_exp, (size_t)2 * DFF * DM); }
    GRID_BAR();
    for (int rep = 0; rep < REP_GEMM; ++rep) { LA; const int Mm = A.meta[0] * 256; pg8::Gemm g{A.hbuf, A.Wm2, Mm, DM, DFF}; pg8::StaticOrder S; S.init(Mm, DM, G, vcu);
      pg8::gemm_phase<pg8::EStore, pg8::StaticOrder, 0>((PG8_LAS unsigned char*)lds3, g, S, pg8::EStore{A.ysorted, DM}, nullptr, A.tile_exp, (size_t)DM * DFF); }
    GRID_BAR();
    { LA; ph_final(A, vcu, G); }
}

static inline size_t al256(size_t x) { return (x + 255) & ~(size_t)255; }
extern "C" void kernel_launch(void* const* d_in, const int* in_sizes, int n_in, void* d_out, int out_size, void* d_ws, size_t ws_size, hipStream_t stream) {
    static int grid = 0;
    Args a{};
    const float** ins = (const float**)&a.x;
    for (int i = 0; i < 20; ++i) ins[i] = (const float*)d_in[i];
    a.xres = (float*)d_out;
    char* w = (char*)d_ws; size_t off = 0;
    auto take = [&](size_t bytes) { char* p = w + off; off = al256(off + bytes); return p; };
    a.bar = (unsigned*)take(XCD_BAR_WORDS * 4);
    a.cnt = (int*)take(256);
    a.meta = (int*)take(256);
    const size_t ctl_bytes = off;
    char* regY = w + off;
    a.Wm13 = (bf16_t*)take((size_t)NEXP * 2 * DFF * DM * 2);
    a.Win = (bf16_t*)take((size_t)2 * DINP * DM * 2);
    a.Wout = (bf16_t*)take((size_t)2 * DM * DM * 2);
    a.W13 = (bf16_t*)take((size_t)2 * DFF * DM * 2);
    a.W2 = (bf16_t*)take((size_t)DM * DFF * 2);
    a.xb = (bf16_t*)take((size_t)NTOK * DM * 2);
    a.ysorted = (bf16_t*)regY;
    a.Wm2 = (bf16_t*)take((size_t)NEXP * DM * DFF * 2);
    a.W1b = (bf16_t*)take((size_t)4 * 256 * 2048 * 2);
    a.W2b = (bf16_t*)take((size_t)4 * 256 * 256 * 2);
    a.Wpw = (bf16_t*)take((size_t)2 * 256 * 256 * 2);
    a.bias1 = (float*)take(4 * 256 * 4);
    a.rot = (float*)take((size_t)4096 * 32 * 2 * 4);
    a.ssq = (float*)take((size_t)NTOK * NSLOT * 4);
    a.tok_list = (int*)take((size_t)NEXP * NTOK * 4);
    a.row_tok = (int*)take((size_t)PMAX * 4);
    a.slot = (int*)take((size_t)NTOK * 2 * 4);
    a.tile_exp = (int*)take(1024 * 4);
    a.gate = (float*)take((size_t)NTOK * 2 * 4);
    char* regR = w + off;
    a.proj = (bf16_t*)take((size_t)NTOK * DINP * 2);
    a.ocat = (bf16_t*)take((size_t)NTOK * DM * 2);
    a.hc = (bf16_t*)take((size_t)2 * 4096 * 256 * 2);
    a.kcb = (bf16_t*)take((size_t)4096 * 64 * 2);
    a.vcb = (bf16_t*)take((size_t)4096 * 64 * 2);
    a.hconv = (bf16_t*)take((size_t)NTOK * 256 * 2);
    a.qr = (float*)take((size_t)NTOK * 256 * 4);
    a.kr = (float*)take((size_t)NTOK * 256 * 4);
    a.KV = (float*)take((size_t)1024 * 4096 * 4);
    a.Sst = (float*)take((size_t)1024 * 4096 * 4);
    a.vcT = (bf16_t*)take((size_t)16 * 64 * 256 * 2);
    a.VsT = (bf16_t*)take((size_t)16 * 64 * SEQ * 2);
    a.VwT = (bf16_t*)take((size_t)16 * 64 * SEQ * 2);
    a.qrb = (bf16_t*)take((size_t)NTOK * 256 * 2);
    a.krb = (bf16_t*)take((size_t)NTOK * 256 * 2);
    a.KzT = (bf16_t*)take((size_t)32 * 64 * SEQ * 2);
    a.VrT = (bf16_t*)take((size_t)32 * 64 * SEQ * 2);
    a.ST = (bf16_t*)take((size_t)32 * 32 * 4096 * 2);
    a.hbuf = (bf16_t*)regR;
    const size_t need = (size_t)(regR - w) + (size_t)PMAX * DFF * 2;
    if (grid == 0) {
        if (need > ws_size || off > ws_size || n_in != 20) { fprintf(stderr, "kernel_launch: workspace too small: need %zu / %zu have %zu\n", need, off, ws_size); grid = -1; return; }
        int dev = 0, cus = 0;
        if (hipGetDevice(&dev) != hipSuccess || hipDeviceGetAttribute(&cus, hipDeviceAttributeMultiprocessorCount, dev) != hipSuccess) { grid = -1; return; }
        if (hipFuncSetAttribute((const void*)mega, hipFuncAttributeMaxDynamicSharedMemorySize, LDS_BYTES) != hipSuccess) { fprintf(stderr, "kernel_launch: hipFuncSetAttribute failed\n"); grid = -1; return; }
        int per_cu = 0;
        if (hipOccupancyMaxActiveBlocksPerMultiprocessor(&per_cu, (const void*)mega, NT, LDS_BYTES) != hipSuccess || per_cu < 1) { fprintf(stderr, "kernel_launch: occupancy query says %d\n", per_cu); }
        (void)hipGetLastError();
        grid = cus;
    }
    if (grid < 0) return;
    (void)hipMemsetAsync(w, 0, ctl_bytes, stream);
    hipLaunchKernelGGL(mega, dim3(grid), dim3(NT), LDS_BYTES, stream, a);
}
```

```cpp
#include <hip/hip_runtime.h>
#include <stdint.h>
#include <stdio.h>

typedef unsigned short bf16_t;
typedef short bf16x8 __attribute__((ext_vector_type(8)));
typedef float f32x4 __attribute__((ext_vector_type(4)));
typedef unsigned u32x4_t __attribute__((ext_vector_type(4)));

constexpr int NTOK = 32768, DM = 1024, NB = 8, SEQ = 4096;
constexpr int DIN = 2840, DINP = 3072, DFF = 2816, NEXP = 8;
constexpr int C_Q = 0, C_KC = 512, C_VC = 640, C_KS = 768, C_VS = 896, C_KW = 1024, C_VW = 1152, C_GL = 1280,
              C_CONV = 1304, C_RQ = 1816, C_RK = 2072, C_RV = 2328, C_RG = 2584;
constexpr int NSLOT = 16;
constexpr int PMAX = 65536 + 8 * 256;
constexpr int NT = 512, NW = 8;
constexpr int LDS_BYTES = 144 * 1024, MISC_OFF = LDS_BYTES - 256;

#define XB_TMO      128
#define XB_XCNT(j)  (256  + 64 * (j))
#define XB_XSUB(j)  (1280 + 64 * (j))
#define XB_XGEN(j)  (2304 + 64 * (j))
#define XB_TOP      3328
#define XB_TOPGEN   3392
#define XCD_BAR_WORDS 3456
#define XB_SPIN_CAP (1u << 20)
#define LAS __attribute__((address_space(3)))
__device__ __forceinline__ unsigned xb_ld(unsigned* p)              { return __hip_atomic_load(p, __ATOMIC_RELAXED, __HIP_MEMORY_SCOPE_AGENT); }
__device__ __forceinline__ unsigned xb_add(unsigned* p, unsigned v) { return __hip_atomic_fetch_add(p, v, __ATOMIC_RELAXED, __HIP_MEMORY_SCOPE_AGENT); }
__device__ __forceinline__ unsigned xb_xcc_id() { return (unsigned)__builtin_amdgcn_s_getreg((3 << 11) | 20) & 0xFu; }
#define XB_SPIN(cond, bar) do { unsigned _sp = 0; while (cond) { __builtin_amdgcn_s_sleep(1); \
    if ((++_sp & 255u) == 0u) { if (xb_ld(&(bar)[XB_TMO])) break; if (_sp > XB_SPIN_CAP) { atomicAdd(&(bar)[XB_TMO], 1u); break; } } } } while (0)
struct XcdBarrier { unsigned* bar; unsigned x; volatile LAS unsigned* st; };
__device__ __forceinline__ XcdBarrier xcd_barrier_post(unsigned* bar, volatile LAS unsigned* st) {
    XcdBarrier b; b.bar = bar; b.x = xb_xcc_id(); b.st = st;
    if (threadIdx.x == 0) (void)xb_add(&bar[XB_XCNT(b.x)], 1u);
    return b;
}
__device__ __forceinline__ void xcd_barrier_complete(unsigned* bar, unsigned x, unsigned& nloc, unsigned& nx) {
    const unsigned G = gridDim.x * gridDim.y * gridDim.z;
    unsigned sum, cnt, mine, sp = 0u;
    for (;;) {
        sum = 0u; cnt = 0u; mine = 0u;
#pragma unroll
        for (unsigned j = 0; j < 16; ++j) { const unsigned c = xb_ld(&bar[XB_XCNT(j)]); sum += c; cnt += (c > 0u) ? 1u : 0u; mine = (j == x) ? c : mine; }
        if (sum == G) break;
        __builtin_amdgcn_s_sleep(1);
        if ((++sp & 255u) == 0u) { if (xb_ld(&bar[XB_TMO])) break; if (sp > XB_SPIN_CAP) { atomicAdd(&bar[XB_TMO], 1u); break; } }
    }
    nloc = mine > 0u ? mine : 1u; nx = cnt > 0u ? cnt : 1u;
}
__device__ __forceinline__ void xcd_barrier(const XcdBarrier& b) {
    asm volatile("s_waitcnt vmcnt(0)" ::: "memory");
    __syncthreads();
    if (threadIdx.x == 0) {
        unsigned* bar = b.bar;
        __builtin_amdgcn_s_waitcnt(0);
        const unsigned bx = xb_xcc_id();
        unsigned nloc = b.st[0], nx = b.st[1];
        if (nloc == 0u) { xcd_barrier_complete(bar, bx, nloc, nx); b.st[0] = nloc; b.st[1] = nx; }
        const unsigned old = xb_add(&bar[XB_XSUB(bx)], 1u);
        const unsigned gen = old / nloc;
        if (old + 1u == (gen + 1u) * nloc) {
            __builtin_amdgcn_fence(__ATOMIC_RELEASE, "agent");
            asm volatile("s_waitcnt vmcnt(0)" ::: "memory");
            const unsigned og = xb_add(&bar[XB_TOP], 1u);
            const unsigned tg = og / nx;
            if (og + 1u == (tg + 1u) * nx) xb_add(&bar[XB_TOPGEN], 1u);
            else XB_SPIN(xb_ld(&bar[XB_TOPGEN]) == tg, bar);
            __builtin_amdgcn_fence(__ATOMIC_ACQUIRE, "agent");
            xb_add(&bar[XB_XGEN(bx)], 1u);
            asm volatile("s_waitcnt vmcnt(0)" ::: "memory");
        } else {
            XB_SPIN(xb_ld(&bar[XB_XGEN(bx)]) == gen, bar);
            __builtin_amdgcn_fence(__ATOMIC_ACQUIRE, "agent");
            asm volatile("s_waitcnt vmcnt(0)" ::: "memory");
        }
    }
    __syncthreads();
}

__device__ __forceinline__ bf16_t f2bf(float f) { unsigned u = __float_as_uint(f); u += 0x7fffu + ((u >> 16) & 1u); return (bf16_t)(u >> 16); }
__device__ __forceinline__ unsigned pk2bf(float lo, float hi) { unsigned r; asm volatile("v_cvt_pk_bf16_f32 %0, %1, %2" : "=v"(r) : "v"(lo), "v"(hi)); return r; }
__device__ __forceinline__ float bf2f(bf16_t h) { return __uint_as_float(((unsigned)h) << 16); }
__device__ __forceinline__ float wsum(float v) {
#pragma unroll
    for (int o = 32; o > 0; o >>= 1) v += __shfl_xor(v, o);
    return v; }
__device__ __forceinline__ float wmax(float v) {
#pragma unroll
    for (int o = 32; o > 0; o >>= 1) v = fmaxf(v, __shfl_xor(v, o));
    return v; }
__device__ __forceinline__ float siluf(float x) { return x / (1.f + __expf(-x)); }
__device__ __forceinline__ float sigmf(float x) { return 1.f / (1.f + __expf(-x)); }
__device__ __forceinline__ float row_rstd(const float* ssq, int row) { const f32x4* p = (const f32x4*)(ssq + (size_t)row * NSLOT); const f32x4 a = p[0], b = p[1], c = p[2], d = p[3];
    const f32x4 t = (a + b) + (c + d); return rsqrtf(((t[0] + t[1]) + (t[2] + t[3])) * (1.f / DM) + 1e-6f); }

struct Args {
    const float *x, *ln_attn, *w_in, *cmp_pe, *cmp_w1, *cmp_w2, *conv_w, *conv_b, *conv_lg, *conv_lb, *conv_pw, *ret_gn, *w_out, *ln_ffn, *ffn_w13, *ffn_w2, *router, *moe_w13, *moe_w2, *ln_final;
    float* xres;
    bf16_t *Wm13, *Win, *Wout, *W13, *W2, *xb, *ysorted, *Wm2, *W1b, *W2b, *Wpw;
    float *bias1, *rot, *ssq; int *cnt, *meta, *tok_list, *row_tok, *slot, *tile_exp; float* gate;
    bf16_t *proj, *ocat, *hc, *kcb, *vcb, *hconv; float *qr, *kr, *KV, *Sst; bf16_t* hbuf; bf16_t *vcT, *VsT, *VwT, *qrb, *krb, *KzT, *VrT, *ST;
    unsigned* bar;
};

struct ConvJob { const float* src; bf16_t* dst; const float* g; int ldsrc, K, Npad, nvalid, mode, pad; };
__device__ __forceinline__ ConvJob get_job(const Args& a, int j) {
    ConvJob c; c.g = nullptr; c.mode = 0; c.pad = 0;
    if (j < 2) { c.src = a.w_in + (size_t)j * DM * DIN; c.dst = a.Win + (size_t)j * DINP * DM; c.g = a.ln_attn + j * DM; c.ldsrc = DIN; c.K = DM; c.Npad = DINP; c.nvalid = DIN; c.mode = 1; }
    else if (j < 4) { const int l = j - 2; c.src = a.w_out + (size_t)l * DM * DM; c.dst = a.Wout + (size_t)l * DM * DM; c.ldsrc = DM; c.K = DM; c.Npad = DM; c.nvalid = DM; }
    else if (j < 6) { const int l = j - 4; c.src = a.conv_pw + (size_t)l * 65536; c.dst = a.Wpw + (size_t)l * 65536; c.ldsrc = 256; c.K = 256; c.Npad = 256; c.nvalid = 256; }
    else if (j < 10) { const int i = j - 6; c.src = a.cmp_w1 + (size_t)i * 2048 * 256; c.dst = a.W1b + (size_t)i * 256 * 2048; c.ldsrc = 256; c.K = 2048; c.Npad = 256; c.nvalid = 256; }
    else if (j < 14) { const int i = j - 10; c.src = a.cmp_w2 + (size_t)i * 256 * 64; c.dst = a.W2b + (size_t)i * 256 * 256; c.ldsrc = 64; c.K = 256; c.Npad = 256; c.nvalid = 64; }
    else if (j == 14) { c.src = a.ffn_w13; c.dst = a.W13; c.g = a.ln_ffn; c.ldsrc = 2 * DFF; c.K = DM; c.Npad = 2 * DFF; c.nvalid = 2 * DFF; c.mode = 2; }
    else if (j == 15) { c.src = a.ffn_w2; c.dst = a.W2; c.ldsrc = DM; c.K = DFF; c.Npad = DM; c.nvalid = DM; }
    else if (j < 24) { const int e = j - 16; c.src = a.moe_w13 + (size_t)e * DM * 2 * DFF; c.dst = a.Wm13 + (size_t)e * 2 * DFF * DM; c.g = a.ln_ffn + DM; c.ldsrc = 2 * DFF; c.K = DM; c.Npad = 2 * DFF; c.nvalid = 2 * DFF; c.mode = 2; }
    else { const int e = j - 24; c.src = a.moe_w2 + (size_t)e * DFF * DM; c.dst = a.Wm2 + (size_t)e * DM * DFF; c.ldsrc = DM; c.K = DFF; c.Npad = DM; c.nvalid = DM; }
    return c;
}
constexpr int NJOBS = 32;
__device__ __forceinline__ void conv_super(const ConvJob& c, int st, LAS float* lt, int tid_) {
    const int nsn = c.Npad / 256, n0 = (st % nsn) * 256, k0 = (st / nsn) * 64, lane = tid_ & 63, wv = tid_ >> 6;
    float v[32];
#pragma unroll
    for (int q = 0; q < 4; ++q) { const int n = n0 + q * 64 + lane; int sc;
        if (c.mode == 2) { const int pn = n >> 8, i = n & 255; sc = i < 128 ? 128 * pn + i : DFF + 128 * pn + (i - 128); } else sc = n < c.nvalid ? n : -1;
#pragma unroll
        for (int i = 0; i < 8; ++i) v[q * 8 + i] = sc >= 0 ? c.src[(size_t)(k0 + wv + 8 * i) * c.ldsrc + sc] : 0.f; }
#pragma unroll
    for (int q = 0; q < 4; ++q)
#pragma unroll
        for (int i = 0; i < 8; ++i) lt[(wv + 8 * i) * 257 + q * 64 + lane] = v[q * 8 + i];
    __syncthreads();
    const int nl = tid_ >> 3, ch = tid_ & 7;
    float gs[8];
#pragma unroll
    for (int e = 0; e < 8; ++e) gs[e] = c.g ? c.g[k0 + 8 * ch + e] : 1.f;
#pragma unroll
    for (int q = 0; q < 4; ++q) { const int n = n0 + q * 64 + nl; const float cs = (c.mode == 1 && (n < 512 || (n >= C_RK && n < C_RV))) ? 0.125f : 1.f; float x[8];
#pragma unroll
        for (int e = 0; e < 8; ++e) x[e] = lt[(8 * ch + e) * 257 + q * 64 + nl] * gs[e] * cs;
        u32x4_t w; w.x = pk2bf(x[0], x[1]); w.y = pk2bf(x[2], x[3]); w.z = pk2bf(x[4], x[5]); w.w = pk2bf(x[6], x[7]);
        *(u32x4_t*)(c.dst + (size_t)n * c.K + k0 + 8 * ch) = w; }
    __syncthreads();
}
__device__ __forceinline__ void ph_prologue(const Args& a, LAS char* lds, int vcu, int G) {
    int tid_ = threadIdx.x; asm volatile("" : "+v"(tid_)); asm volatile("" : "+s"(vcu));
    LAS float* lt = (LAS float*)lds; int acc = 0;
    for (int j = 0; j < NJOBS; ++j) { const ConvJob c = get_job(a, j); const int nt = (c.Npad / 256) * (c.K / 64);
        int t0 = vcu - (acc % G); if (t0 < 0) t0 += G;
        for (int t = t0; t < nt; t += G) conv_super(c, t, lt, tid_);
        acc += nt; }
    for (int u = vcu; u < 16; u += G) { const int i = u >> 2, nl = tid_ & 63, kp = tid_ >> 6, n = (u & 3) * 64 + nl; float s = 0.f;
        const float* pe = a.cmp_pe + (size_t)i * 2048; const float* w1 = a.cmp_w1 + (size_t)i * 2048 * 256;
        for (int k = kp; k < 2048; k += NW) s += pe[k] * w1[(size_t)k * 256 + n];
        lt[kp * 64 + nl] = s; __syncthreads();
        if (kp == 0) { float t = 0.f; for (int q = 0; q < NW; ++q) t += lt[q * 64 + nl]; a.bias1[i * 256 + n] = t; }
        __syncthreads(); }
    for (int idx = vcu * NT + tid_; idx < 4096 * 32; idx += G * NT) { const int pos = idx >> 5, i = idx & 31; const float inv = powf(10000.f, -(float)i / 32.f), ang = (float)pos * inv;
        a.rot[idx * 2] = cosf(ang); a.rot[idx * 2 + 1] = sinf(ang); }
    const int lane = tid_ & 63;
    for (int row = vcu * NW + (tid_ >> 6); row < NTOK; row += G * NW) { float s = 0.f;
        for (int c = lane * 4; c < DM; c += 256) { const float4 v = *(const float4*)(a.x + (size_t)row * DM + c); s += v.x * v.x + v.y * v.y + v.z * v.z + v.w * v.w;
            ushort4 o; o.x = f2bf(v.x); o.y = f2bf(v.y); o.z = f2bf(v.z); o.w = f2bf(v.w); *(ushort4*)(a.xb + (size_t)row * DM + c) = o; }
        s = wsum(s); if (lane < NSLOT) a.ssq[(size_t)row * NSLOT + lane] = lane == 0 ? s : 0.f; }
}

struct APlain { const bf16_t* A; int lda; __device__ __forceinline__ const bf16_t* ptr(int row, int k) const { return A + (size_t)row * lda + k; } };
struct AGather { const bf16_t* A; const int* row_tok; int lda; __device__ __forceinline__ const bf16_t* ptr(int row, int k) const { const int t = row_tok[row]; return t < 0 ? nullptr : A + (size_t)t * lda + k; } };
struct ACmp { const bf16_t* proj; int coloff;
    __device__ __forceinline__ const bf16_t* ptr(int row, int k) const { const int c = row & 255, g = (row >> 8) & 1, b = row >> 9; if (c == 255) return nullptr;
        return proj + (size_t)(b * SEQ + 16 * c + (k >> 6)) * DINP + coloff + g * 64 + (k & 63); } };
struct SchedPlain { int nM, nN; __device__ __forceinline__ int count() const { return nM * nN; }
    __device__ __forceinline__ void get(int u, int& row0, int& col0, size_t& boff) const { row0 = (u / nN) * 256; col0 = (u % nN) * 256; boff = 0; } };
struct SchedMoe { const int* meta; const int* tile_exp; size_t estride; int nN;
    __device__ __forceinline__ int count() const { return meta[0] * nN; }
    __device__ __forceinline__ void get(int u, int& row0, int& col0, size_t& boff) const { row0 = (u / nN) * 256; col0 = (u % nN) * 256; boff = (size_t)tile_exp[row0 >> 8] * estride; } };

struct EpiIn { bf16_t* proj; const float* ssq;
    __device__ __forceinline__ void apply(const f32x4 (&acc)[2][16], int rowb, int col0, int lane) const {
#pragma unroll
        for (int mi = 0; mi < 2; ++mi)
#pragma unroll
            for (int r = 0; r < 4; ++r) { const int row = rowb + mi * 16 + (lane >> 4) * 4 + r; const float rs = row_rstd(ssq, row);
#pragma unroll
                for (int n = 0; n < 16; ++n) proj[(size_t)row * DINP + col0 + n * 16 + (lane & 15)] = f2bf(acc[mi][n][r] * rs); } } };
struct EpiRes { const float* xold; float* xnew; bf16_t* xb; float* ssq;
    __device__ __forceinline__ void apply(const f32x4 (&acc)[2][16], int rowb, int col0, int lane) const {
#pragma unroll
        for (int mi = 0; mi < 2; ++mi)
#pragma unroll
            for (int r = 0; r < 4; ++r) { const int row = rowb + mi * 16 + (lane >> 4) * 4 + r; float s = 0.f;
#pragma unroll
                for (int n = 0; n < 16; ++n) { const size_t o = (size_t)row * DM + col0 + n * 16 + (lane & 15); const float v = xold[o] + acc[mi][n][r]; xnew[o] = v; xb[o] = f2bf(v); s += v * v; }
                s += __shfl_xor(s, 1); s += __shfl_xor(s, 2); s += __shfl_xor(s, 4); s += __shfl_xor(s, 8);
                if ((lane & 15) < 4) ssq[(size_t)row * NSLOT + (col0 >> 8) * 4 + (lane & 15)] = (lane & 15) == 0 ? s : 0.f; } } };
struct EpiSwiglu { bf16_t* h; const float* ssq; const int* row_tok;
    __device__ __forceinline__ void apply(const f32x4 (&acc)[2][16], int rowb, int col0, int lane) const {
#pragma unroll
        for (int mi = 0; mi < 2; ++mi)
#pragma unroll
            for (int r = 0; r < 4; ++r) { const int row = rowb + mi * 16 + (lane >> 4) * 4 + r; const int t = row_tok ? row_tok[row] : row;
                const float rs = t < 0 ? 0.f : row_rstd(ssq, t < 0 ? 0 : t);
#pragma unroll
                for (int n = 0; n < 8; ++n) { const float av = acc[mi][n][r] * rs, bv = acc[mi][n + 8][r] * rs; h[(size_t)row * DFF + (col0 >> 1) + n * 16 + (lane & 15)] = f2bf(siluf(av) * bv); } } } };
struct EpiStore { bf16_t* out; int ldc, coloff, ncols;
    __device__ __forceinline__ void apply(const f32x4 (&acc)[2][16], int rowb, int col0, int lane) const {
#pragma unroll
        for (int mi = 0; mi < 2; ++mi)
#pragma unroll
            for (int r = 0; r < 4; ++r) { const int row = rowb + mi * 16 + (lane >> 4) * 4 + r;
#pragma unroll
                for (int n = 0; n < 16; ++n) { const int c = col0 + n * 16 + (lane & 15); if (c < ncols) out[(size_t)row * ldc + coloff + c] = f2bf(acc[mi][n][r]); } } } };
struct EpiStoreT { bf16_t* out;
    __device__ __forceinline__ void apply(const f32x4 (&acc)[2][16], int rowb, int col0, int lane) const {
#pragma unroll
        for (int mi = 0; mi < 2; ++mi)
#pragma unroll
            for (int r = 0; r < 4; ++r) { const int row = rowb + mi * 16 + (lane >> 4) * 4 + r;
#pragma unroll
                for (int n = 0; n < 4; ++n) { const int c = col0 + n * 16 + (lane & 15); out[(size_t)(row >> 8) * 16384 + c * 256 + (row & 255)] = f2bf(acc[mi][n][r]); } } } };
struct EpiSiluBias { bf16_t* out; const float* bias; int ldc;
    __device__ __forceinline__ void apply(const f32x4 (&acc)[2][16], int rowb, int col0, int lane) const {
#pragma unroll
        for (int mi = 0; mi < 2; ++mi)
#pragma unroll
            for (int r = 0; r < 4; ++r) { const int row = rowb + mi * 16 + (lane >> 4) * 4 + r;
#pragma unroll
                for (int n = 0; n < 16; ++n) { const int c = col0 + n * 16 + (lane & 15); out[(size_t)row * ldc + c] = f2bf(siluf(acc[mi][n][r] + bias[c])); } } } };

template <class AS, class Epi, class Sched>
__device__ __forceinline__ void ph_gemm(LAS char* lds, const AS as, const bf16_t* __restrict__ Bt, const int K, const Epi epi, const Sched sched, int vcu, int G) {
    int tid_ = threadIdx.x; asm volatile("" : "+v"(tid_)); asm volatile("" : "+s"(vcu));
    LAS bf16_t* sA = (LAS bf16_t*)lds; LAS bf16_t* sB = (LAS bf16_t*)(lds + 256 * 40 * 2);
    const int tid = tid_, wave = tid >> 6, lane = tid & 63;
    const int nunits = sched.count();
    for (int u = vcu; u < nunits; u += G) {
        int row0, col0; size_t boff; sched.get(u, row0, col0, boff);
        const bf16_t* Bu = Bt + boff;
        f32x4 acc[2][16];
#pragma unroll
        for (int mi = 0; mi < 2; ++mi)
#pragma unroll
            for (int n = 0; n < 16; ++n) acc[mi][n] = (f32x4){0.f, 0.f, 0.f, 0.f};
#pragma unroll 1
        for (int k0 = 0; k0 < K; k0 += 32) {
#pragma unroll
            for (int i = 0; i < 2; ++i) { const int c = tid + i * NT, r = c >> 2, kc = (c & 3) * 8; const bf16_t* p = as.ptr(row0 + r, k0 + kc);
                uint4 v = make_uint4(0u, 0u, 0u, 0u); if (p) v = *(const uint4*)p; *(LAS u32x4_t*)&sA[r * 40 + kc] = (u32x4_t){v.x, v.y, v.z, v.w}; }
#pragma unroll
            for (int i = 0; i < 2; ++i) { const int c = tid + i * NT, r = c >> 2, kc = (c & 3) * 8;
                *(LAS u32x4_t*)&sB[r * 40 + kc] = *(const u32x4_t*)(Bu + (size_t)(col0 + r) * K + k0 + kc); }
            __syncthreads();
            bf16x8 af[2];
#pragma unroll
            for (int mi = 0; mi < 2; ++mi) af[mi] = *(const LAS bf16x8*)&sA[(wave * 32 + mi * 16 + (lane & 15)) * 40 + (lane >> 4) * 8];
#pragma unroll
            for (int n = 0; n < 16; ++n) { const bf16x8 bfr = *(const LAS bf16x8*)&sB[(n * 16 + (lane & 15)) * 40 + (lane >> 4) * 8];
#pragma unroll
                for (int mi = 0; mi < 2; ++mi) acc[mi][n] = __builtin_amdgcn_mfma_f32_16x16x32_bf16(af[mi], bfr, acc[mi][n], 0, 0, 0); }
            __syncthreads();
        }
        epi.apply(acc, row0 + wave * 32, col0, lane);
    }
}


namespace pg8 {
#define PG8_LAS __attribute__((address_space(3)))
typedef unsigned u32x4 __attribute__((ext_vector_type(4)));
typedef unsigned u32x2 __attribute__((ext_vector_type(2)));
constexpr int BM = 256, BK = 64, HALF = 128, HTB = HALF * BK * 2  , STAGE_BYTES = 8 * HTB, NXCD = 8, WGM = 8;
__host__ __device__ __forceinline__ int lds_byte(int r, int c) { const int st = (r >> 4) * 2 + (c >> 5), rr = r & 15, cc = c & 31, ob = rr * 64 + cc * 2; return st * 1024 + (ob ^ (((ob >> 9) & 1) << 5)); }
__host__ __device__ __forceinline__ void stage_rc(int b, int& R, int& C) { const int st = b / 1024, sb = b % 1024, swz = sb ^ (((sb >> 9) & 1) << 5); R = (st >> 1) * 16 + swz / 64; C = (st & 1) * 32 + (swz % 64) / 2; }
__host__ __device__ __forceinline__ int perm32(int rho) { const int n = rho >> 4, i = rho & 15; return 8 * (i >> 2) + 4 * n + (i & 3); }
struct Unit { int pm, pn; };
struct Gemm { const bf16_t* A; const bf16_t* Bt; int M, N, K; };
struct StaticOrder {
    int nM, nN, nwg, G, c;
    __device__ __forceinline__ void init(int M, int N, int G_, int c_) { nM = M / BM; nN = N / BM; nwg = nM * nN; G = G_; c = c_; }
    __device__ __forceinline__ bool next(int i, Unit& u) const {
        const long L = (long)i * G + c; if (L >= nwg) return false;
        int wgid = (int)L; { const int q = nwg / NXCD, r = nwg % NXCD, xcd = wgid % NXCD, off = wgid / NXCD; wgid = (xcd < r ? xcd * (q + 1) : r * (q + 1) + (xcd - r) * q) + off; }
        const int nig = WGM * nN, gid = wgid / nig, fm = gid * WGM, gsz = (nM - fm) < WGM ? (nM - fm) : WGM;
        u.pm = fm + ((wgid % nig) % gsz); u.pn = (wgid % nig) / gsz; return true;
    }
};
__device__ __forceinline__ unsigned cvt_pk_bf16(float lo, float hi) { unsigned r; asm volatile("v_cvt_pk_bf16_f32 %0, %1, %2" : "=v"(r) : "v"(lo), "v"(hi)); return r; }

template <class Epi, class Sched, int AMODE>
__device__ __forceinline__ void gemm_phase(PG8_LAS unsigned char* lds, const Gemm g, const Sched& S, const Epi& E, const int* __restrict__ rowmap, const int* __restrict__ tile_exp, const size_t estride) {
    constexpr bool GATHER = AMODE != 0;
    int tid = threadIdx.x; asm volatile("" : "+v"(tid));
    const int wid = __builtin_amdgcn_readfirstlane(tid >> 6), lane = tid & 63, wr = wid >> 2, wc = wid & 3, fr = lane & 15, fq = lane >> 4;
    const int K = g.K, nt = K / BK;
    unsigned voffA[2], voffB[2]; int rA[2];
#pragma unroll
    for (int i = 0; i < 2; ++i) { int R, C; stage_rc(tid * 16 + i * 8192, R, C); const int Rb = (R & ~31) + perm32(R & 31);
        voffA[i] = (unsigned)(R * K + C) * 2u; voffB[i] = (unsigned)(Rb * K + C) * 2u; rA[i] = R; if (GATHER) voffA[i] = (unsigned)C * 2u; }
    const size_t kstep = (size_t)(BK * 2);
    const size_t kstepA = AMODE == 2 ? (size_t)DINP * 2 : kstep;
    const size_t hstep = (size_t)HALF * K * 2;
    const size_t tstep = 2 * hstep;
    const unsigned ldsw = (unsigned)wid * 1024u;
    const int aoff = lds_byte(wr * 64 + fr, fq * 8), boff = lds_byte(wc * 32 + fr, fq * 8);
#define PG8_SA(b, h) (((b) * 2 + (h)) * HTB)
#define PG8_SB(b, h) ((4 + (b) * 2 + (h)) * HTB)
#define PG8_STAGE(bufoff, gbase, voff) do { _Pragma("unroll") for (int _i = 0; _i < 2; ++_i) \
        __builtin_amdgcn_global_load_lds((const unsigned*)((const char*)(gbase) + (voff)[_i]), (PG8_LAS unsigned*)(lds + (bufoff) + ldsw + _i * 8192), 16, 0, 0); } while (0)
#define PG8_LDA(dst, b, h) do { _Pragma("unroll") for (int m = 0; m < 4; ++m) _Pragma("unroll") for (int k = 0; k < 2; ++k) dst[m][k] = *(const PG8_LAS bf16x8*)(lds + PG8_SA(b, h) + aoff + m * 2048 + k * 1024); } while (0)
#define PG8_LDB(dst, b, h) do { _Pragma("unroll") for (int n = 0; n < 2; ++n) _Pragma("unroll") for (int k = 0; k < 2; ++k) dst[n][k] = *(const PG8_LAS bf16x8*)(lds + PG8_SB(b, h) + boff + n * 2048 + k * 1024); } while (0)
#define PG8_MMA(ai, bj, At, Bt) do { __builtin_amdgcn_s_setprio(1); _Pragma("unroll") for (int m = 0; m < 4; ++m) _Pragma("unroll") for (int n = 0; n < 2; ++n) _Pragma("unroll") for (int k = 0; k < 2; ++k) \
        acc[ai][bj][m][n] = __builtin_amdgcn_mfma_f32_16x16x32_bf16(Bt[n][k], At[m][k], acc[ai][bj][m][n], 0, 0, 0); __builtin_amdgcn_s_setprio(0); } while (0)
#define PG8_WAIT_V(n) asm volatile("s_waitcnt vmcnt(" #n ")" ::: "memory")
#define PG8_WAIT_L(n) asm volatile("s_waitcnt lgkmcnt(" #n ")" ::: "memory")
#define PG8_BAR __builtin_amdgcn_s_barrier()
#define PG8_SCHED __builtin_amdgcn_sched_barrier(0)
    unsigned vgc[2][2], vgn[2][2];
#define PG8_GOFF(dst, pm_) do { if constexpr (AMODE == 1) { _Pragma("unroll") for (int _h = 0; _h < 2; ++_h) _Pragma("unroll") for (int _i = 0; _i < 2; ++_i) { int _t = rowmap[(pm_) * BM + _h * HALF + rA[_i]]; _t = _t < 0 ? 0 : _t; \
        dst[_h][_i] = (unsigned)_t * (unsigned)(K * 2) + voffA[_i]; } } \
      else if constexpr (AMODE == 2) { _Pragma("unroll") for (int _h = 0; _h < 2; ++_h) _Pragma("unroll") for (int _i = 0; _i < 2; ++_i) { const int _r = (pm_) * BM + _h * HALF + rA[_i]; int _c = _r & 255; _c = _c > 254 ? 254 : _c; \
        dst[_h][_i] = (unsigned)(((_r >> 9) * SEQ + 16 * _c) * DINP + (int)estride + ((_r >> 8) & 1) * 64) * 2u + voffA[_i]; } } } while (0)
#define PG8_STA(bufoff, gptr, h, arr) do { if constexpr (GATHER) { PG8_STAGE(bufoff, gptr, arr[h]); } else { PG8_STAGE(bufoff, (gptr) + ((h) ? hstep : 0), voffA); } } while (0)
    Unit cur, nxt; int ui = 0;
    if (!S.next(0, cur)) return;
    f32x4 acc[2][2][4][2];
#pragma unroll
    for (int a = 0; a < 2; ++a)
#pragma unroll
        for (int b = 0; b < 2; ++b)
#pragma unroll
            for (int m = 0; m < 4; ++m)
#pragma unroll
                for (int n = 0; n < 2; ++n) acc[a][b][m][n] = (f32x4){0.f, 0.f, 0.f, 0.f};
    bf16x8 At[4][2], B0[2][2], B1[2][2];
    const char* cA = (const char*)g.A + (GATHER ? (size_t)0 : (size_t)cur.pm * tstep);
    const char* cB = (const char*)g.Bt + (tile_exp ? (size_t)tile_exp[cur.pm] * estride * 2 : (size_t)0) + (size_t)cur.pn * tstep;
    PG8_GOFF(vgc, cur.pm);
    PG8_STAGE(PG8_SB(0, 0), cB, voffB); PG8_STAGE(PG8_SB(0, 1), cB + hstep, voffB); PG8_STA(PG8_SA(0, 0), cA, 0, vgc); PG8_STA(PG8_SA(0, 1), cA, 1, vgc);
    if (wr == 1) PG8_BAR;
    PG8_WAIT_V(2); PG8_BAR;
    PG8_STAGE(PG8_SB(1, 0), cB + kstep, voffB); PG8_STA(PG8_SA(1, 0), cA + kstepA, 0, vgc); PG8_STAGE(PG8_SB(1, 1), cB + hstep + kstep, voffB);
    PG8_WAIT_V(6); PG8_BAR;
    for (;;) {
        const bool has_next = S.next(ui + 1, nxt);
        const char* nA = has_next ? (const char*)g.A + (GATHER ? (size_t)0 : (size_t)nxt.pm * tstep) : cA;
        const char* nB = has_next ? (const char*)g.Bt + (tile_exp ? (size_t)tile_exp[nxt.pm] * estride * 2 : (size_t)0) + (size_t)nxt.pn * tstep : cB;
        if constexpr (GATHER) { if (has_next) { PG8_GOFF(vgn, nxt.pm); } else {
#pragma unroll
            for (int _h = 0; _h < 2; ++_h)
#pragma unroll
                for (int _i = 0; _i < 2; ++_i) vgn[_h][_i] = vgc[_h][_i]; } }
        for (int t = 0; t < nt; t += 2) {
            const bool last = (t == nt - 2);
            const char* a1 = cA + (size_t)(t + 1) * kstepA;
            const char* a2 = last ? nA : cA + (size_t)(t + 2) * kstepA; const char* b2 = last ? nB : cB + (size_t)(t + 2) * kstep;
            const char* a3 = a2 + kstepA; const char* b3 = b2 + kstep;
            unsigned v2[2][2];
            if constexpr (GATHER) {
#pragma unroll
            for (int _h = 0; _h < 2; ++_h)
#pragma unroll
                for (int _i = 0; _i < 2; ++_i) v2[_h][_i] = last ? vgn[_h][_i] : vgc[_h][_i]; }
            PG8_LDB(B0, 0, 0); PG8_LDB(B1, 0, 1); PG8_SCHED; PG8_LDA(At, 0, 0); PG8_STA(PG8_SA(1, 1), a1, 1, vgc);
            PG8_WAIT_V(8); PG8_WAIT_L(0); PG8_BAR; PG8_MMA(0, 0, At, B0); PG8_MMA(0, 1, At, B1); PG8_BAR; PG8_SCHED;
            PG8_LDA(At, 0, 1); PG8_STAGE(PG8_SB(0, 0), b2, voffB); PG8_STAGE(PG8_SB(0, 1), b2 + hstep, voffB); PG8_STA(PG8_SA(0, 0), a2, 0, v2);
            PG8_WAIT_V(8); PG8_WAIT_L(0); PG8_BAR; PG8_MMA(1, 0, At, B0); PG8_MMA(1, 1, At, B1); PG8_BAR; PG8_SCHED;
            PG8_LDB(B0, 1, 0); PG8_LDB(B1, 1, 1); PG8_SCHED; PG8_LDA(At, 1, 0); PG8_STA(PG8_SA(0, 1), a2, 1, v2);
            PG8_WAIT_V(8); PG8_WAIT_L(0); PG8_BAR; PG8_MMA(0, 0, At, B0); PG8_MMA(0, 1, At, B1); PG8_BAR; PG8_SCHED;
            PG8_LDA(At, 1, 1); PG8_STAGE(PG8_SB(1, 0), b3, voffB); PG8_STAGE(PG8_SB(1, 1), b3 + hstep, voffB); PG8_STA(PG8_SA(1, 0), a3, 0, v2);
            PG8_WAIT_V(8); PG8_WAIT_L(0); PG8_BAR; PG8_MMA(1, 0, At, B0); PG8_MMA(1, 1, At, B1); PG8_BAR; PG8_SCHED;
        }
        if (wr == 0) PG8_BAR;
        E(acc, cur, wr, wc, fr, fq);
        if (!has_next) break;
#pragma unroll
        for (int a = 0; a < 2; ++a)
#pragma unroll
            for (int b = 0; b < 2; ++b)
#pragma unroll
                for (int m = 0; m < 4; ++m)
#pragma unroll
                    for (int n = 0; n < 2; ++n) acc[a][b][m][n] = (f32x4){0.f, 0.f, 0.f, 0.f};
        cur = nxt; cA = nA; cB = nB; ++ui;
        if constexpr (GATHER) {
#pragma unroll
        for (int _h = 0; _h < 2; ++_h)
#pragma unroll
            for (int _i = 0; _i < 2; ++_i) vgc[_h][_i] = vgn[_h][_i]; }
        if (wr == 1) PG8_BAR;
    }
    PG8_WAIT_V(0);
    PG8_BAR;
#undef PG8_SA
#undef PG8_SB
#undef PG8_STAGE
#undef PG8_LDA
#undef PG8_LDB
#undef PG8_MMA
#undef PG8_WAIT_V
#undef PG8_WAIT_L
#undef PG8_BAR
#undef PG8_SCHED
#undef PG8_GOFF
#undef PG8_STA
}

typedef const f32x4 (&AccT)[2][2][4][2];
struct EIn { bf16_t* proj; const float* ssq;
    __device__ __forceinline__ void operator()(AccT acc, const Unit& u, int wr, int wc, int fr, int fq) const {
        const int col0 = u.pn * BM + wc * 32 + 8 * fq;
#pragma unroll
        for (int ai = 0; ai < 2; ++ai)
#pragma unroll
            for (int m = 0; m < 4; ++m) { const int row = u.pm * BM + ai * HALF + wr * 64 + m * 16 + fr; const float rs = row_rstd(ssq, row); bf16_t* rowp = proj + (size_t)row * DINP + col0;
#pragma unroll
                for (int bj = 0; bj < 2; ++bj) { const f32x4 v0 = acc[ai][bj][m][0] * rs, v1 = acc[ai][bj][m][1] * rs; u32x4 w; w.x = cvt_pk_bf16(v0[0], v0[1]); w.y = cvt_pk_bf16(v0[2], v0[3]); w.z = cvt_pk_bf16(v1[0], v1[1]); w.w = cvt_pk_bf16(v1[2], v1[3]);
                    *(u32x4*)(rowp + bj * HALF) = w; } } } };
struct ERes { const float* xin; bf16_t* xb; float* ssq;
    __device__ __forceinline__ void operator()(AccT acc, const Unit& u, int wr, int wc, int fr, int fq) const {
        const int col0 = u.pn * BM + wc * 32 + 8 * fq;
#pragma unroll
        for (int ai = 0; ai < 2; ++ai)
#pragma unroll
            for (int m = 0; m < 4; ++m) { const int row = u.pm * BM + ai * HALF + wr * 64 + m * 16 + fr; const size_t o = (size_t)row * DM + col0; float s = 0.f;
#pragma unroll
                for (int bj = 0; bj < 2; ++bj) { f32x4 x0, x1;
                    if (xin) { x0 = *(const f32x4*)(xin + o + bj * HALF); x1 = *(const f32x4*)(xin + o + bj * HALF + 4); }
                    else { const u32x4 w = *(const u32x4*)(xb + o + bj * HALF); x0 = (f32x4){__uint_as_float(w.x << 16), __uint_as_float(w.x & 0xffff0000u), __uint_as_float(w.y << 16), __uint_as_float(w.y & 0xffff0000u)};
                           x1 = (f32x4){__uint_as_float(w.z << 16), __uint_as_float(w.z & 0xffff0000u), __uint_as_float(w.w << 16), __uint_as_float(w.w & 0xffff0000u)}; }
                    const f32x4 v0 = x0 + acc[ai][bj][m][0], v1 = x1 + acc[ai][bj][m][1];
                    u32x4 w; w.x = cvt_pk_bf16(v0[0], v0[1]); w.y = cvt_pk_bf16(v0[2], v0[3]); w.z = cvt_pk_bf16(v1[0], v1[1]); w.w = cvt_pk_bf16(v1[2], v1[3]);
                    *(u32x4*)(xb + o + bj * HALF) = w;
                    s += (v0[0] * v0[0] + v0[1] * v0[1]) + (v0[2] * v0[2] + v0[3] * v0[3]) + (v1[0] * v1[0] + v1[1] * v1[1]) + (v1[2] * v1[2] + v1[3] * v1[3]); }
                s += __shfl_xor(s, 16); s += __shfl_xor(s, 32);
                if (fq == 0) ssq[(size_t)row * NSLOT + u.pn * 4 + wc] = s; } } };
struct ESwiglu { bf16_t* h; const float* ssq; const int* row_tok;
    __device__ __forceinline__ void operator()(AccT acc, const Unit& u, int wr, int wc, int fr, int fq) const {
        const int col0 = u.pn * HALF + wc * 32 + 8 * fq;
#pragma unroll
        for (int ai = 0; ai < 2; ++ai)
#pragma unroll
            for (int m = 0; m < 4; ++m) { const int row = u.pm * BM + ai * HALF + wr * 64 + m * 16 + fr; const int t = row_tok ? row_tok[row] : row; const float rs = t < 0 ? 0.f : row_rstd(ssq, t < 0 ? 0 : t);
                float o[8];
#pragma unroll
                for (int n = 0; n < 2; ++n)
#pragma unroll
                    for (int e = 0; e < 4; ++e) { const float av = acc[ai][0][m][n][e] * rs, bv = acc[ai][1][m][n][e] * rs; o[n * 4 + e] = siluf(av) * bv; }
                u32x4 w; w.x = cvt_pk_bf16(o[0], o[1]); w.y = cvt_pk_bf16(o[2], o[3]); w.z = cvt_pk_bf16(o[4], o[5]); w.w = cvt_pk_bf16(o[6], o[7]);
                *(u32x4*)(h + (size_t)row * DFF + col0) = w; } } };
struct ESiluBias { bf16_t* out; const float* bias;
    __device__ __forceinline__ void operator()(AccT acc, const Unit& u, int wr, int wc, int fr, int fq) const {
        const int col0 = u.pn * BM + wc * 32 + 8 * fq;
#pragma unroll
        for (int ai = 0; ai < 2; ++ai)
#pragma unroll
            for (int m = 0; m < 4; ++m) { const int row = u.pm * BM + ai * HALF + wr * 64 + m * 16 + fr; bf16_t* rowp = out + (size_t)row * 256 + col0;
#pragma unroll
                for (int bj = 0; bj < 2; ++bj) { const f32x4 b0 = *(const f32x4*)(bias + col0 + bj * HALF), b1 = *(const f32x4*)(bias + col0 + bj * HALF + 4); const f32x4 v0 = acc[ai][bj][m][0] + b0, v1 = acc[ai][bj][m][1] + b1;
                    u32x4 w; w.x = cvt_pk_bf16(siluf(v0[0]), siluf(v0[1])); w.y = cvt_pk_bf16(siluf(v0[2]), siluf(v0[3])); w.z = cvt_pk_bf16(siluf(v1[0]), siluf(v1[1])); w.w = cvt_pk_bf16(siluf(v1[2]), siluf(v1[3]));
                    *(u32x4*)(rowp + bj * HALF) = w; } } } };
struct EKc { bf16_t* out; int transposed, pad;
    __device__ __forceinline__ void operator()(AccT acc, const Unit& u, int wr, int wc, int fr, int fq) const {
        if (wc >= 2) return;
        const int col0 = wc * 32 + 8 * fq;
#pragma unroll
        for (int ai = 0; ai < 2; ++ai)
#pragma unroll
            for (int m = 0; m < 4; ++m) { const int row = u.pm * BM + ai * HALF + wr * 64 + m * 16 + fr; const f32x4 v0 = acc[ai][0][m][0], v1 = acc[ai][0][m][1];
                if (!transposed) { u32x4 w; w.x = cvt_pk_bf16(v0[0], v0[1]); w.y = cvt_pk_bf16(v0[2], v0[3]); w.z = cvt_pk_bf16(v1[0], v1[1]); w.w = cvt_pk_bf16(v1[2], v1[3]); *(u32x4*)(out + (size_t)row * 64 + col0) = w; }
                else { bf16_t* o = out + (size_t)(row >> 8) * 16384 + (size_t)col0 * 256 + (row & 255);
#pragma unroll
                    for (int x = 0; x < 4; ++x) { o[x * 256] = f2bf(v0[x]); o[(4 + x) * 256] = f2bf(v1[x]); } } } } };
struct EStore { bf16_t* out; int ldc;
    __device__ __forceinline__ void operator()(AccT acc, const Unit& u, int wr, int wc, int fr, int fq) const {
        const int col0 = u.pn * BM + wc * 32 + 8 * fq;
#pragma unroll
        for (int ai = 0; ai < 2; ++ai)
#pragma unroll
            for (int m = 0; m < 4; ++m) { const int row = u.pm * BM + ai * HALF + wr * 64 + m * 16 + fr; bf16_t* rowp = out + (size_t)row * ldc + col0;
#pragma unroll
                for (int bj = 0; bj < 2; ++bj) { const f32x4 v0 = acc[ai][bj][m][0], v1 = acc[ai][bj][m][1]; u32x4 w; w.x = cvt_pk_bf16(v0[0], v0[1]); w.y = cvt_pk_bf16(v0[2], v0[3]); w.z = cvt_pk_bf16(v1[0], v1[1]); w.w = cvt_pk_bf16(v1[2], v1[3]);
                    *(u32x4*)(rowp + bj * HALF) = w; } } } };
}

#ifndef NSA_REP_SEL
#define NSA_REP_SEL 1
#endif
#ifndef NSA_REP_WIN
#define NSA_REP_WIN 1
#endif
namespace nsa {
typedef float f32x16 __attribute__((ext_vector_type(16)));
typedef unsigned u32x4 __attribute__((ext_vector_type(4)));
typedef unsigned u32x2 __attribute__((ext_vector_type(2)));
constexpr int KSTR = 144, VSTR = 144;
constexpr int KT_B = 64 * KSTR, VT_B = 64 * VSTR, BUF_B = KT_B + VT_B;
constexpr int IMP_OFF = 2 * BUF_B  , SELM_OFF = IMP_OFF + 8 * 2048  , WUN_OFF = SELM_OFF + 512;
constexpr float L2E = 1.4426950408889634f;
#define NLAS __attribute__((address_space(3)))
__device__ __forceinline__ unsigned pk2(float lo, float hi) { unsigned r; asm volatile("v_cvt_pk_bf16_f32 %0, %1, %2" : "=v"(r) : "v"(lo), "v"(hi)); return r; }
struct Stage { u32x4 k, v; };
__device__ __forceinline__ void stage_issue(Stage& st, const bf16_t* kg, size_t kstride, const bf16_t* vg, size_t vstride, int tid) {
    const int r = tid >> 3, c = (tid & 7) * 8;
    st.k = *(const u32x4*)(kg + (size_t)r * kstride + c); st.v = *(const u32x4*)(vg + (size_t)r * vstride + c);
}
__device__ __forceinline__ void stage_write(const Stage& st, NLAS char* buf, int tid) {
    const int r = tid >> 3, c = (tid & 7) * 16;
    *(NLAS u32x4*)(buf + r * KSTR + c) = st.k;
    { const int cc = tid & 7, vo = KT_B + r * VSTR + (cc >> 1) * 32 + (cc & 1) * 8;
      *(NLAS u32x2*)(buf + vo) = (u32x2){st.v.x, st.v.y}; *(NLAS u32x2*)(buf + vo + 16) = (u32x2){st.v.z, st.v.w}; }
}
__device__ __forceinline__ void compute_S(NLAS const char* buf, const bf16x8 (&Qf)[4], f32x16& S0, f32x16& S1, int lane) {
    const int kr = lane & 31, hi = lane >> 5;
#pragma unroll
    for (int i = 0; i < 16; ++i) { S0[i] = 0.f; S1[i] = 0.f; }
    bf16x8 af[8];
#pragma unroll
    for (int s = 0; s < 4; ++s) { af[2 * s] = *(NLAS const bf16x8*)(buf + kr * KSTR + s * 32 + hi * 16); af[2 * s + 1] = *(NLAS const bf16x8*)(buf + (32 + kr) * KSTR + s * 32 + hi * 16); }
    __builtin_amdgcn_sched_barrier(0);
#pragma unroll
    for (int s = 0; s < 4; ++s) { S0 = __builtin_amdgcn_mfma_f32_32x32x16_bf16(af[2 * s], Qf[s], S0, 0, 0, 0); S1 = __builtin_amdgcn_mfma_f32_32x32x16_bf16(af[2 * s + 1], Qf[s], S1, 0, 0, 0); }
}
__device__ __forceinline__ void mask_S(f32x16& S0, f32x16& S1, int lo, int hi, int lane) {
    const int h4 = (lane >> 5) * 4, lo2 = lo - h4, hi2 = hi - h4;
#pragma unroll
    for (int i = 0; i < 16; ++i) { const int c0 = (i & 3) + 8 * (i >> 2); S0[i] = (c0 >= lo2 && c0 <= hi2) ? S0[i] : -INFINITY; S1[i] = (c0 + 32 >= lo2 && c0 + 32 <= hi2) ? S1[i] : -INFINITY; }
}
__device__ __forceinline__ float max3f(float a, float b, float c) { float r; asm("v_max3_f32 %0, %1, %2, %3" : "=v"(r) : "v"(a), "v"(b), "v"(c)); return r; }
__device__ __forceinline__ float max_S(const f32x16& S0, const f32x16& S1) { float m = max3f(S0[0], S1[0], S0[1]);
    m = max3f(m, S1[1], S0[2]); m = max3f(m, S1[2], S0[3]); m = max3f(m, S1[3], S0[4]); m = max3f(m, S1[4], S0[5]); m = max3f(m, S1[5], S0[6]); m = max3f(m, S1[6], S0[7]); m = max3f(m, S1[7], S0[8]);
    m = max3f(m, S1[8], S0[9]); m = max3f(m, S1[9], S0[10]); m = max3f(m, S1[10], S0[11]); m = max3f(m, S1[11], S0[12]); m = max3f(m, S1[12], S0[13]); m = max3f(m, S1[13], S0[14]); m = max3f(m, S1[14], S0[15]);
    float o = __shfl_xor(m, 32); return max3f(m, S1[15], o); }
__device__ __forceinline__ float exp_S(f32x16& S0, f32x16& S1, float mL) { float l0 = 0.f, l1 = 0.f;
#pragma unroll
    for (int i = 0; i < 16; ++i) { S0[i] = __builtin_amdgcn_exp2f(fmaf(S0[i], L2E, -mL)); S1[i] = __builtin_amdgcn_exp2f(fmaf(S1[i], L2E, -mL)); l0 += S0[i]; l1 += S1[i]; }
    return l0 + l1; }
__device__ __forceinline__ void pack_P(const f32x16& S0, const f32x16& S1, unsigned andm, bf16x8 (&Pf)[4]) {
#pragma unroll
    for (int s2 = 0; s2 < 4; ++s2) { u32x4 w;
#pragma unroll
        for (int q = 0; q < 4; ++q) { const int i = (s2 & 1) * 8 + q * 2; w[q] = (s2 < 2 ? pk2(S0[i], S0[i + 1]) : pk2(S1[i], S1[i + 1])) & andm; }
        Pf[s2] = __builtin_bit_cast(bf16x8, w); }
}
__device__ __forceinline__ void pv(NLAS const char* buf, const bf16x8 (&Pf)[4], f32x16& O0, f32x16& O1, int lane) {
    const int dr = lane & 31, hi = lane >> 5; NLAS const char* vt = buf + KT_B;
    bf16x8 vf[8];
#pragma unroll
    for (int s2 = 0; s2 < 4; ++s2) { vf[2 * s2] = *(NLAS const bf16x8*)(vt + dr * VSTR + (16 * s2 + 8 * hi) * 2); vf[2 * s2 + 1] = *(NLAS const bf16x8*)(vt + (32 + dr) * VSTR + (16 * s2 + 8 * hi) * 2); }
    __builtin_amdgcn_sched_barrier(0);
#pragma unroll
    for (int s2 = 0; s2 < 4; ++s2) { O0 = __builtin_amdgcn_mfma_f32_32x32x16_bf16(vf[2 * s2], Pf[s2], O0, 0, 0, 0); O1 = __builtin_amdgcn_mfma_f32_32x32x16_bf16(vf[2 * s2 + 1], Pf[s2], O1, 0, 0, 0); }
}
__device__ __forceinline__ void online_block(NLAS const char* buf, const bf16x8 (&Qf)[4], f32x16& O0, f32x16& O1, float& m, float& l, bool lane_on, bool use_mask, int lo, int hi, int lane) {
    f32x16 S0, S1; compute_S(buf, Qf, S0, S1, lane);
    if (use_mask) mask_S(S0, S1, lo, hi, lane);
    float mt = max_S(S0, S1); if (!lane_on) mt = -INFINITY;
    const float mn = max3f(m, mt, mt), ms = mn == -INFINITY ? 0.f : mn;
    const float ls = exp_S(S0, S1, ms * L2E);
    if (__any(mn != m)) { const float al = __builtin_amdgcn_exp2f((m - ms) * L2E); l *= al;
#pragma unroll
        for (int i = 0; i < 16; ++i) { O0[i] *= al; O1[i] *= al; } }
    l += (lane_on ? ls : 0.f); m = mn;
    bf16x8 Pf[4]; pack_P(S0, S1, lane_on ? 0xffffffffu : 0u, Pf);
    pv(buf, Pf, O0, O1, lane);
}

struct BitIter { unsigned long long rem; __device__ __forceinline__ int next() { if (!rem) return -1; const int j = __builtin_ctzll(rem); rem &= rem - 1; return j; } };
struct RangeIter { int cur, end; __device__ __forceinline__ int next() { return cur <= end ? cur++ : -1; } };
struct SelPar { unsigned long long mq; int qb, tq;
    __device__ __forceinline__ void get(int j, bool& on, bool& um, int& lo, int& hi) const { on = (mq >> j) & 1ull; um = (j == qb); lo = 0; hi = tq; } };
struct WinPar { int qb, tq;
    __device__ __forceinline__ void get(int j, bool& on, bool& um, int& lo, int& hi) const { const bool first = (j == qb - 8), diag = (j == qb); on = true; um = first || diag; lo = first ? tq + 1 : 0; hi = diag ? tq : 63; } };
template <class It, class Par>
__device__ __forceinline__ void run_blocks(It it, const Par par, const bf16_t* kg, const bf16_t* vg, NLAS char* lds, const bf16x8 (&Qf)[4], f32x16& O0, f32x16& O1, float& m, float& l, int tid, int lane) {
    int j0 = it.next(), j1 = it.next();
    Stage sa, sb;
    stage_issue(sa, kg + (size_t)j0 * 64 * DINP, DINP, vg + j0 * 64, SEQ, tid);
    if (j1 >= 0) stage_issue(sb, kg + (size_t)j1 * 64 * DINP, DINP, vg + j1 * 64, SEQ, tid);
    stage_write(sa, lds, tid); __syncthreads();
    for (;;) {
        const int j2 = it.next();
        if (j2 >= 0) stage_issue(sa, kg + (size_t)j2 * 64 * DINP, DINP, vg + j2 * 64, SEQ, tid);
        { bool on, um; int lo, hi; par.get(j0, on, um, lo, hi); if (__any(on)) online_block(lds, Qf, O0, O1, m, l, on, um, lo, hi, lane); }
        if (j1 >= 0) stage_write(sb, lds + BUF_B, tid);
        __syncthreads();
        if (j1 < 0) break;
        const int j3 = it.next();
        if (j3 >= 0) stage_issue(sb, kg + (size_t)j3 * 64 * DINP, DINP, vg + j3 * 64, SEQ, tid);
        { bool on, um; int lo, hi; par.get(j1, on, um, lo, hi); if (__any(on)) online_block(lds + BUF_B, Qf, O0, O1, m, l, on, um, lo, hi, lane); }
        if (j2 >= 0) stage_write(sa, lds, tid);
        __syncthreads();
        if (j2 < 0) break;
        j0 = j2; j1 = j3;
    }
}
}

__device__ __forceinline__ void ph_nsa(const Args& a, LAS char* lds_, int vcu, int G) {
    using namespace nsa;
    int tid = threadIdx.x; asm volatile("" : "+v"(tid)); asm volatile("" : "+s"(vcu));
    NLAS char* lds = lds_;
    const int w = __builtin_amdgcn_readfirstlane(tid >> 6), lane = tid & 63, hi = lane >> 5, r = lane & 31, tql = r >> 2, hpg = r & 3;
    NLAS float* impw = (NLAS float*)(lds + IMP_OFF + w * 2048);
    NLAS unsigned long long* selm = (NLAS unsigned long long*)(lds + SELM_OFF);
    NLAS unsigned long long* wun = (NLAS unsigned long long*)(lds + WUN_OFF);
    const bf16_t* proj = a.proj;
    for (int it = 0; it * G + vcu < 1024; ++it) {
        asm volatile("" : "+v"(tid));
        const int idx = it * G + vcu, rnd = idx >> 8, k16 = (idx & 255) >> 4, bg = idx & 15;
        const int qb = (rnd == 0) ? 63 - k16 : (rnd == 1) ? 32 + k16 : (rnd == 2) ? 31 - k16 : k16;
        const int b = bg >> 1, g = bg & 1;
        const int tq = 8 * w + tql, t = 64 * qb + tq; const size_t row = (size_t)b * SEQ + t; const bf16_t* prow = proj + row * DINP;
        bf16x8 Qf[4];
#pragma unroll
        for (int s = 0; s < 4; ++s) Qf[s] = *(const bf16x8*)(prow + C_Q + g * 256 + hpg * 64 + 16 * s + 8 * hi);
        f32x16 Oo0, Oo1;
        const int hh = g * 4 + hpg; const float g0 = sigmf(bf2f(prow[C_GL + hh * 3 + 0])), g1 = sigmf(bf2f(prow[C_GL + hh * 3 + 1])), g2 = sigmf(bf2f(prow[C_GL + hh * 3 + 2]));
        Stage st;
        const bf16_t* kcg = a.kcb + (size_t)bg * 256 * 64; const bf16_t* vcg = a.vcT + (size_t)bg * 64 * 256;
        const int nbc = (4 * qb + 3 + 63) >> 6;
        const int cmax = t >= 31 ? (t - 31) >> 4 : -1;
        float mc = -INFINITY, lc = 0.f;
        __syncthreads();
        stage_issue(st, kcg, 64, vcg, 256, tid); stage_write(st, lds, tid); __syncthreads();
        for (int kb = 0; kb < nbc; ++kb) {
            NLAS char* buf = lds + (kb & 1) * BUF_B;
            if (kb + 1 < nbc) stage_issue(st, kcg + (size_t)(kb + 1) * 64 * 64, 64, vcg + (kb + 1) * 64, 256, tid);
            f32x16 S0, S1; compute_S(buf, Qf, S0, S1, lane); mask_S(S0, S1, 0, cmax - 64 * kb, lane);
            const float mt = max_S(S0, S1), mn = max3f(mc, mt, mt), ms = mn == -INFINITY ? 0.f : mn, al = __builtin_amdgcn_exp2f((mc - ms) * L2E);
            lc = lc * al + exp_S(S0, S1, ms * L2E); mc = mn;
            if (kb + 1 < nbc) stage_write(st, lds + ((kb + 1) & 1) * BUF_B, tid);
            __syncthreads();
        }
        lc += __shfl_xor(lc, 32);
        const float mLc = (mc == -INFINITY ? 0.f : mc) * L2E, ilc = lc > 0.f ? 1.f / lc : 0.f;
        f32x16 Oc0, Oc1, Z0, Z1;
#pragma unroll
        for (int i = 0; i < 16; ++i) { Oc0[i] = 0.f; Oc1[i] = 0.f; Z0[i] = 0.f; Z1[i] = 0.f; }
        stage_issue(st, kcg, 64, vcg, 256, tid); stage_write(st, lds, tid); __syncthreads();
        for (int kb = 0; kb < nbc; ++kb) {
            NLAS char* buf = lds + (kb & 1) * BUF_B;
            if (kb + 1 < nbc) stage_issue(st, kcg + (size_t)(kb + 1) * 64 * 64, 64, vcg + (kb + 1) * 64, 256, tid);
            f32x16 S0, S1; compute_S(buf, Qf, S0, S1, lane); mask_S(S0, S1, 0, cmax - 64 * kb, lane);
            (void)exp_S(S0, S1, mLc);
#pragma unroll
            for (int i = 0; i < 16; ++i) { S0[i] *= ilc; S1[i] *= ilc; }
            bf16x8 Pf[4]; pack_P(S0, S1, 0xffffffffu, Pf);
            pv(buf, Pf, Oc0, Oc1, lane);
#pragma unroll
            for (int s2 = 0; s2 < 4; ++s2) {
#pragma unroll
                for (int stl = 0; stl < 2; ++stl) { const int sblk = 32 * stl + r; u32x4 wv;
#pragma unroll
                    for (int q = 0; q < 4; ++q) { unsigned x = 0u;
#pragma unroll
                        for (int e = 0; e < 2; ++e) { const int j = q * 2 + e, c = 64 * kb + 16 * s2 + 8 * (j >> 2) + 4 * hi + (j & 3); if (c >= 4 * sblk - 1 && c <= 4 * sblk + 3) x |= (0x3f80u << (16 * e)); }
                        wv[q] = x; }
                    if (stl == 0) Z0 = __builtin_amdgcn_mfma_f32_32x32x16_bf16(Pf[s2], __builtin_bit_cast(bf16x8, wv), Z0, 0, 0, 0);
                    else          Z1 = __builtin_amdgcn_mfma_f32_32x32x16_bf16(Pf[s2], __builtin_bit_cast(bf16x8, wv), Z1, 0, 0, 0); } }
            if (kb + 1 < nbc) stage_write(st, lds + ((kb + 1) & 1) * BUF_B, tid);
            __syncthreads();
        }
#pragma unroll
        for (int i = 0; i < 16; ++i) { Oo0[i] = g0 * Oc0[i]; Oo1[i] = g0 * Oc1[i]; }
#pragma unroll
        for (int q4 = 0; q4 < 4; ++q4) { impw[(2 * q4 + hi) * 64 + r] = (Z0[4 * q4] + Z0[4 * q4 + 1]) + (Z0[4 * q4 + 2] + Z0[4 * q4 + 3]); impw[(2 * q4 + hi) * 64 + 32 + r] = (Z1[4 * q4] + Z1[4 * q4 + 1]) + (Z1[4 * q4 + 2] + Z1[4 * q4 + 3]); }
        __syncthreads();
        unsigned long long wu = 0ull;
        for (int q = 0; q < 8; ++q) { const float imp = impw[q * 64 + lane];
            const bool valid = lane <= qb, forced = lane == 0 || lane == qb || lane == qb - 1; const float val = valid ? (forced ? 1e9f : imp) : -1e30f; int rank = 0;
#pragma unroll
            for (int s2 = 0; s2 < 64; ++s2) { const float v2 = __builtin_bit_cast(float, __builtin_amdgcn_readlane(__builtin_bit_cast(int, val), s2)); rank += (v2 > val || (v2 == val && s2 < lane)) ? 1 : 0; }
            const unsigned long long mk = __ballot(valid && rank < 16); wu |= mk;
            if (lane == 0) selm[8 * w + q] = mk; }
        if (lane == 0) wun[w] = wu;
        __syncthreads();
        unsigned long long um = 0ull;
#pragma unroll
        for (int q = 0; q < 8; ++q) um |= wun[q];
        um = ((unsigned long long)__builtin_amdgcn_readfirstlane((unsigned)(um >> 32)) << 32) | (unsigned)__builtin_amdgcn_readfirstlane((unsigned)um);
        const unsigned long long mq = selm[tq];
        {
            const bf16_t* kg = proj + (size_t)b * SEQ * DINP + C_KS + g * 64; const bf16_t* vg = a.VsT + (size_t)bg * 64 * SEQ;
            f32x16 O0, O1;
#pragma unroll
            for (int i = 0; i < 16; ++i) { O0[i] = 0.f; O1[i] = 0.f; }
            float m = -INFINITY, l = 0.f;
            for (int rep = 0; rep < NSA_REP_SEL; ++rep) {
#pragma unroll
            for (int i = 0; i < 16; ++i) { O0[i] = 0.f; O1[i] = 0.f; }
            m = -INFINITY; l = 0.f;
            run_blocks(BitIter{um}, SelPar{mq, qb, tq}, kg, vg, lds, Qf, O0, O1, m, l, tid, lane); }
            l += __shfl_xor(l, 32); const float sc = l > 0.f ? g1 / l : 0.f;
#pragma unroll
            for (int i = 0; i < 16; ++i) { Oo0[i] += sc * O0[i]; Oo1[i] += sc * O1[i]; }
        }
        {
            const bf16_t* kg = proj + (size_t)b * SEQ * DINP + C_KW + g * 64; const bf16_t* vg = a.VwT + (size_t)bg * 64 * SEQ;
            f32x16 O0, O1;
#pragma unroll
            for (int i = 0; i < 16; ++i) { O0[i] = 0.f; O1[i] = 0.f; }
            float m = -INFINITY, l = 0.f;
            for (int rep = 0; rep < NSA_REP_WIN; ++rep) {
#pragma unroll
            for (int i = 0; i < 16; ++i) { O0[i] = 0.f; O1[i] = 0.f; }
            m = -INFINITY; l = 0.f;
            run_blocks(RangeIter{qb - 8 > 0 ? qb - 8 : 0, qb}, WinPar{qb, tq}, kg, vg, lds, Qf, O0, O1, m, l, tid, lane); }
            l += __shfl_xor(l, 32); const float sc = l > 0.f ? g2 / l : 0.f;
#pragma unroll
            for (int i = 0; i < 16; ++i) { Oo0[i] += sc * O0[i]; Oo1[i] += sc * O1[i]; }
        }
        bf16_t* op = a.ocat + row * DM + hh * 64 + 4 * hi;
#pragma unroll
        for (int q4 = 0; q4 < 4; ++q4) { u32x2 w0, w1; w0.x = pk2(Oo0[4 * q4], Oo0[4 * q4 + 1]); w0.y = pk2(Oo0[4 * q4 + 2], Oo0[4 * q4 + 3]); w1.x = pk2(Oo1[4 * q4], Oo1[4 * q4 + 1]); w1.y = pk2(Oo1[4 * q4 + 2], Oo1[4 * q4 + 3]);
            *(u32x2*)(op + 8 * q4) = w0; *(u32x2*)(op + 32 + 8 * q4) = w1; }
    }
}

__device__ __forceinline__ void ph_vtrans(const Args& a, LAS char* lds_, int vcu, int G) {
    int tid = threadIdx.x; asm volatile("" : "+v"(tid)); asm volatile("" : "+s"(vcu));
    LAS bf16_t* tile = (LAS bf16_t*)lds_;
    for (int u = vcu; u < 2 * 16 * 64; u += G) { const int tb = u & 63, bg = (u >> 6) & 15, which = u >> 10, b = bg >> 1, g = bg & 1;
        const bf16_t* src = a.proj + ((size_t)b * SEQ + tb * 64) * DINP + (which ? C_VW : C_VS) + g * 64; bf16_t* dst = (which ? a.VwT : a.VsT) + (size_t)bg * 64 * SEQ + tb * 64;
        const int r = tid >> 3, c = (tid & 7) * 8;
        const uint4 v = *(const uint4*)(src + (size_t)r * DINP + c); const unsigned wv[4] = {v.x, v.y, v.z, v.w};
        __syncthreads();
#pragma unroll
        for (int e = 0; e < 4; ++e) { tile[(c + 2 * e) * 72 + r] = (bf16_t)(wv[e] & 0xffffu); tile[(c + 2 * e + 1) * 72 + r] = (bf16_t)(wv[e] >> 16); }
        __syncthreads();
        *(u32x4_t*)(dst + (size_t)r * SEQ + c) = *(const LAS u32x4_t*)(tile + r * 72 + c);
    }
}

__device__ __forceinline__ void ph_conv_naive(const Args& a, int l, LAS char* lds, int vcu, int G) {
    int tid_ = threadIdx.x; asm volatile("" : "+v"(tid_)); asm volatile("" : "+s"(vcu));
    const int half = tid_ >> 8, c = tid_ & 255; LAS float* hs = (LAS float*)(lds + half * 63488);
    const float* cw = a.conv_w + (size_t)l * 31 * 256; const float* lg = a.conv_lg + l * 256; const float* lb = a.conv_lb + l * 256;
    float w[31];
#pragma unroll
    for (int k = 0; k < 31; ++k) w[k] = cw[k * 256 + c];
    const float bias = a.conv_b[l * 256 + c];
    for (int unit = vcu; unit < NTOK / 64; unit += G) {
        const int tile = unit * 2 + half, b = tile >> 7, t0 = (tile & 127) * 32;
        __syncthreads();
        for (int i = 0; i < 62; ++i) { const int t = t0 - 30 + i; float v = 0.f;
            if (t >= 0) { const bf16_t* p = a.proj + ((size_t)b * SEQ + t) * DINP + C_CONV; v = bf2f(p[c]) * sigmf(bf2f(p[256 + c])); }
            hs[i * 256 + c] = v; }
        __syncthreads();
        float outv[32];
#pragma unroll
        for (int tt = 0; tt < 32; ++tt) { float s = bias;
#pragma unroll
            for (int k = 0; k < 31; ++k) s += hs[(tt + k) * 256 + c] * w[k];
            outv[tt] = s; }
        __syncthreads();
#pragma unroll
        for (int tt = 0; tt < 32; ++tt) hs[tt * 256 + c] = outv[tt];
        __syncthreads();
        const int wave = c >> 6, lane = c & 63;
        for (int tt = wave; tt < 32; tt += 4) { float v[4], s = 0.f;
#pragma unroll
            for (int i = 0; i < 4; ++i) { v[i] = hs[tt * 256 + lane + 64 * i]; s += v[i]; }
            const float mu = wsum(s) * (1.f / 256.f); float q = 0.f;
#pragma unroll
            for (int i = 0; i < 4; ++i) q += (v[i] - mu) * (v[i] - mu);
            const float rs = rsqrtf(wsum(q) * (1.f / 256.f) + 1e-5f);
#pragma unroll
            for (int i = 0; i < 4; ++i) { const int ch = lane + 64 * i; const float y = (v[i] - mu) * rs * lg[ch] + lb[ch]; a.hconv[((size_t)b * SEQ + t0 + tt) * 256 + ch] = f2bf(siluf(y)); } }
    }
}


namespace ret {
using nsa::f32x16; using nsa::u32x4; using nsa::u32x2; using nsa::pk2;
__device__ __forceinline__ float lg2g(int h) { return log2f(1.f - exp2f(-5.f - (float)h)); }
}
__device__ __forceinline__ void ph_ret_prep(const Args& a, LAS char* lds, int vcu, int G) {
    int tid = threadIdx.x; asm volatile("" : "+v"(tid)); asm volatile("" : "+s"(vcu));
    LAS bf16_t* tK = (LAS bf16_t*)lds; LAS bf16_t* tV = (LAS bf16_t*)(lds + 256 * 72 * 2);
    for (int u = vcu; u < NB * 64; u += G) { const int b = u >> 6, tb = u & 63;
        __syncthreads();
#pragma unroll
        for (int it = 0; it < 2; ++it) { const int item = tid + NT * it, tok = item >> 4, h = (item >> 2) & 3, ch = item & 3; const int pos = tb * 64 + tok; const size_t row = (size_t)b * SEQ + pos;
            const bf16_t* p = a.proj + row * DINP; const int c0 = h * 64 + 8 * ch;
            const u32x4_t ql = *(const u32x4_t*)(p + C_RQ + c0), qh = *(const u32x4_t*)(p + C_RQ + c0 + 32), kl = *(const u32x4_t*)(p + C_RK + c0), kh = *(const u32x4_t*)(p + C_RK + c0 + 32);
            const u32x4_t vl = *(const u32x4_t*)(p + C_RV + c0), vh = *(const u32x4_t*)(p + C_RV + c0 + 32);
            const float* cs = a.rot + ((size_t)pos * 32 + 8 * ch) * 2; float co[8], si[8];
#pragma unroll
            for (int e = 0; e < 4; ++e) { const f32x4 t4 = *(const f32x4*)(cs + 4 * e); co[2 * e] = t4[0]; si[2 * e] = t4[1]; co[2 * e + 1] = t4[2]; si[2 * e + 1] = t4[3]; }
            const float zeta = exp2f((float)(127 - (pos & 127)) * ret::lg2g(h));
            u32x4_t oql, oqh, okl, okh;
#pragma unroll
            for (int e2 = 0; e2 < 4; ++e2) { float r1[2], r2[2], k1[2], k2[2];
#pragma unroll
                for (int e1 = 0; e1 < 2; ++e1) { const int e = e2 * 2 + e1; const float x1 = __uint_as_float(e1 ? (ql[e2] & 0xffff0000u) : (ql[e2] << 16)), x2 = __uint_as_float(e1 ? (qh[e2] & 0xffff0000u) : (qh[e2] << 16));
                    const float y1 = __uint_as_float(e1 ? (kl[e2] & 0xffff0000u) : (kl[e2] << 16)), y2 = __uint_as_float(e1 ? (kh[e2] & 0xffff0000u) : (kh[e2] << 16));
                    r1[e1] = x1 * co[e] - x2 * si[e]; r2[e1] = x1 * si[e] + x2 * co[e]; k1[e1] = y1 * co[e] - y2 * si[e]; k2[e1] = y1 * si[e] + y2 * co[e];
                    tK[(c0 + e) * 72 + tok] = f2bf(k1[e1] * zeta); tK[(c0 + 32 + e) * 72 + tok] = f2bf(k2[e1] * zeta);
                    tV[(c0 + e) * 72 + tok] = (bf16_t)(e1 ? (vl[e2] >> 16) : (vl[e2] & 0xffffu)); tV[(c0 + 32 + e) * 72 + tok] = (bf16_t)(e1 ? (vh[e2] >> 16) : (vh[e2] & 0xffffu)); }
                oql[e2] = nsa::pk2(r1[0], r1[1]); oqh[e2] = nsa::pk2(r2[0], r2[1]); okl[e2] = nsa::pk2(k1[0], k1[1]); okh[e2] = nsa::pk2(k2[0], k2[1]); }
            *(u32x4_t*)(a.qrb + row * 256 + c0) = oql; *(u32x4_t*)(a.qrb + row * 256 + c0 + 32) = oqh; *(u32x4_t*)(a.krb + row * 256 + c0) = okl; *(u32x4_t*)(a.krb + row * 256 + c0 + 32) = okh; }
        __syncthreads();
#pragma unroll
        for (int it = 0; it < 4; ++it) { const int q = tid + NT * it, ri = q >> 3, cc = (q & 7) * 8; const size_t o = ((size_t)b * 256 + ri) * SEQ + tb * 64 + cc;
            *(u32x4_t*)(a.KzT + o) = *(const LAS u32x4_t*)(tK + ri * 72 + cc); *(u32x4_t*)(a.VrT + o) = *(const LAS u32x4_t*)(tV + ri * 72 + cc); }
    }
}
__device__ __forceinline__ void ph_ret_state(const Args& a, int vcu, int G) {
    using namespace ret;
    int tid = threadIdx.x; asm volatile("" : "+v"(tid)); asm volatile("" : "+s"(vcu));
    const int w = tid >> 6, lane = tid & 63, hi = lane >> 5, r = lane & 31;
    if (w >= 4) return;
    for (int u = vcu; u < 32; u += G) { const int h = u & 3, et = w >> 1, dt = w & 1; const float gc = exp2f(128.f * lg2g(h));
        const bf16_t* va = a.VrT + ((size_t)u * 64 + 32 * et + r) * SEQ + 8 * hi; const bf16_t* kb = a.KzT + ((size_t)u * 64 + 32 * dt + r) * SEQ + 8 * hi;
        f32x16 S;
#pragma unroll
        for (int i = 0; i < 16; ++i) S[i] = 0.f;
        bf16x8 A[8], B[8];
#pragma unroll
        for (int s2 = 0; s2 < 8; ++s2) { A[s2] = *(const bf16x8*)(va + 16 * s2); B[s2] = *(const bf16x8*)(kb + 16 * s2); }
        for (int c = 0; c < 32; ++c) {
            bf16_t* sp = a.ST + (((size_t)u * 32 + c) * 64 + 32 * et + 4 * hi) * 64 + 32 * dt + r;
#pragma unroll
            for (int i = 0; i < 16; ++i) sp[((i & 3) + 8 * (i >> 2)) * 64] = f2bf(S[i]);
            f32x16 KV;
#pragma unroll
            for (int i = 0; i < 16; ++i) KV[i] = 0.f;
            bf16x8 An[8], Bn[8]; const int cn = c < 31 ? c + 1 : c;
#pragma unroll
            for (int s2 = 0; s2 < 8; ++s2) { An[s2] = *(const bf16x8*)(va + cn * 128 + 16 * s2); Bn[s2] = *(const bf16x8*)(kb + cn * 128 + 16 * s2); }
#pragma unroll
            for (int s2 = 0; s2 < 8; ++s2) KV = __builtin_amdgcn_mfma_f32_32x32x16_bf16(A[s2], B[s2], KV, 0, 0, 0);
#pragma unroll
            for (int i = 0; i < 16; ++i) S[i] = gc * S[i] + KV[i];
#pragma unroll
            for (int s2 = 0; s2 < 8; ++s2) { A[s2] = An[s2]; B[s2] = Bn[s2]; }
        }
    }
}
__device__ __forceinline__ void ph_ret_out(const Args& a, int l, int vcu, int G) {
    using namespace ret;
    int tid = threadIdx.x; asm volatile("" : "+v"(tid)); asm volatile("" : "+s"(vcu));
    const int w = tid >> 6, lane = tid & 63, hi = lane >> 5, r = lane & 31, h = w >> 1, qh = w & 1;
    const float lg = lg2g(h); const float* gn = a.ret_gn + l * 256 + h * 64;
    for (int u = vcu; u < NB * 32; u += G) { const int b = u >> 5, c = u & 31, bh = b * 4 + h;
        const bf16_t* stp = a.ST + ((size_t)bh * 32 + c) * 4096; const bf16_t* vt = a.VrT + (size_t)bh * 64 * SEQ + c * 128;
#pragma unroll 1
        for (int qt = 0; qt < 2; ++qt) { const int q = 2 * qh + qt; const size_t row = (size_t)b * SEQ + c * 128 + 32 * q + r;
            bf16x8 Qf[4];
#pragma unroll
            for (int s = 0; s < 4; ++s) Qf[s] = *(const bf16x8*)(a.qrb + row * 256 + h * 64 + 16 * s + 8 * hi);
            f32x16 O0, O1;
#pragma unroll
            for (int i = 0; i < 16; ++i) { O0[i] = 0.f; O1[i] = 0.f; }
#pragma unroll
            for (int s = 0; s < 4; ++s) { const bf16x8 a0 = *(const bf16x8*)(stp + r * 64 + 16 * s + 8 * hi), a1 = *(const bf16x8*)(stp + (32 + r) * 64 + 16 * s + 8 * hi);
                O0 = __builtin_amdgcn_mfma_f32_32x32x16_bf16(a0, Qf[s], O0, 0, 0, 0); O1 = __builtin_amdgcn_mfma_f32_32x32x16_bf16(a1, Qf[s], O1, 0, 0, 0); }
            const float xi = exp2f((float)(32 * q + r + 1) * lg);
#pragma unroll
            for (int i = 0; i < 16; ++i) { O0[i] *= xi; O1[i] *= xi; }
            for (int kt = 0; kt <= q; ++kt) { const size_t krow = (size_t)b * SEQ + c * 128 + 32 * kt + r;
                f32x16 S;
#pragma unroll
                for (int i = 0; i < 16; ++i) S[i] = 0.f;
#pragma unroll
                for (int s = 0; s < 4; ++s) { const bf16x8 ka = *(const bf16x8*)(a.krb + krow * 256 + h * 64 + 16 * s + 8 * hi); S = __builtin_amdgcn_mfma_f32_32x32x16_bf16(ka, Qf[s], S, 0, 0, 0); }
                const int dbase = 32 * (q - kt) + r - 4 * hi;
#pragma unroll
                for (int i = 0; i < 16; ++i) { const int dl = dbase - ((i & 3) + 8 * (i >> 2)); S[i] = dl >= 0 ? S[i] * exp2f((float)dl * lg) : 0.f; }
#pragma unroll
                for (int s2 = 0; s2 < 2; ++s2) { u32x4 pw;
#pragma unroll
                    for (int x = 0; x < 4; ++x) pw[x] = pk2(S[8 * s2 + 2 * x], S[8 * s2 + 2 * x + 1]);
                    const bf16x8 Pf = __builtin_bit_cast(bf16x8, pw);
                    const bf16_t* v0 = vt + (size_t)r * SEQ + 32 * kt + 16 * s2 + 4 * hi; const bf16_t* v1 = v0 + (size_t)32 * SEQ;
                    const u32x2 x0 = *(const u32x2*)v0, y0 = *(const u32x2*)(v0 + 8), x1 = *(const u32x2*)v1, y1 = *(const u32x2*)(v1 + 8);
                    O0 = __builtin_amdgcn_mfma_f32_32x32x16_bf16(__builtin_bit_cast(bf16x8, (u32x4){x0.x, x0.y, y0.x, y0.y}), Pf, O0, 0, 0, 0);
                    O1 = __builtin_amdgcn_mfma_f32_32x32x16_bf16(__builtin_bit_cast(bf16x8, (u32x4){x1.x, x1.y, y1.x, y1.y}), Pf, O1, 0, 0, 0); }
            }
            float sm = 0.f;
#pragma unroll
            for (int i = 0; i < 16; ++i) sm += O0[i] + O1[i];
            sm += __shfl_xor(sm, 32); const float mu = sm * (1.f / 64.f); float vq = 0.f;
#pragma unroll
            for (int i = 0; i < 16; ++i) { const float d0 = O0[i] - mu, d1 = O1[i] - mu; vq += d0 * d0 + d1 * d1; }
            vq += __shfl_xor(vq, 32); const float rs = rsqrtf(vq * (1.f / 64.f) + 1e-5f);
            const bf16_t* gp = a.proj + row * DINP + C_RG + h * 64 + 4 * hi; bf16_t* op = a.ocat + row * DM + 768 + h * 64 + 4 * hi;
#pragma unroll
            for (int q4 = 0; q4 < 4; ++q4) {
#pragma unroll
                for (int et = 0; et < 2; ++et) { const int e0 = 32 * et + 8 * q4; const u32x2 gt = *(const u32x2*)(gp + e0); const f32x4 gg = *(const f32x4*)(gn + e0 + 4 * hi);
                    float o[4];
#pragma unroll
                    for (int x = 0; x < 4; ++x) { const float ov = et ? O1[4 * q4 + x] : O0[4 * q4 + x]; const unsigned gw = x < 2 ? gt.x : gt.y; const float gv = __uint_as_float((x & 1) ? (gw & 0xffff0000u) : (gw << 16));
                        o[x] = siluf(gv) * (ov - mu) * rs * gg[x]; }
                    u32x2 ow; ow.x = pk2(o[0], o[1]); ow.y = pk2(o[2], o[3]); *(u32x2*)(op + e0) = ow; } }
        }
    }
}

__device__ __forceinline__ void ph_route(const Args& a, LAS char* lds, int vcu, int G) {
    int tid_ = threadIdx.x; asm volatile("" : "+v"(tid_)); asm volatile("" : "+s"(vcu));
    const int lane = tid_ & 63, wv = tid_ >> 6; const float* g = a.ln_ffn + DM; LAS float* gr = (LAS float*)lds;
    LAS int* sel = (LAS int*)(lds + 32768);
    LAS int* lcnt = sel + 256;
    __syncthreads();
    for (int q = tid_; q < DM * 8; q += NT) gr[q] = a.router[q] * g[q >> 3];
    for (int r0 = vcu * 128; r0 < NTOK; r0 += G * 128) {
        if (tid_ < 16) lcnt[tid_] = 0;
        __syncthreads();
        for (int i = 0; i < 16; ++i) { const int rl = wv * 16 + i, row = r0 + rl; float lg[8];
#pragma unroll
            for (int e = 0; e < 8; ++e) lg[e] = 0.f;
            u32x4_t xr[2];
#pragma unroll
            for (int h = 0; h < 2; ++h) xr[h] = *(const u32x4_t*)(a.xb + (size_t)row * DM + lane * 8 + 512 * h);
#pragma unroll
            for (int h = 0; h < 2; ++h)
#pragma unroll
                for (int jj = 0; jj < 8; ++jj) { const int k = lane * 8 + 512 * h + jj; const f32x4 q0 = *(const LAS f32x4*)(gr + k * 8), q1 = *(const LAS f32x4*)(gr + k * 8 + 4);
                    const unsigned wd = xr[h][jj >> 1]; const float x = __uint_as_float((jj & 1) ? (wd & 0xffff0000u) : (wd << 16));
                    lg[0] += x * q0[0]; lg[1] += x * q0[1]; lg[2] += x * q0[2]; lg[3] += x * q0[3]; lg[4] += x * q1[0]; lg[5] += x * q1[1]; lg[6] += x * q1[2]; lg[7] += x * q1[3]; }
            const float rs = row_rstd(a.ssq, row);
#pragma unroll
            for (int e = 0; e < 8; ++e) lg[e] = wsum(lg[e]) * rs;
            int e1 = 0; float v1 = lg[0];
#pragma unroll
            for (int e = 1; e < 8; ++e) if (lg[e] > v1) { v1 = lg[e]; e1 = e; }
            int e2 = -1; float v2 = -INFINITY;
#pragma unroll
            for (int e = 0; e < 8; ++e) if (e != e1 && lg[e] > v2) { v2 = lg[e]; e2 = e; }
            if (lane == 0) { const float g1 = 1.f / (1.f + __expf(v2 - v1)); a.gate[row * 2] = g1; a.gate[row * 2 + 1] = 1.f - g1; sel[rl * 2] = e1; sel[rl * 2 + 1] = e2; } }
        __syncthreads();
        int e = 0, rank = 0;
        if (tid_ < 256) { e = sel[tid_]; rank = __hip_atomic_fetch_add(&lcnt[e], 1, __ATOMIC_RELAXED, __HIP_MEMORY_SCOPE_WORKGROUP); }
        __syncthreads();
        if (tid_ < 8) lcnt[8 + tid_] = atomicAdd(&a.cnt[tid_], lcnt[tid_]);
        __syncthreads();
        if (tid_ < 256) a.tok_list[e * NTOK + lcnt[8 + e] + rank] = (r0 + (tid_ >> 1)) * 2 + (tid_ & 1);
        __syncthreads();
    }
}
__device__ __forceinline__ void ph_route_build(const Args& a, int vcu, int G) {
    int tid_ = threadIdx.x; asm volatile("" : "+v"(tid_)); asm volatile("" : "+s"(vcu));
    for (int idx = vcu * NT + tid_; idx < NEXP * NTOK; idx += G * NT) { const int e = idx >> 15, i = idx & (NTOK - 1);
        int ps = 0; for (int q = 0; q < e; ++q) ps += (a.cnt[q] + 255) & ~255;
        const int ce = a.cnt[e], pe = (ce + 255) & ~255;
        if (i < ce) { const int en = a.tok_list[e * NTOK + i]; a.row_tok[ps + i] = en >> 1; a.slot[en] = ps + i; } else if (i < pe) a.row_tok[ps + i] = -1;
        if (i < pe && (i & 255) == 0) a.tile_exp[(ps + i) >> 8] = e;
        if (idx == 0) { int tot = 0; for (int q = 0; q < 8; ++q) tot += (a.cnt[q] + 255) & ~255; a.meta[0] = tot >> 8; } }
}
__device__ __forceinline__ void ph_final(const Args& a, int vcu, int G) {
    int tid_ = threadIdx.x; asm volatile("" : "+v"(tid_)); asm volatile("" : "+s"(vcu));
    const int lane = tid_ & 63; float* xio = a.xres;
    for (int row = vcu * NW + (tid_ >> 6); row < NTOK; row += G * NW) { const int s1 = a.slot[row * 2], s2 = a.slot[row * 2 + 1]; const float g1 = a.gate[row * 2], g2 = a.gate[row * 2 + 1];
        float v[16]; float ss = 0.f;
#pragma unroll
        for (int i = 0; i < 4; ++i) { const int c = lane * 4 + i * 256; const ushort4 xq = *(const ushort4*)(a.xb + (size_t)row * DM + c); float4 xv; xv.x = bf2f(xq.x); xv.y = bf2f(xq.y); xv.z = bf2f(xq.z); xv.w = bf2f(xq.w);
            const ushort4 p = *(const ushort4*)(a.ysorted + (size_t)s1 * DM + c), q = *(const ushort4*)(a.ysorted + (size_t)s2 * DM + c);
            v[i * 4 + 0] = xv.x + g1 * bf2f(p.x) + g2 * bf2f(q.x); v[i * 4 + 1] = xv.y + g1 * bf2f(p.y) + g2 * bf2f(q.y);
            v[i * 4 + 2] = xv.z + g1 * bf2f(p.z) + g2 * bf2f(q.z); v[i * 4 + 3] = xv.w + g1 * bf2f(p.w) + g2 * bf2f(q.w);
#pragma unroll
            for (int j = 0; j < 4; ++j) ss += v[i * 4 + j] * v[i * 4 + j]; }
        const float rs = rsqrtf(wsum(ss) * (1.f / DM) + 1e-6f);
#pragma unroll
        for (int i = 0; i < 4; ++i) { const int c = lane * 4 + i * 256; const float4 gf = *(const float4*)(a.ln_final + c); float4 o; o.x = v[i * 4] * rs * gf.x; o.y = v[i * 4 + 1] * rs * gf.y; o.z = v[i * 4 + 2] * rs * gf.z; o.w = v[i * 4 + 3] * rs * gf.w;
            *(float4*)(xio + (size_t)row * DM + c) = o; } }
}

__global__ void __launch_bounds__(NT, 2) mega(Args a) {
    extern __shared__ __attribute__((aligned(16))) char lds[];
    volatile LAS unsigned* misc = (volatile LAS unsigned*)((LAS char*)lds + MISC_OFF);
    if (threadIdx.x < 64) misc[threadIdx.x] = 0u;
    __syncthreads();
    XcdBarrier bar = xcd_barrier_post(a.bar, misc);
    const int G = gridDim.x, vcu = blockIdx.x;
    LAS char* const lds3 = (LAS char*)lds;
#ifndef REP_PRO
#define REP_PRO 1
#endif
#ifndef REP_GEMM
#define REP_GEMM 1
#endif
#ifndef REP_NSA
#define REP_NSA 1
#endif
#ifndef REP_X
#define REP_X 1
#endif
#define GRID_BAR() xcd_barrier(bar)
#define AS4 __attribute__((address_space(4)))
#if defined(__HIP_DEVICE_COMPILE__)
#define LA const AS4 Args* ap_ = (const AS4 Args*)__builtin_amdgcn_kernarg_segment_ptr(); asm volatile("" : "+s"(ap_)); Args A; __builtin_memcpy(&A, ap_, sizeof(Args))
#else
#define LA const Args A = a
#endif

    { LA; ph_prologue(A, lds3, vcu, G); }
    GRID_BAR();
#pragma unroll
    for (int l = 0; l < 2; ++l) {
        for (int rep = 0; rep < REP_GEMM; ++rep) { LA; pg8::Gemm g{A.xb, A.Win + (size_t)l * DINP * DM, NTOK, DINP, DM}; pg8::StaticOrder S; S.init(NTOK, DINP, G, vcu);
          pg8::gemm_phase<pg8::EIn, pg8::StaticOrder, 0>((PG8_LAS unsigned char*)lds3, g, S, pg8::EIn{A.proj, A.ssq}, nullptr, nullptr, 0); }
        GRID_BAR();
#pragma unroll 1
        for (int rep = 0; rep < REP_X; ++rep) {
#pragma unroll 1
        for (int kv = 0; kv < 2; ++kv) { const int i = l * 2 + kv;
            { LA; pg8::Gemm g{A.proj, A.W1b + (size_t)i * 256 * 2048, 4096, 256, 2048}; pg8::StaticOrder S; S.init(4096, 256, G, (vcu + G - kv * 16) % G);
              pg8::gemm_phase<pg8::ESiluBias, pg8::StaticOrder, 2>((PG8_LAS unsigned char*)lds3, g, S, pg8::ESiluBias{A.hc + (size_t)kv * 4096 * 256, A.bias1 + i * 256}, nullptr, nullptr, (size_t)(kv ? C_VC : C_KC)); } }
        { LA; ph_vtrans(A, lds3, vcu, G); }
        { LA; ph_conv_naive(A, l, lds3, vcu, G); }
        { LA; ph_ret_prep(A, lds3, vcu, G); }
        }
        GRID_BAR();
#pragma unroll 1
        for (int rep = 0; rep < REP_X; ++rep) {
        { LA; pg8::Gemm g{A.hc, A.W2b + (size_t)(l * 2) * 256 * 256, 4096, 256, 256}; pg8::StaticOrder S; S.init(4096, 256, G, vcu);
          pg8::gemm_phase<pg8::EKc, pg8::StaticOrder, 0>((PG8_LAS unsigned char*)lds3, g, S, pg8::EKc{A.kcb, 0, 0}, nullptr, nullptr, 0); }
        { LA; pg8::Gemm g{A.hc + (size_t)4096 * 256, A.W2b + (size_t)(l * 2 + 1) * 256 * 256, 4096, 256, 256}; pg8::StaticOrder S; S.init(4096, 256, G, (vcu + G - 16) % G);
          pg8::gemm_phase<pg8::EKc, pg8::StaticOrder, 0>((PG8_LAS unsigned char*)lds3, g, S, pg8::EKc{A.vcT, 1, 0}, nullptr, nullptr, 0); }
        { LA; pg8::Gemm g{A.hconv, A.Wpw + (size_t)l * 65536, NTOK, 256, 256}; pg8::StaticOrder S; S.init(NTOK, 256, G, (vcu + G - 32) % G);
          pg8::gemm_phase<pg8::EStore, pg8::StaticOrder, 0>((PG8_LAS unsigned char*)lds3, g, S, pg8::EStore{A.ocat + 512, DM}, nullptr, nullptr, 0); }
        { LA; ph_ret_state(A, (vcu + G - 64) % G, G); }
        }
        GRID_BAR();
        { LA; ph_ret_out(A, l, vcu, G); }
        for (int rep = 0; rep < REP_NSA; ++rep) { LA; ph_nsa(A, lds3, vcu, G); }
        GRID_BAR();
        { LA; pg8::Gemm g{A.ocat, A.Wout + (size_t)l * DM * DM, NTOK, DM, DM}; pg8::StaticOrder S; S.init(NTOK, DM, G, vcu);
          pg8::gemm_phase<pg8::ERes, pg8::StaticOrder, 0>((PG8_LAS unsigned char*)lds3, g, S, pg8::ERes{l == 0 ? A.x : nullptr, A.xb, A.ssq}, nullptr, nullptr, 0); }
        GRID_BAR();
        if (l == 0) {
            for (int rep = 0; rep < REP_GEMM; ++rep) { LA; pg8::Gemm g{A.xb, A.W13, NTOK, 2 * DFF, DM}; pg8::StaticOrder S; S.init(NTOK, 2 * DFF, G, vcu);
              pg8::gemm_phase<pg8::ESwiglu, pg8::StaticOrder, 0>((PG8_LAS unsigned char*)lds3, g, S, pg8::ESwiglu{A.hbuf, A.ssq, nullptr}, nullptr, nullptr, 0); }
            GRID_BAR();
            { LA; pg8::Gemm g{A.hbuf, A.W2, NTOK, DM, DFF}; pg8::StaticOrder S; S.init(NTOK, DM, G, vcu);
              pg8::gemm_phase<pg8::ERes, pg8::StaticOrder, 0>((PG8_LAS unsigned char*)lds3, g, S, pg8::ERes{nullptr, A.xb, A.ssq}, nullptr, nullptr, 0); }
            GRID_BAR();
        }
    }
    { LA; ph_route(A, lds3, vcu, G); }
    GRID_BAR();
    { LA; ph_route_build(A, vcu, G); }
    GRID_BAR();
    for (int rep = 0; rep < REP_GEMM; ++rep) { LA; const int Mm = A.meta[0] * 256; pg8::Gemm g{A.xb, A.Wm13, Mm, 2 * DFF, DM}; pg8::StaticOrder S; S.init(Mm, 2 * DFF, G, vcu);
      pg8::gemm_phase<pg8::ESwiglu, pg8::StaticOrder, 1>((PG8_LAS unsigned char*)lds3, g, S, pg8::ESwiglu{A.hbuf, A.ssq, A.row_tok}, A.row_tok, A.tile_exp, (size_t)2 * DFF * DM); }
    GRID_BAR();
    for (int rep = 0; rep < REP_GEMM; ++rep) { LA; const int Mm = A.meta[0] * 256; pg8::Gemm g{A.hbuf, A.Wm2, Mm, DM, DFF}; pg8::StaticOrder S; S.init(Mm, DM, G, vcu);
      pg8::gemm_phase<pg8::EStore, pg8::StaticOrder, 0>((PG8_LAS unsigned char*)lds3, g, S, pg8::EStore{A.ysorted, DM}, nullptr, A.tile_exp, (size_t)DM * DFF); }
    GRID_BAR();
    { LA; ph_final(A, vcu, G); }
}

static inline size_t al256(size_t x) { return (x + 255) & ~(size_t)255; }
extern "C" void kernel_launch(void* const* d_in, const int* in_sizes, int n_in, void* d_out, int out_size, void* d_ws, size_t ws_size, hipStream_t stream) {
    static int grid = 0;
    Args a{};
    const float** ins = (const float**)&a.x;
    for (int i = 0; i < 20; ++i) ins[i] = (const float*)d_in[i];
    a.xres = (float*)d_out;
    char* w = (char*)d_ws; size_t off = 0;
    auto take = [&](size_t bytes) { char* p = w + off; off = al256(off + bytes); return p; };
    a.bar = (unsigned*)take(XCD_BAR_WORDS * 4);
    a.cnt = (int*)take(256);
    a.meta = (int*)take(256);
    const size_t ctl_bytes = off;
    char* regY = w + off;
    a.Wm13 = (bf16_t*)take((size_t)NEXP * 2 * DFF * DM * 2);
    a.Win = (bf16_t*)take((size_t)2 * DINP * DM * 2);
    a.Wout = (bf16_t*)take((size_t)2 * DM * DM * 2);
    a.W13 = (bf16_t*)take((size_t)2 * DFF * DM * 2);
    a.W2 = (bf16_t*)take((size_t)DM * DFF * 2);
    a.ysorted = (bf16_t*)regY;
    if (off < (size_t)(regY - w) + (size_t)PMAX * DM * 2) off = al256((size_t)(regY - w) + (size_t)PMAX * DM * 2);
    a.xb = (bf16_t*)take((size_t)NTOK * DM * 2);
    a.Wm2 = (bf16_t*)take((size_t)NEXP * DM * DFF * 2);
    a.W1b = (bf16_t*)take((size_t)4 * 256 * 2048 * 2);
    a.W2b = (bf16_t*)take((size_t)4 * 256 * 256 * 2);
    a.Wpw = (bf16_t*)take((size_t)2 * 256 * 256 * 2);
    a.bias1 = (float*)take(4 * 256 * 4);
    a.rot = (float*)take((size_t)4096 * 32 * 2 * 4);
    a.ssq = (float*)take((size_t)NTOK * NSLOT * 4);
    a.tok_list = (int*)take((size_t)NEXP * NTOK * 4);
    a.row_tok = (int*)take((size_t)PMAX * 4);
    a.slot = (int*)take((size_t)NTOK * 2 * 4);
    a.tile_exp = (int*)take(1024 * 4);
    a.gate = (float*)take((size_t)NTOK * 2 * 4);
    char* regR = w + off;
    a.proj = (bf16_t*)take((size_t)NTOK * DINP * 2);
    a.ocat = (bf16_t*)take((size_t)NTOK * DM * 2);
    a.hc = (bf16_t*)take((size_t)2 * 4096 * 256 * 2);
    a.kcb = (bf16_t*)take((size_t)4096 * 64 * 2);
    a.hconv = (bf16_t*)take((size_t)NTOK * 256 * 2);
    a.vcT = (bf16_t*)take((size_t)16 * 64 * 256 * 2);
    a.VsT = (bf16_t*)take((size_t)16 * 64 * SEQ * 2);
    a.VwT = (bf16_t*)take((size_t)16 * 64 * SEQ * 2);
    a.qrb = (bf16_t*)take((size_t)NTOK * 256 * 2);
    a.krb = (bf16_t*)take((size_t)NTOK * 256 * 2);
    a.KzT = (bf16_t*)take((size_t)32 * 64 * SEQ * 2);
    a.VrT = (bf16_t*)take((size_t)32 * 64 * SEQ * 2);
    a.ST = (bf16_t*)take((size_t)32 * 32 * 4096 * 2);
    a.hbuf = (bf16_t*)regR;
    const size_t need = (size_t)(regR - w) + (size_t)PMAX * DFF * 2;
    if (grid == 0) {
        if (need > ws_size || off > ws_size || n_in != 20) { fprintf(stderr, "kernel_launch: workspace too small: need %zu / %zu have %zu\n", need, off, ws_size); grid = -1; return; }
        int dev = 0, cus = 0;
        if (hipGetDevice(&dev) != hipSuccess || hipDeviceGetAttribute(&cus, hipDeviceAttributeMultiprocessorCount, dev) != hipSuccess) { grid = -1; return; }
        if (hipFuncSetAttribute((const void*)mega, hipFuncAttributeMaxDynamicSharedMemorySize, LDS_BYTES) != hipSuccess) { fprintf(stderr, "kernel_launch: hipFuncSetAttribute failed\n"); grid = -1; return; }
        int per_cu = 0;
        if (hipOccupancyMaxActiveBlocksPerMultiprocessor(&per_cu, (const void*)mega, NT, LDS_BYTES) != hipSuccess || per_cu < 1) { fprintf(stderr, "kernel_launch: occupancy query says %d\n", per_cu); }
        (void)hipGetLastError();
        grid = cus;
    }
    if (grid < 0) return;
    (void)hipMemsetAsync(w, 0, ctl_bytes, stream);
    hipLaunchKernelGGL(mega, dim3(grid), dim3(NT), LDS_BYTES, stream, a);
}
```

```cpp
#include <hip/hip_runtime.h>
#include <stdint.h>
#include <stdio.h>

typedef unsigned short bf16_t;
typedef short bf16x8 __attribute__((ext_vector_type(8)));
typedef float f32x4 __attribute__((ext_vector_type(4)));
typedef unsigned u32x4_t __attribute__((ext_vector_type(4)));

constexpr int NTOK = 32768, DM = 1024, NB = 8, SEQ = 4096;
constexpr int DIN = 2840, DINP = 3072, DFF = 2816, NEXP = 8;
constexpr int C_Q = 0, C_KC = 512, C_VC = 640, C_KS = 768, C_VS = 896, C_KW = 1024, C_VW = 1152, C_GL = 1280,
              C_CONV = 1304, C_RQ = 1816, C_RK = 2072, C_RV = 2328, C_RG = 2584;
constexpr int NSLOT = 16;
constexpr int PMAX = 65536 + 8 * 256;
constexpr int NT = 512, NW = 8;
constexpr int LDS_BYTES = 144 * 1024, MISC_OFF = LDS_BYTES - 256;

#define XB_TMO      128
#define XB_XCNT(j)  (256  + 64 * (j))
#define XB_XSUB(j)  (1280 + 64 * (j))
#define XB_XGEN(j)  (2304 + 64 * (j))
#define XB_TOP      3328
#define XB_TOPGEN   3392
#define XCD_BAR_WORDS 3456
#define XB_SPIN_CAP (1u << 20)
#define LAS __attribute__((address_space(3)))
__device__ __forceinline__ unsigned xb_ld(unsigned* p)              { return __hip_atomic_load(p, __ATOMIC_RELAXED, __HIP_MEMORY_SCOPE_AGENT); }
__device__ __forceinline__ unsigned xb_add(unsigned* p, unsigned v) { return __hip_atomic_fetch_add(p, v, __ATOMIC_RELAXED, __HIP_MEMORY_SCOPE_AGENT); }
__device__ __forceinline__ unsigned xb_xcc_id() { return (unsigned)__builtin_amdgcn_s_getreg((3 << 11) | 20) & 0xFu; }
#define XB_SPIN(cond, bar) do { unsigned _sp = 0; while (cond) { __builtin_amdgcn_s_sleep(1); \
    if ((++_sp & 255u) == 0u) { if (xb_ld(&(bar)[XB_TMO])) break; if (_sp > XB_SPIN_CAP) { atomicAdd(&(bar)[XB_TMO], 1u); break; } } } } while (0)
struct XcdBarrier { unsigned* bar; unsigned x; volatile LAS unsigned* st; };
__device__ __forceinline__ XcdBarrier xcd_barrier_post(unsigned* bar, volatile LAS unsigned* st) {
    XcdBarrier b; b.bar = bar; b.x = xb_xcc_id(); b.st = st;
    if (threadIdx.x == 0) (void)xb_add(&bar[XB_XCNT(b.x)], 1u);
    return b;
}
__device__ __forceinline__ void xcd_barrier_complete(unsigned* bar, unsigned x, unsigned& nloc, unsigned& nx) {
    const unsigned G = gridDim.x * gridDim.y * gridDim.z;
    unsigned sum, cnt, mine, sp = 0u;
    for (;;) {
        sum = 0u; cnt = 0u; mine = 0u;
#pragma unroll
        for (unsigned j = 0; j < 16; ++j) { const unsigned c = xb_ld(&bar[XB_XCNT(j)]); sum += c; cnt += (c > 0u) ? 1u : 0u; mine = (j == x) ? c : mine; }
        if (sum == G) break;
        __builtin_amdgcn_s_sleep(1);
        if ((++sp & 255u) == 0u) { if (xb_ld(&bar[XB_TMO])) break; if (sp > XB_SPIN_CAP) { atomicAdd(&bar[XB_TMO], 1u); break; } }
    }
    nloc = mine > 0u ? mine : 1u; nx = cnt > 0u ? cnt : 1u;
}
__device__ __forceinline__ void xcd_barrier(const XcdBarrier& b) {
    asm volatile("s_waitcnt vmcnt(0)" ::: "memory");
    __syncthreads();
    if (threadIdx.x == 0) {
        unsigned* bar = b.bar;
        __builtin_amdgcn_s_waitcnt(0);
        const unsigned bx = xb_xcc_id();
        unsigned nloc = b.st[0], nx = b.st[1];
        if (nloc == 0u) { xcd_barrier_complete(bar, bx, nloc, nx); b.st[0] = nloc; b.st[1] = nx; }
        const unsigned old = xb_add(&bar[XB_XSUB(bx)], 1u);
        const unsigned gen = old / nloc;
        if (old + 1u == (gen + 1u) * nloc) {
            __builtin_amdgcn_fence(__ATOMIC_RELEASE, "agent");
            asm volatile("s_waitcnt vmcnt(0)" ::: "memory");
            const unsigned og = xb_add(&bar[XB_TOP], 1u);
            const unsigned tg = og / nx;
            if (og + 1u == (tg + 1u) * nx) xb_add(&bar[XB_TOPGEN], 1u);
            else XB_SPIN(xb_ld(&bar[XB_TOPGEN]) == tg, bar);
            __builtin_amdgcn_fence(__ATOMIC_ACQUIRE, "agent");
            xb_add(&bar[XB_XGEN(bx)], 1u);
            asm volatile("s_waitcnt vmcnt(0)" ::: "memory");
        } else {
            XB_SPIN(xb_ld(&bar[XB_XGEN(bx)]) == gen, bar);
            __builtin_amdgcn_fence(__ATOMIC_ACQUIRE, "agent");
            asm volatile("s_waitcnt vmcnt(0)" ::: "memory");
        }
    }
    __syncthreads();
}

__device__ __forceinline__ bf16_t f2bf(float f) { unsigned u = __float_as_uint(f); u += 0x7fffu + ((u >> 16) & 1u); return (bf16_t)(u >> 16); }
__device__ __forceinline__ unsigned pk2bf(float lo, float hi) { unsigned r; asm volatile("v_cvt_pk_bf16_f32 %0, %1, %2" : "=v"(r) : "v"(lo), "v"(hi)); return r; }
__device__ __forceinline__ float bf2f(bf16_t h) { return __uint_as_float(((unsigned)h) << 16); }
__device__ __forceinline__ float wsum(float v) {
#pragma unroll
    for (int o = 32; o > 0; o >>= 1) v += __shfl_xor(v, o);
    return v; }
__device__ __forceinline__ float wmax(float v) {
#pragma unroll
    for (int o = 32; o > 0; o >>= 1) v = fmaxf(v, __shfl_xor(v, o));
    return v; }
__device__ __forceinline__ float siluf(float x) { return x / (1.f + __expf(-x)); }
__device__ __forceinline__ float sigmf(float x) { return 1.f / (1.f + __expf(-x)); }
__device__ __forceinline__ float row_rstd(const float* ssq, int row) { const f32x4* p = (const f32x4*)(ssq + (size_t)row * NSLOT); const f32x4 a = p[0], b = p[1], c = p[2], d = p[3];
    const f32x4 t = (a + b) + (c + d); return rsqrtf(((t[0] + t[1]) + (t[2] + t[3])) * (1.f / DM) + 1e-6f); }

struct Args {
    const float *x, *ln_attn, *w_in, *cmp_pe, *cmp_w1, *cmp_w2, *conv_w, *conv_b, *conv_lg, *conv_lb, *conv_pw, *ret_gn, *w_out, *ln_ffn, *ffn_w13, *ffn_w2, *router, *moe_w13, *moe_w2, *ln_final;
    float* xres;
    bf16_t *Wm13, *Win, *Wout, *W13, *W2, *xb, *ysorted, *Wm2, *W1b, *W2b, *Wpw;
    float *bias1, *rot, *ssq; int *cnt, *meta, *tok_list, *row_tok, *slot, *tile_exp; float* gate;
    bf16_t *proj, *ocat, *hc, *kcb, *vcb, *hconv; float *qr, *kr, *KV, *Sst; bf16_t* hbuf; bf16_t *vcT, *VsT, *VwT, *qrb, *krb, *KzT, *VrT, *ST;
    unsigned* bar; unsigned* wq;
};

struct ConvJob { const float* src; bf16_t* dst; const float* g; int ldsrc, K, Npad, nvalid, mode, pad; };
__device__ __forceinline__ ConvJob get_job(const Args& a, int j) {
    ConvJob c; c.g = nullptr; c.mode = 0; c.pad = 0;
    if (j < 2) { c.src = a.w_in + (size_t)j * DM * DIN; c.dst = a.Win + (size_t)j * DINP * DM; c.g = a.ln_attn + j * DM; c.ldsrc = DIN; c.K = DM; c.Npad = DINP; c.nvalid = DIN; c.mode = 1; }
    else if (j < 4) { const int l = j - 2; c.src = a.w_out + (size_t)l * DM * DM; c.dst = a.Wout + (size_t)l * DM * DM; c.ldsrc = DM; c.K = DM; c.Npad = DM; c.nvalid = DM; }
    else if (j < 6) { const int l = j - 4; c.src = a.conv_pw + (size_t)l * 65536; c.dst = a.Wpw + (size_t)l * 65536; c.ldsrc = 256; c.K = 256; c.Npad = 256; c.nvalid = 256; }
    else if (j < 10) { const int i = j - 6; c.src = a.cmp_w1 + (size_t)i * 2048 * 256; c.dst = a.W1b + (size_t)i * 256 * 2048; c.ldsrc = 256; c.K = 2048; c.Npad = 256; c.nvalid = 256; }
    else if (j < 14) { const int i = j - 10; c.src = a.cmp_w2 + (size_t)i * 256 * 64; c.dst = a.W2b + (size_t)i * 256 * 256; c.ldsrc = 64; c.K = 256; c.Npad = 256; c.nvalid = 64; }
    else if (j == 14) { c.src = a.ffn_w13; c.dst = a.W13; c.g = a.ln_ffn; c.ldsrc = 2 * DFF; c.K = DM; c.Npad = 2 * DFF; c.nvalid = 2 * DFF; c.mode = 2; }
    else if (j == 15) { c.src = a.ffn_w2; c.dst = a.W2; c.ldsrc = DM; c.K = DFF; c.Npad = DM; c.nvalid = DM; }
    else if (j < 24) { const int e = j - 16; c.src = a.moe_w13 + (size_t)e * DM * 2 * DFF; c.dst = a.Wm13 + (size_t)e * 2 * DFF * DM; c.g = a.ln_ffn + DM; c.ldsrc = 2 * DFF; c.K = DM; c.Npad = 2 * DFF; c.nvalid = 2 * DFF; c.mode = 2; }
    else { const int e = j - 24; c.src = a.moe_w2 + (size_t)e * DFF * DM; c.dst = a.Wm2 + (size_t)e * DM * DFF; c.ldsrc = DM; c.K = DFF; c.Npad = DM; c.nvalid = DM; }
    return c;
}
constexpr int NJOBS = 32;
__device__ __forceinline__ void conv_super(const ConvJob& c, int st, LAS float* lt, int tid_) {
    const int nsn = c.Npad / 256, n0 = (st % nsn) * 256, k0 = (st / nsn) * 64, lane = tid_ & 63, wv = tid_ >> 6;
    float v[32];
#pragma unroll
    for (int q = 0; q < 4; ++q) { const int n = n0 + q * 64 + lane; int sc;
        if (c.mode == 2) { const int pn = n >> 8, i = n & 255; sc = i < 128 ? 128 * pn + i : DFF + 128 * pn + (i - 128); } else sc = n < c.nvalid ? n : -1;
#pragma unroll
        for (int i = 0; i < 8; ++i) v[q * 8 + i] = sc >= 0 ? c.src[(size_t)(k0 + wv + 8 * i) * c.ldsrc + sc] : 0.f; }
#pragma unroll
    for (int q = 0; q < 4; ++q)
#pragma unroll
        for (int i = 0; i < 8; ++i) lt[(wv + 8 * i) * 257 + q * 64 + lane] = v[q * 8 + i];
    __syncthreads();
    const int nl = tid_ >> 3, ch = tid_ & 7;
    float gs[8];
#pragma unroll
    for (int e = 0; e < 8; ++e) gs[e] = c.g ? c.g[k0 + 8 * ch + e] : 1.f;
#pragma unroll
    for (int q = 0; q < 4; ++q) { const int n = n0 + q * 64 + nl; const float cs = (c.mode == 1 && (n < 512 || (n >= C_RK && n < C_RV))) ? 0.125f : 1.f; float x[8];
#pragma unroll
        for (int e = 0; e < 8; ++e) x[e] = lt[(8 * ch + e) * 257 + q * 64 + nl] * gs[e] * cs;
        u32x4_t w; w.x = pk2bf(x[0], x[1]); w.y = pk2bf(x[2], x[3]); w.z = pk2bf(x[4], x[5]); w.w = pk2bf(x[6], x[7]);
        *(u32x4_t*)(c.dst + (size_t)n * c.K + k0 + 8 * ch) = w; }
    __syncthreads();
}
__device__ __forceinline__ void ph_prologue(const Args& a, LAS char* lds, int vcu, int G) {
    int tid_ = threadIdx.x; asm volatile("" : "+v"(tid_)); asm volatile("" : "+s"(vcu));
    LAS float* lt = (LAS float*)lds; int acc = 0;
    for (int j = 0; j < NJOBS; ++j) { const ConvJob c = get_job(a, j); const int nt = (c.Npad / 256) * (c.K / 64);
        int t0 = vcu - (acc % G); if (t0 < 0) t0 += G;
        for (int t = t0; t < nt; t += G) conv_super(c, t, lt, tid_);
        acc += nt; }
    for (int u = vcu; u < 64; u += G) { const int i = u >> 4, nl = tid_ & 15, kp = tid_ >> 4, n = (u & 15) * 16 + nl; float s = 0.f;
        const float* pe = a.cmp_pe + (size_t)i * 2048; const float* w1 = a.cmp_w1 + (size_t)i * 2048 * 256;
#pragma unroll 16
        for (int j = 0; j < 64; ++j) s += pe[kp + 32 * j] * w1[(size_t)(kp + 32 * j) * 256 + n];
        __syncthreads(); lt[kp * 16 + nl] = s; __syncthreads();
        if (kp == 0) { float t = 0.f;
#pragma unroll
            for (int q = 0; q < 32; ++q) t += lt[q * 16 + nl];
            a.bias1[i * 256 + n] = t; } }
    for (int idx = vcu * NT + tid_; idx < 4096 * 32; idx += G * NT) { const int pos = idx >> 5, i = idx & 31; const float inv = powf(10000.f, -(float)i / 32.f), ang = (float)pos * inv;
        a.rot[idx * 2] = cosf(ang); a.rot[idx * 2 + 1] = sinf(ang); }
    const int lane = tid_ & 63;
    for (int row0 = (vcu * NW + (tid_ >> 6)) * 4; row0 < NTOK; row0 += G * NW * 4) {
        f32x4 v[4][4];
#pragma unroll
        for (int rr = 0; rr < 4; ++rr)
#pragma unroll
            for (int i = 0; i < 4; ++i) v[rr][i] = *(const f32x4*)(a.x + (size_t)(row0 + rr) * DM + lane * 4 + 256 * i);
#pragma unroll
        for (int rr = 0; rr < 4; ++rr) { float sq = 0.f;
#pragma unroll
            for (int i = 0; i < 4; ++i) { const f32x4 t = v[rr][i]; sq += (t[0] * t[0] + t[1] * t[1]) + (t[2] * t[2] + t[3] * t[3]);
                uint2 o; o.x = pk2bf(t[0], t[1]); o.y = pk2bf(t[2], t[3]); *(uint2*)(a.xb + (size_t)(row0 + rr) * DM + lane * 4 + 256 * i) = o; }
            sq = wsum(sq); if (lane < NSLOT) a.ssq[(size_t)(row0 + rr) * NSLOT + lane] = lane == 0 ? sq : 0.f; } }
}

struct APlain { const bf16_t* A; int lda; __device__ __forceinline__ const bf16_t* ptr(int row, int k) const { return A + (size_t)row * lda + k; } };
struct AGather { const bf16_t* A; const int* row_tok; int lda; __device__ __forceinline__ const bf16_t* ptr(int row, int k) const { const int t = row_tok[row]; return t < 0 ? nullptr : A + (size_t)t * lda + k; } };
struct ACmp { const bf16_t* proj; int coloff;
    __device__ __forceinline__ const bf16_t* ptr(int row, int k) const { const int c = row & 255, g = (row >> 8) & 1, b = row >> 9; if (c == 255) return nullptr;
        return proj + (size_t)(b * SEQ + 16 * c + (k >> 6)) * DINP + coloff + g * 64 + (k & 63); } };
struct SchedPlain { int nM, nN; __device__ __forceinline__ int count() const { return nM * nN; }
    __device__ __forceinline__ void get(int u, int& row0, int& col0, size_t& boff) const { row0 = (u / nN) * 256; col0 = (u % nN) * 256; boff = 0; } };
struct SchedMoe { const int* meta; const int* tile_exp; size_t estride; int nN;
    __device__ __forceinline__ int count() const { return meta[0] * nN; }
    __device__ __forceinline__ void get(int u, int& row0, int& col0, size_t& boff) const { row0 = (u / nN) * 256; col0 = (u % nN) * 256; boff = (size_t)tile_exp[row0 >> 8] * estride; } };

struct EpiIn { bf16_t* proj; const float* ssq;
    __device__ __forceinline__ void apply(const f32x4 (&acc)[2][16], int rowb, int col0, int lane) const {
#pragma unroll
        for (int mi = 0; mi < 2; ++mi)
#pragma unroll
            for (int r = 0; r < 4; ++r) { const int row = rowb + mi * 16 + (lane >> 4) * 4 + r; const float rs = row_rstd(ssq, row);
#pragma unroll
                for (int n = 0; n < 16; ++n) proj[(size_t)row * DINP + col0 + n * 16 + (lane & 15)] = f2bf(acc[mi][n][r] * rs); } } };
struct EpiRes { const float* xold; float* xnew; bf16_t* xb; float* ssq;
    __device__ __forceinline__ void apply(const f32x4 (&acc)[2][16], int rowb, int col0, int lane) const {
#pragma unroll
        for (int mi = 0; mi < 2; ++mi)
#pragma unroll
            for (int r = 0; r < 4; ++r) { const int row = rowb + mi * 16 + (lane >> 4) * 4 + r; float s = 0.f;
#pragma unroll
                for (int n = 0; n < 16; ++n) { const size_t o = (size_t)row * DM + col0 + n * 16 + (lane & 15); const float v = xold[o] + acc[mi][n][r]; xnew[o] = v; xb[o] = f2bf(v); s += v * v; }
                s += __shfl_xor(s, 1); s += __shfl_xor(s, 2); s += __shfl_xor(s, 4); s += __shfl_xor(s, 8);
                if ((lane & 15) < 4) ssq[(size_t)row * NSLOT + (col0 >> 8) * 4 + (lane & 15)] = (lane & 15) == 0 ? s : 0.f; } } };
struct EpiSwiglu { bf16_t* h; const float* ssq; const int* row_tok;
    __device__ __forceinline__ void apply(const f32x4 (&acc)[2][16], int rowb, int col0, int lane) const {
#pragma unroll
        for (int mi = 0; mi < 2; ++mi)
#pragma unroll
            for (int r = 0; r < 4; ++r) { const int row = rowb + mi * 16 + (lane >> 4) * 4 + r; const int t = row_tok ? row_tok[row] : row;
                const float rs = t < 0 ? 0.f : row_rstd(ssq, t < 0 ? 0 : t);
#pragma unroll
                for (int n = 0; n < 8; ++n) { const float av = acc[mi][n][r] * rs, bv = acc[mi][n + 8][r] * rs; h[(size_t)row * DFF + (col0 >> 1) + n * 16 + (lane & 15)] = f2bf(siluf(av) * bv); } } } };
struct EpiStore { bf16_t* out; int ldc, coloff, ncols;
    __device__ __forceinline__ void apply(const f32x4 (&acc)[2][16], int rowb, int col0, int lane) const {
#pragma unroll
        for (int mi = 0; mi < 2; ++mi)
#pragma unroll
            for (int r = 0; r < 4; ++r) { const int row = rowb + mi * 16 + (lane >> 4) * 4 + r;
#pragma unroll
                for (int n = 0; n < 16; ++n) { const int c = col0 + n * 16 + (lane & 15); if (c < ncols) out[(size_t)row * ldc + coloff + c] = f2bf(acc[mi][n][r]); } } } };
struct EpiStoreT { bf16_t* out;
    __device__ __forceinline__ void apply(const f32x4 (&acc)[2][16], int rowb, int col0, int lane) const {
#pragma unroll
        for (int mi = 0; mi < 2; ++mi)
#pragma unroll
            for (int r = 0; r < 4; ++r) { const int row = rowb + mi * 16 + (lane >> 4) * 4 + r;
#pragma unroll
                for (int n = 0; n < 4; ++n) { const int c = col0 + n * 16 + (lane & 15); out[(size_t)(row >> 8) * 16384 + c * 256 + (row & 255)] = f2bf(acc[mi][n][r]); } } } };
struct EpiSiluBias { bf16_t* out; const float* bias; int ldc;
    __device__ __forceinline__ void apply(const f32x4 (&acc)[2][16], int rowb, int col0, int lane) const {
#pragma unroll
        for (int mi = 0; mi < 2; ++mi)
#pragma unroll
            for (int r = 0; r < 4; ++r) { const int row = rowb + mi * 16 + (lane >> 4) * 4 + r;
#pragma unroll
                for (int n = 0; n < 16; ++n) { const int c = col0 + n * 16 + (lane & 15); out[(size_t)row * ldc + c] = f2bf(siluf(acc[mi][n][r] + bias[c])); } } } };

template <class AS, class Epi, class Sched>
__device__ __forceinline__ void ph_gemm(LAS char* lds, const AS as, const bf16_t* __restrict__ Bt, const int K, const Epi epi, const Sched sched, int vcu, int G) {
    int tid_ = threadIdx.x; asm volatile("" : "+v"(tid_)); asm volatile("" : "+s"(vcu));
    LAS bf16_t* sA = (LAS bf16_t*)lds; LAS bf16_t* sB = (LAS bf16_t*)(lds + 256 * 40 * 2);
    const int tid = tid_, wave = tid >> 6, lane = tid & 63;
    const int nunits = sched.count();
    for (int u = vcu; u < nunits; u += G) {
        int row0, col0; size_t boff; sched.get(u, row0, col0, boff);
        const bf16_t* Bu = Bt + boff;
        f32x4 acc[2][16];
#pragma unroll
        for (int mi = 0; mi < 2; ++mi)
#pragma unroll
            for (int n = 0; n < 16; ++n) acc[mi][n] = (f32x4){0.f, 0.f, 0.f, 0.f};
#pragma unroll 1
        for (int k0 = 0; k0 < K; k0 += 32) {
#pragma unroll
            for (int i = 0; i < 2; ++i) { const int c = tid + i * NT, r = c >> 2, kc = (c & 3) * 8; const bf16_t* p = as.ptr(row0 + r, k0 + kc);
                uint4 v = make_uint4(0u, 0u, 0u, 0u); if (p) v = *(const uint4*)p; *(LAS u32x4_t*)&sA[r * 40 + kc] = (u32x4_t){v.x, v.y, v.z, v.w}; }
#pragma unroll
            for (int i = 0; i < 2; ++i) { const int c = tid + i * NT, r = c >> 2, kc = (c & 3) * 8;
                *(LAS u32x4_t*)&sB[r * 40 + kc] = *(const u32x4_t*)(Bu + (size_t)(col0 + r) * K + k0 + kc); }
            __syncthreads();
            bf16x8 af[2];
#pragma unroll
            for (int mi = 0; mi < 2; ++mi) af[mi] = *(const LAS bf16x8*)&sA[(wave * 32 + mi * 16 + (lane & 15)) * 40 + (lane >> 4) * 8];
#pragma unroll
            for (int n = 0; n < 16; ++n) { const bf16x8 bfr = *(const LAS bf16x8*)&sB[(n * 16 + (lane & 15)) * 40 + (lane >> 4) * 8];
#pragma unroll
                for (int mi = 0; mi < 2; ++mi) acc[mi][n] = __builtin_amdgcn_mfma_f32_16x16x32_bf16(af[mi], bfr, acc[mi][n], 0, 0, 0); }
            __syncthreads();
        }
        epi.apply(acc, row0 + wave * 32, col0, lane);
    }
}


namespace pg8 {
#define PG8_LAS __attribute__((address_space(3)))
typedef unsigned u32x4 __attribute__((ext_vector_type(4)));
typedef unsigned u32x2 __attribute__((ext_vector_type(2)));
constexpr int BM = 256, BK = 64, HALF = 128, HTB = HALF * BK * 2  , STAGE_BYTES = 8 * HTB, NXCD = 8, WGM = 8;
__host__ __device__ __forceinline__ int lds_byte(int r, int c) { const int st = (r >> 4) * 2 + (c >> 5), rr = r & 15, cc = c & 31, ob = rr * 64 + cc * 2; return st * 1024 + (ob ^ (((ob >> 9) & 1) << 5)); }
__host__ __device__ __forceinline__ void stage_rc(int b, int& R, int& C) { const int st = b / 1024, sb = b % 1024, swz = sb ^ (((sb >> 9) & 1) << 5); R = (st >> 1) * 16 + swz / 64; C = (st & 1) * 32 + (swz % 64) / 2; }
__host__ __device__ __forceinline__ int perm32(int rho) { const int n = rho >> 4, i = rho & 15; return 8 * (i >> 2) + 4 * n + (i & 3); }
struct Unit { int pm, pn; };
struct Gemm { const bf16_t* A; const bf16_t* Bt; int M, N, K; };
struct StaticOrder {
    int nM, nN, nwg, G, c;
    __device__ __forceinline__ void init(int M, int N, int G_, int c_) { nM = M / BM; nN = N / BM; nwg = nM * nN; G = G_; c = c_; }
    __device__ __forceinline__ bool next(int i, Unit& u) const {
        const long L = (long)i * G + c; if (L >= nwg) return false;
        int wgid = (int)L; { const int q = nwg / NXCD, r = nwg % NXCD, xcd = wgid % NXCD, off = wgid / NXCD; wgid = (xcd < r ? xcd * (q + 1) : r * (q + 1) + (xcd - r) * q) + off; }
        const int nig = WGM * nN, gid = wgid / nig, fm = gid * WGM, gsz = (nM - fm) < WGM ? (nM - fm) : WGM;
        u.pm = fm + ((wgid % nig) % gsz); u.pn = (wgid % nig) / gsz; return true;
    }
};
__device__ __forceinline__ unsigned cvt_pk_bf16(float lo, float hi) { unsigned r; asm volatile("v_cvt_pk_bf16_f32 %0, %1, %2" : "=v"(r) : "v"(lo), "v"(hi)); return r; }

template <class Epi, class Sched, int AMODE>
__device__ __forceinline__ void gemm_phase(PG8_LAS unsigned char* lds, const Gemm g, const Sched& S, const Epi& E, const int* __restrict__ rowmap, const int* __restrict__ tile_exp, const size_t estride) {
    constexpr bool GATHER = AMODE != 0;
    int tid = threadIdx.x; asm volatile("" : "+v"(tid));
    const int wid = __builtin_amdgcn_readfirstlane(tid >> 6), lane = tid & 63, wr = wid >> 2, wc = wid & 3, fr = lane & 15, fq = lane >> 4;
    const int K = g.K, nt = K / BK;
    unsigned voffA[2], voffB[2]; int rA[2];
#pragma unroll
    for (int i = 0; i < 2; ++i) { int R, C; stage_rc(tid * 16 + i * 8192, R, C); const int Rb = (R & ~31) + perm32(R & 31);
        voffA[i] = (unsigned)(R * K + C) * 2u; voffB[i] = (unsigned)(Rb * K + C) * 2u; rA[i] = R; if (GATHER) voffA[i] = (unsigned)C * 2u; }
    const size_t kstep = (size_t)(BK * 2);
    const size_t kstepA = AMODE == 2 ? (size_t)DINP * 2 : kstep;
    const size_t hstep = (size_t)HALF * K * 2;
    const size_t tstep = 2 * hstep;
    const unsigned ldsw = (unsigned)wid * 1024u;
    const int aoff = lds_byte(wr * 64 + fr, fq * 8), boff = lds_byte(wc * 32 + fr, fq * 8);
#define PG8_SA(b, h) (((b) * 2 + (h)) * HTB)
#define PG8_SB(b, h) ((4 + (b) * 2 + (h)) * HTB)
#define PG8_STAGE(bufoff, gbase, voff) do { _Pragma("unroll") for (int _i = 0; _i < 2; ++_i) \
        __builtin_amdgcn_global_load_lds((const unsigned*)((const char*)(gbase) + (voff)[_i]), (PG8_LAS unsigned*)(lds + (bufoff) + ldsw + _i * 8192), 16, 0, 0); } while (0)
#define PG8_LDA(dst, b, h) do { _Pragma("unroll") for (int m = 0; m < 4; ++m) _Pragma("unroll") for (int k = 0; k < 2; ++k) dst[m][k] = *(const PG8_LAS bf16x8*)(lds + PG8_SA(b, h) + aoff + m * 2048 + k * 1024); } while (0)
#define PG8_LDB(dst, b, h) do { _Pragma("unroll") for (int n = 0; n < 2; ++n) _Pragma("unroll") for (int k = 0; k < 2; ++k) dst[n][k] = *(const PG8_LAS bf16x8*)(lds + PG8_SB(b, h) + boff + n * 2048 + k * 1024); } while (0)
#define PG8_MMA(ai, bj, At, Bt) do { __builtin_amdgcn_s_setprio(1); _Pragma("unroll") for (int m = 0; m < 4; ++m) _Pragma("unroll") for (int n = 0; n < 2; ++n) _Pragma("unroll") for (int k = 0; k < 2; ++k) \
        acc[ai][bj][m][n] = __builtin_amdgcn_mfma_f32_16x16x32_bf16(Bt[n][k], At[m][k], acc[ai][bj][m][n], 0, 0, 0); __builtin_amdgcn_s_setprio(0); } while (0)
#define PG8_WAIT_V(n) asm volatile("s_waitcnt vmcnt(" #n ")" ::: "memory")
#define PG8_WAIT_L(n) asm volatile("s_waitcnt lgkmcnt(" #n ")" ::: "memory")
#define PG8_BAR __builtin_amdgcn_s_barrier()
#define PG8_SCHED __builtin_amdgcn_sched_barrier(0)
    unsigned vgc[2][2], vgn[2][2];
#define PG8_GOFF(dst, pm_) do { if constexpr (AMODE == 1) { _Pragma("unroll") for (int _h = 0; _h < 2; ++_h) _Pragma("unroll") for (int _i = 0; _i < 2; ++_i) { int _t = rowmap[(pm_) * BM + _h * HALF + rA[_i]]; _t = _t < 0 ? 0 : _t; \
        dst[_h][_i] = (unsigned)_t * (unsigned)(K * 2) + voffA[_i]; } } \
      else if constexpr (AMODE == 2) { _Pragma("unroll") for (int _h = 0; _h < 2; ++_h) _Pragma("unroll") for (int _i = 0; _i < 2; ++_i) { const int _r = (pm_) * BM + _h * HALF + rA[_i]; int _c = _r & 255; _c = _c > 254 ? 254 : _c; \
        dst[_h][_i] = (unsigned)(((_r >> 9) * SEQ + 16 * _c) * DINP + (int)estride + ((_r >> 8) & 1) * 64) * 2u + voffA[_i]; } } } while (0)
#define PG8_STA(bufoff, gptr, h, arr) do { if constexpr (GATHER) { PG8_STAGE(bufoff, gptr, arr[h]); } else { PG8_STAGE(bufoff, (gptr) + ((h) ? hstep : 0), voffA); } } while (0)
    Unit cur, nxt; int ui = 0;
    if (!S.next(0, cur)) return;
    f32x4 acc[2][2][4][2];
#pragma unroll
    for (int a = 0; a < 2; ++a)
#pragma unroll
        for (int b = 0; b < 2; ++b)
#pragma unroll
            for (int m = 0; m < 4; ++m)
#pragma unroll
                for (int n = 0; n < 2; ++n) acc[a][b][m][n] = (f32x4){0.f, 0.f, 0.f, 0.f};
    bf16x8 At[4][2], B0[2][2], B1[2][2];
    const char* cA = (const char*)g.A + (GATHER ? (size_t)0 : (size_t)cur.pm * tstep);
    const char* cB = (const char*)g.Bt + (tile_exp ? (size_t)tile_exp[cur.pm] * estride * 2 : (size_t)0) + (size_t)cur.pn * tstep;
    PG8_GOFF(vgc, cur.pm);
    PG8_STAGE(PG8_SB(0, 0), cB, voffB); PG8_STAGE(PG8_SB(0, 1), cB + hstep, voffB); PG8_STA(PG8_SA(0, 0), cA, 0, vgc); PG8_STA(PG8_SA(0, 1), cA, 1, vgc);
    if (wr == 1) PG8_BAR;
    PG8_WAIT_V(2); PG8_BAR;
    PG8_STAGE(PG8_SB(1, 0), cB + kstep, voffB); PG8_STA(PG8_SA(1, 0), cA + kstepA, 0, vgc); PG8_STAGE(PG8_SB(1, 1), cB + hstep + kstep, voffB);
    PG8_WAIT_V(6); PG8_BAR;
    for (;;) {
        const bool has_next = S.next(ui + 1, nxt);
        const char* nA = has_next ? (const char*)g.A + (GATHER ? (size_t)0 : (size_t)nxt.pm * tstep) : cA;
        const char* nB = has_next ? (const char*)g.Bt + (tile_exp ? (size_t)tile_exp[nxt.pm] * estride * 2 : (size_t)0) + (size_t)nxt.pn * tstep : cB;
        if constexpr (GATHER) { if (has_next) { PG8_GOFF(vgn, nxt.pm); } else {
#pragma unroll
            for (int _h = 0; _h < 2; ++_h)
#pragma unroll
                for (int _i = 0; _i < 2; ++_i) vgn[_h][_i] = vgc[_h][_i]; } }
        for (int t = 0; t < nt; t += 2) {
            const bool last = (t == nt - 2);
            const char* a1 = cA + (size_t)(t + 1) * kstepA;
            const char* a2 = last ? nA : cA + (size_t)(t + 2) * kstepA; const char* b2 = last ? nB : cB + (size_t)(t + 2) * kstep;
            const char* a3 = a2 + kstepA; const char* b3 = b2 + kstep;
            unsigned v2[2][2];
            if constexpr (GATHER) {
#pragma unroll
            for (int _h = 0; _h < 2; ++_h)
#pragma unroll
                for (int _i = 0; _i < 2; ++_i) v2[_h][_i] = last ? vgn[_h][_i] : vgc[_h][_i]; }
            PG8_LDB(B0, 0, 0); PG8_LDB(B1, 0, 1); PG8_SCHED; PG8_LDA(At, 0, 0); PG8_STA(PG8_SA(1, 1), a1, 1, vgc);
            PG8_WAIT_V(8); PG8_WAIT_L(0); PG8_BAR; PG8_MMA(0, 0, At, B0); PG8_MMA(0, 1, At, B1); PG8_BAR; PG8_SCHED;
            PG8_LDA(At, 0, 1); PG8_STAGE(PG8_SB(0, 0), b2, voffB); PG8_STAGE(PG8_SB(0, 1), b2 + hstep, voffB); PG8_STA(PG8_SA(0, 0), a2, 0, v2);
            PG8_WAIT_V(8); PG8_WAIT_L(0); PG8_BAR; PG8_MMA(1, 0, At, B0); PG8_MMA(1, 1, At, B1); PG8_BAR; PG8_SCHED;
            PG8_LDB(B0, 1, 0); PG8_LDB(B1, 1, 1); PG8_SCHED; PG8_LDA(At, 1, 0); PG8_STA(PG8_SA(0, 1), a2, 1, v2);
            PG8_WAIT_V(8); PG8_WAIT_L(0); PG8_BAR; PG8_MMA(0, 0, At, B0); PG8_MMA(0, 1, At, B1); PG8_BAR; PG8_SCHED;
            PG8_LDA(At, 1, 1); PG8_STAGE(PG8_SB(1, 0), b3, voffB); PG8_STAGE(PG8_SB(1, 1), b3 + hstep, voffB); PG8_STA(PG8_SA(1, 0), a3, 0, v2);
            PG8_WAIT_V(8); PG8_WAIT_L(0); PG8_BAR; PG8_MMA(1, 0, At, B0); PG8_MMA(1, 1, At, B1); PG8_BAR; PG8_SCHED;
        }
        if (wr == 0) PG8_BAR;
        E(acc, cur, wr, wc, fr, fq);
        if (!has_next) break;
#pragma unroll
        for (int a = 0; a < 2; ++a)
#pragma unroll
            for (int b = 0; b < 2; ++b)
#pragma unroll
                for (int m = 0; m < 4; ++m)
#pragma unroll
                    for (int n = 0; n < 2; ++n) acc[a][b][m][n] = (f32x4){0.f, 0.f, 0.f, 0.f};
        cur = nxt; cA = nA; cB = nB; ++ui;
        if constexpr (GATHER) {
#pragma unroll
        for (int _h = 0; _h < 2; ++_h)
#pragma unroll
            for (int _i = 0; _i < 2; ++_i) vgc[_h][_i] = vgn[_h][_i]; }
        if (wr == 1) PG8_BAR;
    }
    PG8_WAIT_V(0);
    PG8_BAR;
#undef PG8_SA
#undef PG8_SB
#undef PG8_STAGE
#undef PG8_LDA
#undef PG8_LDB
#undef PG8_MMA
#undef PG8_WAIT_V
#undef PG8_WAIT_L
#undef PG8_BAR
#undef PG8_SCHED
#undef PG8_GOFF
#undef PG8_STA
}

typedef const f32x4 (&AccT)[2][2][4][2];
struct EIn { bf16_t* proj; const float* ssq;
    __device__ __forceinline__ void operator()(AccT acc, const Unit& u, int wr, int wc, int fr, int fq) const {
        const int col0 = u.pn * BM + wc * 32 + 8 * fq;
#pragma unroll
        for (int ai = 0; ai < 2; ++ai)
#pragma unroll
            for (int m = 0; m < 4; ++m) { const int row = u.pm * BM + ai * HALF + wr * 64 + m * 16 + fr; const float rs = row_rstd(ssq, row); bf16_t* rowp = proj + (size_t)row * DINP + col0;
#pragma unroll
                for (int bj = 0; bj < 2; ++bj) { const f32x4 v0 = acc[ai][bj][m][0] * rs, v1 = acc[ai][bj][m][1] * rs; u32x4 w; w.x = cvt_pk_bf16(v0[0], v0[1]); w.y = cvt_pk_bf16(v0[2], v0[3]); w.z = cvt_pk_bf16(v1[0], v1[1]); w.w = cvt_pk_bf16(v1[2], v1[3]);
                    *(u32x4*)(rowp + bj * HALF) = w; } } } };
struct ERes { const float* xin; bf16_t* xb; float* ssq;
    __device__ __forceinline__ void operator()(AccT acc, const Unit& u, int wr, int wc, int fr, int fq) const {
        const int col0 = u.pn * BM + wc * 32 + 8 * fq;
#pragma unroll
        for (int ai = 0; ai < 2; ++ai)
#pragma unroll
            for (int m = 0; m < 4; ++m) { const int row = u.pm * BM + ai * HALF + wr * 64 + m * 16 + fr; const size_t o = (size_t)row * DM + col0; float s = 0.f;
#pragma unroll
                for (int bj = 0; bj < 2; ++bj) { f32x4 x0, x1;
                    if (xin) { x0 = *(const f32x4*)(xin + o + bj * HALF); x1 = *(const f32x4*)(xin + o + bj * HALF + 4); }
                    else { const u32x4 w = *(const u32x4*)(xb + o + bj * HALF); x0 = (f32x4){__uint_as_float(w.x << 16), __uint_as_float(w.x & 0xffff0000u), __uint_as_float(w.y << 16), __uint_as_float(w.y & 0xffff0000u)};
                           x1 = (f32x4){__uint_as_float(w.z << 16), __uint_as_float(w.z & 0xffff0000u), __uint_as_float(w.w << 16), __uint_as_float(w.w & 0xffff0000u)}; }
                    const f32x4 v0 = x0 + acc[ai][bj][m][0], v1 = x1 + acc[ai][bj][m][1];
                    u32x4 w; w.x = cvt_pk_bf16(v0[0], v0[1]); w.y = cvt_pk_bf16(v0[2], v0[3]); w.z = cvt_pk_bf16(v1[0], v1[1]); w.w = cvt_pk_bf16(v1[2], v1[3]);
                    *(u32x4*)(xb + o + bj * HALF) = w;
                    s += (v0[0] * v0[0] + v0[1] * v0[1]) + (v0[2] * v0[2] + v0[3] * v0[3]) + (v1[0] * v1[0] + v1[1] * v1[1]) + (v1[2] * v1[2] + v1[3] * v1[3]); }
                s += __shfl_xor(s, 16); s += __shfl_xor(s, 32);
                if (fq == 0) ssq[(size_t)row * NSLOT + u.pn * 4 + wc] = s; } } };
struct ESwiglu { bf16_t* h; const float* ssq; const int* row_tok;
    __device__ __forceinline__ void operator()(AccT acc, const Unit& u, int wr, int wc, int fr, int fq) const {
        const int col0 = u.pn * HALF + wc * 32 + 8 * fq;
#pragma unroll
        for (int ai = 0; ai < 2; ++ai)
#pragma unroll
            for (int m = 0; m < 4; ++m) { const int row = u.pm * BM + ai * HALF + wr * 64 + m * 16 + fr; const int t = row_tok ? row_tok[row] : row; const float rs = t < 0 ? 0.f : row_rstd(ssq, t < 0 ? 0 : t);
                float o[8];
#pragma unroll
                for (int n = 0; n < 2; ++n)
#pragma unroll
                    for (int e = 0; e < 4; ++e) { const float av = acc[ai][0][m][n][e] * rs, bv = acc[ai][1][m][n][e] * rs; o[n * 4 + e] = siluf(av) * bv; }
                u32x4 w; w.x = cvt_pk_bf16(o[0], o[1]); w.y = cvt_pk_bf16(o[2], o[3]); w.z = cvt_pk_bf16(o[4], o[5]); w.w = cvt_pk_bf16(o[6], o[7]);
                *(u32x4*)(h + (size_t)row * DFF + col0) = w; } } };
struct ESiluBias { bf16_t* out; const float* bias;
    __device__ __forceinline__ void operator()(AccT acc, const Unit& u, int wr, int wc, int fr, int fq) const {
        const int col0 = u.pn * BM + wc * 32 + 8 * fq;
#pragma unroll
        for (int ai = 0; ai < 2; ++ai)
#pragma unroll
            for (int m = 0; m < 4; ++m) { const int row = u.pm * BM + ai * HALF + wr * 64 + m * 16 + fr; bf16_t* rowp = out + (size_t)row * 256 + col0;
#pragma unroll
                for (int bj = 0; bj < 2; ++bj) { const f32x4 b0 = *(const f32x4*)(bias + col0 + bj * HALF), b1 = *(const f32x4*)(bias + col0 + bj * HALF + 4); const f32x4 v0 = acc[ai][bj][m][0] + b0, v1 = acc[ai][bj][m][1] + b1;
                    u32x4 w; w.x = cvt_pk_bf16(siluf(v0[0]), siluf(v0[1])); w.y = cvt_pk_bf16(siluf(v0[2]), siluf(v0[3])); w.z = cvt_pk_bf16(siluf(v1[0]), siluf(v1[1])); w.w = cvt_pk_bf16(siluf(v1[2]), siluf(v1[3]));
                    *(u32x4*)(rowp + bj * HALF) = w; } } } };
struct EKc { bf16_t* out; int transposed, pad;
    __device__ __forceinline__ void operator()(AccT acc, const Unit& u, int wr, int wc, int fr, int fq) const {
        if (wc >= 2) return;
        const int col0 = wc * 32 + 8 * fq;
#pragma unroll
        for (int ai = 0; ai < 2; ++ai)
#pragma unroll
            for (int m = 0; m < 4; ++m) { const int row = u.pm * BM + ai * HALF + wr * 64 + m * 16 + fr; const f32x4 v0 = acc[ai][0][m][0], v1 = acc[ai][0][m][1];
                if (!transposed) { u32x4 w; w.x = cvt_pk_bf16(v0[0], v0[1]); w.y = cvt_pk_bf16(v0[2], v0[3]); w.z = cvt_pk_bf16(v1[0], v1[1]); w.w = cvt_pk_bf16(v1[2], v1[3]); *(u32x4*)(out + (size_t)row * 64 + col0) = w; }
                else { bf16_t* o = out + (size_t)(row >> 8) * 16384 + (size_t)col0 * 256 + (row & 255);
#pragma unroll
                    for (int x = 0; x < 4; ++x) { o[x * 256] = f2bf(v0[x]); o[(4 + x) * 256] = f2bf(v1[x]); } } } } };
struct EStore { bf16_t* out; int ldc;
    __device__ __forceinline__ void operator()(AccT acc, const Unit& u, int wr, int wc, int fr, int fq) const {
        const int col0 = u.pn * BM + wc * 32 + 8 * fq;
#pragma unroll
        for (int ai = 0; ai < 2; ++ai)
#pragma unroll
            for (int m = 0; m < 4; ++m) { const int row = u.pm * BM + ai * HALF + wr * 64 + m * 16 + fr; bf16_t* rowp = out + (size_t)row * ldc + col0;
#pragma unroll
                for (int bj = 0; bj < 2; ++bj) { const f32x4 v0 = acc[ai][bj][m][0], v1 = acc[ai][bj][m][1]; u32x4 w; w.x = cvt_pk_bf16(v0[0], v0[1]); w.y = cvt_pk_bf16(v0[2], v0[3]); w.z = cvt_pk_bf16(v1[0], v1[1]); w.w = cvt_pk_bf16(v1[2], v1[3]);
                    *(u32x4*)(rowp + bj * HALF) = w; } } } };
}

#ifndef NSA_REP_SEL
#define NSA_REP_SEL 1
#endif
#ifndef NSA_REP_WIN
#define NSA_REP_WIN 1
#endif
namespace nsa {
typedef float f32x16 __attribute__((ext_vector_type(16)));
typedef unsigned u32x4 __attribute__((ext_vector_type(4)));
typedef unsigned u32x2 __attribute__((ext_vector_type(2)));
constexpr int KSTR = 144, VSTR = 144;
constexpr int KT_B = 64 * KSTR, VT_B = 64 * VSTR, BUF_B = KT_B + VT_B;
constexpr int IMP_OFF = 2 * BUF_B  , SELM_OFF = IMP_OFF + 8 * 2048  , WUN_OFF = SELM_OFF + 512;
constexpr float L2E = 1.4426950408889634f;
#define NLAS __attribute__((address_space(3)))
__device__ __forceinline__ unsigned pk2(float lo, float hi) { unsigned r; asm volatile("v_cvt_pk_bf16_f32 %0, %1, %2" : "=v"(r) : "v"(lo), "v"(hi)); return r; }
struct Stage { u32x4 k, v; };
__device__ __forceinline__ void stage_issue(Stage& st, const bf16_t* kg, size_t kstride, const bf16_t* vg, size_t vstride, int tid) {
    const int r = tid >> 3, c = (tid & 7) * 8;
    st.k = *(const u32x4*)(kg + (size_t)r * kstride + c); st.v = *(const u32x4*)(vg + (size_t)r * vstride + c);
}
__device__ __forceinline__ void stage_write(const Stage& st, NLAS char* buf, int tid) {
    const int r = tid >> 3, c = (tid & 7) * 16;
    *(NLAS u32x4*)(buf + r * KSTR + c) = st.k;
    { const int cc = tid & 7, vo = KT_B + r * VSTR + (cc >> 1) * 32 + (cc & 1) * 8;
      *(NLAS u32x2*)(buf + vo) = (u32x2){st.v.x, st.v.y}; *(NLAS u32x2*)(buf + vo + 16) = (u32x2){st.v.z, st.v.w}; }
}
__device__ __forceinline__ void compute_S(NLAS const char* buf, const bf16x8 (&Qf)[4], f32x16& S0, f32x16& S1, int lane) {
    const int kr = lane & 31, hi = lane >> 5;
#pragma unroll
    for (int i = 0; i < 16; ++i) { S0[i] = 0.f; S1[i] = 0.f; }
    bf16x8 af[8];
#pragma unroll
    for (int s = 0; s < 4; ++s) { af[2 * s] = *(NLAS const bf16x8*)(buf + kr * KSTR + s * 32 + hi * 16); af[2 * s + 1] = *(NLAS const bf16x8*)(buf + (32 + kr) * KSTR + s * 32 + hi * 16); }
    __builtin_amdgcn_sched_barrier(0);
#pragma unroll
    for (int s = 0; s < 4; ++s) { S0 = __builtin_amdgcn_mfma_f32_32x32x16_bf16(af[2 * s], Qf[s], S0, 0, 0, 0); S1 = __builtin_amdgcn_mfma_f32_32x32x16_bf16(af[2 * s + 1], Qf[s], S1, 0, 0, 0); }
}
__device__ __forceinline__ void mask_S(f32x16& S0, f32x16& S1, int lo, int hi, int lane) {
    const int h4 = (lane >> 5) * 4, lo2 = lo - h4, hi2 = hi - h4;
#pragma unroll
    for (int i = 0; i < 16; ++i) { const int c0 = (i & 3) + 8 * (i >> 2); S0[i] = (c0 >= lo2 && c0 <= hi2) ? S0[i] : -INFINITY; S1[i] = (c0 + 32 >= lo2 && c0 + 32 <= hi2) ? S1[i] : -INFINITY; }
}
__device__ __forceinline__ float max3f(float a, float b, float c) { float r; asm("v_max3_f32 %0, %1, %2, %3" : "=v"(r) : "v"(a), "v"(b), "v"(c)); return r; }
__device__ __forceinline__ float max_S(const f32x16& S0, const f32x16& S1) { float m = max3f(S0[0], S1[0], S0[1]);
    m = max3f(m, S1[1], S0[2]); m = max3f(m, S1[2], S0[3]); m = max3f(m, S1[3], S0[4]); m = max3f(m, S1[4], S0[5]); m = max3f(m, S1[5], S0[6]); m = max3f(m, S1[6], S0[7]); m = max3f(m, S1[7], S0[8]);
    m = max3f(m, S1[8], S0[9]); m = max3f(m, S1[9], S0[10]); m = max3f(m, S1[10], S0[11]); m = max3f(m, S1[11], S0[12]); m = max3f(m, S1[12], S0[13]); m = max3f(m, S1[13], S0[14]); m = max3f(m, S1[14], S0[15]);
    float o = __shfl_xor(m, 32); return max3f(m, S1[15], o); }
__device__ __forceinline__ float exp_S(f32x16& S0, f32x16& S1, float mL) { float l0 = 0.f, l1 = 0.f;
#pragma unroll
    for (int i = 0; i < 16; ++i) { S0[i] = __builtin_amdgcn_exp2f(fmaf(S0[i], L2E, -mL)); S1[i] = __builtin_amdgcn_exp2f(fmaf(S1[i], L2E, -mL)); l0 += S0[i]; l1 += S1[i]; }
    return l0 + l1; }
__device__ __forceinline__ void pack_P(const f32x16& S0, const f32x16& S1, unsigned andm, bf16x8 (&Pf)[4]) {
#pragma unroll
    for (int s2 = 0; s2 < 4; ++s2) { u32x4 w;
#pragma unroll
        for (int q = 0; q < 4; ++q) { const int i = (s2 & 1) * 8 + q * 2; w[q] = (s2 < 2 ? pk2(S0[i], S0[i + 1]) : pk2(S1[i], S1[i + 1])) & andm; }
        Pf[s2] = __builtin_bit_cast(bf16x8, w); }
}
__device__ __forceinline__ void pv(NLAS const char* buf, const bf16x8 (&Pf)[4], f32x16& O0, f32x16& O1, int lane) {
    const int dr = lane & 31, hi = lane >> 5; NLAS const char* vt = buf + KT_B;
    bf16x8 vf[8];
#pragma unroll
    for (int s2 = 0; s2 < 4; ++s2) { vf[2 * s2] = *(NLAS const bf16x8*)(vt + dr * VSTR + (16 * s2 + 8 * hi) * 2); vf[2 * s2 + 1] = *(NLAS const bf16x8*)(vt + (32 + dr) * VSTR + (16 * s2 + 8 * hi) * 2); }
    __builtin_amdgcn_sched_barrier(0);
#pragma unroll
    for (int s2 = 0; s2 < 4; ++s2) { O0 = __builtin_amdgcn_mfma_f32_32x32x16_bf16(vf[2 * s2], Pf[s2], O0, 0, 0, 0); O1 = __builtin_amdgcn_mfma_f32_32x32x16_bf16(vf[2 * s2 + 1], Pf[s2], O1, 0, 0, 0); }
}
__device__ __forceinline__ void online_block(NLAS const char* buf, const bf16x8 (&Qf)[4], f32x16& O0, f32x16& O1, float& m, float& l, bool lane_on, bool use_mask, int lo, int hi, int lane) {
    f32x16 S0, S1; compute_S(buf, Qf, S0, S1, lane);
    if (use_mask) mask_S(S0, S1, lo, hi, lane);
    float mt = max_S(S0, S1); if (!lane_on) mt = -INFINITY;
    const float mn = max3f(m, mt, mt), ms = mn == -INFINITY ? 0.f : mn;
    const float ls = exp_S(S0, S1, ms * L2E);
    if (__any(mn != m)) { const float al = __builtin_amdgcn_exp2f((m - ms) * L2E); l *= al;
#pragma unroll
        for (int i = 0; i < 16; ++i) { O0[i] *= al; O1[i] *= al; } }
    l += (lane_on ? ls : 0.f); m = mn;
    bf16x8 Pf[4]; pack_P(S0, S1, lane_on ? 0xffffffffu : 0u, Pf);
    pv(buf, Pf, O0, O1, lane);
}

struct BitIter { unsigned long long rem; __device__ __forceinline__ int next() { if (!rem) return -1; const int j = __builtin_ctzll(rem); rem &= rem - 1; return j; } };
struct RangeIter { int cur, end; __device__ __forceinline__ int next() { return cur <= end ? cur++ : -1; } };
struct SelPar { unsigned long long mq; int qb, tq;
    __device__ __forceinline__ void get(int j, bool& on, bool& um, int& lo, int& hi) const { on = (mq >> j) & 1ull; um = (j == qb); lo = 0; hi = tq; } };
struct WinPar { int qb, tq;
    __device__ __forceinline__ void get(int j, bool& on, bool& um, int& lo, int& hi) const { const bool first = (j == qb - 8), diag = (j == qb); on = true; um = first || diag; lo = first ? tq + 1 : 0; hi = diag ? tq : 63; } };
template <class It, class Par>
__device__ __forceinline__ void run_blocks(It it, const Par par, const bf16_t* kg, const bf16_t* vg, NLAS char* lds, const bf16x8 (&Qf)[4], f32x16& O0, f32x16& O1, float& m, float& l, int tid, int lane) {
    int j0 = it.next(), j1 = it.next();
    Stage sa, sb;
    stage_issue(sa, kg + (size_t)j0 * 64 * DINP, DINP, vg + j0 * 64, SEQ, tid);
    { const int jj = j1 >= 0 ? j1 : 0; stage_issue(sb, kg + (size_t)jj * 64 * DINP, DINP, vg + jj * 64, SEQ, tid); }
    stage_write(sa, lds, tid); __syncthreads();
    for (;;) {
        const int j2 = it.next();
        { const int jj = j2 >= 0 ? j2 : 0; stage_issue(sa, kg + (size_t)jj * 64 * DINP, DINP, vg + jj * 64, SEQ, tid); }
        { bool on, um; int lo, hi; par.get(j0, on, um, lo, hi); if (__any(on)) online_block(lds, Qf, O0, O1, m, l, on, um, lo, hi, lane); }
        stage_write(sb, lds + BUF_B, tid);
        __syncthreads();
        if (j1 < 0) break;
        const int j3 = it.next();
        { const int jj = j3 >= 0 ? j3 : 0; stage_issue(sb, kg + (size_t)jj * 64 * DINP, DINP, vg + jj * 64, SEQ, tid); }
        { bool on, um; int lo, hi; par.get(j1, on, um, lo, hi); if (__any(on)) online_block(lds + BUF_B, Qf, O0, O1, m, l, on, um, lo, hi, lane); }
        stage_write(sa, lds, tid);
        __syncthreads();
        if (j2 < 0) break;
        j0 = j2; j1 = j3;
    }
    __syncthreads();
}
}

__device__ __forceinline__ void nsa_unit(const Args& a, LAS char* lds_, const int qb, const int bg) {
    using namespace nsa;
    int tid = threadIdx.x; asm volatile("" : "+v"(tid));
    NLAS char* lds = lds_;
    const int w = __builtin_amdgcn_readfirstlane(tid >> 6), lane = tid & 63, hi = lane >> 5, r = lane & 31, tql = r >> 2, hpg = r & 3;
    NLAS float* impw = (NLAS float*)(lds + IMP_OFF + w * 2048);
    NLAS unsigned long long* selm = (NLAS unsigned long long*)(lds + SELM_OFF);
    NLAS unsigned long long* wun = (NLAS unsigned long long*)(lds + WUN_OFF);
    const bf16_t* proj = a.proj;
    {
        const int b = bg >> 1, g = bg & 1;
        const int tq = 8 * w + tql, t = 64 * qb + tq; const size_t row = (size_t)b * SEQ + t; const bf16_t* prow = proj + row * DINP;
        bf16x8 Qf[4];
#pragma unroll
        for (int s = 0; s < 4; ++s) Qf[s] = *(const bf16x8*)(prow + C_Q + g * 256 + hpg * 64 + 16 * s + 8 * hi);
        f32x16 Oo0, Oo1;
        const int hh = g * 4 + hpg; const float g0 = sigmf(bf2f(prow[C_GL + hh * 3 + 0])), g1 = sigmf(bf2f(prow[C_GL + hh * 3 + 1])), g2 = sigmf(bf2f(prow[C_GL + hh * 3 + 2]));
        Stage st;
        const bf16_t* kcg = a.kcb + (size_t)bg * 256 * 64; const bf16_t* vcg = a.vcT + (size_t)bg * 64 * 256;
        const int nbc = (4 * qb + 3 + 63) >> 6;
        const int cmax = t >= 31 ? (t - 31) >> 4 : -1;
        float mc = -INFINITY, lc = 0.f;
        __syncthreads();
        stage_issue(st, kcg, 64, vcg, 256, tid); stage_write(st, lds, tid); __syncthreads();
        for (int kb = 0; kb < nbc; ++kb) {
            NLAS char* buf = lds + (kb & 1) * BUF_B;
            if (kb + 1 < nbc) stage_issue(st, kcg + (size_t)(kb + 1) * 64 * 64, 64, vcg + (kb + 1) * 64, 256, tid);
            f32x16 S0, S1; compute_S(buf, Qf, S0, S1, lane); mask_S(S0, S1, 0, cmax - 64 * kb, lane);
            const float mt = max_S(S0, S1), mn = max3f(mc, mt, mt), ms = mn == -INFINITY ? 0.f : mn, al = __builtin_amdgcn_exp2f((mc - ms) * L2E);
            lc = lc * al + exp_S(S0, S1, ms * L2E); mc = mn;
            if (kb + 1 < nbc) stage_write(st, lds + ((kb + 1) & 1) * BUF_B, tid);
            __syncthreads();
        }
        lc += __shfl_xor(lc, 32);
        const float mLc = (mc == -INFINITY ? 0.f : mc) * L2E, ilc = lc > 0.f ? 1.f / lc : 0.f;
        f32x16 Oc0, Oc1, Z0, Z1;
#pragma unroll
        for (int i = 0; i < 16; ++i) { Oc0[i] = 0.f; Oc1[i] = 0.f; Z0[i] = 0.f; Z1[i] = 0.f; }
        stage_issue(st, kcg, 64, vcg, 256, tid); stage_write(st, lds, tid); __syncthreads();
        for (int kb = 0; kb < nbc; ++kb) {
            NLAS char* buf = lds + (kb & 1) * BUF_B;
            if (kb + 1 < nbc) stage_issue(st, kcg + (size_t)(kb + 1) * 64 * 64, 64, vcg + (kb + 1) * 64, 256, tid);
            f32x16 S0, S1; compute_S(buf, Qf, S0, S1, lane); mask_S(S0, S1, 0, cmax - 64 * kb, lane);
            (void)exp_S(S0, S1, mLc);
#pragma unroll
            for (int i = 0; i < 16; ++i) { S0[i] *= ilc; S1[i] *= ilc; }
            bf16x8 Pf[4]; pack_P(S0, S1, 0xffffffffu, Pf);
            pv(buf, Pf, Oc0, Oc1, lane);
#pragma unroll
            for (int s2 = 0; s2 < 4; ++s2) {
#pragma unroll
                for (int stl = 0; stl < 2; ++stl) { const int sblk = 32 * stl + r; u32x4 wv;
#pragma unroll
                    for (int q = 0; q < 4; ++q) { unsigned x = 0u;
#pragma unroll
                        for (int e = 0; e < 2; ++e) { const int j = q * 2 + e, c = 64 * kb + 16 * s2 + 8 * (j >> 2) + 4 * hi + (j & 3); if (c >= 4 * sblk - 1 && c <= 4 * sblk + 3) x |= (0x3f80u << (16 * e)); }
                        wv[q] = x; }
                    if (stl == 0) Z0 = __builtin_amdgcn_mfma_f32_32x32x16_bf16(Pf[s2], __builtin_bit_cast(bf16x8, wv), Z0, 0, 0, 0);
                    else          Z1 = __builtin_amdgcn_mfma_f32_32x32x16_bf16(Pf[s2], __builtin_bit_cast(bf16x8, wv), Z1, 0, 0, 0); } }
            if (kb + 1 < nbc) stage_write(st, lds + ((kb + 1) & 1) * BUF_B, tid);
            __syncthreads();
        }
#pragma unroll
        for (int i = 0; i < 16; ++i) { Oo0[i] = g0 * Oc0[i]; Oo1[i] = g0 * Oc1[i]; }
#pragma unroll
        for (int q4 = 0; q4 < 4; ++q4) { impw[(2 * q4 + hi) * 64 + r] = (Z0[4 * q4] + Z0[4 * q4 + 1]) + (Z0[4 * q4 + 2] + Z0[4 * q4 + 3]); impw[(2 * q4 + hi) * 64 + 32 + r] = (Z1[4 * q4] + Z1[4 * q4 + 1]) + (Z1[4 * q4 + 2] + Z1[4 * q4 + 3]); }
        __syncthreads();
        unsigned long long wu = 0ull;
        for (int q = 0; q < 8; ++q) { const float imp = impw[q * 64 + lane];
            const bool valid = lane <= qb, forced = lane == 0 || lane == qb || lane == qb - 1; const float val = valid ? (forced ? 1e9f : imp) : -1e30f; int rank = 0;
#pragma unroll
            for (int s2 = 0; s2 < 64; ++s2) { const float v2 = __builtin_bit_cast(float, __builtin_amdgcn_readlane(__builtin_bit_cast(int, val), s2)); rank += (v2 > val || (v2 == val && s2 < lane)) ? 1 : 0; }
            const unsigned long long mk = __ballot(valid && rank < 16); wu |= mk;
            if (lane == 0) selm[8 * w + q] = mk; }
        if (lane == 0) wun[w] = wu;
        __syncthreads();
        unsigned long long um = 0ull;
#pragma unroll
        for (int q = 0; q < 8; ++q) um |= wun[q];
        um = ((unsigned long long)__builtin_amdgcn_readfirstlane((unsigned)(um >> 32)) << 32) | (unsigned)__builtin_amdgcn_readfirstlane((unsigned)um);
        const unsigned long long mq = selm[tq];
        {
            const bf16_t* kg = proj + (size_t)b * SEQ * DINP + C_KS + g * 64; const bf16_t* vg = a.VsT + (size_t)bg * 64 * SEQ;
            f32x16 O0, O1;
#pragma unroll
            for (int i = 0; i < 16; ++i) { O0[i] = 0.f; O1[i] = 0.f; }
            float m = -INFINITY, l = 0.f;
            for (int rep = 0; rep < NSA_REP_SEL; ++rep) {
#pragma unroll
            for (int i = 0; i < 16; ++i) { O0[i] = 0.f; O1[i] = 0.f; }
            m = -INFINITY; l = 0.f;
            run_blocks(BitIter{um}, SelPar{mq, qb, tq}, kg, vg, lds, Qf, O0, O1, m, l, tid, lane); }
            l += __shfl_xor(l, 32); const float sc = l > 0.f ? g1 / l : 0.f;
#pragma unroll
            for (int i = 0; i < 16; ++i) { Oo0[i] += sc * O0[i]; Oo1[i] += sc * O1[i]; }
        }
        {
            const bf16_t* kg = proj + (size_t)b * SEQ * DINP + C_KW + g * 64; const bf16_t* vg = a.VwT + (size_t)bg * 64 * SEQ;
            f32x16 O0, O1;
#pragma unroll
            for (int i = 0; i < 16; ++i) { O0[i] = 0.f; O1[i] = 0.f; }
            float m = -INFINITY, l = 0.f;
            for (int rep = 0; rep < NSA_REP_WIN; ++rep) {
#pragma unroll
            for (int i = 0; i < 16; ++i) { O0[i] = 0.f; O1[i] = 0.f; }
            m = -INFINITY; l = 0.f;
            run_blocks(RangeIter{qb - 8 > 0 ? qb - 8 : 0, qb}, WinPar{qb, tq}, kg, vg, lds, Qf, O0, O1, m, l, tid, lane); }
            l += __shfl_xor(l, 32); const float sc = l > 0.f ? g2 / l : 0.f;
#pragma unroll
            for (int i = 0; i < 16; ++i) { Oo0[i] += sc * O0[i]; Oo1[i] += sc * O1[i]; }
        }
        bf16_t* op = a.ocat + row * DM + hh * 64 + 4 * hi;
#pragma unroll
        for (int q4 = 0; q4 < 4; ++q4) { u32x2 w0, w1; w0.x = pk2(Oo0[4 * q4], Oo0[4 * q4 + 1]); w0.y = pk2(Oo0[4 * q4 + 2], Oo0[4 * q4 + 3]); w1.x = pk2(Oo1[4 * q4], Oo1[4 * q4 + 1]); w1.y = pk2(Oo1[4 * q4 + 2], Oo1[4 * q4 + 3]);
            *(u32x2*)(op + 8 * q4) = w0; *(u32x2*)(op + 32 + 8 * q4) = w1; }
    }
}

__device__ __forceinline__ void ph_vtrans(const Args& a, LAS char* lds_, int vcu, int G) {
    int tid = threadIdx.x; asm volatile("" : "+v"(tid)); asm volatile("" : "+s"(vcu));
    LAS bf16_t* tile = (LAS bf16_t*)lds_;
    for (int u = vcu; u < 2 * 16 * 64; u += G) { const int tb = u & 63, bg = (u >> 6) & 15, which = u >> 10, b = bg >> 1, g = bg & 1;
        const bf16_t* src = a.proj + ((size_t)b * SEQ + tb * 64) * DINP + (which ? C_VW : C_VS) + g * 64; bf16_t* dst = (which ? a.VwT : a.VsT) + (size_t)bg * 64 * SEQ + tb * 64;
        const int r = tid >> 3, c = (tid & 7) * 8;
        const uint4 v = *(const uint4*)(src + (size_t)r * DINP + c); const unsigned wv[4] = {v.x, v.y, v.z, v.w};
        __syncthreads();
#pragma unroll
        for (int e = 0; e < 4; ++e) { tile[(c + 2 * e) * 72 + r] = (bf16_t)(wv[e] & 0xffffu); tile[(c + 2 * e + 1) * 72 + r] = (bf16_t)(wv[e] >> 16); }
        __syncthreads();
        *(u32x4_t*)(dst + (size_t)r * SEQ + c) = *(const LAS u32x4_t*)(tile + r * 72 + c);
    }
}

__device__ __forceinline__ void ph_conv_naive(const Args& a, int l, LAS char* lds, int vcu, int G) {
    int tid_ = threadIdx.x; asm volatile("" : "+v"(tid_)); asm volatile("" : "+s"(vcu));
    const int half = tid_ >> 8, c = tid_ & 255; LAS float* hs = (LAS float*)(lds + half * 63488);
    const float* cw = a.conv_w + (size_t)l * 31 * 256; const float* lg = a.conv_lg + l * 256; const float* lb = a.conv_lb + l * 256;
    float w[31];
#pragma unroll
    for (int k = 0; k < 31; ++k) w[k] = cw[k * 256 + c];
    const float bias = a.conv_b[l * 256 + c];
    for (int unit = vcu; unit < NTOK / 64; unit += G) {
        const int tile = unit * 2 + half, b = tile >> 7, t0 = (tile & 127) * 32;
        __syncthreads();
        for (int i = 0; i < 62; ++i) { const int t = t0 - 30 + i; float v = 0.f;
            if (t >= 0) { const bf16_t* p = a.proj + ((size_t)b * SEQ + t) * DINP + C_CONV; v = bf2f(p[c]) * sigmf(bf2f(p[256 + c])); }
            hs[i * 256 + c] = v; }
        __syncthreads();
        float outv[32];
#pragma unroll
        for (int tt = 0; tt < 32; ++tt) { float s = bias;
#pragma unroll
            for (int k = 0; k < 31; ++k) s += hs[(tt + k) * 256 + c] * w[k];
            outv[tt] = s; }
        __syncthreads();
#pragma unroll
        for (int tt = 0; tt < 32; ++tt) hs[tt * 256 + c] = outv[tt];
        __syncthreads();
        const int wave = c >> 6, lane = c & 63;
        for (int tt = wave; tt < 32; tt += 4) { float v[4], s = 0.f;
#pragma unroll
            for (int i = 0; i < 4; ++i) { v[i] = hs[tt * 256 + lane + 64 * i]; s += v[i]; }
            const float mu = wsum(s) * (1.f / 256.f); float q = 0.f;
#pragma unroll
            for (int i = 0; i < 4; ++i) q += (v[i] - mu) * (v[i] - mu);
            const float rs = rsqrtf(wsum(q) * (1.f / 256.f) + 1e-5f);
#pragma unroll
            for (int i = 0; i < 4; ++i) { const int ch = lane + 64 * i; const float y = (v[i] - mu) * rs * lg[ch] + lb[ch]; a.hconv[((size_t)b * SEQ + t0 + tt) * 256 + ch] = f2bf(siluf(y)); } }
    }
}


namespace ret {
using nsa::f32x16; using nsa::u32x4; using nsa::u32x2; using nsa::pk2;
__device__ __forceinline__ float lg2g(int h) { return log2f(1.f - exp2f(-5.f - (float)h)); }
}
__device__ __forceinline__ void ph_ret_prep(const Args& a, LAS char* lds, int vcu, int G) {
    int tid = threadIdx.x; asm volatile("" : "+v"(tid)); asm volatile("" : "+s"(vcu));
    LAS bf16_t* tK = (LAS bf16_t*)lds; LAS bf16_t* tV = (LAS bf16_t*)(lds + 256 * 72 * 2);
    for (int u = vcu; u < NB * 64; u += G) { const int b = u >> 6, tb = u & 63;
        __syncthreads();
#pragma unroll
        for (int it = 0; it < 2; ++it) { const int item = tid + NT * it, tok = item >> 4, h = (item >> 2) & 3, ch = item & 3; const int pos = tb * 64 + tok; const size_t row = (size_t)b * SEQ + pos;
            const bf16_t* p = a.proj + row * DINP; const int c0 = h * 64 + 8 * ch;
            const u32x4_t ql = *(const u32x4_t*)(p + C_RQ + c0), qh = *(const u32x4_t*)(p + C_RQ + c0 + 32), kl = *(const u32x4_t*)(p + C_RK + c0), kh = *(const u32x4_t*)(p + C_RK + c0 + 32);
            const u32x4_t vl = *(const u32x4_t*)(p + C_RV + c0), vh = *(const u32x4_t*)(p + C_RV + c0 + 32);
            const float* cs = a.rot + ((size_t)pos * 32 + 8 * ch) * 2; float co[8], si[8];
#pragma unroll
            for (int e = 0; e < 4; ++e) { const f32x4 t4 = *(const f32x4*)(cs + 4 * e); co[2 * e] = t4[0]; si[2 * e] = t4[1]; co[2 * e + 1] = t4[2]; si[2 * e + 1] = t4[3]; }
            const float zeta = exp2f((float)(127 - (pos & 127)) * ret::lg2g(h));
            u32x4_t oql, oqh, okl, okh;
#pragma unroll
            for (int e2 = 0; e2 < 4; ++e2) { float r1[2], r2[2], k1[2], k2[2];
#pragma unroll
                for (int e1 = 0; e1 < 2; ++e1) { const int e = e2 * 2 + e1; const float x1 = __uint_as_float(e1 ? (ql[e2] & 0xffff0000u) : (ql[e2] << 16)), x2 = __uint_as_float(e1 ? (qh[e2] & 0xffff0000u) : (qh[e2] << 16));
                    const float y1 = __uint_as_float(e1 ? (kl[e2] & 0xffff0000u) : (kl[e2] << 16)), y2 = __uint_as_float(e1 ? (kh[e2] & 0xffff0000u) : (kh[e2] << 16));
                    r1[e1] = x1 * co[e] - x2 * si[e]; r2[e1] = x1 * si[e] + x2 * co[e]; k1[e1] = y1 * co[e] - y2 * si[e]; k2[e1] = y1 * si[e] + y2 * co[e];
                    tK[(c0 + e) * 72 + tok] = f2bf(k1[e1] * zeta); tK[(c0 + 32 + e) * 72 + tok] = f2bf(k2[e1] * zeta);
                    tV[(c0 + e) * 72 + tok] = (bf16_t)(e1 ? (vl[e2] >> 16) : (vl[e2] & 0xffffu)); tV[(c0 + 32 + e) * 72 + tok] = (bf16_t)(e1 ? (vh[e2] >> 16) : (vh[e2] & 0xffffu)); }
                oql[e2] = nsa::pk2(r1[0], r1[1]); oqh[e2] = nsa::pk2(r2[0], r2[1]); okl[e2] = nsa::pk2(k1[0], k1[1]); okh[e2] = nsa::pk2(k2[0], k2[1]); }
            *(u32x4_t*)(a.qrb + row * 256 + c0) = oql; *(u32x4_t*)(a.qrb + row * 256 + c0 + 32) = oqh; *(u32x4_t*)(a.krb + row * 256 + c0) = okl; *(u32x4_t*)(a.krb + row * 256 + c0 + 32) = okh; }
        __syncthreads();
#pragma unroll
        for (int it = 0; it < 4; ++it) { const int q = tid + NT * it, ri = q >> 3, cc = (q & 7) * 8; const size_t o = ((size_t)b * 256 + ri) * SEQ + tb * 64 + cc;
            *(u32x4_t*)(a.KzT + o) = *(const LAS u32x4_t*)(tK + ri * 72 + cc); *(u32x4_t*)(a.VrT + o) = *(const LAS u32x4_t*)(tV + ri * 72 + cc); }
    }
}
__device__ __forceinline__ void ret_state_unit(const Args& a, const int u0) {
    using namespace ret;
    int tid = threadIdx.x; asm volatile("" : "+v"(tid));
    const int w = tid >> 6, lane = tid & 63, hi = lane >> 5, r = lane & 31;
    if (w >= 4) return;
    { const int u = u0; const int h = u & 3, et = w >> 1, dt = w & 1; const float gc = exp2f(128.f * lg2g(h));
        const bf16_t* va = a.VrT + ((size_t)u * 64 + 32 * et + r) * SEQ + 8 * hi; const bf16_t* kb = a.KzT + ((size_t)u * 64 + 32 * dt + r) * SEQ + 8 * hi;
        f32x16 S;
#pragma unroll
        for (int i = 0; i < 16; ++i) S[i] = 0.f;
        bf16x8 A[8], B[8];
#pragma unroll
        for (int s2 = 0; s2 < 8; ++s2) { A[s2] = *(const bf16x8*)(va + 16 * s2); B[s2] = *(const bf16x8*)(kb + 16 * s2); }
        for (int c = 0; c < 32; ++c) {
            bf16_t* sp = a.ST + (((size_t)u * 32 + c) * 64 + 32 * et + 4 * hi) * 64 + 32 * dt + r;
#pragma unroll
            for (int i = 0; i < 16; ++i) sp[((i & 3) + 8 * (i >> 2)) * 64] = f2bf(S[i]);
            f32x16 KV;
#pragma unroll
            for (int i = 0; i < 16; ++i) KV[i] = 0.f;
            bf16x8 An[8], Bn[8]; const int cn = c < 31 ? c + 1 : c;
#pragma unroll
            for (int s2 = 0; s2 < 8; ++s2) { An[s2] = *(const bf16x8*)(va + cn * 128 + 16 * s2); Bn[s2] = *(const bf16x8*)(kb + cn * 128 + 16 * s2); }
#pragma unroll
            for (int s2 = 0; s2 < 8; ++s2) KV = __builtin_amdgcn_mfma_f32_32x32x16_bf16(A[s2], B[s2], KV, 0, 0, 0);
#pragma unroll
            for (int i = 0; i < 16; ++i) S[i] = gc * S[i] + KV[i];
#pragma unroll
            for (int s2 = 0; s2 < 8; ++s2) { A[s2] = An[s2]; B[s2] = Bn[s2]; }
        }
    }
}
__device__ __forceinline__ void ret_out_unit(const Args& a, int l, const int u0) {
    using namespace ret;
    int tid = threadIdx.x; asm volatile("" : "+v"(tid));
    const int w = tid >> 6, lane = tid & 63, hi = lane >> 5, r = lane & 31, h = w >> 1, qh = w & 1;
    const float lg = lg2g(h); const float* gn = a.ret_gn + l * 256 + h * 64;
    { const int u = u0; const int b = u >> 5, c = u & 31, bh = b * 4 + h;
        const bf16_t* stp = a.ST + ((size_t)bh * 32 + c) * 4096; const bf16_t* vt = a.VrT + (size_t)bh * 64 * SEQ + c * 128;
#pragma unroll 1
        for (int qt = 0; qt < 2; ++qt) { const int q = 2 * qh + qt; const size_t row = (size_t)b * SEQ + c * 128 + 32 * q + r;
            bf16x8 Qf[4];
#pragma unroll
            for (int s = 0; s < 4; ++s) Qf[s] = *(const bf16x8*)(a.qrb + row * 256 + h * 64 + 16 * s + 8 * hi);
            f32x16 O0, O1;
#pragma unroll
            for (int i = 0; i < 16; ++i) { O0[i] = 0.f; O1[i] = 0.f; }
#pragma unroll
            for (int s = 0; s < 4; ++s) { const bf16x8 a0 = *(const bf16x8*)(stp + r * 64 + 16 * s + 8 * hi), a1 = *(const bf16x8*)(stp + (32 + r) * 64 + 16 * s + 8 * hi);
                O0 = __builtin_amdgcn_mfma_f32_32x32x16_bf16(a0, Qf[s], O0, 0, 0, 0); O1 = __builtin_amdgcn_mfma_f32_32x32x16_bf16(a1, Qf[s], O1, 0, 0, 0); }
            const float xi = exp2f((float)(32 * q + r + 1) * lg);
#pragma unroll
            for (int i = 0; i < 16; ++i) { O0[i] *= xi; O1[i] *= xi; }
            for (int kt = 0; kt <= q; ++kt) { const size_t krow = (size_t)b * SEQ + c * 128 + 32 * kt + r;
                f32x16 S;
#pragma unroll
                for (int i = 0; i < 16; ++i) S[i] = 0.f;
#pragma unroll
                for (int s = 0; s < 4; ++s) { const bf16x8 ka = *(const bf16x8*)(a.krb + krow * 256 + h * 64 + 16 * s + 8 * hi); S = __builtin_amdgcn_mfma_f32_32x32x16_bf16(ka, Qf[s], S, 0, 0, 0); }
                const int dbase = 32 * (q - kt) + r - 4 * hi;
#pragma unroll
                for (int i = 0; i < 16; ++i) { const int dl = dbase - ((i & 3) + 8 * (i >> 2)); S[i] = dl >= 0 ? S[i] * exp2f((float)dl * lg) : 0.f; }
#pragma unroll
                for (int s2 = 0; s2 < 2; ++s2) { u32x4 pw;
#pragma unroll
                    for (int x = 0; x < 4; ++x) pw[x] = pk2(S[8 * s2 + 2 * x], S[8 * s2 + 2 * x + 1]);
                    const bf16x8 Pf = __builtin_bit_cast(bf16x8, pw);
                    const bf16_t* v0 = vt + (size_t)r * SEQ + 32 * kt + 16 * s2 + 4 * hi; const bf16_t* v1 = v0 + (size_t)32 * SEQ;
                    const u32x2 x0 = *(const u32x2*)v0, y0 = *(const u32x2*)(v0 + 8), x1 = *(const u32x2*)v1, y1 = *(const u32x2*)(v1 + 8);
                    O0 = __builtin_amdgcn_mfma_f32_32x32x16_bf16(__builtin_bit_cast(bf16x8, (u32x4){x0.x, x0.y, y0.x, y0.y}), Pf, O0, 0, 0, 0);
                    O1 = __builtin_amdgcn_mfma_f32_32x32x16_bf16(__builtin_bit_cast(bf16x8, (u32x4){x1.x, x1.y, y1.x, y1.y}), Pf, O1, 0, 0, 0); }
            }
            float sm = 0.f;
#pragma unroll
            for (int i = 0; i < 16; ++i) sm += O0[i] + O1[i];
            sm += __shfl_xor(sm, 32); const float mu = sm * (1.f / 64.f); float vq = 0.f;
#pragma unroll
            for (int i = 0; i < 16; ++i) { const float d0 = O0[i] - mu, d1 = O1[i] - mu; vq += d0 * d0 + d1 * d1; }
            vq += __shfl_xor(vq, 32); const float rs = rsqrtf(vq * (1.f / 64.f) + 1e-5f);
            const bf16_t* gp = a.proj + row * DINP + C_RG + h * 64 + 4 * hi; bf16_t* op = a.ocat + row * DM + 768 + h * 64 + 4 * hi;
#pragma unroll
            for (int q4 = 0; q4 < 4; ++q4) {
#pragma unroll
                for (int et = 0; et < 2; ++et) { const int e0 = 32 * et + 8 * q4; const u32x2 gt = *(const u32x2*)(gp + e0); const f32x4 gg = *(const f32x4*)(gn + e0 + 4 * hi);
                    float o[4];
#pragma unroll
                    for (int x = 0; x < 4; ++x) { const float ov = et ? O1[4 * q4 + x] : O0[4 * q4 + x]; const unsigned gw = x < 2 ? gt.x : gt.y; const float gv = __uint_as_float((x & 1) ? (gw & 0xffff0000u) : (gw << 16));
                        o[x] = siluf(gv) * (ov - mu) * rs * gg[x]; }
                    u32x2 ow; ow.x = pk2(o[0], o[1]); ow.y = pk2(o[2], o[3]); *(u32x2*)(op + e0) = ow; } }
        }
    }
}


constexpr int MIX_ITEMS = 32 + 1024 + 256;
__device__ __forceinline__ void ph_mix(const Args& a, int l, LAS char* lds) {
    int tid = threadIdx.x; asm volatile("" : "+v"(tid));
    volatile LAS int* slot = (volatile LAS int*)(lds + MISC_OFF + 64);
    unsigned* wq = a.wq + 64 * l; unsigned* rsdone = a.wq + 128 + 64 * l; unsigned* tmo = a.wq + 192;
    if (tid == 0) slot[0] = (int)__hip_atomic_fetch_add(wq, 1u, __ATOMIC_RELAXED, __HIP_MEMORY_SCOPE_AGENT);
    __syncthreads();
    for (int n = 0;; ++n) {
        const int idx = slot[n & 1];
        if (idx >= MIX_ITEMS) break;
        if (tid == 0) slot[(n + 1) & 1] = (int)__hip_atomic_fetch_add(wq, 1u, __ATOMIC_RELAXED, __HIP_MEMORY_SCOPE_AGENT);
        if (idx < 32) {
            ret_state_unit(a, idx);
            asm volatile("s_waitcnt vmcnt(0)" ::: "memory"); __syncthreads();
            if (tid == 0) { __builtin_amdgcn_fence(__ATOMIC_RELEASE, "agent"); asm volatile("s_waitcnt vmcnt(0)" ::: "memory"); (void)__hip_atomic_fetch_add(rsdone, 1u, __ATOMIC_RELAXED, __HIP_MEMORY_SCOPE_AGENT); }
        } else if (idx >= 32 + 512 && idx < 32 + 512 + 256) {
            if (tid == 0) { unsigned sp = 0;
                while (__hip_atomic_load(rsdone, __ATOMIC_RELAXED, __HIP_MEMORY_SCOPE_AGENT) < 32u) { __builtin_amdgcn_s_sleep(2); if (++sp > (1u << 22)) { __hip_atomic_store(tmo, 1u, __ATOMIC_RELAXED, __HIP_MEMORY_SCOPE_AGENT); break; } }
                __builtin_amdgcn_fence(__ATOMIC_ACQUIRE, "agent"); asm volatile("s_waitcnt vmcnt(0)" ::: "memory"); }
            __syncthreads();
            ret_out_unit(a, l, idx - (32 + 512));
        } else { const int i = idx < 32 + 512 ? idx - 32 : idx - 32 - 256; nsa_unit(a, lds, 63 - (i >> 4), i & 15); }
        __syncthreads();
    }
    __syncthreads();
}

__device__ __forceinline__ void ph_route(const Args& a, LAS char* lds, int vcu, int G) {
    int tid_ = threadIdx.x; asm volatile("" : "+v"(tid_)); asm volatile("" : "+s"(vcu));
    const int lane = tid_ & 63, wv = tid_ >> 6; const float* g = a.ln_ffn + DM; LAS float* gr = (LAS float*)lds;
    LAS int* sel = (LAS int*)(lds + 32768);
    LAS int* lcnt = sel + 256;
    __syncthreads();
    for (int q = tid_; q < DM * 8; q += NT) gr[q] = a.router[q] * g[q >> 3];
    for (int r0 = vcu * 128; r0 < NTOK; r0 += G * 128) {
        if (tid_ < 16) lcnt[tid_] = 0;
        __syncthreads();
        for (int i = 0; i < 16; ++i) { const int rl = wv * 16 + i, row = r0 + rl; float lg[8];
#pragma unroll
            for (int e = 0; e < 8; ++e) lg[e] = 0.f;
            u32x4_t xr[2];
#pragma unroll
            for (int h = 0; h < 2; ++h) xr[h] = *(const u32x4_t*)(a.xb + (size_t)row * DM + lane * 8 + 512 * h);
#pragma unroll
            for (int h = 0; h < 2; ++h)
#pragma unroll
                for (int jj = 0; jj < 8; ++jj) { const int k = lane * 8 + 512 * h + jj; const f32x4 q0 = *(const LAS f32x4*)(gr + k * 8), q1 = *(const LAS f32x4*)(gr + k * 8 + 4);
                    const unsigned wd = xr[h][jj >> 1]; const float x = __uint_as_float((jj & 1) ? (wd & 0xffff0000u) : (wd << 16));
                    lg[0] += x * q0[0]; lg[1] += x * q0[1]; lg[2] += x * q0[2]; lg[3] += x * q0[3]; lg[4] += x * q1[0]; lg[5] += x * q1[1]; lg[6] += x * q1[2]; lg[7] += x * q1[3]; }
            const float rs = row_rstd(a.ssq, row);
#pragma unroll
            for (int e = 0; e < 8; ++e) lg[e] = wsum(lg[e]) * rs;
            int e1 = 0; float v1 = lg[0];
#pragma unroll
            for (int e = 1; e < 8; ++e) if (lg[e] > v1) { v1 = lg[e]; e1 = e; }
            int e2 = -1; float v2 = -INFINITY;
#pragma unroll
            for (int e = 0; e < 8; ++e) if (e != e1 && lg[e] > v2) { v2 = lg[e]; e2 = e; }
            if (lane == 0) { const float g1 = 1.f / (1.f + __expf(v2 - v1)); a.gate[row * 2] = g1; a.gate[row * 2 + 1] = 1.f - g1; sel[rl * 2] = e1; sel[rl * 2 + 1] = e2; } }
        __syncthreads();
        int e = 0, rank = 0;
        if (tid_ < 256) { e = sel[tid_]; rank = __hip_atomic_fetch_add(&lcnt[e], 1, __ATOMIC_RELAXED, __HIP_MEMORY_SCOPE_WORKGROUP); }
        __syncthreads();
        if (tid_ < 8) lcnt[8 + tid_] = atomicAdd(&a.cnt[tid_], lcnt[tid_]);
        __syncthreads();
        if (tid_ < 256) a.tok_list[e * NTOK + lcnt[8 + e] + rank] = (r0 + (tid_ >> 1)) * 2 + (tid_ & 1);
        __syncthreads();
    }
}
__device__ __forceinline__ void ph_route_build(const Args& a, int vcu, int G) {
    int tid_ = threadIdx.x; asm volatile("" : "+v"(tid_)); asm volatile("" : "+s"(vcu));
    for (int idx = vcu * NT + tid_; idx < NEXP * NTOK; idx += G * NT) { const int e = idx >> 15, i = idx & (NTOK - 1);
        int ps = 0; for (int q = 0; q < e; ++q) ps += (a.cnt[q] + 255) & ~255;
        const int ce = a.cnt[e], pe = (ce + 255) & ~255;
        if (i < ce) { const int en = a.tok_list[e * NTOK + i]; a.row_tok[ps + i] = en >> 1; a.slot[en] = ps + i; } else if (i < pe) a.row_tok[ps + i] = -1;
        if (i < pe && (i & 255) == 0) a.tile_exp[(ps + i) >> 8] = e;
        if (idx == 0) { int tot = 0; for (int q = 0; q < 8; ++q) tot += (a.cnt[q] + 255) & ~255; a.meta[0] = tot >> 8; } }
}
__device__ __forceinline__ void ph_final(const Args& a, int vcu, int G) {
    int tid_ = threadIdx.x; asm volatile("" : "+v"(tid_)); asm volatile("" : "+s"(vcu));
    const int lane = tid_ & 63; float* xio = a.xres;
    for (int row = vcu * NW + (tid_ >> 6); row < NTOK; row += G * NW) { const int s1 = a.slot[row * 2], s2 = a.slot[row * 2 + 1]; const float g1 = a.gate[row * 2], g2 = a.gate[row * 2 + 1];
        float v[16]; float ss = 0.f;
#pragma unroll
        for (int i = 0; i < 4; ++i) { const int c = lane * 4 + i * 256; const ushort4 xq = *(const ushort4*)(a.xb + (size_t)row * DM + c); float4 xv; xv.x = bf2f(xq.x); xv.y = bf2f(xq.y); xv.z = bf2f(xq.z); xv.w = bf2f(xq.w);
            const ushort4 p = *(const ushort4*)(a.ysorted + (size_t)s1 * DM + c), q = *(const ushort4*)(a.ysorted + (size_t)s2 * DM + c);
            v[i * 4 + 0] = xv.x + g1 * bf2f(p.x) + g2 * bf2f(q.x); v[i * 4 + 1] = xv.y + g1 * bf2f(p.y) + g2 * bf2f(q.y);
            v[i * 4 + 2] = xv.z + g1 * bf2f(p.z) + g2 * bf2f(q.z); v[i * 4 + 3] = xv.w + g1 * bf2f(p.w) + g2 * bf2f(q.w);
#pragma unroll
            for (int j = 0; j < 4; ++j) ss += v[i * 4 + j] * v[i * 4 + j]; }
        const float rs = rsqrtf(wsum(ss) * (1.f / DM) + 1e-6f);
#pragma unroll
        for (int i = 0; i < 4; ++i) { const int c = lane * 4 + i * 256; const float4 gf = *(const float4*)(a.ln_final + c); float4 o; o.x = v[i * 4] * rs * gf.x; o.y = v[i * 4 + 1] * rs * gf.y; o.z = v[i * 4 + 2] * rs * gf.z; o.w = v[i * 4 + 3] * rs * gf.w;
            *(float4*)(xio + (size_t)row * DM + c) = o; } }
}

__global__ void __launch_bounds__(NT, 2) mega(Args a) {
    extern __shared__ __attribute__((aligned(16))) char lds[];
    volatile LAS unsigned* misc = (volatile LAS unsigned*)((LAS char*)lds + MISC_OFF);
    if (threadIdx.x < 64) misc[threadIdx.x] = 0u;
    __syncthreads();
    XcdBarrier bar = xcd_barrier_post(a.bar, misc);
    const int G = gridDim.x, vcu = blockIdx.x;
    LAS char* const lds3 = (LAS char*)lds;
#ifndef REP_PRO
#define REP_PRO 1
#endif
#ifndef REP_GEMM
#define REP_GEMM 1
#endif
#ifndef REP_NSA
#define REP_NSA 1
#endif
#ifndef REP_X
#define REP_X 1
#endif
#define GRID_BAR() xcd_barrier(bar)
#define AS4 __attribute__((address_space(4)))
#if defined(__HIP_DEVICE_COMPILE__)
#define LA const AS4 Args* ap_ = (const AS4 Args*)__builtin_amdgcn_kernarg_segment_ptr(); asm volatile("" : "+s"(ap_)); Args A; __builtin_memcpy(&A, ap_, sizeof(Args))
#else
#define LA const Args A = a
#endif

    { LA; ph_prologue(A, lds3, vcu, G); }
    GRID_BAR();
#pragma unroll
    for (int l = 0; l < 2; ++l) {
        for (int rep = 0; rep < REP_GEMM; ++rep) { LA; pg8::Gemm g{A.xb, A.Win + (size_t)l * DINP * DM, NTOK, DINP, DM}; pg8::StaticOrder S; S.init(NTOK, DINP, G, vcu);
          pg8::gemm_phase<pg8::EIn, pg8::StaticOrder, 0>((PG8_LAS unsigned char*)lds3, g, S, pg8::EIn{A.proj, A.ssq}, nullptr, nullptr, 0); }
        GRID_BAR();
#pragma unroll 1
        for (int rep = 0; rep < REP_X; ++rep) {
#pragma unroll 1
        for (int kv = 0; kv < 2; ++kv) { const int i = l * 2 + kv;
            { LA; pg8::Gemm g{A.proj, A.W1b + (size_t)i * 256 * 2048, 4096, 256, 2048}; pg8::StaticOrder S; S.init(4096, 256, G, (vcu + G - kv * 16) % G);
              pg8::gemm_phase<pg8::ESiluBias, pg8::StaticOrder, 2>((PG8_LAS unsigned char*)lds3, g, S, pg8::ESiluBias{A.hc + (size_t)kv * 4096 * 256, A.bias1 + i * 256}, nullptr, nullptr, (size_t)(kv ? C_VC : C_KC)); } }
        { LA; ph_vtrans(A, lds3, vcu, G); }
        { LA; ph_conv_naive(A, l, lds3, vcu, G); }
        { LA; ph_ret_prep(A, lds3, vcu, G); }
        }
        GRID_BAR();
#pragma unroll 1
        for (int rep = 0; rep < REP_X; ++rep) {
        { LA; pg8::Gemm g{A.hc, A.W2b + (size_t)(l * 2) * 256 * 256, 4096, 256, 256}; pg8::StaticOrder S; S.init(4096, 256, G, vcu);
          pg8::gemm_phase<pg8::EKc, pg8::StaticOrder, 0>((PG8_LAS unsigned char*)lds3, g, S, pg8::EKc{A.kcb, 0, 0}, nullptr, nullptr, 0); }
        { LA; pg8::Gemm g{A.hc + (size_t)4096 * 256, A.W2b + (size_t)(l * 2 + 1) * 256 * 256, 4096, 256, 256}; pg8::StaticOrder S; S.init(4096, 256, G, (vcu + G - 16) % G);
          pg8::gemm_phase<pg8::EKc, pg8::StaticOrder, 0>((PG8_LAS unsigned char*)lds3, g, S, pg8::EKc{A.vcT, 1, 0}, nullptr, nullptr, 0); }
        { LA; pg8::Gemm g{A.hconv, A.Wpw + (size_t)l * 65536, NTOK, 256, 256}; pg8::StaticOrder S; S.init(NTOK, 256, G, (vcu + G - 32) % G);
          pg8::gemm_phase<pg8::EStore, pg8::StaticOrder, 0>((PG8_LAS unsigned char*)lds3, g, S, pg8::EStore{A.ocat + 512, DM}, nullptr, nullptr, 0); }
        }
        GRID_BAR();
        { LA; ph_mix(A, l, lds3); }
        GRID_BAR();
        { LA; pg8::Gemm g{A.ocat, A.Wout + (size_t)l * DM * DM, NTOK, DM, DM}; pg8::StaticOrder S; S.init(NTOK, DM, G, vcu);
          pg8::gemm_phase<pg8::ERes, pg8::StaticOrder, 0>((PG8_LAS unsigned char*)lds3, g, S, pg8::ERes{l == 0 ? A.x : nullptr, A.xb, A.ssq}, nullptr, nullptr, 0); }
        GRID_BAR();
        if (l == 0) {
            for (int rep = 0; rep < REP_GEMM; ++rep) { LA; pg8::Gemm g{A.xb, A.W13, NTOK, 2 * DFF, DM}; pg8::StaticOrder S; S.init(NTOK, 2 * DFF, G, vcu);
              pg8::gemm_phase<pg8::ESwiglu, pg8::StaticOrder, 0>((PG8_LAS unsigned char*)lds3, g, S, pg8::ESwiglu{A.hbuf, A.ssq, nullptr}, nullptr, nullptr, 0); }
            GRID_BAR();
            { LA; pg8::Gemm g{A.hbuf, A.W2, NTOK, DM, DFF}; pg8::StaticOrder S; S.init(NTOK, DM, G, vcu);
              pg8::gemm_phase<pg8::ERes, pg8::StaticOrder, 0>((PG8_LAS unsigned char*)lds3, g, S, pg8::ERes{nullptr, A.xb, A.ssq}, nullptr, nullptr, 0); }
            GRID_BAR();
        }
    }
    { LA; ph_route(A, lds3, vcu, G); }
    GRID_BAR();
    { LA; ph_route_build(A, vcu, G); }
    GRID_BAR();
    for (int rep = 0; rep < REP_GEMM; ++rep) { LA; const int Mm = A.meta[0] * 256; pg8::Gemm g{A.xb, A.Wm13, Mm, 2 * DFF, DM}; pg8::StaticOrder S; S.init(Mm, 2 * DFF, G, vcu);
      pg8::gemm_phase<pg8::ESwiglu, pg8::StaticOrder, 1>((PG8_LAS unsigned char*)lds3, g, S, pg8::ESwiglu{A.hbuf, A.ssq, A.row_tok}, A.row_tok, A.tile_exp, (size_t)2 * DFF * DM); }
    GRID_BAR();
    for (int rep = 0; rep < REP_GEMM; ++rep) { LA; const int Mm = A.meta[0] * 256; pg8::Gemm g{A.hbuf, A.Wm2, Mm, DM, DFF}; pg8::StaticOrder S; S.init(Mm, DM, G, vcu);
      pg8::gemm_phase<pg8::EStore, pg8::StaticOrder, 0>((PG8_LAS unsigned char*)lds3, g, S, pg8::EStore{A.ysorted, DM}, nullptr, A.tile_exp, (size_t)DM * DFF); }
    GRID_BAR();
    { LA; ph_final(A, vcu, G); }
}

static inline size_t al256(size_t x) { return (x + 255) & ~(size_t)255; }
extern "C" void kernel_launch(void* const* d_in, const int* in_sizes, int n_in, void* d_out, int out_size, void* d_ws, size_t ws_size, hipStream_t stream) {
    static int grid = 0;
    Args a{};
    const float** ins = (const float**)&a.x;
    for (int i = 0; i < 20; ++i) ins[i] = (const float*)d_in[i];
    a.xres = (float*)d_out;
    char* w = (char*)d_ws; size_t off = 0;
    auto take = [&](size_t bytes) { char* p = w + off; off = al256(off + bytes); return p; };
    a.bar = (unsigned*)take(XCD_BAR_WORDS * 4);
    a.cnt = (int*)take(256);
    a.meta = (int*)take(256);
    a.wq = (unsigned*)take(1024);
    const size_t ctl_bytes = off;
    char* regY = w + off;
    a.Wm13 = (bf16_t*)take((size_t)NEXP * 2 * DFF * DM * 2);
    a.Win = (bf16_t*)take((size_t)2 * DINP * DM * 2);
    a.Wout = (bf16_t*)take((size_t)2 * DM * DM * 2);
    a.W13 = (bf16_t*)take((size_t)2 * DFF * DM * 2);
    a.W2 = (bf16_t*)take((size_t)DM * DFF * 2);
    a.ysorted = (bf16_t*)regY;
    if (off < (size_t)(regY - w) + (size_t)PMAX * DM * 2) off = al256((size_t)(regY - w) + (size_t)PMAX * DM * 2);
    a.xb = (bf16_t*)take((size_t)NTOK * DM * 2);
    a.Wm2 = (bf16_t*)take((size_t)NEXP * DM * DFF * 2);
    a.W1b = (bf16_t*)take((size_t)4 * 256 * 2048 * 2);
    a.W2b = (bf16_t*)take((size_t)4 * 256 * 256 * 2);
    a.Wpw = (bf16_t*)take((size_t)2 * 256 * 256 * 2);
    a.bias1 = (float*)take(4 * 256 * 4);
    a.rot = (float*)take((size_t)4096 * 32 * 2 * 4);
    a.ssq = (float*)take((size_t)NTOK * NSLOT * 4);
    a.tok_list = (int*)take((size_t)NEXP * NTOK * 4);
    a.row_tok = (int*)take((size_t)PMAX * 4);
    a.slot = (int*)take((size_t)NTOK * 2 * 4);
    a.tile_exp = (int*)take(1024 * 4);
    a.gate = (float*)take((size_t)NTOK * 2 * 4);
    char* regR = w + off;
    a.proj = (bf16_t*)take((size_t)NTOK * DINP * 2);
    a.ocat = (bf16_t*)take((size_t)NTOK * DM * 2);
    a.hc = (bf16_t*)take((size_t)2 * 4096 * 256 * 2);
    a.kcb = (bf16_t*)take((size_t)4096 * 64 * 2);
    a.hconv = (bf16_t*)take((size_t)NTOK * 256 * 2);
    a.vcT = (bf16_t*)take((size_t)16 * 64 * 256 * 2);
    a.VsT = (bf16_t*)take((size_t)16 * 64 * SEQ * 2);
    a.VwT = (bf16_t*)take((size_t)16 * 64 * SEQ * 2);
    a.qrb = (bf16_t*)take((size_t)NTOK * 256 * 2);
    a.krb = (bf16_t*)take((size_t)NTOK * 256 * 2);
    a.KzT = (bf16_t*)take((size_t)32 * 64 * SEQ * 2);
    a.VrT = (bf16_t*)take((size_t)32 * 64 * SEQ * 2);
    a.ST = (bf16_t*)take((size_t)32 * 32 * 4096 * 2);
    a.hbuf = (bf16_t*)regR;
    const size_t need = (size_t)(regR - w) + (size_t)PMAX * DFF * 2;
    if (grid == 0) {
        if (need > ws_size || off > ws_size || n_in != 20) { fprintf(stderr, "kernel_launch: workspace too small: need %zu / %zu have %zu\n", need, off, ws_size); grid = -1; return; }
        int dev = 0, cus = 0;
        if (hipGetDevice(&dev) != hipSuccess || hipDeviceGetAttribute(&cus, hipDeviceAttributeMultiprocessorCount, dev) != hipSuccess) { grid = -1; return; }
        if (hipFuncSetAttribute((const void*)mega, hipFuncAttributeMaxDynamicSharedMemorySize, LDS_BYTES) != hipSuccess) { fprintf(stderr, "kernel_launch: hipFuncSetAttribute failed\n"); grid = -1; return; }
        int per_cu = 0;
        if (hipOccupancyMaxActiveBlocksPerMultiprocessor(&per_cu, (const void*)mega, NT, LDS_BYTES) != hipSuccess || per_cu < 1) { fprintf(stderr, "kernel_launch: occupancy query says %d\n", per_cu); }
        (void)hipGetLastError();
        grid = cus;
    }
    if (grid < 0) return;
    (void)hipMemsetAsync(w, 0, ctl_bytes, stream);
    hipLaunchKernelGGL(mega, dim3(grid), dim3(NT), LDS_BYTES, stream, a);
}
```

```cpp
#include <hip/hip_runtime.h>
#include <stdint.h>
#include <stdio.h>

typedef unsigned short bf16_t;
typedef short bf16x8 __attribute__((ext_vector_type(8)));
typedef float f32x4 __attribute__((ext_vector_type(4)));
typedef unsigned u32x4_t __attribute__((ext_vector_type(4)));

constexpr int NTOK = 32768, DM = 1024, NB = 8, SEQ = 4096;
constexpr int DIN = 2840, DINP = 3072, DFF = 2816, NEXP = 8;
constexpr int C_Q = 0, C_KC = 512, C_VC = 640, C_KS = 768, C_VS = 896, C_KW = 1024, C_VW = 1152, C_GL = 1280,
              C_CONV = 1304, C_RQ = 1816, C_RK = 2072, C_RV = 2328, C_RG = 2584;
constexpr int NSLOT = 16;
constexpr int PMAX = 65536 + 8 * 256;
constexpr int NT = 512, NW = 8;
constexpr int LDS_BYTES = 144 * 1024, MISC_OFF = LDS_BYTES - 256;

#define XB_TMO      128
#define XB_XCNT(j)  (256  + 64 * (j))
#define XB_XSUB(j)  (1280 + 64 * (j))
#define XB_XGEN(j)  (2304 + 64 * (j))
#define XB_TOP      3328
#define XB_TOPGEN   3392
#define XCD_BAR_WORDS 3456
#define XB_SPIN_CAP (1u << 20)
#define LAS __attribute__((address_space(3)))
__device__ __forceinline__ unsigned xb_ld(unsigned* p)              { return __hip_atomic_load(p, __ATOMIC_RELAXED, __HIP_MEMORY_SCOPE_AGENT); }
__device__ __forceinline__ unsigned xb_add(unsigned* p, unsigned v) { return __hip_atomic_fetch_add(p, v, __ATOMIC_RELAXED, __HIP_MEMORY_SCOPE_AGENT); }
__device__ __forceinline__ unsigned xb_xcc_id() { return (unsigned)__builtin_amdgcn_s_getreg((3 << 11) | 20) & 0xFu; }
#define XB_SPIN(cond, bar) do { unsigned _sp = 0; while (cond) { __builtin_amdgcn_s_sleep(1); \
    if ((++_sp & 255u) == 0u) { if (xb_ld(&(bar)[XB_TMO])) break; if (_sp > XB_SPIN_CAP) { atomicAdd(&(bar)[XB_TMO], 1u); break; } } } } while (0)
struct XcdBarrier { unsigned* bar; unsigned x; volatile LAS unsigned* st; };
__device__ __forceinline__ XcdBarrier xcd_barrier_post(unsigned* bar, volatile LAS unsigned* st) {
    XcdBarrier b; b.bar = bar; b.x = xb_xcc_id(); b.st = st;
    if (threadIdx.x == 0) (void)xb_add(&bar[XB_XCNT(b.x)], 1u);
    return b;
}
__device__ __forceinline__ void xcd_barrier_complete(unsigned* bar, unsigned x, unsigned& nloc, unsigned& nx) {
    const unsigned G = gridDim.x * gridDim.y * gridDim.z;
    unsigned sum, cnt, mine, sp = 0u;
    for (;;) {
        sum = 0u; cnt = 0u; mine = 0u;
#pragma unroll
        for (unsigned j = 0; j < 16; ++j) { const unsigned c = xb_ld(&bar[XB_XCNT(j)]); sum += c; cnt += (c > 0u) ? 1u : 0u; mine = (j == x) ? c : mine; }
        if (sum == G) break;
        __builtin_amdgcn_s_sleep(1);
        if ((++sp & 255u) == 0u) { if (xb_ld(&bar[XB_TMO])) break; if (sp > XB_SPIN_CAP) { atomicAdd(&bar[XB_TMO], 1u); break; } }
    }
    nloc = mine > 0u ? mine : 1u; nx = cnt > 0u ? cnt : 1u;
}
__device__ __forceinline__ void xcd_barrier(const XcdBarrier& b) {
    asm volatile("s_waitcnt vmcnt(0)" ::: "memory");
    __syncthreads();
    if (threadIdx.x == 0) {
        unsigned* bar = b.bar;
        __builtin_amdgcn_s_waitcnt(0);
        const unsigned bx = xb_xcc_id();
        unsigned nloc = b.st[0], nx = b.st[1];
        if (nloc == 0u) { xcd_barrier_complete(bar, bx, nloc, nx); b.st[0] = nloc; b.st[1] = nx; }
        const unsigned old = xb_add(&bar[XB_XSUB(bx)], 1u);
        const unsigned gen = old / nloc;
        if (old + 1u == (gen + 1u) * nloc) {
            __builtin_amdgcn_fence(__ATOMIC_RELEASE, "agent");
            asm volatile("s_waitcnt vmcnt(0)" ::: "memory");
            const unsigned og = xb_add(&bar[XB_TOP], 1u);
            const unsigned tg = og / nx;
            if (og + 1u == (tg + 1u) * nx) xb_add(&bar[XB_TOPGEN], 1u);
            else XB_SPIN(xb_ld(&bar[XB_TOPGEN]) == tg, bar);
            __builtin_amdgcn_fence(__ATOMIC_ACQUIRE, "agent");
            xb_add(&bar[XB_XGEN(bx)], 1u);
            asm volatile("s_waitcnt vmcnt(0)" ::: "memory");
        } else {
            XB_SPIN(xb_ld(&bar[XB_XGEN(bx)]) == gen, bar);
            __builtin_amdgcn_fence(__ATOMIC_ACQUIRE, "agent");
            asm volatile("s_waitcnt vmcnt(0)" ::: "memory");
        }
    }
    __syncthreads();
}

__device__ __forceinline__ bf16_t f2bf(float f) { unsigned u = __float_as_uint(f); u += 0x7fffu + ((u >> 16) & 1u); return (bf16_t)(u >> 16); }
__device__ __forceinline__ unsigned pk2bf(float lo, float hi) { unsigned r; asm volatile("v_cvt_pk_bf16_f32 %0, %1, %2" : "=v"(r) : "v"(lo), "v"(hi)); return r; }
__device__ __forceinline__ float bf2f(bf16_t h) { return __uint_as_float(((unsigned)h) << 16); }
__device__ __forceinline__ float wsum(float v) {
#pragma unroll
    for (int o = 32; o > 0; o >>= 1) v += __shfl_xor(v, o);
    return v; }
__device__ __forceinline__ float wmax(float v) {
#pragma unroll
    for (int o = 32; o > 0; o >>= 1) v = fmaxf(v, __shfl_xor(v, o));
    return v; }
__device__ __forceinline__ float siluf(float x) { return x * __builtin_amdgcn_rcpf(1.f + __builtin_amdgcn_exp2f(-1.4426950408889634f * x)); }
__device__ __forceinline__ float sigmf(float x) { return __builtin_amdgcn_rcpf(1.f + __builtin_amdgcn_exp2f(-1.4426950408889634f * x)); }
__device__ __forceinline__ float row_rstd(const float* ssq, int row) { const f32x4* p = (const f32x4*)(ssq + (size_t)row * NSLOT); const f32x4 a = p[0], b = p[1], c = p[2], d = p[3];
    const f32x4 t = (a + b) + (c + d); return rsqrtf(((t[0] + t[1]) + (t[2] + t[3])) * (1.f / DM) + 1e-6f); }


constexpr int MOE_TAB_OFF = MISC_OFF + 128;
__device__ __forceinline__ void moe_table(const int* cnt, LAS char* lds) {
    LAS int* mps = (LAS int*)(lds + MOE_TAB_OFF); LAS int* mcnt = mps + 16;
    if (threadIdx.x == 0) { int ps = 0;
        for (int e = 0; e < 8; ++e) { const int c = __hip_atomic_load(cnt + e, __ATOMIC_RELAXED, __HIP_MEMORY_SCOPE_AGENT); mps[e] = ps; mcnt[e] = c; ps += (c + 255) & ~255; }
        mps[8] = ps; }
    __syncthreads();
}
__device__ __forceinline__ int moe_e(const LAS int* mps, int pm) { const int r = pm * 256; int e = 0;
#pragma unroll
    for (int q = 1; q < 8; ++q) e += (mps[q] <= r) ? 1 : 0;
    return __builtin_amdgcn_readfirstlane(e); }

struct Args {
    const float *x, *ln_attn, *w_in, *cmp_pe, *cmp_w1, *cmp_w2, *conv_w, *conv_b, *conv_lg, *conv_lb, *conv_pw, *ret_gn, *w_out, *ln_ffn, *ffn_w13, *ffn_w2, *router, *moe_w13, *moe_w2, *ln_final;
    float* xres;
    bf16_t *Wm13, *Win, *Wout, *W13, *W2, *xb, *ysorted, *Wm2, *W1b, *W2b, *Wpw;
    float *bias1, *rot, *ssq; int *cnt, *meta, *tok_list, *row_tok, *slot, *tile_exp; float* gate;
    bf16_t *proj, *ocat, *hc, *kcb, *vcb, *hconv; float *qr, *kr, *KV, *Sst; bf16_t* hbuf; bf16_t *vcT, *VsT, *VwT, *qrb, *krb, *KzT, *VrT, *ST;
    unsigned* bar; unsigned* wq; float* rsrow;
};

struct ConvJob { const float* src; bf16_t* dst; const float* g; int ldsrc, K, Npad, nvalid, mode, pad; };
__device__ __forceinline__ ConvJob get_job(const Args& a, int j) {
    ConvJob c; c.g = nullptr; c.mode = 0; c.pad = 0;
    if (j < 2) { c.src = a.w_in + (size_t)j * DM * DIN; c.dst = a.Win + (size_t)j * DINP * DM; c.g = a.ln_attn + j * DM; c.ldsrc = DIN; c.K = DM; c.Npad = DINP; c.nvalid = DIN; c.mode = 1; }
    else if (j < 4) { const int l = j - 2; c.src = a.w_out + (size_t)l * DM * DM; c.dst = a.Wout + (size_t)l * DM * DM; c.ldsrc = DM; c.K = DM; c.Npad = DM; c.nvalid = DM; }
    else if (j < 6) { const int l = j - 4; c.src = a.conv_pw + (size_t)l * 65536; c.dst = a.Wpw + (size_t)l * 65536; c.ldsrc = 256; c.K = 256; c.Npad = 256; c.nvalid = 256; }
    else if (j < 10) { const int i = j - 6; c.src = a.cmp_w1 + (size_t)i * 2048 * 256; c.dst = a.W1b + (size_t)i * 256 * 2048; c.ldsrc = 256; c.K = 2048; c.Npad = 256; c.nvalid = 256; }
    else if (j < 14) { const int i = j - 10; c.src = a.cmp_w2 + (size_t)i * 256 * 64; c.dst = a.W2b + (size_t)i * 256 * 256; c.ldsrc = 64; c.K = 256; c.Npad = 256; c.nvalid = 64; }
    else if (j == 14) { c.src = a.ffn_w13; c.dst = a.W13; c.g = a.ln_ffn; c.ldsrc = 2 * DFF; c.K = DM; c.Npad = 2 * DFF; c.nvalid = 2 * DFF; c.mode = 2; }
    else if (j == 15) { c.src = a.ffn_w2; c.dst = a.W2; c.ldsrc = DM; c.K = DFF; c.Npad = DM; c.nvalid = DM; }
    else if (j < 24) { const int e = j - 16; c.src = a.moe_w13 + (size_t)e * DM * 2 * DFF; c.dst = a.Wm13 + (size_t)e * 2 * DFF * DM; c.g = a.ln_ffn + DM; c.ldsrc = 2 * DFF; c.K = DM; c.Npad = 2 * DFF; c.nvalid = 2 * DFF; c.mode = 2; }
    else { const int e = j - 24; c.src = a.moe_w2 + (size_t)e * DFF * DM; c.dst = a.Wm2 + (size_t)e * DM * DFF; c.ldsrc = DM; c.K = DFF; c.Npad = DM; c.nvalid = DM; }
    return c;
}
constexpr int NJOBS = 32;
__device__ __forceinline__ void conv_super(const ConvJob& c, int st, LAS float* lt, int tid_) {
    const int nsn = c.Npad / 256, n0 = (st % nsn) * 256, k0 = (st / nsn) * 64, lane = tid_ & 63, wv = tid_ >> 6;
    float v[32];
#pragma unroll
    for (int q = 0; q < 4; ++q) { const int n = n0 + q * 64 + lane; int sc;
        if (c.mode == 2) { const int pn = n >> 8, i = n & 255; sc = i < 128 ? 128 * pn + i : DFF + 128 * pn + (i - 128); } else sc = n < c.nvalid ? n : -1;
#pragma unroll
        for (int i = 0; i < 8; ++i) v[q * 8 + i] = sc >= 0 ? c.src[(size_t)(k0 + wv + 8 * i) * c.ldsrc + sc] : 0.f; }
#pragma unroll
    for (int q = 0; q < 4; ++q)
#pragma unroll
        for (int i = 0; i < 8; ++i) lt[(wv + 8 * i) * 257 + q * 64 + lane] = v[q * 8 + i];
    __syncthreads();
    const int nl = tid_ >> 3, ch = tid_ & 7;
    float gs[8];
#pragma unroll
    for (int e = 0; e < 8; ++e) gs[e] = c.g ? c.g[k0 + 8 * ch + e] : 1.f;
#pragma unroll
    for (int q = 0; q < 4; ++q) { const int n = n0 + q * 64 + nl; const float cs = (c.mode == 1 && (n < 512 || (n >= C_RK && n < C_RV))) ? 0.125f : 1.f; float x[8];
#pragma unroll
        for (int e = 0; e < 8; ++e) x[e] = lt[(8 * ch + e) * 257 + q * 64 + nl] * gs[e] * cs;
        u32x4_t w; w.x = pk2bf(x[0], x[1]); w.y = pk2bf(x[2], x[3]); w.z = pk2bf(x[4], x[5]); w.w = pk2bf(x[6], x[7]);
        *(u32x4_t*)(c.dst + (size_t)n * c.K + k0 + 8 * ch) = w; }
    __syncthreads();
}
__device__ __forceinline__ void ph_prologue(const Args& a, LAS char* lds, int vcu, int G) {
    int tid_ = threadIdx.x; asm volatile("" : "+v"(tid_)); asm volatile("" : "+s"(vcu));
    LAS float* lt = (LAS float*)lds; int acc = 0;
    for (int j = 0; j < 14; ++j) { if (j >= 1 && j < 4) continue;
        const ConvJob c = get_job(a, j); const int nt = (c.Npad / 256) * (c.K / 64);
        int t0 = vcu - (acc % G); if (t0 < 0) t0 += G;
        for (int t = t0; t < nt; t += G) conv_super(c, t, lt, tid_);
        acc += nt; }
    for (int u = vcu; u < 64; u += G) { const int i = u >> 4, nl = tid_ & 15, kp = tid_ >> 4, n = (u & 15) * 16 + nl; float s = 0.f;
        const float* pe = a.cmp_pe + (size_t)i * 2048; const float* w1 = a.cmp_w1 + (size_t)i * 2048 * 256;
#pragma unroll 16
        for (int j = 0; j < 64; ++j) s += pe[kp + 32 * j] * w1[(size_t)(kp + 32 * j) * 256 + n];
        __syncthreads(); lt[kp * 16 + nl] = s; __syncthreads();
        if (kp == 0) { float t = 0.f;
#pragma unroll
            for (int q = 0; q < 32; ++q) t += lt[q * 16 + nl];
            a.bias1[i * 256 + n] = t; } }
    for (int idx = vcu * NT + tid_; idx < 4096 * 32; idx += G * NT) { const int pos = idx >> 5, i = idx & 31; const float inv = powf(10000.f, -(float)i / 32.f), ang = (float)pos * inv;
        a.rot[idx * 2] = cosf(ang); a.rot[idx * 2 + 1] = sinf(ang); }
    const int lane = tid_ & 63;
    for (int row0 = (vcu * NW + (tid_ >> 6)) * 4; row0 < NTOK; row0 += G * NW * 4) {
        f32x4 v[4][4];
#pragma unroll
        for (int rr = 0; rr < 4; ++rr)
#pragma unroll
            for (int i = 0; i < 4; ++i) v[rr][i] = *(const f32x4*)(a.x + (size_t)(row0 + rr) * DM + lane * 4 + 256 * i);
#pragma unroll
        for (int rr = 0; rr < 4; ++rr) { float sq = 0.f;
#pragma unroll
            for (int i = 0; i < 4; ++i) { const f32x4 t = v[rr][i]; sq += (t[0] * t[0] + t[1] * t[1]) + (t[2] * t[2] + t[3] * t[3]);
                uint2 o; o.x = pk2bf(t[0], t[1]); o.y = pk2bf(t[2], t[3]); *(uint2*)(a.xb + (size_t)(row0 + rr) * DM + lane * 4 + 256 * i) = o; }
            sq = wsum(sq); if (lane < NSLOT) a.ssq[(size_t)(row0 + rr) * NSLOT + lane] = lane == 0 ? sq : 0.f; } }
}

struct APlain { const bf16_t* A; int lda; __device__ __forceinline__ const bf16_t* ptr(int row, int k) const { return A + (size_t)row * lda + k; } };
struct AGather { const bf16_t* A; const int* row_tok; int lda; __device__ __forceinline__ const bf16_t* ptr(int row, int k) const { const int t = row_tok[row]; return t < 0 ? nullptr : A + (size_t)t * lda + k; } };
struct ACmp { const bf16_t* proj; int coloff;
    __device__ __forceinline__ const bf16_t* ptr(int row, int k) const { const int c = row & 255, g = (row >> 8) & 1, b = row >> 9; if (c == 255) return nullptr;
        return proj + (size_t)(b * SEQ + 16 * c + (k >> 6)) * DINP + coloff + g * 64 + (k & 63); } };
struct SchedPlain { int nM, nN; __device__ __forceinline__ int count() const { return nM * nN; }
    __device__ __forceinline__ void get(int u, int& row0, int& col0, size_t& boff) const { row0 = (u / nN) * 256; col0 = (u % nN) * 256; boff = 0; } };
struct SchedMoe { const int* meta; const int* tile_exp; size_t estride; int nN;
    __device__ __forceinline__ int count() const { return meta[0] * nN; }
    __device__ __forceinline__ void get(int u, int& row0, int& col0, size_t& boff) const { row0 = (u / nN) * 256; col0 = (u % nN) * 256; boff = (size_t)tile_exp[row0 >> 8] * estride; } };

struct EpiIn { bf16_t* proj; const float* ssq;
    __device__ __forceinline__ void apply(const f32x4 (&acc)[2][16], int rowb, int col0, int lane) const {
#pragma unroll
        for (int mi = 0; mi < 2; ++mi)
#pragma unroll
            for (int r = 0; r < 4; ++r) { const int row = rowb + mi * 16 + (lane >> 4) * 4 + r; const float rs = row_rstd(ssq, row);
#pragma unroll
                for (int n = 0; n < 16; ++n) proj[(size_t)row * DINP + col0 + n * 16 + (lane & 15)] = f2bf(acc[mi][n][r] * rs); } } };
struct EpiRes { const float* xold; float* xnew; bf16_t* xb; float* ssq;
    __device__ __forceinline__ void apply(const f32x4 (&acc)[2][16], int rowb, int col0, int lane) const {
#pragma unroll
        for (int mi = 0; mi < 2; ++mi)
#pragma unroll
            for (int r = 0; r < 4; ++r) { const int row = rowb + mi * 16 + (lane >> 4) * 4 + r; float s = 0.f;
#pragma unroll
                for (int n = 0; n < 16; ++n) { const size_t o = (size_t)row * DM + col0 + n * 16 + (lane & 15); const float v = xold[o] + acc[mi][n][r]; xnew[o] = v; xb[o] = f2bf(v); s += v * v; }
                s += __shfl_xor(s, 1); s += __shfl_xor(s, 2); s += __shfl_xor(s, 4); s += __shfl_xor(s, 8);
                if ((lane & 15) < 4) ssq[(size_t)row * NSLOT + (col0 >> 8) * 4 + (lane & 15)] = (lane & 15) == 0 ? s : 0.f; } } };
struct EpiSwiglu { bf16_t* h; const float* ssq; const int* row_tok;
    __device__ __forceinline__ void apply(const f32x4 (&acc)[2][16], int rowb, int col0, int lane) const {
#pragma unroll
        for (int mi = 0; mi < 2; ++mi)
#pragma unroll
            for (int r = 0; r < 4; ++r) { const int row = rowb + mi * 16 + (lane >> 4) * 4 + r; const int t = row_tok ? row_tok[row] : row;
                const float rs = t < 0 ? 0.f : row_rstd(ssq, t < 0 ? 0 : t);
#pragma unroll
                for (int n = 0; n < 8; ++n) { const float av = acc[mi][n][r] * rs, bv = acc[mi][n + 8][r] * rs; h[(size_t)row * DFF + (col0 >> 1) + n * 16 + (lane & 15)] = f2bf(siluf(av) * bv); } } } };
struct EpiStore { bf16_t* out; int ldc, coloff, ncols;
    __device__ __forceinline__ void apply(const f32x4 (&acc)[2][16], int rowb, int col0, int lane) const {
#pragma unroll
        for (int mi = 0; mi < 2; ++mi)
#pragma unroll
            for (int r = 0; r < 4; ++r) { const int row = rowb + mi * 16 + (lane >> 4) * 4 + r;
#pragma unroll
                for (int n = 0; n < 16; ++n) { const int c = col0 + n * 16 + (lane & 15); if (c < ncols) out[(size_t)row * ldc + coloff + c] = f2bf(acc[mi][n][r]); } } } };
struct EpiStoreT { bf16_t* out;
    __device__ __forceinline__ void apply(const f32x4 (&acc)[2][16], int rowb, int col0, int lane) const {
#pragma unroll
        for (int mi = 0; mi < 2; ++mi)
#pragma unroll
            for (int r = 0; r < 4; ++r) { const int row = rowb + mi * 16 + (lane >> 4) * 4 + r;
#pragma unroll
                for (int n = 0; n < 4; ++n) { const int c = col0 + n * 16 + (lane & 15); out[(size_t)(row >> 8) * 16384 + c * 256 + (row & 255)] = f2bf(acc[mi][n][r]); } } } };
struct EpiSiluBias { bf16_t* out; const float* bias; int ldc;
    __device__ __forceinline__ void apply(const f32x4 (&acc)[2][16], int rowb, int col0, int lane) const {
#pragma unroll
        for (int mi = 0; mi < 2; ++mi)
#pragma unroll
            for (int r = 0; r < 4; ++r) { const int row = rowb + mi * 16 + (lane >> 4) * 4 + r;
#pragma unroll
                for (int n = 0; n < 16; ++n) { const int c = col0 + n * 16 + (lane & 15); out[(size_t)row * ldc + c] = f2bf(siluf(acc[mi][n][r] + bias[c])); } } } };

template <class AS, class Epi, class Sched>
__device__ __forceinline__ void ph_gemm(LAS char* lds, const AS as, const bf16_t* __restrict__ Bt, const int K, const Epi epi, const Sched sched, int vcu, int G) {
    int tid_ = threadIdx.x; asm volatile("" : "+v"(tid_)); asm volatile("" : "+s"(vcu));
    LAS bf16_t* sA = (LAS bf16_t*)lds; LAS bf16_t* sB = (LAS bf16_t*)(lds + 256 * 40 * 2);
    const int tid = tid_, wave = tid >> 6, lane = tid & 63;
    const int nunits = sched.count();
    for (int u = vcu; u < nunits; u += G) {
        int row0, col0; size_t boff; sched.get(u, row0, col0, boff);
        const bf16_t* Bu = Bt + boff;
        f32x4 acc[2][16];
#pragma unroll
        for (int mi = 0; mi < 2; ++mi)
#pragma unroll
            for (int n = 0; n < 16; ++n) acc[mi][n] = (f32x4){0.f, 0.f, 0.f, 0.f};
#pragma unroll 1
        for (int k0 = 0; k0 < K; k0 += 32) {
#pragma unroll
            for (int i = 0; i < 2; ++i) { const int c = tid + i * NT, r = c >> 2, kc = (c & 3) * 8; const bf16_t* p = as.ptr(row0 + r, k0 + kc);
                uint4 v = make_uint4(0u, 0u, 0u, 0u); if (p) v = *(const uint4*)p; *(LAS u32x4_t*)&sA[r * 40 + kc] = (u32x4_t){v.x, v.y, v.z, v.w}; }
#pragma unroll
            for (int i = 0; i < 2; ++i) { const int c = tid + i * NT, r = c >> 2, kc = (c & 3) * 8;
                *(LAS u32x4_t*)&sB[r * 40 + kc] = *(const u32x4_t*)(Bu + (size_t)(col0 + r) * K + k0 + kc); }
            __syncthreads();
            bf16x8 af[2];
#pragma unroll
            for (int mi = 0; mi < 2; ++mi) af[mi] = *(const LAS bf16x8*)&sA[(wave * 32 + mi * 16 + (lane & 15)) * 40 + (lane >> 4) * 8];
#pragma unroll
            for (int n = 0; n < 16; ++n) { const bf16x8 bfr = *(const LAS bf16x8*)&sB[(n * 16 + (lane & 15)) * 40 + (lane >> 4) * 8];
#pragma unroll
                for (int mi = 0; mi < 2; ++mi) acc[mi][n] = __builtin_amdgcn_mfma_f32_16x16x32_bf16(af[mi], bfr, acc[mi][n], 0, 0, 0); }
            __syncthreads();
        }
        epi.apply(acc, row0 + wave * 32, col0, lane);
    }
}


namespace pg8 {
#define PG8_LAS __attribute__((address_space(3)))
typedef unsigned u32x4 __attribute__((ext_vector_type(4)));
typedef unsigned u32x2 __attribute__((ext_vector_type(2)));
constexpr int BM = 256, BK = 64, HALF = 128, HTB = HALF * BK * 2  , STAGE_BYTES = 8 * HTB, NXCD = 8, WGM = 8;
__host__ __device__ __forceinline__ int lds_byte(int r, int c) { const int st = (r >> 4) * 2 + (c >> 5), rr = r & 15, cc = c & 31, ob = rr * 64 + cc * 2; return st * 1024 + (ob ^ (((ob >> 9) & 1) << 5)); }
__host__ __device__ __forceinline__ void stage_rc(int b, int& R, int& C) { const int st = b / 1024, sb = b % 1024, swz = sb ^ (((sb >> 9) & 1) << 5); R = (st >> 1) * 16 + swz / 64; C = (st & 1) * 32 + (swz % 64) / 2; }
__host__ __device__ __forceinline__ int perm32(int rho) { const int n = rho >> 4, i = rho & 15; return 8 * (i >> 2) + 4 * n + (i & 3); }
struct Unit { int pm, pn; };
struct Gemm { const bf16_t* A; const bf16_t* Bt; int M, N, K; };
struct StaticOrder {
    int nM, nN, nwg, G, c;
    __device__ __forceinline__ void init(int M, int N, int G_, int c_) { nM = M / BM; nN = N / BM; nwg = nM * nN; G = G_; c = c_; }
    __device__ __forceinline__ bool next(int i, Unit& u) const {
        const long L = (long)i * G + c; if (L >= nwg) return false;
        int wgid = (int)L; { const int q = nwg / NXCD, r = nwg % NXCD, xcd = wgid % NXCD, off = wgid / NXCD; wgid = (xcd < r ? xcd * (q + 1) : r * (q + 1) + (xcd - r) * q) + off; }
        const int nig = WGM * nN, gid = wgid / nig, fm = gid * WGM, gsz = (nM - fm) < WGM ? (nM - fm) : WGM;
        const int wi = wgid % nig; if (gsz == WGM) { u.pm = fm + (wi & (WGM - 1)); u.pn = wi >> 3; } else { u.pm = fm + (wi % gsz); u.pn = wi / gsz; } return true;
    }
};
__device__ __forceinline__ unsigned cvt_pk_bf16(float lo, float hi) { unsigned r; asm volatile("v_cvt_pk_bf16_f32 %0, %1, %2" : "=v"(r) : "v"(lo), "v"(hi)); return r; }

template <class Epi, class Sched, int AMODE, bool MOE = false>
__device__ __forceinline__ void gemm_phase(PG8_LAS unsigned char* lds, const Gemm g, const Sched& S_, const Epi& E, const int* __restrict__ rowmap, const int* __restrict__ tile_exp, const size_t estride) {
    Sched S = S_; asm volatile("" : "+s"(S.c));
    const PG8_LAS int* mps = (const PG8_LAS int*)(lds + MOE_TAB_OFF); const PG8_LAS int* mcnt = mps + 16;
    constexpr bool GATHER = AMODE != 0;
    int tid = threadIdx.x; asm volatile("" : "+v"(tid));
    const int wid = __builtin_amdgcn_readfirstlane(tid >> 6), lane = tid & 63, wr = wid >> 2, wc = wid & 3, fr = lane & 15, fq = lane >> 4;
    const int K = g.K, nt = K / BK;
    unsigned voffA[2], voffB[2];
#pragma unroll
    for (int i = 0; i < 2; ++i) { int R, C; stage_rc(tid * 16 + i * 8192, R, C); const int Rb = (R & ~31) + perm32(R & 31);
        voffA[i] = (unsigned)(R * K + C) * 2u; voffB[i] = (unsigned)(Rb * K + C) * 2u; if (GATHER) voffA[i] = (unsigned)C * 2u; }
    const size_t kstep = (size_t)(BK * 2);
    const size_t kstepA = AMODE == 2 ? (size_t)DINP * 2 : kstep;
    const size_t hstep = (size_t)HALF * K * 2;
    const size_t tstep = 2 * hstep;
    const unsigned ldsw = (unsigned)wid * 1024u;
    const int aoff = lds_byte(wr * 64 + fr, fq * 8), boff = lds_byte(wc * 32 + fr, fq * 8);
#define PG8_SA(b, h) (((b) * 2 + (h)) * HTB)
#define PG8_SB(b, h) ((4 + (b) * 2 + (h)) * HTB)
#define PG8_STAGE(bufoff, gbase, voff) do { _Pragma("unroll") for (int _i = 0; _i < 2; ++_i) \
        __builtin_amdgcn_global_load_lds((const unsigned*)((const char*)(gbase) + (voff)[_i]), (PG8_LAS unsigned*)(lds + (bufoff) + ldsw + _i * 8192), 16, 0, 0); } while (0)
#define PG8_LDA(dst, b, h) do { _Pragma("unroll") for (int m = 0; m < 4; ++m) _Pragma("unroll") for (int k = 0; k < 2; ++k) dst[m][k] = *(const PG8_LAS bf16x8*)(lds + PG8_SA(b, h) + aoff + m * 2048 + k * 1024); } while (0)
#define PG8_LDB(dst, b, h) do { _Pragma("unroll") for (int n = 0; n < 2; ++n) _Pragma("unroll") for (int k = 0; k < 2; ++k) dst[n][k] = *(const PG8_LAS bf16x8*)(lds + PG8_SB(b, h) + boff + n * 2048 + k * 1024); } while (0)
#define PG8_MMA(ai, bj, At, Bt) do { __builtin_amdgcn_s_setprio(1); _Pragma("unroll") for (int m = 0; m < 4; ++m) _Pragma("unroll") for (int n = 0; n < 2; ++n) _Pragma("unroll") for (int k = 0; k < 2; ++k) \
        acc[ai][bj][m][n] = __builtin_amdgcn_mfma_f32_16x16x32_bf16(Bt[n][k], At[m][k], acc[ai][bj][m][n], 0, 0, 0); __builtin_amdgcn_s_setprio(0); } while (0)
#define PG8_WAIT_V(n) asm volatile("s_waitcnt vmcnt(" #n ")" ::: "memory")
#define PG8_WAIT_L(n) asm volatile("s_waitcnt lgkmcnt(" #n ")" ::: "memory")
#define PG8_BAR __builtin_amdgcn_s_barrier()
#define PG8_SCHED __builtin_amdgcn_sched_barrier(0)
    unsigned vgc[2][2], vgn[2][2];
#define PG8_GOFF(dst, pm_) do { if constexpr (AMODE == 1) { const int _e = moe_e(mps, (pm_)), _p0 = mps[_e], _c0 = mcnt[_e]; _Pragma("unroll") for (int _h = 0; _h < 2; ++_h) _Pragma("unroll") for (int _i = 0; _i < 2; ++_i) { \
        int _R, _C; stage_rc(tid * 16 + _i * 8192, _R, _C); const int _ix = (pm_) * BM + _h * HALF + _R - _p0; const int _t = _ix < _c0 ? (rowmap[_e * NTOK + _ix] >> 1) : 0; \
        dst[_h][_i] = (unsigned)_t * (unsigned)(K * 2) + voffA[_i]; } } \
      else if constexpr (AMODE == 2) { _Pragma("unroll") for (int _h = 0; _h < 2; ++_h) _Pragma("unroll") for (int _i = 0; _i < 2; ++_i) { int _R, _C; stage_rc(tid * 16 + _i * 8192, _R, _C); const int _r = (pm_) * BM + _h * HALF + _R; int _c = _r & 255; _c = _c > 254 ? 254 : _c; \
        dst[_h][_i] = (unsigned)(((_r >> 9) * SEQ + 16 * _c) * DINP + (int)estride + ((_r >> 8) & 1) * 64) * 2u + voffA[_i]; } } } while (0)
#define PG8_STA(bufoff, gptr, h, arr) do { if constexpr (GATHER) { PG8_STAGE(bufoff, gptr, arr[h]); } else { PG8_STAGE(bufoff, (gptr) + ((h) ? hstep : 0), voffA); } } while (0)
    Unit cur, nxt; int ui = 0;
    if constexpr (Epi::NEEDS_RST) {
        PG8_LAS float* rst = (PG8_LAS float*)(lds + STAGE_BYTES);
        if (wid < 4) { Unit tu; for (int i = 0; i < 12 && S.next(i, tu); ++i) rst[i * 256 + wid * 64 + lane] = row_rstd(E.ssq, tu.pm * BM + wid * 64 + lane); }
        __syncthreads();
    }
    if (!S.next(0, cur)) return;
    f32x4 acc[2][2][4][2];
#pragma unroll
    for (int a = 0; a < 2; ++a)
#pragma unroll
        for (int b = 0; b < 2; ++b)
#pragma unroll
            for (int m = 0; m < 4; ++m)
#pragma unroll
                for (int n = 0; n < 2; ++n) acc[a][b][m][n] = (f32x4){0.f, 0.f, 0.f, 0.f};
    bf16x8 At[4][2], B0[2][2], B1[2][2];
    const char* cA = (const char*)g.A + (GATHER ? (size_t)0 : (size_t)cur.pm * tstep);
    const char* cB = (const char*)g.Bt + (MOE ? (size_t)moe_e(mps, cur.pm) * estride * 2 : (size_t)0) + (size_t)cur.pn * tstep;
    PG8_GOFF(vgc, cur.pm);
#define PG8_RSM(pm_, slot_) do { if constexpr (Epi::NEEDS_RSM) { if (wid == 0) { const int _e = moe_e(mps, (pm_)); const float* _src = E.ssq + (size_t)_e * NTOK + ((pm_) * BM - mps[_e]) + lane * 4; \
        __builtin_amdgcn_global_load_lds((const unsigned*)_src, (PG8_LAS unsigned*)(lds + STAGE_BYTES + (slot_) * 1024), 16, 0, 0); } } } while (0)
    PG8_RSM(cur.pm, 0);
    if constexpr (AMODE == 1) { Unit n1; if (S.next(1, n1)) { PG8_GOFF(vgn, n1.pm); } else {
#pragma unroll
        for (int _h = 0; _h < 2; ++_h)
#pragma unroll
            for (int _i = 0; _i < 2; ++_i) vgn[_h][_i] = vgc[_h][_i]; } }
    PG8_STAGE(PG8_SB(0, 0), cB, voffB); PG8_STAGE(PG8_SB(0, 1), cB + hstep, voffB); PG8_STA(PG8_SA(0, 0), cA, 0, vgc); PG8_STA(PG8_SA(0, 1), cA, 1, vgc);
    if (wr == 1) PG8_BAR;
    PG8_WAIT_V(2); PG8_BAR;
    PG8_STAGE(PG8_SB(1, 0), cB + kstep, voffB); PG8_STA(PG8_SA(1, 0), cA + kstepA, 0, vgc); PG8_STAGE(PG8_SB(1, 1), cB + hstep + kstep, voffB);
    PG8_WAIT_V(6); PG8_BAR;
    for (;;) {
        const bool has_next = S.next(ui + 1, nxt);
        const char* nA = has_next ? (const char*)g.A + (GATHER ? (size_t)0 : (size_t)nxt.pm * tstep) : cA;
        const char* nB = has_next ? (const char*)g.Bt + (MOE ? (size_t)moe_e(mps, nxt.pm) * estride * 2 : (size_t)0) + (size_t)nxt.pn * tstep : cB;
        if constexpr (AMODE == 2) { if (has_next) { PG8_GOFF(vgn, nxt.pm); } else {
#pragma unroll
            for (int _h = 0; _h < 2; ++_h)
#pragma unroll
                for (int _i = 0; _i < 2; ++_i) vgn[_h][_i] = vgc[_h][_i]; } }
        for (int t = 0; t < nt; t += 2) {
            const bool last = (t == nt - 2);
            const char* a1 = cA + (size_t)(t + 1) * kstepA;
            const char* a2 = last ? nA : cA + (size_t)(t + 2) * kstepA; const char* b2 = last ? nB : cB + (size_t)(t + 2) * kstep;
            const char* a3 = a2 + kstepA; const char* b3 = b2 + kstep;
            unsigned v2[2][2];
            if constexpr (GATHER) {
#pragma unroll
            for (int _h = 0; _h < 2; ++_h)
#pragma unroll
                for (int _i = 0; _i < 2; ++_i) v2[_h][_i] = last ? vgn[_h][_i] : vgc[_h][_i]; }
            PG8_LDB(B0, 0, 0); PG8_LDB(B1, 0, 1); PG8_SCHED; PG8_LDA(At, 0, 0); PG8_STA(PG8_SA(1, 1), a1, 1, vgc);
            PG8_WAIT_V(8); PG8_WAIT_L(0); PG8_BAR; PG8_MMA(0, 0, At, B0); PG8_MMA(0, 1, At, B1); PG8_BAR; PG8_SCHED;
            PG8_LDA(At, 0, 1); PG8_STAGE(PG8_SB(0, 0), b2, voffB); PG8_STAGE(PG8_SB(0, 1), b2 + hstep, voffB); PG8_STA(PG8_SA(0, 0), a2, 0, v2);
            PG8_WAIT_V(8); PG8_WAIT_L(0); PG8_BAR; PG8_MMA(1, 0, At, B0); PG8_MMA(1, 1, At, B1); PG8_BAR; PG8_SCHED;
            PG8_LDB(B0, 1, 0); PG8_LDB(B1, 1, 1); PG8_SCHED; PG8_LDA(At, 1, 0); PG8_STA(PG8_SA(0, 1), a2, 1, v2);
            PG8_WAIT_V(8); PG8_WAIT_L(0); PG8_BAR; PG8_MMA(0, 0, At, B0); PG8_MMA(0, 1, At, B1); PG8_BAR; PG8_SCHED;
            PG8_LDA(At, 1, 1); PG8_STAGE(PG8_SB(1, 0), b3, voffB); PG8_STAGE(PG8_SB(1, 1), b3 + hstep, voffB); PG8_STA(PG8_SA(1, 0), a3, 0, v2);
            PG8_WAIT_V(8); PG8_WAIT_L(0); PG8_BAR; PG8_MMA(1, 0, At, B0); PG8_MMA(1, 1, At, B1); PG8_BAR; PG8_SCHED;
        }
        if (wr == 0) PG8_BAR;
        if constexpr (Epi::NEEDS_RST) E(acc, cur, wr, wc, fr, fq, (const PG8_LAS float*)(lds + STAGE_BYTES) + ui * 256);
        else if constexpr (Epi::NEEDS_RSM) E(acc, cur, wr, wc, fr, fq, (const PG8_LAS float*)(lds + STAGE_BYTES) + (ui & 1) * 256);
        else E(acc, cur, wr, wc, fr, fq);
        if (!has_next) break;
#pragma unroll
        for (int a = 0; a < 2; ++a)
#pragma unroll
            for (int b = 0; b < 2; ++b)
#pragma unroll
                for (int m = 0; m < 4; ++m)
#pragma unroll
                    for (int n = 0; n < 2; ++n) acc[a][b][m][n] = (f32x4){0.f, 0.f, 0.f, 0.f};
        cur = nxt; cA = nA; cB = nB; ++ui;
        if constexpr (GATHER) {
#pragma unroll
        for (int _h = 0; _h < 2; ++_h)
#pragma unroll
            for (int _i = 0; _i < 2; ++_i) vgc[_h][_i] = vgn[_h][_i]; }
        PG8_RSM(cur.pm, ui & 1);
        if constexpr (AMODE == 1) { Unit n2; if (S.next(ui + 1, n2)) { PG8_GOFF(vgn, n2.pm); } }
        if (wr == 1) PG8_BAR;
    }
    PG8_WAIT_V(0);
    PG8_BAR;
#undef PG8_SA
#undef PG8_SB
#undef PG8_STAGE
#undef PG8_LDA
#undef PG8_LDB
#undef PG8_MMA
#undef PG8_WAIT_V
#undef PG8_WAIT_L
#undef PG8_BAR
#undef PG8_SCHED
#undef PG8_GOFF
#undef PG8_RSM
#undef PG8_STA
}

typedef const f32x4 (&AccT)[2][2][4][2];
struct EIn { static constexpr bool NEEDS_RST = true; static constexpr bool NEEDS_RSM = false; bf16_t* proj; const float* ssq;
    __device__ __forceinline__ void operator()(AccT acc, const Unit& u, int wr, int wc, int fr, int fq, const PG8_LAS float* rst) const {
        const int col0 = u.pn * BM + wc * 32 + 8 * fq;
#pragma unroll
        for (int ai = 0; ai < 2; ++ai)
#pragma unroll
            for (int m = 0; m < 4; ++m) { const int rl = ai * HALF + wr * 64 + m * 16 + fr, row = u.pm * BM + rl; const float rs = rst[rl]; bf16_t* rowp = proj + (size_t)row * DINP + col0;
#pragma unroll
                for (int bj = 0; bj < 2; ++bj) { const f32x4 v0 = acc[ai][bj][m][0] * rs, v1 = acc[ai][bj][m][1] * rs; u32x4 w; w.x = cvt_pk_bf16(v0[0], v0[1]); w.y = cvt_pk_bf16(v0[2], v0[3]); w.z = cvt_pk_bf16(v1[0], v1[1]); w.w = cvt_pk_bf16(v1[2], v1[3]);
                    *(u32x4*)(rowp + bj * HALF) = w; } } } };
struct ERes { static constexpr bool NEEDS_RST = false; static constexpr bool NEEDS_RSM = false; bf16_t* xb; float* ssq;
    __device__ __forceinline__ void operator()(AccT acc, const Unit& u, int wr, int wc, int fr, int fq) const {
        const int col0 = u.pn * BM + wc * 32 + 8 * fq;
#pragma unroll
        for (int ai = 0; ai < 2; ++ai) {
            u32x4 xo[4][2];
#pragma unroll
            for (int m = 0; m < 4; ++m)
#pragma unroll
                for (int bj = 0; bj < 2; ++bj) xo[m][bj] = *(const u32x4*)(xb + (size_t)(u.pm * BM + ai * HALF + wr * 64 + m * 16 + fr) * DM + col0 + bj * HALF);
#pragma unroll
            for (int m = 0; m < 4; ++m) { const int row = u.pm * BM + ai * HALF + wr * 64 + m * 16 + fr; const size_t o = (size_t)row * DM + col0; float s = 0.f;
#pragma unroll
                for (int bj = 0; bj < 2; ++bj) { const u32x4 w0 = xo[m][bj];
                    const f32x4 x0 = (f32x4){__uint_as_float(w0.x << 16), __uint_as_float(w0.x & 0xffff0000u), __uint_as_float(w0.y << 16), __uint_as_float(w0.y & 0xffff0000u)};
                    const f32x4 x1 = (f32x4){__uint_as_float(w0.z << 16), __uint_as_float(w0.z & 0xffff0000u), __uint_as_float(w0.w << 16), __uint_as_float(w0.w & 0xffff0000u)};
                    const f32x4 v0 = x0 + acc[ai][bj][m][0], v1 = x1 + acc[ai][bj][m][1];
                    u32x4 w; w.x = cvt_pk_bf16(v0[0], v0[1]); w.y = cvt_pk_bf16(v0[2], v0[3]); w.z = cvt_pk_bf16(v1[0], v1[1]); w.w = cvt_pk_bf16(v1[2], v1[3]);
                    *(u32x4*)(xb + o + bj * HALF) = w;
                    s += (v0[0] * v0[0] + v0[1] * v0[1]) + (v0[2] * v0[2] + v0[3] * v0[3]) + (v1[0] * v1[0] + v1[1] * v1[1]) + (v1[2] * v1[2] + v1[3] * v1[3]); }
                s += __shfl_xor(s, 16); s += __shfl_xor(s, 32);
                if (fq == 0) ssq[(size_t)row * NSLOT + u.pn * 4 + wc] = s; } } } };
struct ESwiglu { static constexpr bool NEEDS_RST = true; static constexpr bool NEEDS_RSM = false; bf16_t* h; const float* ssq;
    __device__ __forceinline__ void operator()(AccT acc, const Unit& u, int wr, int wc, int fr, int fq, const PG8_LAS float* rst) const {
        const int col0 = u.pn * HALF + wc * 32 + 8 * fq;
#pragma unroll
        for (int ai = 0; ai < 2; ++ai)
#pragma unroll
            for (int m = 0; m < 4; ++m) { const int rl = ai * HALF + wr * 64 + m * 16 + fr, row = u.pm * BM + rl; const float rs = rst[rl];
                float o[8];
#pragma unroll
                for (int n = 0; n < 2; ++n)
#pragma unroll
                    for (int e = 0; e < 4; ++e) { const float av = acc[ai][0][m][n][e] * rs, bv = acc[ai][1][m][n][e] * rs; o[n * 4 + e] = siluf(av) * bv; }
                u32x4 w; w.x = cvt_pk_bf16(o[0], o[1]); w.y = cvt_pk_bf16(o[2], o[3]); w.z = cvt_pk_bf16(o[4], o[5]); w.w = cvt_pk_bf16(o[6], o[7]);
                *(u32x4*)(h + (size_t)row * DFF + col0) = w; } } };
struct ESwigluMoe { static constexpr bool NEEDS_RST = false; static constexpr bool NEEDS_RSM = true; bf16_t* h; const float* ssq; const int* tok_list; const PG8_LAS int* mps;
    __device__ __forceinline__ void operator()(AccT acc, const Unit& u, int wr, int wc, int fr, int fq, const PG8_LAS float* rst) const {
        const int col0 = u.pn * HALF + wc * 32 + 8 * fq; const int e = moe_e(mps, u.pm), p0 = mps[e], c0 = mps[16 + e];
#pragma unroll
        for (int ai = 0; ai < 2; ++ai)
#pragma unroll
            for (int m = 0; m < 4; ++m) { const int row = u.pm * BM + ai * HALF + wr * 64 + m * 16 + fr; const int ix = row - p0; const float rs = ix < c0 ? rst[row - u.pm * BM] : 0.f;
                float o[8];
#pragma unroll
                for (int n = 0; n < 2; ++n)
#pragma unroll
                    for (int e = 0; e < 4; ++e) { const float av = acc[ai][0][m][n][e] * rs, bv = acc[ai][1][m][n][e] * rs; o[n * 4 + e] = siluf(av) * bv; }
                u32x4 w; w.x = cvt_pk_bf16(o[0], o[1]); w.y = cvt_pk_bf16(o[2], o[3]); w.z = cvt_pk_bf16(o[4], o[5]); w.w = cvt_pk_bf16(o[6], o[7]);
                *(u32x4*)(h + (size_t)row * DFF + col0) = w; } } };
struct ESiluBias { static constexpr bool NEEDS_RST = false; static constexpr bool NEEDS_RSM = false; bf16_t* out; const float* bias;
    __device__ __forceinline__ void operator()(AccT acc, const Unit& u, int wr, int wc, int fr, int fq) const {
        const int col0 = u.pn * BM + wc * 32 + 8 * fq;
#pragma unroll
        for (int ai = 0; ai < 2; ++ai)
#pragma unroll
            for (int m = 0; m < 4; ++m) { const int row = u.pm * BM + ai * HALF + wr * 64 + m * 16 + fr; bf16_t* rowp = out + (size_t)row * 256 + col0;
#pragma unroll
                for (int bj = 0; bj < 2; ++bj) { const f32x4 b0 = *(const f32x4*)(bias + col0 + bj * HALF), b1 = *(const f32x4*)(bias + col0 + bj * HALF + 4); const f32x4 v0 = acc[ai][bj][m][0] + b0, v1 = acc[ai][bj][m][1] + b1;
                    u32x4 w; w.x = cvt_pk_bf16(siluf(v0[0]), siluf(v0[1])); w.y = cvt_pk_bf16(siluf(v0[2]), siluf(v0[3])); w.z = cvt_pk_bf16(siluf(v1[0]), siluf(v1[1])); w.w = cvt_pk_bf16(siluf(v1[2]), siluf(v1[3]));
                    *(u32x4*)(rowp + bj * HALF) = w; } } } };
struct EKc { static constexpr bool NEEDS_RST = false; static constexpr bool NEEDS_RSM = false; bf16_t* out; int transposed, pad;
    __device__ __forceinline__ void operator()(AccT acc, const Unit& u, int wr, int wc, int fr, int fq) const {
        if (wc >= 2) return;
        const int col0 = wc * 32 + 8 * fq;
#pragma unroll
        for (int ai = 0; ai < 2; ++ai)
#pragma unroll
            for (int m = 0; m < 4; ++m) { const int row = u.pm * BM + ai * HALF + wr * 64 + m * 16 + fr; const f32x4 v0 = acc[ai][0][m][0], v1 = acc[ai][0][m][1];
                if (!transposed) { u32x4 w; w.x = cvt_pk_bf16(v0[0], v0[1]); w.y = cvt_pk_bf16(v0[2], v0[3]); w.z = cvt_pk_bf16(v1[0], v1[1]); w.w = cvt_pk_bf16(v1[2], v1[3]); *(u32x4*)(out + (size_t)row * 64 + col0) = w; }
                else { bf16_t* o = out + (size_t)(row >> 8) * 16384 + (size_t)col0 * 256 + (row & 255);
#pragma unroll
                    for (int x = 0; x < 4; ++x) { o[x * 256] = f2bf(v0[x]); o[(4 + x) * 256] = f2bf(v1[x]); } } } } };
struct EStore { static constexpr bool NEEDS_RST = false; static constexpr bool NEEDS_RSM = false; bf16_t* out; int ldc;
    __device__ __forceinline__ void operator()(AccT acc, const Unit& u, int wr, int wc, int fr, int fq) const {
        const int col0 = u.pn * BM + wc * 32 + 8 * fq;
#pragma unroll
        for (int ai = 0; ai < 2; ++ai)
#pragma unroll
            for (int m = 0; m < 4; ++m) { const int row = u.pm * BM + ai * HALF + wr * 64 + m * 16 + fr; bf16_t* rowp = out + (size_t)row * ldc + col0;
#pragma unroll
                for (int bj = 0; bj < 2; ++bj) { const f32x4 v0 = acc[ai][bj][m][0], v1 = acc[ai][bj][m][1]; u32x4 w; w.x = cvt_pk_bf16(v0[0], v0[1]); w.y = cvt_pk_bf16(v0[2], v0[3]); w.z = cvt_pk_bf16(v1[0], v1[1]); w.w = cvt_pk_bf16(v1[2], v1[3]);
                    *(u32x4*)(rowp + bj * HALF) = w; } } } };
}

#ifndef NSA_REP_SEL
#define NSA_REP_SEL 1
#endif
#ifndef NSA_REP_WIN
#define NSA_REP_WIN 1
#endif
namespace nsa {
typedef float f32x16 __attribute__((ext_vector_type(16)));
typedef unsigned u32x4 __attribute__((ext_vector_type(4)));
typedef unsigned u32x2 __attribute__((ext_vector_type(2)));
constexpr int KSTR = 144, VSTR = 144;
constexpr int KT_B = 64 * KSTR, VT_B = 64 * VSTR, BUF_B = KT_B + VT_B;
constexpr int IMP_OFF = 2 * BUF_B  , SELM_OFF = IMP_OFF + 8 * 2048  , WUN_OFF = SELM_OFF + 512;
constexpr float L2E = 1.4426950408889634f;
#define NLAS __attribute__((address_space(3)))
__device__ __forceinline__ unsigned pk2(float lo, float hi) { unsigned r; asm volatile("v_cvt_pk_bf16_f32 %0, %1, %2" : "=v"(r) : "v"(lo), "v"(hi)); return r; }
struct Stage { u32x4 k, v; };
__device__ __forceinline__ void stage_issue(Stage& st, const bf16_t* kg, size_t kstride, const bf16_t* vg, size_t vstride, int tid) {
    const int r = tid >> 3, c = (tid & 7) * 8;
    st.k = *(const u32x4*)(kg + (size_t)r * kstride + c); st.v = *(const u32x4*)(vg + (size_t)r * vstride + c);
}
__device__ __forceinline__ void stage_write(const Stage& st, NLAS char* buf, int tid) {
    const int r = tid >> 3, c = (tid & 7) * 16;
    *(NLAS u32x4*)(buf + r * KSTR + c) = st.k;
    { const int cc = tid & 7, vo = KT_B + r * VSTR + (cc >> 1) * 32 + (cc & 1) * 8;
      *(NLAS u32x2*)(buf + vo) = (u32x2){st.v.x, st.v.y}; *(NLAS u32x2*)(buf + vo + 16) = (u32x2){st.v.z, st.v.w}; }
}
__device__ __forceinline__ void compute_S(NLAS const char* buf, const bf16x8 (&Qf)[4], f32x16& S0, f32x16& S1, int lane) {
    const int kr = lane & 31, hi = lane >> 5;
#pragma unroll
    for (int i = 0; i < 16; ++i) { S0[i] = 0.f; S1[i] = 0.f; }
    bf16x8 af[8];
#pragma unroll
    for (int s = 0; s < 4; ++s) { af[2 * s] = *(NLAS const bf16x8*)(buf + kr * KSTR + s * 32 + hi * 16); af[2 * s + 1] = *(NLAS const bf16x8*)(buf + (32 + kr) * KSTR + s * 32 + hi * 16); }
    __builtin_amdgcn_sched_barrier(0);
#pragma unroll
    for (int s = 0; s < 4; ++s) { S0 = __builtin_amdgcn_mfma_f32_32x32x16_bf16(af[2 * s], Qf[s], S0, 0, 0, 0); S1 = __builtin_amdgcn_mfma_f32_32x32x16_bf16(af[2 * s + 1], Qf[s], S1, 0, 0, 0); }
}
__device__ __forceinline__ void mask_S(f32x16& S0, f32x16& S1, int lo, int hi, int lane) {
    const int h4 = (lane >> 5) * 4, lo2 = lo - h4, hi2 = hi - h4;
#pragma unroll
    for (int i = 0; i < 16; ++i) { const int c0 = (i & 3) + 8 * (i >> 2); S0[i] = (c0 >= lo2 && c0 <= hi2) ? S0[i] : -INFINITY; S1[i] = (c0 + 32 >= lo2 && c0 + 32 <= hi2) ? S1[i] : -INFINITY; }
}
__device__ __forceinline__ float max3f(float a, float b, float c) { float r; asm("v_max3_f32 %0, %1, %2, %3" : "=v"(r) : "v"(a), "v"(b), "v"(c)); return r; }
__device__ __forceinline__ float max_S(const f32x16& S0, const f32x16& S1) { float m = max3f(S0[0], S1[0], S0[1]);
    m = max3f(m, S1[1], S0[2]); m = max3f(m, S1[2], S0[3]); m = max3f(m, S1[3], S0[4]); m = max3f(m, S1[4], S0[5]); m = max3f(m, S1[5], S0[6]); m = max3f(m, S1[6], S0[7]); m = max3f(m, S1[7], S0[8]);
    m = max3f(m, S1[8], S0[9]); m = max3f(m, S1[9], S0[10]); m = max3f(m, S1[10], S0[11]); m = max3f(m, S1[11], S0[12]); m = max3f(m, S1[12], S0[13]); m = max3f(m, S1[13], S0[14]); m = max3f(m, S1[14], S0[15]);
    float o = __shfl_xor(m, 32); return max3f(m, S1[15], o); }
__device__ __forceinline__ float exp_S(f32x16& S0, f32x16& S1, float mL) { float l0 = 0.f, l1 = 0.f;
#pragma unroll
    for (int i = 0; i < 16; ++i) { S0[i] = __builtin_amdgcn_exp2f(fmaf(S0[i], L2E, -mL)); S1[i] = __builtin_amdgcn_exp2f(fmaf(S1[i], L2E, -mL)); l0 += S0[i]; l1 += S1[i]; }
    return l0 + l1; }
__device__ __forceinline__ void pack_P(const f32x16& S0, const f32x16& S1, unsigned andm, bf16x8 (&Pf)[4]) {
#pragma unroll
    for (int s2 = 0; s2 < 4; ++s2) { u32x4 w;
#pragma unroll
        for (int q = 0; q < 4; ++q) { const int i = (s2 & 1) * 8 + q * 2; w[q] = (s2 < 2 ? pk2(S0[i], S0[i + 1]) : pk2(S1[i], S1[i + 1])) & andm; }
        Pf[s2] = __builtin_bit_cast(bf16x8, w); }
}
__device__ __forceinline__ void pv(NLAS const char* buf, const bf16x8 (&Pf)[4], f32x16& O0, f32x16& O1, int lane) {
    const int dr = lane & 31, hi = lane >> 5; NLAS const char* vt = buf + KT_B;
    bf16x8 vf[8];
#pragma unroll
    for (int s2 = 0; s2 < 4; ++s2) { vf[2 * s2] = *(NLAS const bf16x8*)(vt + dr * VSTR + (16 * s2 + 8 * hi) * 2); vf[2 * s2 + 1] = *(NLAS const bf16x8*)(vt + (32 + dr) * VSTR + (16 * s2 + 8 * hi) * 2); }
    __builtin_amdgcn_sched_barrier(0);
#pragma unroll
    for (int s2 = 0; s2 < 4; ++s2) { O0 = __builtin_amdgcn_mfma_f32_32x32x16_bf16(vf[2 * s2], Pf[s2], O0, 0, 0, 0); O1 = __builtin_amdgcn_mfma_f32_32x32x16_bf16(vf[2 * s2 + 1], Pf[s2], O1, 0, 0, 0); }
}
__device__ __forceinline__ void online_block(NLAS const char* buf, const bf16x8 (&Qf)[4], f32x16& O0, f32x16& O1, float& m, float& l, bool lane_on, bool use_mask, int lo, int hi, int lane) {
    f32x16 S0, S1; compute_S(buf, Qf, S0, S1, lane);
    if (use_mask) mask_S(S0, S1, lo, hi, lane);
    float mt = max_S(S0, S1); if (!lane_on) mt = -INFINITY;
    const float mn = max3f(m, mt, mt), ms = mn == -INFINITY ? 0.f : mn;
    const float ls = exp_S(S0, S1, ms * L2E);
    if (__any(mn != m)) { const float al = __builtin_amdgcn_exp2f((m - ms) * L2E); l *= al;
#pragma unroll
        for (int i = 0; i < 16; ++i) { O0[i] *= al; O1[i] *= al; } }
    l += (lane_on ? ls : 0.f); m = mn;
    bf16x8 Pf[4]; pack_P(S0, S1, lane_on ? 0xffffffffu : 0u, Pf);
    pv(buf, Pf, O0, O1, lane);
}

struct BitIter { unsigned long long rem; __device__ __forceinline__ int next() { if (!rem) return -1; const int j = __builtin_ctzll(rem); rem &= rem - 1; return j; } };
struct RangeIter { int cur, end; __device__ __forceinline__ int next() { return cur <= end ? cur++ : -1; } };
struct SelPar { unsigned long long mq; int qb, tq;
    __device__ __forceinline__ void get(int j, bool& on, bool& um, int& lo, int& hi) const { on = (mq >> j) & 1ull; um = (j == qb); lo = 0; hi = tq; } };
struct WinPar { int qb, tq;
    __device__ __forceinline__ void get(int j, bool& on, bool& um, int& lo, int& hi) const { const bool first = (j == qb - 8), diag = (j == qb); on = true; um = first || diag; lo = first ? tq + 1 : 0; hi = diag ? tq : 63; } };
template <class It, class Par>
__device__ __forceinline__ void run_blocks(It it, const Par par, const bf16_t* kg, const bf16_t* vg, NLAS char* lds, const bf16x8 (&Qf)[4], f32x16& O0, f32x16& O1, float& m, float& l, int tid, int lane) {
    int j0 = it.next(), j1 = it.next();
    Stage sa, sb;
    stage_issue(sa, kg + (size_t)j0 * 64 * DINP, DINP, vg + j0 * 64, SEQ, tid);
    { const int jj = j1 >= 0 ? j1 : 0; stage_issue(sb, kg + (size_t)jj * 64 * DINP, DINP, vg + jj * 64, SEQ, tid); }
    stage_write(sa, lds, tid); __syncthreads();
    for (;;) {
        const int j2 = it.next();
        { const int jj = j2 >= 0 ? j2 : 0; stage_issue(sa, kg + (size_t)jj * 64 * DINP, DINP, vg + jj * 64, SEQ, tid); }
        { bool on, um; int lo, hi; par.get(j0, on, um, lo, hi); if (__any(on)) online_block(lds, Qf, O0, O1, m, l, on, um, lo, hi, lane); }
        stage_write(sb, lds + BUF_B, tid);
        __syncthreads();
        if (j1 < 0) break;
        const int j3 = it.next();
        { const int jj = j3 >= 0 ? j3 : 0; stage_issue(sb, kg + (size_t)jj * 64 * DINP, DINP, vg + jj * 64, SEQ, tid); }
        { bool on, um; int lo, hi; par.get(j1, on, um, lo, hi); if (__any(on)) online_block(lds + BUF_B, Qf, O0, O1, m, l, on, um, lo, hi, lane); }
        stage_write(sa, lds, tid);
        __syncthreads();
        if (j2 < 0) break;
        j0 = j2; j1 = j3;
    }
    __syncthreads();
}
}

__device__ __forceinline__ void nsa_unit(const Args& a, LAS char* lds_, const int qb, const int bg) {
    using namespace nsa;
    int tid = threadIdx.x; asm volatile("" : "+v"(tid));
    NLAS char* lds = lds_;
    const int w = __builtin_amdgcn_readfirstlane(tid >> 6), lane = tid & 63, hi = lane >> 5, r = lane & 31, tql = r >> 2, hpg = r & 3;
    NLAS float* impw = (NLAS float*)(lds + IMP_OFF + w * 2048);
    NLAS unsigned long long* selm = (NLAS unsigned long long*)(lds + SELM_OFF);
    NLAS unsigned long long* wun = (NLAS unsigned long long*)(lds + WUN_OFF);
    const bf16_t* proj = a.proj;
    {
        const int b = bg >> 1, g = bg & 1;
        const int tq = 8 * w + tql, t = 64 * qb + tq; const size_t row = (size_t)b * SEQ + t; const bf16_t* prow = proj + row * DINP;
        bf16x8 Qf[4];
#pragma unroll
        for (int s = 0; s < 4; ++s) Qf[s] = *(const bf16x8*)(prow + C_Q + g * 256 + hpg * 64 + 16 * s + 8 * hi);
        f32x16 Oo0, Oo1;
        const int hh = g * 4 + hpg; const float g0 = sigmf(bf2f(prow[C_GL + hh * 3 + 0])), g1 = sigmf(bf2f(prow[C_GL + hh * 3 + 1])), g2 = sigmf(bf2f(prow[C_GL + hh * 3 + 2]));
        Stage st;
        const bf16_t* kcg = a.kcb + (size_t)bg * 256 * 64; const bf16_t* vcg = a.vcT + (size_t)bg * 64 * 256;
        const int nbc = (4 * qb + 3 + 63) >> 6;
        const int cmax = t >= 31 ? (t - 31) >> 4 : -1;
        float mc = -INFINITY, lc = 0.f;
        __syncthreads();
        stage_issue(st, kcg, 64, vcg, 256, tid); stage_write(st, lds, tid); __syncthreads();
        for (int kb = 0; kb < nbc; ++kb) {
            NLAS char* buf = lds + (kb & 1) * BUF_B;
            if (kb + 1 < nbc) stage_issue(st, kcg + (size_t)(kb + 1) * 64 * 64, 64, vcg + (kb + 1) * 64, 256, tid);
            f32x16 S0, S1; compute_S(buf, Qf, S0, S1, lane); mask_S(S0, S1, 0, cmax - 64 * kb, lane);
            const float mt = max_S(S0, S1), mn = max3f(mc, mt, mt), ms = mn == -INFINITY ? 0.f : mn, al = __builtin_amdgcn_exp2f((mc - ms) * L2E);
            lc = lc * al + exp_S(S0, S1, ms * L2E); mc = mn;
            if (kb + 1 < nbc) stage_write(st, lds + ((kb + 1) & 1) * BUF_B, tid);
            __syncthreads();
        }
        lc += __shfl_xor(lc, 32);
        const float mLc = (mc == -INFINITY ? 0.f : mc) * L2E, ilc = lc > 0.f ? 1.f / lc : 0.f;
        f32x16 Oc0, Oc1, Z0, Z1;
#pragma unroll
        for (int i = 0; i < 16; ++i) { Oc0[i] = 0.f; Oc1[i] = 0.f; Z0[i] = 0.f; Z1[i] = 0.f; }
        stage_issue(st, kcg, 64, vcg, 256, tid); stage_write(st, lds, tid); __syncthreads();
        for (int kb = 0; kb < nbc; ++kb) {
            NLAS char* buf = lds + (kb & 1) * BUF_B;
            if (kb + 1 < nbc) stage_issue(st, kcg + (size_t)(kb + 1) * 64 * 64, 64, vcg + (kb + 1) * 64, 256, tid);
            f32x16 S0, S1; compute_S(buf, Qf, S0, S1, lane); mask_S(S0, S1, 0, cmax - 64 * kb, lane);
            (void)exp_S(S0, S1, mLc);
#pragma unroll
            for (int i = 0; i < 16; ++i) { S0[i] *= ilc; S1[i] *= ilc; }
            bf16x8 Pf[4]; pack_P(S0, S1, 0xffffffffu, Pf);
            pv(buf, Pf, Oc0, Oc1, lane);
#pragma unroll
            for (int s2 = 0; s2 < 4; ++s2) {
#pragma unroll
                for (int stl = 0; stl < 2; ++stl) { const int sblk = 32 * stl + r; u32x4 wv;
#pragma unroll
                    for (int q = 0; q < 4; ++q) { unsigned x = 0u;
#pragma unroll
                        for (int e = 0; e < 2; ++e) { const int j = q * 2 + e, c = 64 * kb + 16 * s2 + 8 * (j >> 2) + 4 * hi + (j & 3); if (c >= 4 * sblk - 1 && c <= 4 * sblk + 3) x |= (0x3f80u << (16 * e)); }
                        wv[q] = x; }
                    if (stl == 0) Z0 = __builtin_amdgcn_mfma_f32_32x32x16_bf16(Pf[s2], __builtin_bit_cast(bf16x8, wv), Z0, 0, 0, 0);
                    else          Z1 = __builtin_amdgcn_mfma_f32_32x32x16_bf16(Pf[s2], __builtin_bit_cast(bf16x8, wv), Z1, 0, 0, 0); } }
            if (kb + 1 < nbc) stage_write(st, lds + ((kb + 1) & 1) * BUF_B, tid);
            __syncthreads();
        }
#pragma unroll
        for (int i = 0; i < 16; ++i) { Oo0[i] = g0 * Oc0[i]; Oo1[i] = g0 * Oc1[i]; }
#pragma unroll
        for (int q4 = 0; q4 < 4; ++q4) { impw[(2 * q4 + hi) * 64 + r] = (Z0[4 * q4] + Z0[4 * q4 + 1]) + (Z0[4 * q4 + 2] + Z0[4 * q4 + 3]); impw[(2 * q4 + hi) * 64 + 32 + r] = (Z1[4 * q4] + Z1[4 * q4 + 1]) + (Z1[4 * q4 + 2] + Z1[4 * q4 + 3]); }
        __syncthreads();
        unsigned long long wu = 0ull;
        {
            const unsigned long long vmask = qb >= 63 ? ~0ull : ((1ull << (qb + 1)) - 1ull);
            const unsigned long long fmask = (1ull | (1ull << qb) | (qb >= 1 ? (1ull << (qb - 1)) : 0ull)) & vmask;
            const unsigned long long cand = vmask & ~fmask;
            const int K = 16 - __builtin_popcountll(fmask), ncand = __builtin_popcountll(cand);
            const unsigned long long lt_mask = (1ull << lane) - 1ull;
            for (int q = 0; q < 8; ++q) {
                unsigned long long mk = fmask;
                if (ncand <= K) mk |= cand;
                else {
                    const unsigned u = __float_as_uint(impw[q * 64 + lane]);
                    unsigned long long active = cand, chosen = 0ull; int k = K;
#pragma unroll
                    for (int bit = 30; bit >= 0; --bit) { const unsigned long long ones = __ballot((u >> bit) & 1u) & active; const int c = __builtin_popcountll(ones);
                        if (c >= k) active = ones; else { chosen |= ones; k -= c; active &= ~ones; } }
                    const bool tie_take = ((active >> lane) & 1ull) && (__builtin_popcountll(active & lt_mask) < k);
                    mk |= chosen | __ballot(tie_take);
                }
                wu |= mk;
                if (lane == 0) selm[8 * w + q] = mk; }
        }
        if (lane == 0) wun[w] = wu;
        __syncthreads();
        unsigned long long um = 0ull;
#pragma unroll
        for (int q = 0; q < 8; ++q) um |= wun[q];
        um = ((unsigned long long)__builtin_amdgcn_readfirstlane((unsigned)(um >> 32)) << 32) | (unsigned)__builtin_amdgcn_readfirstlane((unsigned)um);
        const unsigned long long mq = selm[tq];
        {
            const bf16_t* kg = proj + (size_t)b * SEQ * DINP + C_KS + g * 64; const bf16_t* vg = a.VsT + (size_t)bg * 64 * SEQ;
            f32x16 O0, O1;
#pragma unroll
            for (int i = 0; i < 16; ++i) { O0[i] = 0.f; O1[i] = 0.f; }
            float m = -INFINITY, l = 0.f;
            for (int rep = 0; rep < NSA_REP_SEL; ++rep) {
#pragma unroll
            for (int i = 0; i < 16; ++i) { O0[i] = 0.f; O1[i] = 0.f; }
            m = -INFINITY; l = 0.f;
            run_blocks(BitIter{um}, SelPar{mq, qb, tq}, kg, vg, lds, Qf, O0, O1, m, l, tid, lane); }
            l += __shfl_xor(l, 32); const float sc = l > 0.f ? g1 / l : 0.f;
#pragma unroll
            for (int i = 0; i < 16; ++i) { Oo0[i] += sc * O0[i]; Oo1[i] += sc * O1[i]; }
        }
        {
            const bf16_t* kg = proj + (size_t)b * SEQ * DINP + C_KW + g * 64; const bf16_t* vg = a.VwT + (size_t)bg * 64 * SEQ;
            f32x16 O0, O1;
#pragma unroll
            for (int i = 0; i < 16; ++i) { O0[i] = 0.f; O1[i] = 0.f; }
            float m = -INFINITY, l = 0.f;
            for (int rep = 0; rep < NSA_REP_WIN; ++rep) {
#pragma unroll
            for (int i = 0; i < 16; ++i) { O0[i] = 0.f; O1[i] = 0.f; }
            m = -INFINITY; l = 0.f;
            run_blocks(RangeIter{qb - 8 > 0 ? qb - 8 : 0, qb}, WinPar{qb, tq}, kg, vg, lds, Qf, O0, O1, m, l, tid, lane); }
            l += __shfl_xor(l, 32); const float sc = l > 0.f ? g2 / l : 0.f;
#pragma unroll
            for (int i = 0; i < 16; ++i) { Oo0[i] += sc * O0[i]; Oo1[i] += sc * O1[i]; }
        }
        bf16_t* op = a.ocat + row * DM + hh * 64 + 4 * hi;
#pragma unroll
        for (int q4 = 0; q4 < 4; ++q4) { u32x2 w0, w1; w0.x = pk2(Oo0[4 * q4], Oo0[4 * q4 + 1]); w0.y = pk2(Oo0[4 * q4 + 2], Oo0[4 * q4 + 3]); w1.x = pk2(Oo1[4 * q4], Oo1[4 * q4 + 1]); w1.y = pk2(Oo1[4 * q4 + 2], Oo1[4 * q4 + 3]);
            *(u32x2*)(op + 8 * q4) = w0; *(u32x2*)(op + 32 + 8 * q4) = w1; }
    }
}

__device__ __forceinline__ void ph_vtrans(const Args& a, LAS char* lds_, int vcu, int G) {
    int tid = threadIdx.x; asm volatile("" : "+v"(tid)); asm volatile("" : "+s"(vcu));
    LAS bf16_t* tile = (LAS bf16_t*)lds_;
    for (int u = vcu; u < 2 * 16 * 64; u += G) { const int tb = u & 63, bg = (u >> 6) & 15, which = u >> 10, b = bg >> 1, g = bg & 1;
        const bf16_t* src = a.proj + ((size_t)b * SEQ + tb * 64) * DINP + (which ? C_VW : C_VS) + g * 64; bf16_t* dst = (which ? a.VwT : a.VsT) + (size_t)bg * 64 * SEQ + tb * 64;
        const int r = tid >> 3, c = (tid & 7) * 8;
        const uint4 v = *(const uint4*)(src + (size_t)r * DINP + c); const unsigned wv[4] = {v.x, v.y, v.z, v.w};
        __syncthreads();
#pragma unroll
        for (int e = 0; e < 4; ++e) { tile[(c + 2 * e) * 72 + r] = (bf16_t)(wv[e] & 0xffffu); tile[(c + 2 * e + 1) * 72 + r] = (bf16_t)(wv[e] >> 16); }
        __syncthreads();
        *(u32x4_t*)(dst + (size_t)r * SEQ + c) = *(const LAS u32x4_t*)(tile + r * 72 + c);
    }
}

__device__ __forceinline__ void ph_conv_naive(const Args& a, int l, LAS char* lds, int vcu, int G) {
    int tid_ = threadIdx.x; asm volatile("" : "+v"(tid_)); asm volatile("" : "+s"(vcu));
    const int half = tid_ >> 8, c = tid_ & 255; LAS float* hs = (LAS float*)(lds + half * 63488);
    const float* cw = a.conv_w + (size_t)l * 31 * 256; const float* lg = a.conv_lg + l * 256; const float* lb = a.conv_lb + l * 256;
    float w[31];
#pragma unroll
    for (int k = 0; k < 31; ++k) w[k] = cw[k * 256 + c];
    const float bias = a.conv_b[l * 256 + c];
    for (int unit = vcu; unit < NTOK / 64; unit += G) {
        const int tile = unit * 2 + half, b = tile >> 7, t0 = (tile & 127) * 32;
        __syncthreads();
        for (int i = 0; i < 62; ++i) { const int t = t0 - 30 + i; float v = 0.f;
            if (t >= 0) { const bf16_t* p = a.proj + ((size_t)b * SEQ + t) * DINP + C_CONV; v = bf2f(p[c]) * sigmf(bf2f(p[256 + c])); }
            hs[i * 256 + c] = v; }
        __syncthreads();
        float outv[32];
#pragma unroll
        for (int tt = 0; tt < 32; ++tt) { float s = bias;
#pragma unroll
            for (int k = 0; k < 31; ++k) s += hs[(tt + k) * 256 + c] * w[k];
            outv[tt] = s; }
        __syncthreads();
#pragma unroll
        for (int tt = 0; tt < 32; ++tt) hs[tt * 256 + c] = outv[tt];
        __syncthreads();
        const int wave = c >> 6, lane = c & 63;
        for (int tt = wave; tt < 32; tt += 4) { float v[4], s = 0.f;
#pragma unroll
            for (int i = 0; i < 4; ++i) { v[i] = hs[tt * 256 + lane + 64 * i]; s += v[i]; }
            const float mu = wsum(s) * (1.f / 256.f); float q = 0.f;
#pragma unroll
            for (int i = 0; i < 4; ++i) q += (v[i] - mu) * (v[i] - mu);
            const float rs = rsqrtf(wsum(q) * (1.f / 256.f) + 1e-5f);
#pragma unroll
            for (int i = 0; i < 4; ++i) { const int ch = lane + 64 * i; const float y = (v[i] - mu) * rs * lg[ch] + lb[ch]; a.hconv[((size_t)b * SEQ + t0 + tt) * 256 + ch] = f2bf(siluf(y)); } }
    }
}


__device__ __forceinline__ void prep_unit(const Args& a, LAS char* lds, const int u) {
    int tid = threadIdx.x; asm volatile("" : "+v"(tid));
    constexpr int RS = 258; LAS bf16_t* tK = (LAS bf16_t*)lds; LAS bf16_t* tV = tK + 64 * RS; LAS bf16_t* tS = tV + 64 * RS;
    const int b = u >> 6, tb = u & 63;
    u32x4_t Lq[2][2], Lk[2][2], Lv[2][2], sv[4]; f32x4 Lc[2][4];
#pragma unroll
    for (int it = 0; it < 2; ++it) { const int item = tid + NT * it, tok = item >> 4, h = (item >> 2) & 3, ch = item & 3; const int pos = tb * 64 + tok;
        const bf16_t* p = a.proj + ((size_t)b * SEQ + pos) * DINP; const int c0 = h * 64 + 8 * ch;
        Lq[it][0] = *(const u32x4_t*)(p + C_RQ + c0); Lq[it][1] = *(const u32x4_t*)(p + C_RQ + c0 + 32); Lk[it][0] = *(const u32x4_t*)(p + C_RK + c0); Lk[it][1] = *(const u32x4_t*)(p + C_RK + c0 + 32);
        Lv[it][0] = *(const u32x4_t*)(p + C_RV + c0); Lv[it][1] = *(const u32x4_t*)(p + C_RV + c0 + 32);
        const float* cs = a.rot + ((size_t)pos * 32 + 8 * ch) * 2;
#pragma unroll
        for (int e = 0; e < 4; ++e) Lc[it][e] = *(const f32x4*)(cs + 4 * e); }
#pragma unroll
    for (int it = 0; it < 4; ++it) { const int item = tid + NT * it, tok = item >> 5, cb = (item >> 3) & 3, ch = item & 7;
        sv[it] = *(const u32x4_t*)(a.proj + ((size_t)b * SEQ + tb * 64 + tok) * DINP + ((cb & 2) ? C_VW : C_VS) + (cb & 1) * 64 + ch * 8); }
    __syncthreads();
#pragma unroll
    for (int it = 0; it < 2; ++it) { const int item = tid + NT * it, tok = item >> 4, h = (item >> 2) & 3, ch = item & 3; const int pos = tb * 64 + tok; const size_t row = (size_t)b * SEQ + pos;
        const int c0 = h * 64 + 8 * ch;
        const u32x4_t ql = Lq[it][0], qh = Lq[it][1], kl = Lk[it][0], kh = Lk[it][1], vl = Lv[it][0], vh = Lv[it][1];
        float co[8], si[8];
#pragma unroll
        for (int e = 0; e < 4; ++e) { const f32x4 t4 = Lc[it][e]; co[2 * e] = t4[0]; si[2 * e] = t4[1]; co[2 * e + 1] = t4[2]; si[2 * e + 1] = t4[3]; }
        const float zeta = exp2f((float)(127 - (pos & 127)) * log2f(1.f - exp2f(-5.f - (float)h)));
        u32x4_t oql, oqh, okl, okh; LAS unsigned* wk = (LAS unsigned*)(tK + tok * RS + c0); LAS unsigned* wv = (LAS unsigned*)(tV + tok * RS + c0);
#pragma unroll
        for (int e2 = 0; e2 < 4; ++e2) { float r1[2], r2[2], k1[2], k2[2];
#pragma unroll
            for (int e1 = 0; e1 < 2; ++e1) { const int e = e2 * 2 + e1; const float x1 = __uint_as_float(e1 ? (ql[e2] & 0xffff0000u) : (ql[e2] << 16)), x2 = __uint_as_float(e1 ? (qh[e2] & 0xffff0000u) : (qh[e2] << 16));
                const float y1 = __uint_as_float(e1 ? (kl[e2] & 0xffff0000u) : (kl[e2] << 16)), y2 = __uint_as_float(e1 ? (kh[e2] & 0xffff0000u) : (kh[e2] << 16));
                r1[e1] = x1 * co[e] - x2 * si[e]; r2[e1] = x1 * si[e] + x2 * co[e]; k1[e1] = y1 * co[e] - y2 * si[e]; k2[e1] = y1 * si[e] + y2 * co[e]; }
            oql[e2] = pk2bf(r1[0], r1[1]); oqh[e2] = pk2bf(r2[0], r2[1]); okl[e2] = pk2bf(k1[0], k1[1]); okh[e2] = pk2bf(k2[0], k2[1]);
            wk[e2] = pk2bf(k1[0] * zeta, k1[1] * zeta); wk[16 + e2] = pk2bf(k2[0] * zeta, k2[1] * zeta); wv[e2] = vl[e2]; wv[16 + e2] = vh[e2]; }
        *(u32x4_t*)(a.qrb + row * 256 + c0) = oql; *(u32x4_t*)(a.qrb + row * 256 + c0 + 32) = oqh; *(u32x4_t*)(a.krb + row * 256 + c0) = okl; *(u32x4_t*)(a.krb + row * 256 + c0 + 32) = okh; }
#pragma unroll
    for (int it = 0; it < 4; ++it) { const int item = tid + NT * it, tok = item >> 5, cb = (item >> 3) & 3, ch = item & 7; const u32x4_t v = sv[it];
        LAS unsigned* ws = (LAS unsigned*)(tS + tok * RS + cb * 64 + ch * 8); ws[0] = v.x; ws[1] = v.y; ws[2] = v.z; ws[3] = v.w; }
    __syncthreads();
#pragma unroll
    for (int it = 0; it < 12; ++it) { const int q = tid + NT * it, tl = q >> 11, ri = (q >> 3) & 255, cc = q & 7;
        const LAS bf16_t* src = (tl == 0 ? tK : tl == 1 ? tV : tS) + (cc * 8) * RS + ri; unsigned short e[8];
#pragma unroll
        for (int j = 0; j < 8; ++j) e[j] = src[j * RS];
        u32x4_t w; w.x = e[0] | ((unsigned)e[1] << 16); w.y = e[2] | ((unsigned)e[3] << 16); w.z = e[4] | ((unsigned)e[5] << 16); w.w = e[6] | ((unsigned)e[7] << 16);
        bf16_t* dst = tl == 0 ? a.KzT + ((size_t)b * 256 + ri) * SEQ : tl == 1 ? a.VrT + ((size_t)b * 256 + ri) * SEQ : ((ri & 128) ? a.VwT : a.VsT) + ((size_t)(b * 2 + ((ri >> 6) & 1)) * 64 + (ri & 63)) * SEQ;
        *(u32x4_t*)(dst + tb * 64 + cc * 8) = w; }
}
__device__ __forceinline__ void conv_unit(const Args& a, int l, LAS char* lds, const int u) {
    int tid = threadIdx.x; asm volatile("" : "+v"(tid));
    LAS float* hs = (LAS float*)lds; const int b = u >> 6, t0 = (u & 63) * 64;
    const int p = tid & 255, th = tid >> 8, c = (p & 31) * 8 + (p >> 5);
    const float* cw = a.conv_w + (size_t)l * 31 * 256; float w[31];
#pragma unroll
    for (int k = 0; k < 31; ++k) w[k] = cw[k * 256 + c];
    const float bias = a.conv_b[l * 256 + c];
    __syncthreads();
#pragma unroll
    for (int it = 0; it < 6; ++it) { const int q = tid + NT * it; if (q < 94 * 32) { const int rr = q >> 5, cc = q & 31, t = t0 - 30 + rr; u32x4_t av = (u32x4_t){0u, 0u, 0u, 0u}, gv = av;
            if (t >= 0) { const bf16_t* pp = a.proj + ((size_t)b * SEQ + t) * DINP + C_CONV + cc * 8; av = *(const u32x4_t*)pp; gv = *(const u32x4_t*)(pp + 256); }
#pragma unroll
            for (int e = 0; e < 8; ++e) { const unsigned aw = av[e >> 1], gw = gv[e >> 1]; const float x = __uint_as_float((e & 1) ? (aw & 0xffff0000u) : (aw << 16)), gt = __uint_as_float((e & 1) ? (gw & 0xffff0000u) : (gw << 16));
                hs[rr * 256 + e * 32 + cc] = t >= 0 ? x * sigmf(gt) : 0.f; } } }
    __syncthreads();
    float acc[32];
#pragma unroll
    for (int tt = 0; tt < 32; ++tt) acc[tt] = bias;
#pragma unroll
    for (int j = 0; j < 62; ++j) { const float x = hs[(th * 32 + j) * 256 + p];
#pragma unroll
        for (int tt = 0; tt < 32; ++tt) if (j - tt >= 0 && j - tt <= 30) acc[tt] += x * w[j - tt]; }
    __syncthreads();
#pragma unroll
    for (int tt = 0; tt < 32; ++tt) hs[(th * 32 + tt) * 256 + p] = acc[tt];
    __syncthreads();
    const int wave = tid >> 6, lane = tid & 63; const float* lg = a.conv_lg + l * 256; const float* lb = a.conv_lb + l * 256;
#pragma unroll 2
    for (int i8 = 0; i8 < 8; ++i8) { const int tt = wave * 8 + i8; float v[4], sm = 0.f;
#pragma unroll
        for (int i = 0; i < 4; ++i) { v[i] = hs[tt * 256 + lane + 64 * i]; sm += v[i]; }
        const float mu = wsum(sm) * (1.f / 256.f); float q = 0.f;
#pragma unroll
        for (int i = 0; i < 4; ++i) q += (v[i] - mu) * (v[i] - mu);
        const float rs = rsqrtf(wsum(q) * (1.f / 256.f) + 1e-5f);
#pragma unroll
        for (int i = 0; i < 4; ++i) { const int pp = lane + 64 * i, ch = (pp & 31) * 8 + (pp >> 5); const float y = (v[i] - mu) * rs * lg[ch] + lb[ch]; a.hconv[((size_t)b * SEQ + t0 + tt) * 256 + ch] = f2bf(siluf(y)); } }
}
__device__ __forceinline__ void ph_x1_small(const Args& a, int l, LAS char* lds) {
    int tid = threadIdx.x; asm volatile("" : "+v"(tid));
    volatile LAS int* slot = (volatile LAS int*)(lds + MISC_OFF + 64);
    unsigned* wq = a.wq + 256 + 64 * l;
    __syncthreads();
    if (tid == 0) slot[0] = (int)__hip_atomic_fetch_add(wq, 1u, __ATOMIC_RELAXED, __HIP_MEMORY_SCOPE_AGENT);
    __syncthreads();
    for (int n = 0;; ++n) {
        const int idx = slot[n & 1];
        if (idx >= 1024) break;
        if (tid == 0) slot[(n + 1) & 1] = (int)__hip_atomic_fetch_add(wq, 1u, __ATOMIC_RELAXED, __HIP_MEMORY_SCOPE_AGENT);
        if (idx < 512) conv_unit(a, l, lds, idx); else prep_unit(a, lds, idx - 512);
        __syncthreads();
    }
    __syncthreads();
}

namespace ret {
using nsa::f32x16; using nsa::u32x4; using nsa::u32x2; using nsa::pk2;
__device__ __forceinline__ float lg2g(int h) { return log2f(1.f - exp2f(-5.f - (float)h)); }
}
__device__ __forceinline__ void ph_ret_prep(const Args& a, LAS char* lds, int vcu, int G) {
    int tid = threadIdx.x; asm volatile("" : "+v"(tid)); asm volatile("" : "+s"(vcu));
    LAS bf16_t* tK = (LAS bf16_t*)lds; LAS bf16_t* tV = (LAS bf16_t*)(lds + 256 * 72 * 2);
    for (int u = vcu; u < NB * 64; u += G) { const int b = u >> 6, tb = u & 63;
        __syncthreads();
#pragma unroll
        for (int it = 0; it < 2; ++it) { const int item = tid + NT * it, tok = item >> 4, h = (item >> 2) & 3, ch = item & 3; const int pos = tb * 64 + tok; const size_t row = (size_t)b * SEQ + pos;
            const bf16_t* p = a.proj + row * DINP; const int c0 = h * 64 + 8 * ch;
            const u32x4_t ql = *(const u32x4_t*)(p + C_RQ + c0), qh = *(const u32x4_t*)(p + C_RQ + c0 + 32), kl = *(const u32x4_t*)(p + C_RK + c0), kh = *(const u32x4_t*)(p + C_RK + c0 + 32);
            const u32x4_t vl = *(const u32x4_t*)(p + C_RV + c0), vh = *(const u32x4_t*)(p + C_RV + c0 + 32);
            const float* cs = a.rot + ((size_t)pos * 32 + 8 * ch) * 2; float co[8], si[8];
#pragma unroll
            for (int e = 0; e < 4; ++e) { const f32x4 t4 = *(const f32x4*)(cs + 4 * e); co[2 * e] = t4[0]; si[2 * e] = t4[1]; co[2 * e + 1] = t4[2]; si[2 * e + 1] = t4[3]; }
            const float zeta = exp2f((float)(127 - (pos & 127)) * ret::lg2g(h));
            u32x4_t oql, oqh, okl, okh;
#pragma unroll
            for (int e2 = 0; e2 < 4; ++e2) { float r1[2], r2[2], k1[2], k2[2];
#pragma unroll
                for (int e1 = 0; e1 < 2; ++e1) { const int e = e2 * 2 + e1; const float x1 = __uint_as_float(e1 ? (ql[e2] & 0xffff0000u) : (ql[e2] << 16)), x2 = __uint_as_float(e1 ? (qh[e2] & 0xffff0000u) : (qh[e2] << 16));
                    const float y1 = __uint_as_float(e1 ? (kl[e2] & 0xffff0000u) : (kl[e2] << 16)), y2 = __uint_as_float(e1 ? (kh[e2] & 0xffff0000u) : (kh[e2] << 16));
                    r1[e1] = x1 * co[e] - x2 * si[e]; r2[e1] = x1 * si[e] + x2 * co[e]; k1[e1] = y1 * co[e] - y2 * si[e]; k2[e1] = y1 * si[e] + y2 * co[e];
                    tK[(c0 + e) * 72 + tok] = f2bf(k1[e1] * zeta); tK[(c0 + 32 + e) * 72 + tok] = f2bf(k2[e1] * zeta);
                    tV[(c0 + e) * 72 + tok] = (bf16_t)(e1 ? (vl[e2] >> 16) : (vl[e2] & 0xffffu)); tV[(c0 + 32 + e) * 72 + tok] = (bf16_t)(e1 ? (vh[e2] >> 16) : (vh[e2] & 0xffffu)); }
                oql[e2] = nsa::pk2(r1[0], r1[1]); oqh[e2] = nsa::pk2(r2[0], r2[1]); okl[e2] = nsa::pk2(k1[0], k1[1]); okh[e2] = nsa::pk2(k2[0], k2[1]); }
            *(u32x4_t*)(a.qrb + row * 256 + c0) = oql; *(u32x4_t*)(a.qrb + row * 256 + c0 + 32) = oqh; *(u32x4_t*)(a.krb + row * 256 + c0) = okl; *(u32x4_t*)(a.krb + row * 256 + c0 + 32) = okh; }
        __syncthreads();
#pragma unroll
        for (int it = 0; it < 4; ++it) { const int q = tid + NT * it, ri = q >> 3, cc = (q & 7) * 8; const size_t o = ((size_t)b * 256 + ri) * SEQ + tb * 64 + cc;
            *(u32x4_t*)(a.KzT + o) = *(const LAS u32x4_t*)(tK + ri * 72 + cc); *(u32x4_t*)(a.VrT + o) = *(const LAS u32x4_t*)(tV + ri * 72 + cc); }
    }
}
__device__ __forceinline__ void ret_state_unit(const Args& a, const int u0) {
    using namespace ret;
    int tid = threadIdx.x; asm volatile("" : "+v"(tid));
    const int w = tid >> 6, lane = tid & 63, hi = lane >> 5, r = lane & 31;
    if (w >= 4) return;
    { const int u = u0; const int h = u & 3, et = w >> 1, dt = w & 1; const float gc = exp2f(128.f * lg2g(h));
        const bf16_t* va = a.VrT + ((size_t)u * 64 + 32 * et + r) * SEQ + 8 * hi; const bf16_t* kb = a.KzT + ((size_t)u * 64 + 32 * dt + r) * SEQ + 8 * hi;
        f32x16 S;
#pragma unroll
        for (int i = 0; i < 16; ++i) S[i] = 0.f;
        bf16x8 A[8], B[8];
#pragma unroll
        for (int s2 = 0; s2 < 8; ++s2) { A[s2] = *(const bf16x8*)(va + 16 * s2); B[s2] = *(const bf16x8*)(kb + 16 * s2); }
        for (int c = 0; c < 32; ++c) {
            bf16_t* sp = a.ST + (((size_t)u * 32 + c) * 64 + 32 * et + 4 * hi) * 64 + 32 * dt + r;
#pragma unroll
            for (int i = 0; i < 16; ++i) sp[((i & 3) + 8 * (i >> 2)) * 64] = f2bf(S[i]);
            f32x16 KV;
#pragma unroll
            for (int i = 0; i < 16; ++i) KV[i] = 0.f;
            bf16x8 An[8], Bn[8]; const int cn = c < 31 ? c + 1 : c;
#pragma unroll
            for (int s2 = 0; s2 < 8; ++s2) { An[s2] = *(const bf16x8*)(va + cn * 128 + 16 * s2); Bn[s2] = *(const bf16x8*)(kb + cn * 128 + 16 * s2); }
#pragma unroll
            for (int s2 = 0; s2 < 8; ++s2) KV = __builtin_amdgcn_mfma_f32_32x32x16_bf16(A[s2], B[s2], KV, 0, 0, 0);
#pragma unroll
            for (int i = 0; i < 16; ++i) S[i] = gc * S[i] + KV[i];
#pragma unroll
            for (int s2 = 0; s2 < 8; ++s2) { A[s2] = An[s2]; B[s2] = Bn[s2]; }
        }
    }
}
__device__ __forceinline__ void ret_out_unit(const Args& a, int l, const int u0, LAS char* lds) {
    using namespace ret;
    int tid = threadIdx.x; asm volatile("" : "+v"(tid));
    const int w = tid >> 6, lane = tid & 63, hi = lane >> 5, r = lane & 31, h = w >> 1, pr = w & 1;
    const float lg = lg2g(h); const float* gn = a.ret_gn + l * 256 + h * 64;
    const int u = u0, b = u >> 5, c = u & 31, bh = b * 4 + h;
    constexpr int RK = 144, RV = 272, KH = 128 * RK  , VH = 64 * RV  , VOFF = 4 * KH;
    u32x4_t kreg[8], vreg[8];
#pragma unroll
    for (int i = 0; i < 8; ++i) { const int q = tid + NT * i, kr = q >> 5, cc = q & 31; kreg[i] = *(const u32x4_t*)(a.krb + ((size_t)b * SEQ + c * 128 + kr) * 256 + cc * 8); }
#pragma unroll
    for (int i = 0; i < 8; ++i) { const int q = tid + NT * i, vr = q >> 4, cc = q & 15; vreg[i] = *(const u32x4_t*)(a.VrT + ((size_t)b * 256 + vr) * SEQ + c * 128 + cc * 8); }
    const bf16_t* stp = a.ST + ((size_t)bh * 32 + c) * 4096;
    bf16x8 A0[4], A1[4];
#pragma unroll
    for (int sx = 0; sx < 4; ++sx) { A0[sx] = *(const bf16x8*)(stp + r * 64 + 16 * sx + 8 * hi); A1[sx] = *(const bf16x8*)(stp + (32 + r) * 64 + 16 * sx + 8 * hi); }
    __syncthreads();
#pragma unroll
    for (int i = 0; i < 8; ++i) { const int q = tid + NT * i, kr = q >> 5, cc = q & 31; *(LAS u32x4_t*)(lds + (cc >> 3) * KH + kr * RK + (cc & 7) * 16) = kreg[i]; }
#pragma unroll
    for (int i = 0; i < 8; ++i) { const int q = tid + NT * i, vr = q >> 4, cc = q & 15; LAS char* p = lds + VOFF + (vr >> 6) * VH + (vr & 63) * RV + (cc >> 1) * 32 + (cc & 1) * 8;
        *(LAS nsa::u32x2*)p = (nsa::u32x2){vreg[i].x, vreg[i].y}; *(LAS nsa::u32x2*)(p + 16) = (nsa::u32x2){vreg[i].z, vreg[i].w}; }
    __syncthreads();
    const LAS char* kl = lds + h * KH; const LAS char* vl = lds + VOFF + h * VH;
#pragma unroll 1
    for (int qi = 0; qi < 2; ++qi) { const int q = pr ? (qi ? 2 : 1) : (qi ? 3 : 0); const size_t row = (size_t)b * SEQ + c * 128 + 32 * q + r;
        bf16x8 Qf[4];
#pragma unroll
        for (int sx = 0; sx < 4; ++sx) Qf[sx] = *(const bf16x8*)(a.qrb + row * 256 + h * 64 + 16 * sx + 8 * hi);
        const bf16_t* gp = a.proj + row * DINP + C_RG + h * 64 + 4 * hi; u32x2 gt[4][2];
#pragma unroll
        for (int q4 = 0; q4 < 4; ++q4)
#pragma unroll
            for (int et = 0; et < 2; ++et) gt[q4][et] = *(const u32x2*)(gp + 32 * et + 8 * q4);
        f32x16 O0, O1;
#pragma unroll
        for (int i = 0; i < 16; ++i) { O0[i] = 0.f; O1[i] = 0.f; }
#pragma unroll
        for (int sx = 0; sx < 4; ++sx) { O0 = __builtin_amdgcn_mfma_f32_32x32x16_bf16(A0[sx], Qf[sx], O0, 0, 0, 0); O1 = __builtin_amdgcn_mfma_f32_32x32x16_bf16(A1[sx], Qf[sx], O1, 0, 0, 0); }
        const float xi = exp2f((float)(32 * q + r + 1) * lg);
#pragma unroll
        for (int i = 0; i < 16; ++i) { O0[i] *= xi; O1[i] *= xi; }
        for (int kt = 0; kt <= q; ++kt) {
            bf16x8 ka[4], v0[2], v1[2];
#pragma unroll
            for (int sx = 0; sx < 4; ++sx) ka[sx] = *(const LAS bf16x8*)(kl + (32 * kt + r) * RK + sx * 32 + hi * 16);
#pragma unroll
            for (int s2 = 0; s2 < 2; ++s2) { v0[s2] = *(const LAS bf16x8*)(vl + r * RV + (2 * kt + s2) * 32 + hi * 16); v1[s2] = *(const LAS bf16x8*)(vl + (32 + r) * RV + (2 * kt + s2) * 32 + hi * 16); }
            f32x16 S;
#pragma unroll
            for (int i = 0; i < 16; ++i) S[i] = 0.f;
#pragma unroll
            for (int sx = 0; sx < 4; ++sx) S = __builtin_amdgcn_mfma_f32_32x32x16_bf16(ka[sx], Qf[sx], S, 0, 0, 0);
            const int dbase = 32 * (q - kt) + r - 4 * hi;
#pragma unroll
            for (int i = 0; i < 16; ++i) { const int dl = dbase - ((i & 3) + 8 * (i >> 2)); S[i] = dl >= 0 ? S[i] * exp2f((float)dl * lg) : 0.f; }
#pragma unroll
            for (int s2 = 0; s2 < 2; ++s2) { u32x4 pw;
#pragma unroll
                for (int x = 0; x < 4; ++x) pw[x] = pk2(S[8 * s2 + 2 * x], S[8 * s2 + 2 * x + 1]);
                const bf16x8 Pf = __builtin_bit_cast(bf16x8, pw);
                O0 = __builtin_amdgcn_mfma_f32_32x32x16_bf16(v0[s2], Pf, O0, 0, 0, 0); O1 = __builtin_amdgcn_mfma_f32_32x32x16_bf16(v1[s2], Pf, O1, 0, 0, 0); }
        }
        float sm = 0.f;
#pragma unroll
        for (int i = 0; i < 16; ++i) sm += O0[i] + O1[i];
        sm += __shfl_xor(sm, 32); const float mu = sm * (1.f / 64.f); float vq = 0.f;
#pragma unroll
        for (int i = 0; i < 16; ++i) { const float d0 = O0[i] - mu, d1 = O1[i] - mu; vq += d0 * d0 + d1 * d1; }
        vq += __shfl_xor(vq, 32); const float rs = rsqrtf(vq * (1.f / 64.f) + 1e-5f);
        bf16_t* op = a.ocat + row * DM + 768 + h * 64 + 4 * hi;
#pragma unroll
        for (int q4 = 0; q4 < 4; ++q4) {
#pragma unroll
            for (int et = 0; et < 2; ++et) { const int e0 = 32 * et + 8 * q4; const f32x4 gg = *(const f32x4*)(gn + e0 + 4 * hi);
                float o[4];
#pragma unroll
                for (int x = 0; x < 4; ++x) { const float ov = et ? O1[4 * q4 + x] : O0[4 * q4 + x]; const unsigned gw = x < 2 ? gt[q4][et].x : gt[q4][et].y; const float gv = __uint_as_float((x & 1) ? (gw & 0xffff0000u) : (gw << 16));
                    o[x] = siluf(gv) * (ov - mu) * rs * gg[x]; }
                u32x2 ow; ow.x = pk2(o[0], o[1]); ow.y = pk2(o[2], o[3]); *(u32x2*)(op + e0) = ow; } }
    }
}


__device__ __forceinline__ void conv_super2(const ConvJob& c, int st0, int tid_) {
    const int nsn = c.Npad / 256, lane = tid_ & 63, wv = tid_ >> 6;
    float v[2][32];
#pragma unroll
    for (int t = 0; t < 2; ++t) { const int st = st0 + t, n0 = (st % nsn) * 256, k0 = (st / nsn) * 64;
#pragma unroll
        for (int q = 0; q < 4; ++q) { const int n = n0 + q * 64 + lane; int sc;
            if (c.mode == 2) { const int pn = n >> 8, i = n & 255; sc = i < 128 ? 128 * pn + i : DFF + 128 * pn + (i - 128); } else sc = n < c.nvalid ? n : -1;
#pragma unroll
            for (int e = 0; e < 8; ++e) v[t][q * 8 + e] = sc >= 0 ? c.src[(size_t)(k0 + 8 * wv + e) * c.ldsrc + sc] : 0.f; } }
#pragma unroll
    for (int t = 0; t < 2; ++t) { const int st = st0 + t, n0 = (st % nsn) * 256, k0 = (st / nsn) * 64; float gs[8];
#pragma unroll
        for (int e = 0; e < 8; ++e) gs[e] = c.g ? c.g[k0 + 8 * wv + e] : 1.f;
#pragma unroll
        for (int q = 0; q < 4; ++q) { const int n = n0 + q * 64 + lane; const float cs = (c.mode == 1 && (n < 512 || (n >= C_RK && n < C_RV))) ? 0.125f : 1.f;
            u32x4_t w; w.x = pk2bf(v[t][q * 8 + 0] * gs[0] * cs, v[t][q * 8 + 1] * gs[1] * cs); w.y = pk2bf(v[t][q * 8 + 2] * gs[2] * cs, v[t][q * 8 + 3] * gs[3] * cs);
            w.z = pk2bf(v[t][q * 8 + 4] * gs[4] * cs, v[t][q * 8 + 5] * gs[5] * cs); w.w = pk2bf(v[t][q * 8 + 6] * gs[6] * cs, v[t][q * 8 + 7] * gs[7] * cs);
            *(u32x4_t*)(c.dst + (size_t)n * c.K + k0 + 8 * wv) = w; } }
}
constexpr int DEF_ITEMS0 = (192 + 64 + 64 + 352 + 176 + 4 * (352 + 176)) / 2, DEF_ITEMS1 = 4 * (352 + 176) / 2;
__device__ __forceinline__ void deferred_item(const Args& a, int l, int it2, LAS char* lds) {
    int tid_ = threadIdx.x; asm volatile("" : "+v"(tid_));
    int job, st; const int it = it2 * 2;
    if (l == 0) {
        if (it < 192) { job = 1; st = it; }
        else if (it < 256) { job = 2; st = it - 192; }
        else if (it < 320) { job = 3; st = it - 256; }
        else if (it < 672) { job = 14; st = it - 320; }
        else if (it < 848) { job = 15; st = it - 672; }
        else { const int r = it - 848, e = r / 528, q = r % 528; if (q < 352) { job = 16 + e; st = q; } else { job = 24 + e; st = q - 352; } }
    } else { const int e = 4 + it / 528, q = it % 528; if (q < 352) { job = 16 + e; st = q; } else { job = 24 + e; st = q - 352; } }
    const ConvJob c = get_job(a, job);
    conv_super2(c, st, tid_);
}

constexpr int MIX_ITEMS = 32 + 1024 + 256;
__device__ __forceinline__ void ph_mix(const Args& a, int l, LAS char* lds) {
    int tid = threadIdx.x; asm volatile("" : "+v"(tid));
    volatile LAS int* slot = (volatile LAS int*)(lds + MISC_OFF + 64);
    unsigned* wq = a.wq + 64 * l; unsigned* rsdone = a.wq + 128 + 64 * l; unsigned* tmo = a.wq + 192;
    if (tid == 0) slot[0] = (int)__hip_atomic_fetch_add(wq, 1u, __ATOMIC_RELAXED, __HIP_MEMORY_SCOPE_AGENT);
    __syncthreads();
    for (int n = 0;; ++n) {
        const int idx = slot[n & 1];
        if (idx >= MIX_ITEMS + (l == 0 ? DEF_ITEMS0 : DEF_ITEMS1)) break;
        if (tid == 0) slot[(n + 1) & 1] = (int)__hip_atomic_fetch_add(wq, 1u, __ATOMIC_RELAXED, __HIP_MEMORY_SCOPE_AGENT);
        if (idx >= MIX_ITEMS) { deferred_item(a, l, idx - MIX_ITEMS, lds); }
        else if (idx < 32) {
            ret_state_unit(a, idx);
            asm volatile("s_waitcnt vmcnt(0)" ::: "memory"); __syncthreads();
            if (tid == 0) { __builtin_amdgcn_fence(__ATOMIC_RELEASE, "agent"); asm volatile("s_waitcnt vmcnt(0)" ::: "memory"); (void)__hip_atomic_fetch_add(rsdone, 1u, __ATOMIC_RELAXED, __HIP_MEMORY_SCOPE_AGENT); }
        } else if (idx >= 32 + 512 && idx < 32 + 512 + 256) {
            if (tid == 0) { unsigned sp = 0;
                while (__hip_atomic_load(rsdone, __ATOMIC_RELAXED, __HIP_MEMORY_SCOPE_AGENT) < 32u) { __builtin_amdgcn_s_sleep(2); if (++sp > (1u << 22)) { __hip_atomic_store(tmo, 1u, __ATOMIC_RELAXED, __HIP_MEMORY_SCOPE_AGENT); break; } }
                __builtin_amdgcn_fence(__ATOMIC_ACQUIRE, "agent"); asm volatile("s_waitcnt vmcnt(0)" ::: "memory"); }
            __syncthreads();
            ret_out_unit(a, l, idx - (32 + 512), lds);
        } else { const int i = idx < 32 + 512 ? idx - 32 : idx - 32 - 256; nsa_unit(a, lds, 63 - (i >> 4), i & 15); }
        __syncthreads();
    }
    __syncthreads();
}

__device__ __forceinline__ void ph_route(const Args& a, LAS char* lds, int vcu, int G) {
    int tid_ = threadIdx.x; asm volatile("" : "+v"(tid_)); asm volatile("" : "+s"(vcu));
    const int lane = tid_ & 63, wv = tid_ >> 6; const float* g = a.ln_ffn + DM; LAS float* gr = (LAS float*)lds;
    LAS int* sel = (LAS int*)(lds + 32768);
    LAS int* lcnt = sel + 256;
    LAS float* rsl = (LAS float*)(lcnt + 16);
    __syncthreads();
    for (int q = tid_; q < DM * 8; q += NT) { const int k = q >> 3; gr[(((k & 7) * 128 + (k >> 3)) << 3) + (q & 7)] = a.router[q] * g[k]; }
    for (int r0 = vcu * 128; r0 < NTOK; r0 += G * 128) {
        if (tid_ < 16) lcnt[tid_] = 0;
        __syncthreads();
        for (int i = 0; i < 16; ++i) { const int rl = wv * 16 + i, row = r0 + rl; float lg[8];
#pragma unroll
            for (int e = 0; e < 8; ++e) lg[e] = 0.f;
            u32x4_t xr[2];
#pragma unroll
            for (int h = 0; h < 2; ++h) xr[h] = *(const u32x4_t*)(a.xb + (size_t)row * DM + lane * 8 + 512 * h);
#pragma unroll
            for (int h = 0; h < 2; ++h)
#pragma unroll
                for (int jj = 0; jj < 8; ++jj) { const int kk = (jj * 128 + lane + 64 * h) * 8; const f32x4 q0 = *(const LAS f32x4*)(gr + kk), q1 = *(const LAS f32x4*)(gr + kk + 4);
                    const unsigned wd = xr[h][jj >> 1]; const float x = __uint_as_float((jj & 1) ? (wd & 0xffff0000u) : (wd << 16));
                    lg[0] += x * q0[0]; lg[1] += x * q0[1]; lg[2] += x * q0[2]; lg[3] += x * q0[3]; lg[4] += x * q1[0]; lg[5] += x * q1[1]; lg[6] += x * q1[2]; lg[7] += x * q1[3]; }
            const float rs = row_rstd(a.ssq, row);
#pragma unroll
            for (int e = 0; e < 8; ++e) lg[e] = wsum(lg[e]) * rs;
            int e1 = 0; float v1 = lg[0];
#pragma unroll
            for (int e = 1; e < 8; ++e) if (lg[e] > v1) { v1 = lg[e]; e1 = e; }
            int e2 = -1; float v2 = -INFINITY;
#pragma unroll
            for (int e = 0; e < 8; ++e) if (e != e1 && lg[e] > v2) { v2 = lg[e]; e2 = e; }
            if (lane == 0) { const float g1 = 1.f / (1.f + __expf(v2 - v1)); a.gate[row * 2] = g1; a.gate[row * 2 + 1] = 1.f - g1; sel[rl * 2] = e1; sel[rl * 2 + 1] = e2; rsl[rl] = rs; } }
        __syncthreads();
        int e = 0, rank = 0;
        if (tid_ < 256) { e = sel[tid_]; rank = __hip_atomic_fetch_add(&lcnt[e], 1, __ATOMIC_RELAXED, __HIP_MEMORY_SCOPE_WORKGROUP); }
        __syncthreads();
        if (tid_ < 8) lcnt[8 + tid_] = atomicAdd(&a.cnt[tid_], lcnt[tid_]);
        __syncthreads();
        if (tid_ < 256) { const int ix = lcnt[8 + e] + rank; a.tok_list[e * NTOK + ix] = (r0 + (tid_ >> 1)) * 2 + (tid_ & 1); a.slot[(r0 + (tid_ >> 1)) * 2 + (tid_ & 1)] = e * NTOK + ix; a.rsrow[e * NTOK + ix] = rsl[tid_ >> 1]; }
        __syncthreads();
    }
}
__device__ __forceinline__ void ph_route_build(const Args& a, int vcu, int G) {
    int tid_ = threadIdx.x; asm volatile("" : "+v"(tid_)); asm volatile("" : "+s"(vcu));
    for (int idx = vcu * NT + tid_; idx < NEXP * NTOK; idx += G * NT) { const int e = idx >> 15, i = idx & (NTOK - 1);
        int ps = 0; for (int q = 0; q < e; ++q) ps += (a.cnt[q] + 255) & ~255;
        const int ce = a.cnt[e], pe = (ce + 255) & ~255;
        if (i < ce) { const int en = a.tok_list[e * NTOK + i]; a.row_tok[ps + i] = en >> 1; a.slot[en] = ps + i; } else if (i < pe) a.row_tok[ps + i] = -1;
        if (i < pe && (i & 255) == 0) a.tile_exp[(ps + i) >> 8] = e;
        if (idx == 0) { int tot = 0; for (int q = 0; q < 8; ++q) tot += (a.cnt[q] + 255) & ~255; a.meta[0] = tot >> 8; } }
}
__device__ __forceinline__ void ph_final(const Args& a, LAS char* lds, int vcu, int G) {
    int tid_ = threadIdx.x; asm volatile("" : "+v"(tid_)); asm volatile("" : "+s"(vcu));
    const int lane = tid_ & 63; float* xio = a.xres;
    const LAS int* mps = (const LAS int*)(lds + MOE_TAB_OFF);
    f32x4 gf[4];
#pragma unroll
    for (int i = 0; i < 4; ++i) gf[i] = *(const f32x4*)(a.ln_final + lane * 4 + i * 256);
    for (int row0 = (vcu * NW + (tid_ >> 6)) * 4; row0 < NTOK; row0 += G * NW * 4) {
        int s1[4], s2[4]; float g1[4], g2[4];
#pragma unroll
        for (int r = 0; r < 4; ++r) { const int q1 = a.slot[(row0 + r) * 2], q2 = a.slot[(row0 + r) * 2 + 1]; s1[r] = mps[q1 >> 15] + (q1 & (NTOK - 1)); s2[r] = mps[q2 >> 15] + (q2 & (NTOK - 1)); g1[r] = a.gate[(row0 + r) * 2]; g2[r] = a.gate[(row0 + r) * 2 + 1]; }
        uint2 xq[4][4], pq[4][4], qq[4][4];
#pragma unroll
        for (int r = 0; r < 4; ++r)
#pragma unroll
            for (int i = 0; i < 4; ++i) { const int c = lane * 4 + i * 256; xq[r][i] = *(const uint2*)(a.xb + (size_t)(row0 + r) * DM + c); pq[r][i] = *(const uint2*)(a.ysorted + (size_t)s1[r] * DM + c); qq[r][i] = *(const uint2*)(a.ysorted + (size_t)s2[r] * DM + c); }
#pragma unroll
        for (int r = 0; r < 4; ++r) { float v[16]; float ss = 0.f;
#pragma unroll
            for (int i = 0; i < 4; ++i) {
#pragma unroll
                for (int jj = 0; jj < 4; ++jj) { const unsigned xw = jj < 2 ? xq[r][i].x : xq[r][i].y, pw = jj < 2 ? pq[r][i].x : pq[r][i].y, qw = jj < 2 ? qq[r][i].x : qq[r][i].y;
                    const float xv = __uint_as_float((jj & 1) ? (xw & 0xffff0000u) : (xw << 16)), pv = __uint_as_float((jj & 1) ? (pw & 0xffff0000u) : (pw << 16)), qv = __uint_as_float((jj & 1) ? (qw & 0xffff0000u) : (qw << 16));
                    v[i * 4 + jj] = xv + g1[r] * pv + g2[r] * qv; ss += v[i * 4 + jj] * v[i * 4 + jj]; } }
            const float rs = rsqrtf(wsum(ss) * (1.f / DM) + 1e-6f);
#pragma unroll
            for (int i = 0; i < 4; ++i) { f32x4 o; o[0] = v[i * 4] * rs * gf[i][0]; o[1] = v[i * 4 + 1] * rs * gf[i][1]; o[2] = v[i * 4 + 2] * rs * gf[i][2]; o[3] = v[i * 4 + 3] * rs * gf[i][3];
                *(f32x4*)(xio + (size_t)(row0 + r) * DM + lane * 4 + i * 256) = o; } } }
}

__global__ void __launch_bounds__(NT, 2) mega(Args a) {
    extern __shared__ __attribute__((aligned(16))) char lds[];
    volatile LAS unsigned* misc = (volatile LAS unsigned*)((LAS char*)lds + MISC_OFF);
    if (threadIdx.x < 64) misc[threadIdx.x] = 0u;
    __syncthreads();
    XcdBarrier bar = xcd_barrier_post(a.bar, misc);
    const int G = gridDim.x, vcu = blockIdx.x;
    LAS char* const lds3 = (LAS char*)lds;
#ifndef REP_PRO
#define REP_PRO 1
#endif
#ifndef REP_GEMM
#define REP_GEMM 1
#endif
#ifndef REP_NSA
#define REP_NSA 1
#endif
#ifndef REP_X
#define REP_X 1
#endif
#ifndef PROBE_ID
#define PROBE_ID -1
#endif
#define TS_OFF (MISC_OFF - 512)
#define STAMP(k) do { if (PROBE_ID >= 0 && threadIdx.x == 0) ((volatile LAS unsigned long long*)(lds3 + TS_OFF))[k] = __builtin_amdgcn_s_memrealtime(); } while (0)
#define GRID_BAR() xcd_barrier(bar)
#define AS4 __attribute__((address_space(4)))
#if defined(__HIP_DEVICE_COMPILE__)
#define LA const AS4 Args* ap_ = (const AS4 Args*)__builtin_amdgcn_kernarg_segment_ptr(); asm volatile("" : "+s"(ap_)); Args A; __builtin_memcpy(&A, ap_, sizeof(Args))
#else
#define LA const Args A = a
#endif

    int tsn_ = 1; STAMP(0);
    { LA; ph_prologue(A, lds3, vcu, G); }
    GRID_BAR(); STAMP(tsn_); ++tsn_;
#pragma unroll 1
    for (int l = 0; l < 2; ++l) {
        for (int rep = 0; rep < REP_GEMM; ++rep) { LA; pg8::Gemm g{A.xb, A.Win + (size_t)l * DINP * DM, NTOK, DINP, DM}; pg8::StaticOrder S; S.init(NTOK, DINP, G, vcu);
          pg8::gemm_phase<pg8::EIn, pg8::StaticOrder, 0>((PG8_LAS unsigned char*)lds3, g, S, pg8::EIn{A.proj, A.ssq}, nullptr, nullptr, 0); }
        GRID_BAR(); STAMP(tsn_); ++tsn_;
#pragma unroll 1
        for (int rep = 0; rep < REP_X; ++rep) {
#pragma unroll 1
        for (int kv = 0; kv < 2; ++kv) { const int i = l * 2 + kv;
            { LA; pg8::Gemm g{A.proj, A.W1b + (size_t)i * 256 * 2048, 4096, 256, 2048}; pg8::StaticOrder S; S.init(4096, 256, G, (vcu + G - kv * 16) % G);
              pg8::gemm_phase<pg8::ESiluBias, pg8::StaticOrder, 2>((PG8_LAS unsigned char*)lds3, g, S, pg8::ESiluBias{A.hc + (size_t)kv * 4096 * 256, A.bias1 + i * 256}, nullptr, nullptr, (size_t)(kv ? C_VC : C_KC)); } }
        { LA; ph_x1_small(A, l, lds3); }
        }
        GRID_BAR(); STAMP(tsn_); ++tsn_;
#pragma unroll 1
        for (int rep = 0; rep < REP_X; ++rep) {
        { LA; ph_gemm(lds3, APlain{A.hc, 256}, A.W2b + (size_t)(l * 2) * 256 * 256, 256, EpiStore{A.kcb, 64, 0, 64}, SchedPlain{4096 / 256, 1}, vcu, G); }
        { LA; ph_gemm(lds3, APlain{A.hc + (size_t)4096 * 256, 256}, A.W2b + (size_t)(l * 2 + 1) * 256 * 256, 256, EpiStoreT{A.vcT}, SchedPlain{4096 / 256, 1}, (vcu + G - 16) % G, G); }
        { LA; ph_gemm(lds3, APlain{A.hconv, 256}, A.Wpw + (size_t)l * 65536, 256, EpiStore{A.ocat, DM, 512, 256}, SchedPlain{NTOK / 256, 1}, (vcu + G - 32) % G, G); }
        }
        GRID_BAR(); STAMP(tsn_); ++tsn_;
        { LA; ph_mix(A, l, lds3); }
        GRID_BAR(); STAMP(tsn_); ++tsn_;
        { LA; pg8::Gemm g{A.ocat, A.Wout + (size_t)l * DM * DM, NTOK, DM, DM}; pg8::StaticOrder S; S.init(NTOK, DM, G, vcu);
          pg8::gemm_phase<pg8::ERes, pg8::StaticOrder, 0>((PG8_LAS unsigned char*)lds3, g, S, pg8::ERes{A.xb, A.ssq}, nullptr, nullptr, 0); }
        GRID_BAR(); STAMP(tsn_); ++tsn_;
        if (l == 0) {
            for (int rep = 0; rep < REP_GEMM; ++rep) { LA; pg8::Gemm g{A.xb, A.W13, NTOK, 2 * DFF, DM}; pg8::StaticOrder S; S.init(NTOK, 2 * DFF, G, vcu);
              pg8::gemm_phase<pg8::ESwiglu, pg8::StaticOrder, 0>((PG8_LAS unsigned char*)lds3, g, S, pg8::ESwiglu{A.hbuf, A.ssq}, nullptr, nullptr, 0); }
            GRID_BAR(); STAMP(tsn_); ++tsn_;
            { LA; pg8::Gemm g{A.hbuf, A.W2, NTOK, DM, DFF}; pg8::StaticOrder S; S.init(NTOK, DM, G, vcu);
              pg8::gemm_phase<pg8::ERes, pg8::StaticOrder, 0>((PG8_LAS unsigned char*)lds3, g, S, pg8::ERes{A.xb, A.ssq}, nullptr, nullptr, 0); }
            GRID_BAR(); STAMP(tsn_); ++tsn_;
        }
            }
    { LA; ph_route(A, lds3, vcu, G); }
    GRID_BAR(); STAMP(tsn_); ++tsn_;
    { LA; moe_table(A.cnt, lds3); }
    for (int rep = 0; rep < REP_GEMM; ++rep) { LA; const int Mm = ((const LAS int*)(lds3 + MOE_TAB_OFF))[8]; pg8::Gemm g{A.xb, A.Wm13, Mm, 2 * DFF, DM}; pg8::StaticOrder S; S.init(Mm, 2 * DFF, G, vcu);
      pg8::gemm_phase<pg8::ESwigluMoe, pg8::StaticOrder, 1, true>((PG8_LAS unsigned char*)lds3, g, S, pg8::ESwigluMoe{A.hbuf, A.rsrow, A.tok_list, (const PG8_LAS int*)(lds3 + MOE_TAB_OFF)}, A.tok_list, nullptr, (size_t)2 * DFF * DM); }
    GRID_BAR(); STAMP(tsn_); ++tsn_;
    for (int rep = 0; rep < REP_GEMM; ++rep) { LA; const int Mm = ((const LAS int*)(lds3 + MOE_TAB_OFF))[8]; pg8::Gemm g{A.hbuf, A.Wm2, Mm, DM, DFF}; pg8::StaticOrder S; S.init(Mm, DM, G, vcu);
      pg8::gemm_phase<pg8::EStore, pg8::StaticOrder, 0, true>((PG8_LAS unsigned char*)lds3, g, S, pg8::EStore{A.ysorted, DM}, nullptr, nullptr, (size_t)DM * DFF); }
    GRID_BAR(); STAMP(tsn_); ++tsn_;
    { LA; ph_final(A, lds3, vcu, G); }
    STAMP(tsn_);
    if (PROBE_ID >= 0 && blockIdx.x == 0 && threadIdx.x == 0) { volatile LAS unsigned long long* ts = (volatile LAS unsigned long long*)(lds3 + TS_OFF); const unsigned long long d = ts[PROBE_ID + 1] - ts[PROBE_ID]; const unsigned long long t2 = __builtin_amdgcn_s_memrealtime(); while (__builtin_amdgcn_s_memrealtime() - t2 < 8ull * d) __builtin_amdgcn_s_sleep(8); }
}

static inline size_t al256(size_t x) { return (x + 255) & ~(size_t)255; }
extern "C" void kernel_launch(void* const* d_in, const int* in_sizes, int n_in, void* d_out, int out_size, void* d_ws, size_t ws_size, hipStream_t stream) {
    static int grid = 0;
    Args a{};
    const float** ins = (const float**)&a.x;
    for (int i = 0; i < 20; ++i) ins[i] = (const float*)d_in[i];
    a.xres = (float*)d_out;
    char* w = (char*)d_ws; size_t off = 0;
    auto take = [&](size_t bytes) { char* p = w + off; off = al256(off + bytes); return p; };
    a.bar = (unsigned*)take(XCD_BAR_WORDS * 4);
    a.cnt = (int*)take(256);
    a.meta = (int*)take(256);
    a.wq = (unsigned*)take(4096);
    const size_t ctl_bytes = off;
    char* regY = w + off;
    a.Wm13 = (bf16_t*)take((size_t)NEXP * 2 * DFF * DM * 2);
    a.Win = (bf16_t*)take((size_t)2 * DINP * DM * 2);
    a.Wout = (bf16_t*)take((size_t)2 * DM * DM * 2);
    a.W13 = (bf16_t*)take((size_t)2 * DFF * DM * 2);
    a.W2 = (bf16_t*)take((size_t)DM * DFF * 2);
    a.ysorted = (bf16_t*)regY;
    if (off < (size_t)(regY - w) + (size_t)PMAX * DM * 2) off = al256((size_t)(regY - w) + (size_t)PMAX * DM * 2);
    a.xb = (bf16_t*)take((size_t)NTOK * DM * 2);
    a.Wm2 = (bf16_t*)take((size_t)NEXP * DM * DFF * 2);
    a.W1b = (bf16_t*)take((size_t)4 * 256 * 2048 * 2);
    a.W2b = (bf16_t*)take((size_t)4 * 256 * 256 * 2);
    a.Wpw = (bf16_t*)take((size_t)2 * 256 * 256 * 2);
    a.bias1 = (float*)take(4 * 256 * 4);
    a.rot = (float*)take((size_t)4096 * 32 * 2 * 4);
    a.ssq = (float*)take((size_t)NTOK * NSLOT * 4);
    a.tok_list = (int*)take((size_t)NEXP * NTOK * 4);
    a.row_tok = (int*)take((size_t)PMAX * 4);
    a.slot = (int*)take((size_t)NTOK * 2 * 4);
    a.tile_exp = (int*)take(1024 * 4);
    a.gate = (float*)take((size_t)NTOK * 2 * 4);
    a.rsrow = (float*)take((size_t)NEXP * NTOK * 4);
    char* regR = w + off;
    a.proj = (bf16_t*)take((size_t)NTOK * DINP * 2);
    a.ocat = (bf16_t*)take((size_t)NTOK * DM * 2);
    a.hc = (bf16_t*)take((size_t)2 * 4096 * 256 * 2);
    a.kcb = (bf16_t*)take((size_t)4096 * 64 * 2);
    a.hconv = (bf16_t*)take((size_t)NTOK * 256 * 2);
    a.vcT = (bf16_t*)take((size_t)16 * 64 * 256 * 2);
    a.VsT = (bf16_t*)take((size_t)16 * 64 * SEQ * 2);
    a.VwT = (bf16_t*)take((size_t)16 * 64 * SEQ * 2);
    a.qrb = (bf16_t*)take((size_t)NTOK * 256 * 2);
    a.krb = (bf16_t*)take((size_t)NTOK * 256 * 2);
    a.KzT = (bf16_t*)take((size_t)32 * 64 * SEQ * 2);
    a.VrT = (bf16_t*)take((size_t)32 * 64 * SEQ * 2);
    a.ST = (bf16_t*)take((size_t)32 * 32 * 4096 * 2);
    a.hbuf = (bf16_t*)regR;
    const size_t need = (size_t)(regR - w) + (size_t)PMAX * DFF * 2;
    if (grid == 0) {
        if (need > ws_size || off > ws_size || n_in != 20) { fprintf(stderr, "kernel_launch: workspace too small: need %zu / %zu have %zu\n", need, off, ws_size); grid = -1; return; }
        int dev = 0, cus = 0;
        if (hipGetDevice(&dev) != hipSuccess || hipDeviceGetAttribute(&cus, hipDeviceAttributeMultiprocessorCount, dev) != hipSuccess) { grid = -1; return; }
        if (hipFuncSetAttribute((const void*)mega, hipFuncAttributeMaxDynamicSharedMemorySize, LDS_BYTES) != hipSuccess) { fprintf(stderr, "kernel_launch: hipFuncSetAttribute failed\n"); grid = -1; return; }
        int per_cu = 0;
        if (hipOccupancyMaxActiveBlocksPerMultiprocessor(&per_cu, (const void*)mega, NT, LDS_BYTES) != hipSuccess || per_cu < 1) { fprintf(stderr, "kernel_launch: occupancy query says %d\n", per_cu); }
        (void)hipGetLastError();
        grid = cus;
    }
    if (grid < 0) return;
    (void)hipMemsetAsync(w, 0, ctl_bytes, stream);
    hipLaunchKernelGGL(mega, dim3(grid), dim3(NT), LDS_BYTES, stream, a);
}
```

```cpp
#include <hip/hip_runtime.h>
#include <stdint.h>
#include <stdio.h>

typedef unsigned short bf16_t;
typedef short bf16x8 __attribute__((ext_vector_type(8)));
typedef float f32x4 __attribute__((ext_vector_type(4)));
typedef unsigned u32x4_t __attribute__((ext_vector_type(4)));

constexpr int NTOK = 32768, DM = 1024, NB = 8, SEQ = 4096;
constexpr int DIN = 2840, DINP = 3072, DFF = 2816, NEXP = 8;
constexpr int C_Q = 0, C_KC = 512, C_VC = 640, C_KS = 768, C_VS = 896, C_KW = 1024, C_VW = 1152, C_GL = 1280,
              C_CONV = 1304, C_RQ = 1816, C_RK = 2072, C_RV = 2328, C_RG = 2584;
constexpr int NSLOT = 16;
constexpr int PMAX = 65536 + 8 * 256;
constexpr int NT = 512, NW = 8;
constexpr int LDS_BYTES = 144 * 1024, MISC_OFF = LDS_BYTES - 256;

#define XB_TMO      128
#define XB_XCNT(j)  (256  + 64 * (j))
#define XB_XSUB(j)  (1280 + 64 * (j))
#define XB_XGEN(j)  (2304 + 64 * (j))
#define XB_TOP      3328
#define XB_TOPGEN   3392
#define XCD_BAR_WORDS 3456
#define XB_SPIN_CAP (1u << 20)
#define LAS __attribute__((address_space(3)))
__device__ __forceinline__ unsigned xb_ld(unsigned* p)              { return __hip_atomic_load(p, __ATOMIC_RELAXED, __HIP_MEMORY_SCOPE_AGENT); }
__device__ __forceinline__ unsigned xb_add(unsigned* p, unsigned v) { return __hip_atomic_fetch_add(p, v, __ATOMIC_RELAXED, __HIP_MEMORY_SCOPE_AGENT); }
__device__ __forceinline__ unsigned xb_xcc_id() { return (unsigned)__builtin_amdgcn_s_getreg((3 << 11) | 20) & 0xFu; }
#define XB_SPIN(cond, bar) do { unsigned _sp = 0; while (cond) { __builtin_amdgcn_s_sleep(1); \
    if ((++_sp & 255u) == 0u) { if (xb_ld(&(bar)[XB_TMO])) break; if (_sp > XB_SPIN_CAP) { atomicAdd(&(bar)[XB_TMO], 1u); break; } } } } while (0)
struct XcdBarrier { unsigned* bar; unsigned x; volatile LAS unsigned* st; };
__device__ __forceinline__ XcdBarrier xcd_barrier_post(unsigned* bar, volatile LAS unsigned* st) {
    XcdBarrier b; b.bar = bar; b.x = xb_xcc_id(); b.st = st;
    if (threadIdx.x == 0) (void)xb_add(&bar[XB_XCNT(b.x)], 1u);
    return b;
}
__device__ __forceinline__ void xcd_barrier_complete(unsigned* bar, unsigned x, unsigned& nloc, unsigned& nx) {
    const unsigned G = gridDim.x * gridDim.y * gridDim.z;
    unsigned sum, cnt, mine, sp = 0u;
    for (;;) {
        sum = 0u; cnt = 0u; mine = 0u;
#pragma unroll
        for (unsigned j = 0; j < 16; ++j) { const unsigned c = xb_ld(&bar[XB_XCNT(j)]); sum += c; cnt += (c > 0u) ? 1u : 0u; mine = (j == x) ? c : mine; }
        if (sum == G) break;
        __builtin_amdgcn_s_sleep(1);
        if ((++sp & 255u) == 0u) { if (xb_ld(&bar[XB_TMO])) break; if (sp > XB_SPIN_CAP) { atomicAdd(&bar[XB_TMO], 1u); break; } }
    }
    nloc = mine > 0u ? mine : 1u; nx = cnt > 0u ? cnt : 1u;
}
__device__ __forceinline__ void xcd_barrier(const XcdBarrier& b) {
    asm volatile("s_waitcnt vmcnt(0)" ::: "memory");
    __syncthreads();
    if (threadIdx.x == 0) {
        unsigned* bar = b.bar;
        __builtin_amdgcn_s_waitcnt(0);
        const unsigned bx = xb_xcc_id();
        unsigned nloc = b.st[0], nx = b.st[1];
        if (nloc == 0u) { xcd_barrier_complete(bar, bx, nloc, nx); b.st[0] = nloc; b.st[1] = nx; }
        const unsigned old = xb_add(&bar[XB_XSUB(bx)], 1u);
        const unsigned gen = old / nloc;
        if (old + 1u == (gen + 1u) * nloc) {
            __builtin_amdgcn_fence(__ATOMIC_RELEASE, "agent");
            asm volatile("s_waitcnt vmcnt(0)" ::: "memory");
            const unsigned og = xb_add(&bar[XB_TOP], 1u);
            const unsigned tg = og / nx;
            if (og + 1u == (tg + 1u) * nx) xb_add(&bar[XB_TOPGEN], 1u);
            else XB_SPIN(xb_ld(&bar[XB_TOPGEN]) == tg, bar);
            __builtin_amdgcn_fence(__ATOMIC_ACQUIRE, "agent");
            xb_add(&bar[XB_XGEN(bx)], 1u);
            asm volatile("s_waitcnt vmcnt(0)" ::: "memory");
        } else {
            XB_SPIN(xb_ld(&bar[XB_XGEN(bx)]) == gen, bar);
            __builtin_amdgcn_fence(__ATOMIC_ACQUIRE, "agent");
            asm volatile("s_waitcnt vmcnt(0)" ::: "memory");
        }
    }
    __syncthreads();
}

__device__ __forceinline__ bf16_t f2bf(float f) { unsigned u = __float_as_uint(f); u += 0x7fffu + ((u >> 16) & 1u); return (bf16_t)(u >> 16); }
__device__ __forceinline__ unsigned pk2bf(float lo, float hi) { unsigned r; asm volatile("v_cvt_pk_bf16_f32 %0, %1, %2" : "=v"(r) : "v"(lo), "v"(hi)); return r; }
__device__ __forceinline__ float bf2f(bf16_t h) { return __uint_as_float(((unsigned)h) << 16); }
__device__ __forceinline__ float wsum(float v) {
#pragma unroll
    for (int o = 32; o > 0; o >>= 1) v += __shfl_xor(v, o);
    return v; }
__device__ __forceinline__ float wmax(float v) {
#pragma unroll
    for (int o = 32; o > 0; o >>= 1) v = fmaxf(v, __shfl_xor(v, o));
    return v; }
__device__ __forceinline__ float siluf(float x) { return x * __builtin_amdgcn_rcpf(1.f + __builtin_amdgcn_exp2f(-1.4426950408889634f * x)); }
__device__ __forceinline__ float sigmf(float x) { return __builtin_amdgcn_rcpf(1.f + __builtin_amdgcn_exp2f(-1.4426950408889634f * x)); }
__device__ __forceinline__ float row_rstd(const float* ssq, int row) { const f32x4* p = (const f32x4*)(ssq + (size_t)row * NSLOT); const f32x4 a = p[0], b = p[1], c = p[2], d = p[3];
    const f32x4 t = (a + b) + (c + d); return rsqrtf(((t[0] + t[1]) + (t[2] + t[3])) * (1.f / DM) + 1e-6f); }


constexpr int MOE_TAB_OFF = MISC_OFF + 128;
__device__ __forceinline__ void moe_table(const int* cnt, LAS char* lds) {
    LAS int* mps = (LAS int*)(lds + MOE_TAB_OFF); LAS int* mcnt = mps + 16;
    if (threadIdx.x == 0) { int ps = 0;
        for (int e = 0; e < 8; ++e) { const int c = __hip_atomic_load(cnt + e, __ATOMIC_RELAXED, __HIP_MEMORY_SCOPE_AGENT); mps[e] = ps; mcnt[e] = c; ps += (c + 255) & ~255; }
        mps[8] = ps; }
    __syncthreads();
}
__device__ __forceinline__ int moe_e(const LAS int* mps, int pm) { const int r = pm * 256; int e = 0;
#pragma unroll
    for (int q = 1; q < 8; ++q) e += (mps[q] <= r) ? 1 : 0;
    return __builtin_amdgcn_readfirstlane(e); }

struct Args {
    const float *x, *ln_attn, *w_in, *cmp_pe, *cmp_w1, *cmp_w2, *conv_w, *conv_b, *conv_lg, *conv_lb, *conv_pw, *ret_gn, *w_out, *ln_ffn, *ffn_w13, *ffn_w2, *router, *moe_w13, *moe_w2, *ln_final;
    float* xres;
    bf16_t *Wm13, *Win, *Wout, *W13, *W2, *xb, *ysorted, *Wm2, *W1b, *W2b, *Wpw;
    float *bias1, *rot, *ssq; int *cnt, *meta, *tok_list, *row_tok, *slot, *tile_exp; float* gate;
    bf16_t *proj, *ocat, *hc, *kcb, *vcb, *hconv; float *qr, *kr, *KV, *Sst; bf16_t* hbuf; bf16_t *vcT, *VsT, *VwT, *qrb, *krb, *KzT, *VrT, *ST;
    unsigned* bar; unsigned* wq; float* rsrow;
};

struct ConvJob { const float* src; bf16_t* dst; const float* g; int ldsrc, K, Npad, nvalid, mode, pad; };
__device__ __forceinline__ ConvJob get_job(const Args& a, int j) {
    ConvJob c; c.g = nullptr; c.mode = 0; c.pad = 0;
    if (j < 2) { c.src = a.w_in + (size_t)j * DM * DIN; c.dst = a.Win + (size_t)j * DINP * DM; c.g = a.ln_attn + j * DM; c.ldsrc = DIN; c.K = DM; c.Npad = DINP; c.nvalid = DIN; c.mode = 1; }
    else if (j < 4) { const int l = j - 2; c.src = a.w_out + (size_t)l * DM * DM; c.dst = a.Wout + (size_t)l * DM * DM; c.ldsrc = DM; c.K = DM; c.Npad = DM; c.nvalid = DM; }
    else if (j < 6) { const int l = j - 4; c.src = a.conv_pw + (size_t)l * 65536; c.dst = a.Wpw + (size_t)l * 65536; c.ldsrc = 256; c.K = 256; c.Npad = 256; c.nvalid = 256; }
    else if (j < 10) { const int i = j - 6; c.src = a.cmp_w1 + (size_t)i * 2048 * 256; c.dst = a.W1b + (size_t)i * 256 * 2048; c.ldsrc = 256; c.K = 2048; c.Npad = 256; c.nvalid = 256; }
    else if (j < 14) { const int i = j - 10; c.src = a.cmp_w2 + (size_t)i * 256 * 64; c.dst = a.W2b + (size_t)i * 256 * 256; c.ldsrc = 64; c.K = 256; c.Npad = 256; c.nvalid = 64; }
    else if (j == 14) { c.src = a.ffn_w13; c.dst = a.W13; c.g = a.ln_ffn; c.ldsrc = 2 * DFF; c.K = DM; c.Npad = 2 * DFF; c.nvalid = 2 * DFF; c.mode = 2; }
    else if (j == 15) { c.src = a.ffn_w2; c.dst = a.W2; c.ldsrc = DM; c.K = DFF; c.Npad = DM; c.nvalid = DM; }
    else if (j < 24) { const int e = j - 16; c.src = a.moe_w13 + (size_t)e * DM * 2 * DFF; c.dst = a.Wm13 + (size_t)e * 2 * DFF * DM; c.g = a.ln_ffn + DM; c.ldsrc = 2 * DFF; c.K = DM; c.Npad = 2 * DFF; c.nvalid = 2 * DFF; c.mode = 2; }
    else { const int e = j - 24; c.src = a.moe_w2 + (size_t)e * DFF * DM; c.dst = a.Wm2 + (size_t)e * DM * DFF; c.ldsrc = DM; c.K = DFF; c.Npad = DM; c.nvalid = DM; }
    return c;
}
constexpr int NJOBS = 32;
__device__ __forceinline__ void conv_super(const ConvJob& c, int st, LAS float* lt, int tid_) {
    const int nsn = c.Npad / 256, n0 = (st % nsn) * 256, k0 = (st / nsn) * 64, lane = tid_ & 63, wv = tid_ >> 6;
    float v[32];
#pragma unroll
    for (int q = 0; q < 4; ++q) { const int n = n0 + q * 64 + lane; int sc;
        if (c.mode == 2) { const int pn = n >> 8, i = n & 255; sc = i < 128 ? 128 * pn + i : DFF + 128 * pn + (i - 128); } else sc = n < c.nvalid ? n : -1;
#pragma unroll
        for (int i = 0; i < 8; ++i) v[q * 8 + i] = sc >= 0 ? c.src[(size_t)(k0 + wv + 8 * i) * c.ldsrc + sc] : 0.f; }
#pragma unroll
    for (int q = 0; q < 4; ++q)
#pragma unroll
        for (int i = 0; i < 8; ++i) lt[(wv + 8 * i) * 257 + q * 64 + lane] = v[q * 8 + i];
    __syncthreads();
    const int nl = tid_ >> 3, ch = tid_ & 7;
    float gs[8];
#pragma unroll
    for (int e = 0; e < 8; ++e) gs[e] = c.g ? c.g[k0 + 8 * ch + e] : 1.f;
#pragma unroll
    for (int q = 0; q < 4; ++q) { const int n = n0 + q * 64 + nl; const float cs = (c.mode == 1 && (n < 512 || (n >= C_RK && n < C_RV))) ? 0.125f : 1.f; float x[8];
#pragma unroll
        for (int e = 0; e < 8; ++e) x[e] = lt[(8 * ch + e) * 257 + q * 64 + nl] * gs[e] * cs;
        u32x4_t w; w.x = pk2bf(x[0], x[1]); w.y = pk2bf(x[2], x[3]); w.z = pk2bf(x[4], x[5]); w.w = pk2bf(x[6], x[7]);
        *(u32x4_t*)(c.dst + (size_t)n * c.K + k0 + 8 * ch) = w; }
    __syncthreads();
}
__device__ __forceinline__ void ph_prologue(const Args& a, LAS char* lds, int vcu, int G) {
    int tid_ = threadIdx.x; asm volatile("" : "+v"(tid_)); asm volatile("" : "+s"(vcu));
    LAS float* lt = (LAS float*)lds; int acc = 0;
    for (int j = 0; j < 14; ++j) { if (j >= 1 && j < 4) continue;
        const ConvJob c = get_job(a, j); const int nt = (c.Npad / 256) * (c.K / 64);
        int t0 = vcu - (acc % G); if (t0 < 0) t0 += G;
        for (int t = t0; t < nt; t += G) conv_super(c, t, lt, tid_);
        acc += nt; }
    for (int u = vcu; u < 64; u += G) { const int i = u >> 4, nl = tid_ & 15, kp = tid_ >> 4, n = (u & 15) * 16 + nl; float s = 0.f;
        const float* pe = a.cmp_pe + (size_t)i * 2048; const float* w1 = a.cmp_w1 + (size_t)i * 2048 * 256;
#pragma unroll 16
        for (int j = 0; j < 64; ++j) s += pe[kp + 32 * j] * w1[(size_t)(kp + 32 * j) * 256 + n];
        __syncthreads(); lt[kp * 16 + nl] = s; __syncthreads();
        if (kp == 0) { float t = 0.f;
#pragma unroll
            for (int q = 0; q < 32; ++q) t += lt[q * 16 + nl];
            a.bias1[i * 256 + n] = t; } }
    for (int idx = vcu * NT + tid_; idx < 4096 * 32; idx += G * NT) { const int pos = idx >> 5, i = idx & 31; const float inv = powf(10000.f, -(float)i / 32.f), ang = (float)pos * inv;
        a.rot[idx * 2] = cosf(ang); a.rot[idx * 2 + 1] = sinf(ang); }
    const int lane = tid_ & 63;
    for (int row0 = (vcu * NW + (tid_ >> 6)) * 4; row0 < NTOK; row0 += G * NW * 4) {
        f32x4 v[4][4];
#pragma unroll
        for (int rr = 0; rr < 4; ++rr)
#pragma unroll
            for (int i = 0; i < 4; ++i) v[rr][i] = *(const f32x4*)(a.x + (size_t)(row0 + rr) * DM + lane * 4 + 256 * i);
#pragma unroll
        for (int rr = 0; rr < 4; ++rr) { float sq = 0.f;
#pragma unroll
            for (int i = 0; i < 4; ++i) { const f32x4 t = v[rr][i]; sq += (t[0] * t[0] + t[1] * t[1]) + (t[2] * t[2] + t[3] * t[3]);
                uint2 o; o.x = pk2bf(t[0], t[1]); o.y = pk2bf(t[2], t[3]); *(uint2*)(a.xb + (size_t)(row0 + rr) * DM + lane * 4 + 256 * i) = o; }
            sq = wsum(sq); if (lane < NSLOT) a.ssq[(size_t)(row0 + rr) * NSLOT + lane] = lane == 0 ? sq : 0.f; } }
}

struct APlain { const bf16_t* A; int lda; __device__ __forceinline__ const bf16_t* ptr(int row, int k) const { return A + (size_t)row * lda + k; } };
struct AGather { const bf16_t* A; const int* row_tok; int lda; __device__ __forceinline__ const bf16_t* ptr(int row, int k) const { const int t = row_tok[row]; return t < 0 ? nullptr : A + (size_t)t * lda + k; } };
struct ACmp { const bf16_t* proj; int coloff;
    __device__ __forceinline__ const bf16_t* ptr(int row, int k) const { const int c = row & 255, g = (row >> 8) & 1, b = row >> 9; if (c == 255) return nullptr;
        return proj + (size_t)(b * SEQ + 16 * c + (k >> 6)) * DINP + coloff + g * 64 + (k & 63); } };
struct SchedOne { int pm; __device__ __forceinline__ int count() const { return 1; }
    __device__ __forceinline__ void get(int, int& row0, int& col0, size_t& boff) const { row0 = pm * 256; col0 = 0; boff = 0; } };
struct SchedPlain { int nM, nN; __device__ __forceinline__ int count() const { return nM * nN; }
    __device__ __forceinline__ void get(int u, int& row0, int& col0, size_t& boff) const { row0 = (u / nN) * 256; col0 = (u % nN) * 256; boff = 0; } };
struct SchedMoe { const int* meta; const int* tile_exp; size_t estride; int nN;
    __device__ __forceinline__ int count() const { return meta[0] * nN; }
    __device__ __forceinline__ void get(int u, int& row0, int& col0, size_t& boff) const { row0 = (u / nN) * 256; col0 = (u % nN) * 256; boff = (size_t)tile_exp[row0 >> 8] * estride; } };

struct EpiIn { bf16_t* proj; const float* ssq;
    __device__ __forceinline__ void apply(const f32x4 (&acc)[2][16], int rowb, int col0, int lane) const {
#pragma unroll
        for (int mi = 0; mi < 2; ++mi)
#pragma unroll
            for (int r = 0; r < 4; ++r) { const int row = rowb + mi * 16 + (lane >> 4) * 4 + r; const float rs = row_rstd(ssq, row);
#pragma unroll
                for (int n = 0; n < 16; ++n) proj[(size_t)row * DINP + col0 + n * 16 + (lane & 15)] = f2bf(acc[mi][n][r] * rs); } } };
struct EpiRes { const float* xold; float* xnew; bf16_t* xb; float* ssq;
    __device__ __forceinline__ void apply(const f32x4 (&acc)[2][16], int rowb, int col0, int lane) const {
#pragma unroll
        for (int mi = 0; mi < 2; ++mi)
#pragma unroll
            for (int r = 0; r < 4; ++r) { const int row = rowb + mi * 16 + (lane >> 4) * 4 + r; float s = 0.f;
#pragma unroll
                for (int n = 0; n < 16; ++n) { const size_t o = (size_t)row * DM + col0 + n * 16 + (lane & 15); const float v = xold[o] + acc[mi][n][r]; xnew[o] = v; xb[o] = f2bf(v); s += v * v; }
                s += __shfl_xor(s, 1); s += __shfl_xor(s, 2); s += __shfl_xor(s, 4); s += __shfl_xor(s, 8);
                if ((lane & 15) < 4) ssq[(size_t)row * NSLOT + (col0 >> 8) * 4 + (lane & 15)] = (lane & 15) == 0 ? s : 0.f; } } };
struct EpiSwiglu { bf16_t* h; const float* ssq; const int* row_tok;
    __device__ __forceinline__ void apply(const f32x4 (&acc)[2][16], int rowb, int col0, int lane) const {
#pragma unroll
        for (int mi = 0; mi < 2; ++mi)
#pragma unroll
            for (int r = 0; r < 4; ++r) { const int row = rowb + mi * 16 + (lane >> 4) * 4 + r; const int t = row_tok ? row_tok[row] : row;
                const float rs = t < 0 ? 0.f : row_rstd(ssq, t < 0 ? 0 : t);
#pragma unroll
                for (int n = 0; n < 8; ++n) { const float av = acc[mi][n][r] * rs, bv = acc[mi][n + 8][r] * rs; h[(size_t)row * DFF + (col0 >> 1) + n * 16 + (lane & 15)] = f2bf(siluf(av) * bv); } } } };
struct EpiStore { bf16_t* out; int ldc, coloff, ncols;
    __device__ __forceinline__ void apply(const f32x4 (&acc)[2][16], int rowb, int col0, int lane) const {
#pragma unroll
        for (int mi = 0; mi < 2; ++mi)
#pragma unroll
            for (int r = 0; r < 4; ++r) { const int row = rowb + mi * 16 + (lane >> 4) * 4 + r;
#pragma unroll
                for (int n = 0; n < 16; ++n) { const int c = col0 + n * 16 + (lane & 15); if (c < ncols) out[(size_t)row * ldc + coloff + c] = f2bf(acc[mi][n][r]); } } } };
struct EpiStoreT { bf16_t* out;
    __device__ __forceinline__ void apply(const f32x4 (&acc)[2][16], int rowb, int col0, int lane) const {
#pragma unroll
        for (int mi = 0; mi < 2; ++mi)
#pragma unroll
            for (int r = 0; r < 4; ++r) { const int row = rowb + mi * 16 + (lane >> 4) * 4 + r;
#pragma unroll
                for (int n = 0; n < 4; ++n) { const int c = col0 + n * 16 + (lane & 15); out[(size_t)(row >> 8) * 16384 + c * 256 + (row & 255)] = f2bf(acc[mi][n][r]); } } } };
struct EpiSiluBias { bf16_t* out; const float* bias; int ldc;
    __device__ __forceinline__ void apply(const f32x4 (&acc)[2][16], int rowb, int col0, int lane) const {
#pragma unroll
        for (int mi = 0; mi < 2; ++mi)
#pragma unroll
            for (int r = 0; r < 4; ++r) { const int row = rowb + mi * 16 + (lane >> 4) * 4 + r;
#pragma unroll
                for (int n = 0; n < 16; ++n) { const int c = col0 + n * 16 + (lane & 15); out[(size_t)row * ldc + c] = f2bf(siluf(acc[mi][n][r] + bias[c])); } } } };

template <class AS, class Epi, class Sched>
__device__ __forceinline__ void ph_gemm(LAS char* lds, const AS as, const bf16_t* __restrict__ Bt, const int K, const Epi epi, const Sched sched, int vcu, int G) {
    int tid_ = threadIdx.x; asm volatile("" : "+v"(tid_)); asm volatile("" : "+s"(vcu));
    LAS bf16_t* sA = (LAS bf16_t*)lds; LAS bf16_t* sB = (LAS bf16_t*)(lds + 256 * 40 * 2);
    const int tid = tid_, wave = tid >> 6, lane = tid & 63;
    const int nunits = sched.count();
    for (int u = vcu; u < nunits; u += G) {
        int row0, col0; size_t boff; sched.get(u, row0, col0, boff);
        const bf16_t* Bu = Bt + boff;
        f32x4 acc[2][16];
#pragma unroll
        for (int mi = 0; mi < 2; ++mi)
#pragma unroll
            for (int n = 0; n < 16; ++n) acc[mi][n] = (f32x4){0.f, 0.f, 0.f, 0.f};
#pragma unroll 1
        for (int k0 = 0; k0 < K; k0 += 32) {
#pragma unroll
            for (int i = 0; i < 2; ++i) { const int c = tid + i * NT, r = c >> 2, kc = (c & 3) * 8; const bf16_t* p = as.ptr(row0 + r, k0 + kc);
                uint4 v = make_uint4(0u, 0u, 0u, 0u); if (p) v = *(const uint4*)p; *(LAS u32x4_t*)&sA[r * 40 + kc] = (u32x4_t){v.x, v.y, v.z, v.w}; }
#pragma unroll
            for (int i = 0; i < 2; ++i) { const int c = tid + i * NT, r = c >> 2, kc = (c & 3) * 8;
                *(LAS u32x4_t*)&sB[r * 40 + kc] = *(const u32x4_t*)(Bu + (size_t)(col0 + r) * K + k0 + kc); }
            __syncthreads();
            bf16x8 af[2];
#pragma unroll
            for (int mi = 0; mi < 2; ++mi) af[mi] = *(const LAS bf16x8*)&sA[(wave * 32 + mi * 16 + (lane & 15)) * 40 + (lane >> 4) * 8];
#pragma unroll
            for (int n = 0; n < 16; ++n) { const bf16x8 bfr = *(const LAS bf16x8*)&sB[(n * 16 + (lane & 15)) * 40 + (lane >> 4) * 8];
#pragma unroll
                for (int mi = 0; mi < 2; ++mi) acc[mi][n] = __builtin_amdgcn_mfma_f32_16x16x32_bf16(af[mi], bfr, acc[mi][n], 0, 0, 0); }
            __syncthreads();
        }
        epi.apply(acc, row0 + wave * 32, col0, lane);
    }
}


namespace pg8 {
#define PG8_LAS __attribute__((address_space(3)))
typedef unsigned u32x4 __attribute__((ext_vector_type(4)));
typedef unsigned u32x2 __attribute__((ext_vector_type(2)));
constexpr int BM = 256, BK = 64, HALF = 128, HTB = HALF * BK * 2  , STAGE_BYTES = 8 * HTB, NXCD = 8, WGM = 8;
__host__ __device__ __forceinline__ int lds_byte(int r, int c) { const int st = (r >> 4) * 2 + (c >> 5), rr = r & 15, cc = c & 31, ob = rr * 64 + cc * 2; return st * 1024 + (ob ^ (((ob >> 9) & 1) << 5)); }
__host__ __device__ __forceinline__ void stage_rc(int b, int& R, int& C) { const int st = b / 1024, sb = b % 1024, swz = sb ^ (((sb >> 9) & 1) << 5); R = (st >> 1) * 16 + swz / 64; C = (st & 1) * 32 + (swz % 64) / 2; }
__host__ __device__ __forceinline__ int perm32(int rho) { const int n = rho >> 4, i = rho & 15; return 8 * (i >> 2) + 4 * n + (i & 3); }
struct Unit { int pm, pn; };
struct Gemm { const bf16_t* A; const bf16_t* Bt; int M, N, K; };
struct StaticOrder {
    int nM, nN, nwg, G, c;
    __device__ __forceinline__ void init(int M, int N, int G_, int c_) { nM = M / BM; nN = N / BM; nwg = nM * nN; G = G_; c = c_; }
    __device__ __forceinline__ bool next(int i, Unit& u) const {
        const long L = (long)i * G + c; if (L >= nwg) return false;
        int wgid = (int)L; { const int q = nwg / NXCD, r = nwg % NXCD, xcd = wgid % NXCD, off = wgid / NXCD; wgid = (xcd < r ? xcd * (q + 1) : r * (q + 1) + (xcd - r) * q) + off; }
        const int nig = WGM * nN, gid = wgid / nig, fm = gid * WGM, gsz = (nM - fm) < WGM ? (nM - fm) : WGM;
        const int wi = wgid % nig; if (gsz == WGM) { u.pm = fm + (wi & (WGM - 1)); u.pn = wi >> 3; } else { u.pm = fm + (wi % gsz); u.pn = wi / gsz; } return true;
    }
};
__device__ __forceinline__ unsigned cvt_pk_bf16(float lo, float hi) { unsigned r; asm volatile("v_cvt_pk_bf16_f32 %0, %1, %2" : "=v"(r) : "v"(lo), "v"(hi)); return r; }

template <class Epi, class Sched, int AMODE, bool MOE = false>
__device__ __forceinline__ void gemm_phase(PG8_LAS unsigned char* lds, const Gemm g, const Sched& S_, const Epi& E, const int* __restrict__ rowmap, const int* __restrict__ tile_exp, const size_t estride) {
    Sched S = S_; asm volatile("" : "+s"(S.c));
    const PG8_LAS int* mps = (const PG8_LAS int*)(lds + MOE_TAB_OFF); const PG8_LAS int* mcnt = mps + 16;
    constexpr bool GATHER = AMODE != 0;
    int tid = threadIdx.x; asm volatile("" : "+v"(tid));
    const int wid = __builtin_amdgcn_readfirstlane(tid >> 6), lane = tid & 63, wr = wid >> 2, wc = wid & 3, fr = lane & 15, fq = lane >> 4;
    const int K = g.K, nt = K / BK;
    unsigned voffA[2], voffB[2];
#pragma unroll
    for (int i = 0; i < 2; ++i) { int R, C; stage_rc(tid * 16 + i * 8192, R, C); const int Rb = (R & ~31) + perm32(R & 31);
        voffA[i] = (unsigned)(R * K + C) * 2u; voffB[i] = (unsigned)(Rb * K + C) * 2u; if (GATHER) voffA[i] = (unsigned)C * 2u; }
    const size_t kstep = (size_t)(BK * 2);
    const size_t kstepA = AMODE == 2 ? (size_t)DINP * 2 : kstep;
    const size_t hstep = (size_t)HALF * K * 2;
    const size_t tstep = 2 * hstep;
    const unsigned ldsw = (unsigned)wid * 1024u;
    const int aoff = lds_byte(wr * 64 + fr, fq * 8), boff = lds_byte(wc * 32 + fr, fq * 8);
#define PG8_SA(b, h) (((b) * 2 + (h)) * HTB)
#define PG8_SB(b, h) ((4 + (b) * 2 + (h)) * HTB)
#define PG8_STAGE(bufoff, gbase, voff) do { _Pragma("unroll") for (int _i = 0; _i < 2; ++_i) \
        __builtin_amdgcn_global_load_lds((const unsigned*)((const char*)(gbase) + (voff)[_i]), (PG8_LAS unsigned*)(lds + (bufoff) + ldsw + _i * 8192), 16, 0, 0); } while (0)
#define PG8_LDA(dst, b, h) do { _Pragma("unroll") for (int m = 0; m < 4; ++m) _Pragma("unroll") for (int k = 0; k < 2; ++k) dst[m][k] = *(const PG8_LAS bf16x8*)(lds + PG8_SA(b, h) + aoff + m * 2048 + k * 1024); } while (0)
#define PG8_LDB(dst, b, h) do { _Pragma("unroll") for (int n = 0; n < 2; ++n) _Pragma("unroll") for (int k = 0; k < 2; ++k) dst[n][k] = *(const PG8_LAS bf16x8*)(lds + PG8_SB(b, h) + boff + n * 2048 + k * 1024); } while (0)
#define PG8_MMA(ai, bj, At, Bt) do { __builtin_amdgcn_s_setprio(1); _Pragma("unroll") for (int m = 0; m < 4; ++m) _Pragma("unroll") for (int n = 0; n < 2; ++n) _Pragma("unroll") for (int k = 0; k < 2; ++k) \
        acc[ai][bj][m][n] = __builtin_amdgcn_mfma_f32_16x16x32_bf16(Bt[n][k], At[m][k], acc[ai][bj][m][n], 0, 0, 0); __builtin_amdgcn_s_setprio(0); } while (0)
#define PG8_WAIT_V(n) asm volatile("s_waitcnt vmcnt(" #n ")" ::: "memory")
#define PG8_WAIT_L(n) asm volatile("s_waitcnt lgkmcnt(" #n ")" ::: "memory")
#define PG8_BAR __builtin_amdgcn_s_barrier()
#define PG8_SCHED __builtin_amdgcn_sched_barrier(0)
    unsigned vgc[2][2], vgn[2][2];
#define PG8_GOFF(dst, pm_) do { if constexpr (AMODE == 1) { const int _e = moe_e(mps, (pm_)), _p0 = mps[_e], _c0 = mcnt[_e]; _Pragma("unroll") for (int _h = 0; _h < 2; ++_h) _Pragma("unroll") for (int _i = 0; _i < 2; ++_i) { \
        int _R, _C; stage_rc(tid * 16 + _i * 8192, _R, _C); const int _ix = (pm_) * BM + _h * HALF + _R - _p0; const int _t = _ix < _c0 ? (rowmap[_e * NTOK + _ix] >> 1) : 0; \
        dst[_h][_i] = (unsigned)_t * (unsigned)(K * 2) + voffA[_i]; } } \
      else if constexpr (AMODE == 2) { _Pragma("unroll") for (int _h = 0; _h < 2; ++_h) _Pragma("unroll") for (int _i = 0; _i < 2; ++_i) { int _R, _C; stage_rc(tid * 16 + _i * 8192, _R, _C); const int _r = (pm_) * BM + _h * HALF + _R; int _c = _r & 255; _c = _c > 254 ? 254 : _c; \
        dst[_h][_i] = (unsigned)(((_r >> 9) * SEQ + 16 * _c) * DINP + (int)estride + ((_r >> 8) & 1) * 64) * 2u + voffA[_i]; } } } while (0)
#define PG8_STA(bufoff, gptr, h, arr) do { if constexpr (GATHER) { PG8_STAGE(bufoff, gptr, arr[h]); } else { PG8_STAGE(bufoff, (gptr) + ((h) ? hstep : 0), voffA); } } while (0)
    Unit cur, nxt; int ui = 0;
    if constexpr (Epi::NEEDS_RST) {
        PG8_LAS float* rst = (PG8_LAS float*)(lds + STAGE_BYTES);
        if (wid < 4) { Unit tu; for (int i = 0; i < 12 && S.next(i, tu); ++i) rst[i * 256 + wid * 64 + lane] = row_rstd(E.ssq, tu.pm * BM + wid * 64 + lane); }
        __syncthreads();
    }
    if (!S.next(0, cur)) return;
    f32x4 acc[2][2][4][2];
#pragma unroll
    for (int a = 0; a < 2; ++a)
#pragma unroll
        for (int b = 0; b < 2; ++b)
#pragma unroll
            for (int m = 0; m < 4; ++m)
#pragma unroll
                for (int n = 0; n < 2; ++n) acc[a][b][m][n] = (f32x4){0.f, 0.f, 0.f, 0.f};
    bf16x8 At[4][2], B0[2][2], B1[2][2];
    const char* cA = (const char*)g.A + (GATHER ? (size_t)0 : (size_t)cur.pm * tstep);
    const char* cB = (const char*)g.Bt + (MOE ? (size_t)moe_e(mps, cur.pm) * estride * 2 : (size_t)0) + (size_t)cur.pn * tstep;
    PG8_GOFF(vgc, cur.pm);
#define PG8_RSM(pm_, slot_) do { if constexpr (Epi::NEEDS_RSM) { if (wid == 0) { const int _e = moe_e(mps, (pm_)); const float* _src = E.ssq + (size_t)_e * NTOK + ((pm_) * BM - mps[_e]) + lane * 4; \
        __builtin_amdgcn_global_load_lds((const unsigned*)_src, (PG8_LAS unsigned*)(lds + STAGE_BYTES + (slot_) * 1024), 16, 0, 0); } } } while (0)
    PG8_RSM(cur.pm, 0);
    if constexpr (AMODE == 1) { Unit n1; if (S.next(1, n1)) { PG8_GOFF(vgn, n1.pm); } else {
#pragma unroll
        for (int _h = 0; _h < 2; ++_h)
#pragma unroll
            for (int _i = 0; _i < 2; ++_i) vgn[_h][_i] = vgc[_h][_i]; } }
    PG8_STAGE(PG8_SB(0, 0), cB, voffB); PG8_STAGE(PG8_SB(0, 1), cB + hstep, voffB); PG8_STA(PG8_SA(0, 0), cA, 0, vgc); PG8_STA(PG8_SA(0, 1), cA, 1, vgc);
    if (wr == 1) PG8_BAR;
    PG8_WAIT_V(2); PG8_BAR;
    PG8_STAGE(PG8_SB(1, 0), cB + kstep, voffB); PG8_STA(PG8_SA(1, 0), cA + kstepA, 0, vgc); PG8_STAGE(PG8_SB(1, 1), cB + hstep + kstep, voffB);
    PG8_WAIT_V(6); PG8_BAR;
    for (;;) {
        const bool has_next = S.next(ui + 1, nxt);
        const char* nA = has_next ? (const char*)g.A + (GATHER ? (size_t)0 : (size_t)nxt.pm * tstep) : cA;
        const char* nB = has_next ? (const char*)g.Bt + (MOE ? (size_t)moe_e(mps, nxt.pm) * estride * 2 : (size_t)0) + (size_t)nxt.pn * tstep : cB;
        if constexpr (AMODE == 2) { if (has_next) { PG8_GOFF(vgn, nxt.pm); } else {
#pragma unroll
            for (int _h = 0; _h < 2; ++_h)
#pragma unroll
                for (int _i = 0; _i < 2; ++_i) vgn[_h][_i] = vgc[_h][_i]; } }
        for (int t = 0; t < nt; t += 2) {
            const bool last = (t == nt - 2);
            const char* a1 = cA + (size_t)(t + 1) * kstepA;
            const char* a2 = last ? nA : cA + (size_t)(t + 2) * kstepA; const char* b2 = last ? nB : cB + (size_t)(t + 2) * kstep;
            const char* a3 = a2 + kstepA; const char* b3 = b2 + kstep;
            unsigned v2[2][2];
            if constexpr (GATHER) {
#pragma unroll
            for (int _h = 0; _h < 2; ++_h)
#pragma unroll
                for (int _i = 0; _i < 2; ++_i) v2[_h][_i] = last ? vgn[_h][_i] : vgc[_h][_i]; }
            PG8_LDB(B0, 0, 0); PG8_LDB(B1, 0, 1); PG8_SCHED; PG8_LDA(At, 0, 0); PG8_STA(PG8_SA(1, 1), a1, 1, vgc);
            PG8_WAIT_V(8); PG8_WAIT_L(0); PG8_BAR; PG8_MMA(0, 0, At, B0); PG8_MMA(0, 1, At, B1); PG8_BAR; PG8_SCHED;
            PG8_LDA(At, 0, 1); PG8_STAGE(PG8_SB(0, 0), b2, voffB); PG8_STAGE(PG8_SB(0, 1), b2 + hstep, voffB); PG8_STA(PG8_SA(0, 0), a2, 0, v2);
            PG8_WAIT_V(8); PG8_WAIT_L(0); PG8_BAR; PG8_MMA(1, 0, At, B0); PG8_MMA(1, 1, At, B1); PG8_BAR; PG8_SCHED;
            PG8_LDB(B0, 1, 0); PG8_LDB(B1, 1, 1); PG8_SCHED; PG8_LDA(At, 1, 0); PG8_STA(PG8_SA(0, 1), a2, 1, v2);
            PG8_WAIT_V(8); PG8_WAIT_L(0); PG8_BAR; PG8_MMA(0, 0, At, B0); PG8_MMA(0, 1, At, B1); PG8_BAR; PG8_SCHED;
            PG8_LDA(At, 1, 1); PG8_STAGE(PG8_SB(1, 0), b3, voffB); PG8_STAGE(PG8_SB(1, 1), b3 + hstep, voffB); PG8_STA(PG8_SA(1, 0), a3, 0, v2);
            PG8_WAIT_V(8); PG8_WAIT_L(0); PG8_BAR; PG8_MMA(1, 0, At, B0); PG8_MMA(1, 1, At, B1); PG8_BAR; PG8_SCHED;
        }
        if (wr == 0) PG8_BAR;
        if constexpr (Epi::NEEDS_RST) E(acc, cur, wr, wc, fr, fq, (const PG8_LAS float*)(lds + STAGE_BYTES) + ui * 256);
        else if constexpr (Epi::NEEDS_RSM) E(acc, cur, wr, wc, fr, fq, (const PG8_LAS float*)(lds + STAGE_BYTES) + (ui & 1) * 256);
        else E(acc, cur, wr, wc, fr, fq);
        if (!has_next) break;
#pragma unroll
        for (int a = 0; a < 2; ++a)
#pragma unroll
            for (int b = 0; b < 2; ++b)
#pragma unroll
                for (int m = 0; m < 4; ++m)
#pragma unroll
                    for (int n = 0; n < 2; ++n) acc[a][b][m][n] = (f32x4){0.f, 0.f, 0.f, 0.f};
        cur = nxt; cA = nA; cB = nB; ++ui;
        if constexpr (GATHER) {
#pragma unroll
        for (int _h = 0; _h < 2; ++_h)
#pragma unroll
            for (int _i = 0; _i < 2; ++_i) vgc[_h][_i] = vgn[_h][_i]; }
        PG8_RSM(cur.pm, ui & 1);
        if constexpr (AMODE == 1) { Unit n2; if (S.next(ui + 1, n2)) { PG8_GOFF(vgn, n2.pm); } }
        if (wr == 1) PG8_BAR;
    }
    PG8_WAIT_V(0);
    PG8_BAR;
#undef PG8_SA
#undef PG8_SB
#undef PG8_STAGE
#undef PG8_LDA
#undef PG8_LDB
#undef PG8_MMA
#undef PG8_WAIT_V
#undef PG8_WAIT_L
#undef PG8_BAR
#undef PG8_SCHED
#undef PG8_GOFF
#undef PG8_RSM
#undef PG8_STA
}

typedef const f32x4 (&AccT)[2][2][4][2];
struct EIn { static constexpr bool NEEDS_RST = true; static constexpr bool NEEDS_RSM = false; bf16_t* proj; const float* ssq;
    __device__ __forceinline__ void operator()(AccT acc, const Unit& u, int wr, int wc, int fr, int fq, const PG8_LAS float* rst) const {
        const int col0 = u.pn * BM + wc * 32 + 8 * fq;
#pragma unroll
        for (int ai = 0; ai < 2; ++ai)
#pragma unroll
            for (int m = 0; m < 4; ++m) { const int rl = ai * HALF + wr * 64 + m * 16 + fr, row = u.pm * BM + rl; const float rs = rst[rl]; bf16_t* rowp = proj + (size_t)row * DINP + col0;
#pragma unroll
                for (int bj = 0; bj < 2; ++bj) { const f32x4 v0 = acc[ai][bj][m][0] * rs, v1 = acc[ai][bj][m][1] * rs; u32x4 w; w.x = cvt_pk_bf16(v0[0], v0[1]); w.y = cvt_pk_bf16(v0[2], v0[3]); w.z = cvt_pk_bf16(v1[0], v1[1]); w.w = cvt_pk_bf16(v1[2], v1[3]);
                    *(u32x4*)(rowp + bj * HALF) = w; } } } };
struct ERes { static constexpr bool NEEDS_RST = false; static constexpr bool NEEDS_RSM = false; bf16_t* xb; float* ssq;
    __device__ __forceinline__ void operator()(AccT acc, const Unit& u, int wr, int wc, int fr, int fq) const {
        const int col0 = u.pn * BM + wc * 32 + 8 * fq;
#pragma unroll
        for (int ai = 0; ai < 2; ++ai) {
            u32x4 xo[4][2];
#pragma unroll
            for (int m = 0; m < 4; ++m)
#pragma unroll
                for (int bj = 0; bj < 2; ++bj) xo[m][bj] = *(const u32x4*)(xb + (size_t)(u.pm * BM + ai * HALF + wr * 64 + m * 16 + fr) * DM + col0 + bj * HALF);
#pragma unroll
            for (int m = 0; m < 4; ++m) { const int row = u.pm * BM + ai * HALF + wr * 64 + m * 16 + fr; const size_t o = (size_t)row * DM + col0; float s = 0.f;
#pragma unroll
                for (int bj = 0; bj < 2; ++bj) { const u32x4 w0 = xo[m][bj];
                    const f32x4 x0 = (f32x4){__uint_as_float(w0.x << 16), __uint_as_float(w0.x & 0xffff0000u), __uint_as_float(w0.y << 16), __uint_as_float(w0.y & 0xffff0000u)};
                    const f32x4 x1 = (f32x4){__uint_as_float(w0.z << 16), __uint_as_float(w0.z & 0xffff0000u), __uint_as_float(w0.w << 16), __uint_as_float(w0.w & 0xffff0000u)};
                    const f32x4 v0 = x0 + acc[ai][bj][m][0], v1 = x1 + acc[ai][bj][m][1];
                    u32x4 w; w.x = cvt_pk_bf16(v0[0], v0[1]); w.y = cvt_pk_bf16(v0[2], v0[3]); w.z = cvt_pk_bf16(v1[0], v1[1]); w.w = cvt_pk_bf16(v1[2], v1[3]);
                    *(u32x4*)(xb + o + bj * HALF) = w;
                    s += (v0[0] * v0[0] + v0[1] * v0[1]) + (v0[2] * v0[2] + v0[3] * v0[3]) + (v1[0] * v1[0] + v1[1] * v1[1]) + (v1[2] * v1[2] + v1[3] * v1[3]); }
                s += __shfl_xor(s, 16); s += __shfl_xor(s, 32);
                if (fq == 0) ssq[(size_t)row * NSLOT + u.pn * 4 + wc] = s; } } } };
struct ESwiglu { static constexpr bool NEEDS_RST = true; static constexpr bool NEEDS_RSM = false; bf16_t* h; const float* ssq;
    __device__ __forceinline__ void operator()(AccT acc, const Unit& u, int wr, int wc, int fr, int fq, const PG8_LAS float* rst) const {
        const int col0 = u.pn * HALF + wc * 32 + 8 * fq;
#pragma unroll
        for (int ai = 0; ai < 2; ++ai)
#pragma unroll
            for (int m = 0; m < 4; ++m) { const int rl = ai * HALF + wr * 64 + m * 16 + fr, row = u.pm * BM + rl; const float rs = rst[rl];
                float o[8];
#pragma unroll
                for (int n = 0; n < 2; ++n)
#pragma unroll
                    for (int e = 0; e < 4; ++e) { const float av = acc[ai][0][m][n][e] * rs, bv = acc[ai][1][m][n][e] * rs; o[n * 4 + e] = siluf(av) * bv; }
                u32x4 w; w.x = cvt_pk_bf16(o[0], o[1]); w.y = cvt_pk_bf16(o[2], o[3]); w.z = cvt_pk_bf16(o[4], o[5]); w.w = cvt_pk_bf16(o[6], o[7]);
                *(u32x4*)(h + (size_t)row * DFF + col0) = w; } } };
struct ESwigluMoe { static constexpr bool NEEDS_RST = false; static constexpr bool NEEDS_RSM = true; bf16_t* h; const float* ssq; const int* tok_list; const PG8_LAS int* mps;
    __device__ __forceinline__ void operator()(AccT acc, const Unit& u, int wr, int wc, int fr, int fq, const PG8_LAS float* rst) const {
        const int col0 = u.pn * HALF + wc * 32 + 8 * fq; const int e = moe_e(mps, u.pm), p0 = mps[e], c0 = mps[16 + e];
#pragma unroll
        for (int ai = 0; ai < 2; ++ai)
#pragma unroll
            for (int m = 0; m < 4; ++m) { const int row = u.pm * BM + ai * HALF + wr * 64 + m * 16 + fr; const int ix = row - p0; const float rs = ix < c0 ? rst[row - u.pm * BM] : 0.f;
                float o[8];
#pragma unroll
                for (int n = 0; n < 2; ++n)
#pragma unroll
                    for (int e = 0; e < 4; ++e) { const float av = acc[ai][0][m][n][e] * rs, bv = acc[ai][1][m][n][e] * rs; o[n * 4 + e] = siluf(av) * bv; }
                u32x4 w; w.x = cvt_pk_bf16(o[0], o[1]); w.y = cvt_pk_bf16(o[2], o[3]); w.z = cvt_pk_bf16(o[4], o[5]); w.w = cvt_pk_bf16(o[6], o[7]);
                *(u32x4*)(h + (size_t)row * DFF + col0) = w; } } };
struct ESiluBias { static constexpr bool NEEDS_RST = false; static constexpr bool NEEDS_RSM = false; bf16_t* out; const float* bias;
    __device__ __forceinline__ void operator()(AccT acc, const Unit& u, int wr, int wc, int fr, int fq) const {
        const int col0 = u.pn * BM + wc * 32 + 8 * fq;
#pragma unroll
        for (int ai = 0; ai < 2; ++ai)
#pragma unroll
            for (int m = 0; m < 4; ++m) { const int row = u.pm * BM + ai * HALF + wr * 64 + m * 16 + fr; bf16_t* rowp = out + (size_t)row * 256 + col0;
#pragma unroll
                for (int bj = 0; bj < 2; ++bj) { const f32x4 b0 = *(const f32x4*)(bias + col0 + bj * HALF), b1 = *(const f32x4*)(bias + col0 + bj * HALF + 4); const f32x4 v0 = acc[ai][bj][m][0] + b0, v1 = acc[ai][bj][m][1] + b1;
                    u32x4 w; w.x = cvt_pk_bf16(siluf(v0[0]), siluf(v0[1])); w.y = cvt_pk_bf16(siluf(v0[2]), siluf(v0[3])); w.z = cvt_pk_bf16(siluf(v1[0]), siluf(v1[1])); w.w = cvt_pk_bf16(siluf(v1[2]), siluf(v1[3]));
                    *(u32x4*)(rowp + bj * HALF) = w; } } } };
struct EKc { static constexpr bool NEEDS_RST = false; static constexpr bool NEEDS_RSM = false; bf16_t* out; int transposed, pad;
    __device__ __forceinline__ void operator()(AccT acc, const Unit& u, int wr, int wc, int fr, int fq) const {
        if (wc >= 2) return;
        const int col0 = wc * 32 + 8 * fq;
#pragma unroll
        for (int ai = 0; ai < 2; ++ai)
#pragma unroll
            for (int m = 0; m < 4; ++m) { const int row = u.pm * BM + ai * HALF + wr * 64 + m * 16 + fr; const f32x4 v0 = acc[ai][0][m][0], v1 = acc[ai][0][m][1];
                if (!transposed) { u32x4 w; w.x = cvt_pk_bf16(v0[0], v0[1]); w.y = cvt_pk_bf16(v0[2], v0[3]); w.z = cvt_pk_bf16(v1[0], v1[1]); w.w = cvt_pk_bf16(v1[2], v1[3]); *(u32x4*)(out + (size_t)row * 64 + col0) = w; }
                else { bf16_t* o = out + (size_t)(row >> 8) * 16384 + (size_t)col0 * 256 + (row & 255);
#pragma unroll
                    for (int x = 0; x < 4; ++x) { o[x * 256] = f2bf(v0[x]); o[(4 + x) * 256] = f2bf(v1[x]); } } } } };
struct EStore { static constexpr bool NEEDS_RST = false; static constexpr bool NEEDS_RSM = false; bf16_t* out; int ldc;
    __device__ __forceinline__ void operator()(AccT acc, const Unit& u, int wr, int wc, int fr, int fq) const {
        const int col0 = u.pn * BM + wc * 32 + 8 * fq;
#pragma unroll
        for (int ai = 0; ai < 2; ++ai)
#pragma unroll
            for (int m = 0; m < 4; ++m) { const int row = u.pm * BM + ai * HALF + wr * 64 + m * 16 + fr; bf16_t* rowp = out + (size_t)row * ldc + col0;
#pragma unroll
                for (int bj = 0; bj < 2; ++bj) { const f32x4 v0 = acc[ai][bj][m][0], v1 = acc[ai][bj][m][1]; u32x4 w; w.x = cvt_pk_bf16(v0[0], v0[1]); w.y = cvt_pk_bf16(v0[2], v0[3]); w.z = cvt_pk_bf16(v1[0], v1[1]); w.w = cvt_pk_bf16(v1[2], v1[3]);
                    *(u32x4*)(rowp + bj * HALF) = w; } } } };
}

#ifndef NSA_REP_SEL
#define NSA_REP_SEL 1
#endif
#ifndef NSA_REP_WIN
#define NSA_REP_WIN 1
#endif
namespace nsa {
typedef float f32x16 __attribute__((ext_vector_type(16)));
typedef unsigned u32x4 __attribute__((ext_vector_type(4)));
typedef unsigned u32x2 __attribute__((ext_vector_type(2)));
constexpr int KSTR = 144, VSTR = 144;
constexpr int KT_B = 64 * KSTR, VT_B = 64 * VSTR, BUF_B = KT_B + VT_B;
constexpr int IMP_OFF = 2 * BUF_B  , SELM_OFF = IMP_OFF + 8 * 2048  , WUN_OFF = SELM_OFF + 512;
constexpr float L2E = 1.4426950408889634f;
#define NLAS __attribute__((address_space(3)))
__device__ __forceinline__ unsigned pk2(float lo, float hi) { unsigned r; asm volatile("v_cvt_pk_bf16_f32 %0, %1, %2" : "=v"(r) : "v"(lo), "v"(hi)); return r; }
struct Stage { u32x4 k, v; };
__device__ __forceinline__ void stage_issue(Stage& st, const bf16_t* kg, size_t kstride, const bf16_t* vg, size_t vstride, int tid) {
    const int r = tid >> 3, c = (tid & 7) * 8;
    st.k = *(const u32x4*)(kg + (size_t)r * kstride + c); st.v = *(const u32x4*)(vg + (size_t)r * vstride + c);
}
__device__ __forceinline__ void stage_write(const Stage& st, NLAS char* buf, int tid) {
    const int r = tid >> 3, c = (tid & 7) * 16;
    *(NLAS u32x4*)(buf + r * KSTR + c) = st.k;
    { const int cc = tid & 7, vo = KT_B + r * VSTR + (cc >> 1) * 32 + (cc & 1) * 8;
      *(NLAS u32x2*)(buf + vo) = (u32x2){st.v.x, st.v.y}; *(NLAS u32x2*)(buf + vo + 16) = (u32x2){st.v.z, st.v.w}; }
}
__device__ __forceinline__ void compute_S(NLAS const char* buf, const bf16x8 (&Qf)[4], f32x16& S0, f32x16& S1, int lane) {
    const int kr = lane & 31, hi = lane >> 5;
#pragma unroll
    for (int i = 0; i < 16; ++i) { S0[i] = 0.f; S1[i] = 0.f; }
    bf16x8 af[8];
#pragma unroll
    for (int s = 0; s < 4; ++s) { af[2 * s] = *(NLAS const bf16x8*)(buf + kr * KSTR + s * 32 + hi * 16); af[2 * s + 1] = *(NLAS const bf16x8*)(buf + (32 + kr) * KSTR + s * 32 + hi * 16); }
    __builtin_amdgcn_sched_barrier(0);
#pragma unroll
    for (int s = 0; s < 4; ++s) { S0 = __builtin_amdgcn_mfma_f32_32x32x16_bf16(af[2 * s], Qf[s], S0, 0, 0, 0); S1 = __builtin_amdgcn_mfma_f32_32x32x16_bf16(af[2 * s + 1], Qf[s], S1, 0, 0, 0); }
}
__device__ __forceinline__ void mask_S(f32x16& S0, f32x16& S1, int lo, int hi, int lane) {
    const int h4 = (lane >> 5) * 4, lo2 = lo - h4, hi2 = hi - h4;
#pragma unroll
    for (int i = 0; i < 16; ++i) { const int c0 = (i & 3) + 8 * (i >> 2); S0[i] = (c0 >= lo2 && c0 <= hi2) ? S0[i] : -INFINITY; S1[i] = (c0 + 32 >= lo2 && c0 + 32 <= hi2) ? S1[i] : -INFINITY; }
}
__device__ __forceinline__ float max3f(float a, float b, float c) { float r; asm("v_max3_f32 %0, %1, %2, %3" : "=v"(r) : "v"(a), "v"(b), "v"(c)); return r; }
__device__ __forceinline__ float max_S(const f32x16& S0, const f32x16& S1) { float m = max3f(S0[0], S1[0], S0[1]);
    m = max3f(m, S1[1], S0[2]); m = max3f(m, S1[2], S0[3]); m = max3f(m, S1[3], S0[4]); m = max3f(m, S1[4], S0[5]); m = max3f(m, S1[5], S0[6]); m = max3f(m, S1[6], S0[7]); m = max3f(m, S1[7], S0[8]);
    m = max3f(m, S1[8], S0[9]); m = max3f(m, S1[9], S0[10]); m = max3f(m, S1[10], S0[11]); m = max3f(m, S1[11], S0[12]); m = max3f(m, S1[12], S0[13]); m = max3f(m, S1[13], S0[14]); m = max3f(m, S1[14], S0[15]);
    float o = __shfl_xor(m, 32); return max3f(m, S1[15], o); }
__device__ __forceinline__ float exp_S(f32x16& S0, f32x16& S1, float mL) { float l0 = 0.f, l1 = 0.f;
#pragma unroll
    for (int i = 0; i < 16; ++i) { S0[i] = __builtin_amdgcn_exp2f(fmaf(S0[i], L2E, -mL)); S1[i] = __builtin_amdgcn_exp2f(fmaf(S1[i], L2E, -mL)); l0 += S0[i]; l1 += S1[i]; }
    return l0 + l1; }
__device__ __forceinline__ void pack_P(const f32x16& S0, const f32x16& S1, unsigned andm, bf16x8 (&Pf)[4]) {
#pragma unroll
    for (int s2 = 0; s2 < 4; ++s2) { u32x4 w;
#pragma unroll
        for (int q = 0; q < 4; ++q) { const int i = (s2 & 1) * 8 + q * 2; w[q] = (s2 < 2 ? pk2(S0[i], S0[i + 1]) : pk2(S1[i], S1[i + 1])) & andm; }
        Pf[s2] = __builtin_bit_cast(bf16x8, w); }
}
__device__ __forceinline__ void pv(NLAS const char* buf, const bf16x8 (&Pf)[4], f32x16& O0, f32x16& O1, int lane) {
    const int dr = lane & 31, hi = lane >> 5; NLAS const char* vt = buf + KT_B;
    bf16x8 vf[8];
#pragma unroll
    for (int s2 = 0; s2 < 4; ++s2) { vf[2 * s2] = *(NLAS const bf16x8*)(vt + dr * VSTR + (16 * s2 + 8 * hi) * 2); vf[2 * s2 + 1] = *(NLAS const bf16x8*)(vt + (32 + dr) * VSTR + (16 * s2 + 8 * hi) * 2); }
    __builtin_amdgcn_sched_barrier(0);
#pragma unroll
    for (int s2 = 0; s2 < 4; ++s2) { O0 = __builtin_amdgcn_mfma_f32_32x32x16_bf16(vf[2 * s2], Pf[s2], O0, 0, 0, 0); O1 = __builtin_amdgcn_mfma_f32_32x32x16_bf16(vf[2 * s2 + 1], Pf[s2], O1, 0, 0, 0); }
}
__device__ __forceinline__ void online_block(NLAS const char* buf, const bf16x8 (&Qf)[4], f32x16& O0, f32x16& O1, float& m, float& l, bool lane_on, bool use_mask, int lo, int hi, int lane) {
    f32x16 S0, S1; compute_S(buf, Qf, S0, S1, lane);
    if (use_mask) mask_S(S0, S1, lo, hi, lane);
    float mt = max_S(S0, S1); if (!lane_on) mt = -INFINITY;
    const float mn = max3f(m, mt, mt), ms = mn == -INFINITY ? 0.f : mn;
    const float ls = exp_S(S0, S1, ms * L2E);
    if (__any(mn != m)) { const float al = __builtin_amdgcn_exp2f((m - ms) * L2E); l *= al;
#pragma unroll
        for (int i = 0; i < 16; ++i) { O0[i] *= al; O1[i] *= al; } }
    l += (lane_on ? ls : 0.f); m = mn;
    bf16x8 Pf[4]; pack_P(S0, S1, lane_on ? 0xffffffffu : 0u, Pf);
    pv(buf, Pf, O0, O1, lane);
}

struct BitIter { unsigned long long rem; __device__ __forceinline__ int next() { if (!rem) return -1; const int j = __builtin_ctzll(rem); rem &= rem - 1; return j; } };
struct RangeIter { int cur, end; __device__ __forceinline__ int next() { return cur <= end ? cur++ : -1; } };
struct SelPar { unsigned long long mq; int qb, tq;
    __device__ __forceinline__ void get(int j, bool& on, bool& um, int& lo, int& hi) const { on = (mq >> j) & 1ull; um = (j == qb); lo = 0; hi = tq; } };
struct WinPar { int qb, tq;
    __device__ __forceinline__ void get(int j, bool& on, bool& um, int& lo, int& hi) const { const bool first = (j == qb - 8), diag = (j == qb); on = true; um = first || diag; lo = first ? tq + 1 : 0; hi = diag ? tq : 63; } };
template <class It, class Par>
__device__ __forceinline__ void run_blocks(It it, const Par par, const bf16_t* kg, const bf16_t* vg, NLAS char* lds, const bf16x8 (&Qf)[4], f32x16& O0, f32x16& O1, float& m, float& l, int tid, int lane) {
    int j0 = it.next(), j1 = it.next();
    Stage sa, sb;
    stage_issue(sa, kg + (size_t)j0 * 64 * DINP, DINP, vg + j0 * 64, SEQ, tid);
    { const int jj = j1 >= 0 ? j1 : 0; stage_issue(sb, kg + (size_t)jj * 64 * DINP, DINP, vg + jj * 64, SEQ, tid); }
    stage_write(sa, lds, tid); __syncthreads();
    for (;;) {
        const int j2 = it.next();
        { const int jj = j2 >= 0 ? j2 : 0; stage_issue(sa, kg + (size_t)jj * 64 * DINP, DINP, vg + jj * 64, SEQ, tid); }
        { bool on, um; int lo, hi; par.get(j0, on, um, lo, hi); if (__any(on)) online_block(lds, Qf, O0, O1, m, l, on, um, lo, hi, lane); }
        stage_write(sb, lds + BUF_B, tid);
        __syncthreads();
        if (j1 < 0) break;
        const int j3 = it.next();
        { const int jj = j3 >= 0 ? j3 : 0; stage_issue(sb, kg + (size_t)jj * 64 * DINP, DINP, vg + jj * 64, SEQ, tid); }
        { bool on, um; int lo, hi; par.get(j1, on, um, lo, hi); if (__any(on)) online_block(lds + BUF_B, Qf, O0, O1, m, l, on, um, lo, hi, lane); }
        stage_write(sa, lds, tid);
        __syncthreads();
        if (j2 < 0) break;
        j0 = j2; j1 = j3;
    }
    __syncthreads();
}
}

__device__ __forceinline__ void nsa_unit(const Args& a, LAS char* lds_, const int qb, const int bg) {
    using namespace nsa;
    int tid = threadIdx.x; asm volatile("" : "+v"(tid));
    NLAS char* lds = lds_;
    const int w = __builtin_amdgcn_readfirstlane(tid >> 6), lane = tid & 63, hi = lane >> 5, r = lane & 31, tql = r >> 2, hpg = r & 3;
    NLAS float* impw = (NLAS float*)(lds + IMP_OFF + w * 2048);
    NLAS unsigned long long* selm = (NLAS unsigned long long*)(lds + SELM_OFF);
    NLAS unsigned long long* wun = (NLAS unsigned long long*)(lds + WUN_OFF);
    const bf16_t* proj = a.proj;
    {
        const int b = bg >> 1, g = bg & 1;
        const int tq = 8 * w + tql, t = 64 * qb + tq; const size_t row = (size_t)b * SEQ + t; const bf16_t* prow = proj + row * DINP;
        bf16x8 Qf[4];
#pragma unroll
        for (int s = 0; s < 4; ++s) Qf[s] = *(const bf16x8*)(prow + C_Q + g * 256 + hpg * 64 + 16 * s + 8 * hi);
        f32x16 Oo0, Oo1;
        const int hh = g * 4 + hpg; const float g0 = sigmf(bf2f(prow[C_GL + hh * 3 + 0])), g1 = sigmf(bf2f(prow[C_GL + hh * 3 + 1])), g2 = sigmf(bf2f(prow[C_GL + hh * 3 + 2]));
        Stage st;
        const bf16_t* kcg = a.kcb + (size_t)bg * 256 * 64; const bf16_t* vcg = a.vcT + (size_t)bg * 64 * 256;
        const int nbc = (4 * qb + 3 + 63) >> 6;
        const int cmax = t >= 31 ? (t - 31) >> 4 : -1;
        float mc = -INFINITY, lc = 0.f;
        __syncthreads();
        stage_issue(st, kcg, 64, vcg, 256, tid); stage_write(st, lds, tid); __syncthreads();
        for (int kb = 0; kb < nbc; ++kb) {
            NLAS char* buf = lds + (kb & 1) * BUF_B;
            if (kb + 1 < nbc) stage_issue(st, kcg + (size_t)(kb + 1) * 64 * 64, 64, vcg + (kb + 1) * 64, 256, tid);
            f32x16 S0, S1; compute_S(buf, Qf, S0, S1, lane); mask_S(S0, S1, 0, cmax - 64 * kb, lane);
            const float mt = max_S(S0, S1), mn = max3f(mc, mt, mt), ms = mn == -INFINITY ? 0.f : mn, al = __builtin_amdgcn_exp2f((mc - ms) * L2E);
            lc = lc * al + exp_S(S0, S1, ms * L2E); mc = mn;
            if (kb + 1 < nbc) stage_write(st, lds + ((kb + 1) & 1) * BUF_B, tid);
            __syncthreads();
        }
        lc += __shfl_xor(lc, 32);
        const float mLc = (mc == -INFINITY ? 0.f : mc) * L2E, ilc = lc > 0.f ? 1.f / lc : 0.f;
        f32x16 Oc0, Oc1, Z0, Z1;
#pragma unroll
        for (int i = 0; i < 16; ++i) { Oc0[i] = 0.f; Oc1[i] = 0.f; Z0[i] = 0.f; Z1[i] = 0.f; }
        stage_issue(st, kcg, 64, vcg, 256, tid); stage_write(st, lds, tid); __syncthreads();
        for (int kb = 0; kb < nbc; ++kb) {
            NLAS char* buf = lds + (kb & 1) * BUF_B;
            if (kb + 1 < nbc) stage_issue(st, kcg + (size_t)(kb + 1) * 64 * 64, 64, vcg + (kb + 1) * 64, 256, tid);
            f32x16 S0, S1; compute_S(buf, Qf, S0, S1, lane); mask_S(S0, S1, 0, cmax - 64 * kb, lane);
            (void)exp_S(S0, S1, mLc);
#pragma unroll
            for (int i = 0; i < 16; ++i) { S0[i] *= ilc; S1[i] *= ilc; }
            bf16x8 Pf[4]; pack_P(S0, S1, 0xffffffffu, Pf);
            pv(buf, Pf, Oc0, Oc1, lane);
#pragma unroll
            for (int s2 = 0; s2 < 4; ++s2) {
#pragma unroll
                for (int stl = 0; stl < 2; ++stl) { const int sblk = 32 * stl + r; u32x4 wv;
#pragma unroll
                    for (int q = 0; q < 4; ++q) { unsigned x = 0u;
#pragma unroll
                        for (int e = 0; e < 2; ++e) { const int j = q * 2 + e, c = 64 * kb + 16 * s2 + 8 * (j >> 2) + 4 * hi + (j & 3); if (c >= 4 * sblk - 1 && c <= 4 * sblk + 3) x |= (0x3f80u << (16 * e)); }
                        wv[q] = x; }
                    if (stl == 0) Z0 = __builtin_amdgcn_mfma_f32_32x32x16_bf16(Pf[s2], __builtin_bit_cast(bf16x8, wv), Z0, 0, 0, 0);
                    else          Z1 = __builtin_amdgcn_mfma_f32_32x32x16_bf16(Pf[s2], __builtin_bit_cast(bf16x8, wv), Z1, 0, 0, 0); } }
            if (kb + 1 < nbc) stage_write(st, lds + ((kb + 1) & 1) * BUF_B, tid);
            __syncthreads();
        }
#pragma unroll
        for (int i = 0; i < 16; ++i) { Oo0[i] = g0 * Oc0[i]; Oo1[i] = g0 * Oc1[i]; }
#pragma unroll
        for (int q4 = 0; q4 < 4; ++q4) { impw[(2 * q4 + hi) * 64 + r] = (Z0[4 * q4] + Z0[4 * q4 + 1]) + (Z0[4 * q4 + 2] + Z0[4 * q4 + 3]); impw[(2 * q4 + hi) * 64 + 32 + r] = (Z1[4 * q4] + Z1[4 * q4 + 1]) + (Z1[4 * q4 + 2] + Z1[4 * q4 + 3]); }
        __syncthreads();
        unsigned long long wu = 0ull;
        {
            const unsigned long long vmask = qb >= 63 ? ~0ull : ((1ull << (qb + 1)) - 1ull);
            const unsigned long long fmask = (1ull | (1ull << qb) | (qb >= 1 ? (1ull << (qb - 1)) : 0ull)) & vmask;
            const unsigned long long cand = vmask & ~fmask;
            const int K = 16 - __builtin_popcountll(fmask), ncand = __builtin_popcountll(cand);
            const unsigned long long lt_mask = (1ull << lane) - 1ull;
            for (int q = 0; q < 8; ++q) {
                unsigned long long mk = fmask;
                if (ncand <= K) mk |= cand;
                else {
                    const unsigned u = __float_as_uint(impw[q * 64 + lane]);
                    unsigned long long active = cand, chosen = 0ull; int k = K;
#pragma unroll
                    for (int bit = 30; bit >= 0; --bit) { const unsigned long long ones = __ballot((u >> bit) & 1u) & active; const int c = __builtin_popcountll(ones);
                        if (c >= k) active = ones; else { chosen |= ones; k -= c; active &= ~ones; } }
                    const bool tie_take = ((active >> lane) & 1ull) && (__builtin_popcountll(active & lt_mask) < k);
                    mk |= chosen | __ballot(tie_take);
                }
                wu |= mk;
                if (lane == 0) selm[8 * w + q] = mk; }
        }
        if (lane == 0) wun[w] = wu;
        __syncthreads();
        unsigned long long um = 0ull;
#pragma unroll
        for (int q = 0; q < 8; ++q) um |= wun[q];
        um = ((unsigned long long)__builtin_amdgcn_readfirstlane((unsigned)(um >> 32)) << 32) | (unsigned)__builtin_amdgcn_readfirstlane((unsigned)um);
        const unsigned long long mq = selm[tq];
        {
            const bf16_t* kg = proj + (size_t)b * SEQ * DINP + C_KS + g * 64; const bf16_t* vg = a.VsT + (size_t)bg * 64 * SEQ;
            f32x16 O0, O1;
#pragma unroll
            for (int i = 0; i < 16; ++i) { O0[i] = 0.f; O1[i] = 0.f; }
            float m = -INFINITY, l = 0.f;
            for (int rep = 0; rep < NSA_REP_SEL; ++rep) {
#pragma unroll
            for (int i = 0; i < 16; ++i) { O0[i] = 0.f; O1[i] = 0.f; }
            m = -INFINITY; l = 0.f;
            run_blocks(BitIter{um}, SelPar{mq, qb, tq}, kg, vg, lds, Qf, O0, O1, m, l, tid, lane); }
            l += __shfl_xor(l, 32); const float sc = l > 0.f ? g1 / l : 0.f;
#pragma unroll
            for (int i = 0; i < 16; ++i) { Oo0[i] += sc * O0[i]; Oo1[i] += sc * O1[i]; }
        }
        {
            const bf16_t* kg = proj + (size_t)b * SEQ * DINP + C_KW + g * 64; const bf16_t* vg = a.VwT + (size_t)bg * 64 * SEQ;
            f32x16 O0, O1;
#pragma unroll
            for (int i = 0; i < 16; ++i) { O0[i] = 0.f; O1[i] = 0.f; }
            float m = -INFINITY, l = 0.f;
            for (int rep = 0; rep < NSA_REP_WIN; ++rep) {
#pragma unroll
            for (int i = 0; i < 16; ++i) { O0[i] = 0.f; O1[i] = 0.f; }
            m = -INFINITY; l = 0.f;
            run_blocks(RangeIter{qb - 8 > 0 ? qb - 8 : 0, qb}, WinPar{qb, tq}, kg, vg, lds, Qf, O0, O1, m, l, tid, lane); }
            l += __shfl_xor(l, 32); const float sc = l > 0.f ? g2 / l : 0.f;
#pragma unroll
            for (int i = 0; i < 16; ++i) { Oo0[i] += sc * O0[i]; Oo1[i] += sc * O1[i]; }
        }
        bf16_t* op = a.ocat + row * DM + hh * 64 + 4 * hi;
#pragma unroll
        for (int q4 = 0; q4 < 4; ++q4) { u32x2 w0, w1; w0.x = pk2(Oo0[4 * q4], Oo0[4 * q4 + 1]); w0.y = pk2(Oo0[4 * q4 + 2], Oo0[4 * q4 + 3]); w1.x = pk2(Oo1[4 * q4], Oo1[4 * q4 + 1]); w1.y = pk2(Oo1[4 * q4 + 2], Oo1[4 * q4 + 3]);
            *(u32x2*)(op + 8 * q4) = w0; *(u32x2*)(op + 32 + 8 * q4) = w1; }
    }
}

__device__ __forceinline__ void ph_vtrans(const Args& a, LAS char* lds_, int vcu, int G) {
    int tid = threadIdx.x; asm volatile("" : "+v"(tid)); asm volatile("" : "+s"(vcu));
    LAS bf16_t* tile = (LAS bf16_t*)lds_;
    for (int u = vcu; u < 2 * 16 * 64; u += G) { const int tb = u & 63, bg = (u >> 6) & 15, which = u >> 10, b = bg >> 1, g = bg & 1;
        const bf16_t* src = a.proj + ((size_t)b * SEQ + tb * 64) * DINP + (which ? C_VW : C_VS) + g * 64; bf16_t* dst = (which ? a.VwT : a.VsT) + (size_t)bg * 64 * SEQ + tb * 64;
        const int r = tid >> 3, c = (tid & 7) * 8;
        const uint4 v = *(const uint4*)(src + (size_t)r * DINP + c); const unsigned wv[4] = {v.x, v.y, v.z, v.w};
        __syncthreads();
#pragma unroll
        for (int e = 0; e < 4; ++e) { tile[(c + 2 * e) * 72 + r] = (bf16_t)(wv[e] & 0xffffu); tile[(c + 2 * e + 1) * 72 + r] = (bf16_t)(wv[e] >> 16); }
        __syncthreads();
        *(u32x4_t*)(dst + (size_t)r * SEQ + c) = *(const LAS u32x4_t*)(tile + r * 72 + c);
    }
}

__device__ __forceinline__ void ph_conv_naive(const Args& a, int l, LAS char* lds, int vcu, int G) {
    int tid_ = threadIdx.x; asm volatile("" : "+v"(tid_)); asm volatile("" : "+s"(vcu));
    const int half = tid_ >> 8, c = tid_ & 255; LAS float* hs = (LAS float*)(lds + half * 63488);
    const float* cw = a.conv_w + (size_t)l * 31 * 256; const float* lg = a.conv_lg + l * 256; const float* lb = a.conv_lb + l * 256;
    float w[31];
#pragma unroll
    for (int k = 0; k < 31; ++k) w[k] = cw[k * 256 + c];
    const float bias = a.conv_b[l * 256 + c];
    for (int unit = vcu; unit < NTOK / 64; unit += G) {
        const int tile = unit * 2 + half, b = tile >> 7, t0 = (tile & 127) * 32;
        __syncthreads();
        for (int i = 0; i < 62; ++i) { const int t = t0 - 30 + i; float v = 0.f;
            if (t >= 0) { const bf16_t* p = a.proj + ((size_t)b * SEQ + t) * DINP + C_CONV; v = bf2f(p[c]) * sigmf(bf2f(p[256 + c])); }
            hs[i * 256 + c] = v; }
        __syncthreads();
        float outv[32];
#pragma unroll
        for (int tt = 0; tt < 32; ++tt) { float s = bias;
#pragma unroll
            for (int k = 0; k < 31; ++k) s += hs[(tt + k) * 256 + c] * w[k];
            outv[tt] = s; }
        __syncthreads();
#pragma unroll
        for (int tt = 0; tt < 32; ++tt) hs[tt * 256 + c] = outv[tt];
        __syncthreads();
        const int wave = c >> 6, lane = c & 63;
        for (int tt = wave; tt < 32; tt += 4) { float v[4], s = 0.f;
#pragma unroll
            for (int i = 0; i < 4; ++i) { v[i] = hs[tt * 256 + lane + 64 * i]; s += v[i]; }
            const float mu = wsum(s) * (1.f / 256.f); float q = 0.f;
#pragma unroll
            for (int i = 0; i < 4; ++i) q += (v[i] - mu) * (v[i] - mu);
            const float rs = rsqrtf(wsum(q) * (1.f / 256.f) + 1e-5f);
#pragma unroll
            for (int i = 0; i < 4; ++i) { const int ch = lane + 64 * i; const float y = (v[i] - mu) * rs * lg[ch] + lb[ch]; a.hconv[((size_t)b * SEQ + t0 + tt) * 256 + ch] = f2bf(siluf(y)); } }
    }
}


__device__ __forceinline__ void prep_unit(const Args& a, LAS char* lds, const int u) {
    int tid = threadIdx.x; asm volatile("" : "+v"(tid));
    constexpr int RS = 258; LAS bf16_t* tK = (LAS bf16_t*)lds; LAS bf16_t* tV = tK + 64 * RS; LAS bf16_t* tS = tV + 64 * RS;
    const int b = u >> 6, tb = u & 63;
    __syncthreads();
#pragma unroll
    for (int it = 0; it < 2; ++it) { const int item = tid + NT * it, tok = item >> 4, h = (item >> 2) & 3, ch = item & 3; const int pos = tb * 64 + tok; const size_t row = (size_t)b * SEQ + pos;
        const bf16_t* p = a.proj + row * DINP; const int c0 = h * 64 + 8 * ch;
        const u32x4_t ql = *(const u32x4_t*)(p + C_RQ + c0), qh = *(const u32x4_t*)(p + C_RQ + c0 + 32), kl = *(const u32x4_t*)(p + C_RK + c0), kh = *(const u32x4_t*)(p + C_RK + c0 + 32);
        const u32x4_t vl = *(const u32x4_t*)(p + C_RV + c0), vh = *(const u32x4_t*)(p + C_RV + c0 + 32);
        const float* cs = a.rot + ((size_t)pos * 32 + 8 * ch) * 2; float co[8], si[8];
#pragma unroll
        for (int e = 0; e < 4; ++e) { const f32x4 t4 = *(const f32x4*)(cs + 4 * e); co[2 * e] = t4[0]; si[2 * e] = t4[1]; co[2 * e + 1] = t4[2]; si[2 * e + 1] = t4[3]; }
        const float zeta = exp2f((float)(127 - (pos & 127)) * log2f(1.f - exp2f(-5.f - (float)h)));
        u32x4_t oql, oqh, okl, okh; LAS unsigned* wk = (LAS unsigned*)(tK + tok * RS + c0); LAS unsigned* wv = (LAS unsigned*)(tV + tok * RS + c0);
#pragma unroll
        for (int e2 = 0; e2 < 4; ++e2) { float r1[2], r2[2], k1[2], k2[2];
#pragma unroll
            for (int e1 = 0; e1 < 2; ++e1) { const int e = e2 * 2 + e1; const float x1 = __uint_as_float(e1 ? (ql[e2] & 0xffff0000u) : (ql[e2] << 16)), x2 = __uint_as_float(e1 ? (qh[e2] & 0xffff0000u) : (qh[e2] << 16));
                const float y1 = __uint_as_float(e1 ? (kl[e2] & 0xffff0000u) : (kl[e2] << 16)), y2 = __uint_as_float(e1 ? (kh[e2] & 0xffff0000u) : (kh[e2] << 16));
                r1[e1] = x1 * co[e] - x2 * si[e]; r2[e1] = x1 * si[e] + x2 * co[e]; k1[e1] = y1 * co[e] - y2 * si[e]; k2[e1] = y1 * si[e] + y2 * co[e]; }
            oql[e2] = pk2bf(r1[0], r1[1]); oqh[e2] = pk2bf(r2[0], r2[1]); okl[e2] = pk2bf(k1[0], k1[1]); okh[e2] = pk2bf(k2[0], k2[1]);
            wk[e2] = pk2bf(k1[0] * zeta, k1[1] * zeta); wk[16 + e2] = pk2bf(k2[0] * zeta, k2[1] * zeta); wv[e2] = vl[e2]; wv[16 + e2] = vh[e2]; }
        *(u32x4_t*)(a.qrb + row * 256 + c0) = oql; *(u32x4_t*)(a.qrb + row * 256 + c0 + 32) = oqh; *(u32x4_t*)(a.krb + row * 256 + c0) = okl; *(u32x4_t*)(a.krb + row * 256 + c0 + 32) = okh; }
#pragma unroll
    for (int it = 0; it < 4; ++it) { const int item = tid + NT * it, tok = item >> 5, cb = (item >> 3) & 3, ch = item & 7;
        const u32x4_t v = *(const u32x4_t*)(a.proj + ((size_t)b * SEQ + tb * 64 + tok) * DINP + ((cb & 2) ? C_VW : C_VS) + (cb & 1) * 64 + ch * 8);
        LAS unsigned* ws = (LAS unsigned*)(tS + tok * RS + cb * 64 + ch * 8); ws[0] = v.x; ws[1] = v.y; ws[2] = v.z; ws[3] = v.w; }
    __syncthreads();
#pragma unroll
    for (int it = 0; it < 12; ++it) { const int q = tid + NT * it, tl = q >> 11, ri = (q >> 3) & 255, cc = q & 7;
        const LAS bf16_t* src = (tl == 0 ? tK : tl == 1 ? tV : tS) + (cc * 8) * RS + ri; unsigned short e[8];
#pragma unroll
        for (int j = 0; j < 8; ++j) e[j] = src[j * RS];
        u32x4_t w; w.x = e[0] | ((unsigned)e[1] << 16); w.y = e[2] | ((unsigned)e[3] << 16); w.z = e[4] | ((unsigned)e[5] << 16); w.w = e[6] | ((unsigned)e[7] << 16);
        bf16_t* dst = tl == 0 ? a.KzT + ((size_t)b * 256 + ri) * SEQ : tl == 1 ? a.VrT + ((size_t)b * 256 + ri) * SEQ : ((ri & 128) ? a.VwT : a.VsT) + ((size_t)(b * 2 + ((ri >> 6) & 1)) * 64 + (ri & 63)) * SEQ;
        *(u32x4_t*)(dst + tb * 64 + cc * 8) = w; }
}
__device__ __forceinline__ void conv_unit(const Args& a, int l, LAS char* lds, const int u) {
    int tid = threadIdx.x; asm volatile("" : "+v"(tid));
    LAS float* hs = (LAS float*)lds; const int b = u >> 6, t0 = (u & 63) * 64;
    const int p = tid & 255, th = tid >> 8, c = (p & 31) * 8 + (p >> 5);
    const float* cw = a.conv_w + (size_t)l * 31 * 256; float w[31];
#pragma unroll
    for (int k = 0; k < 31; ++k) w[k] = cw[k * 256 + c];
    const float bias = a.conv_b[l * 256 + c];
    __syncthreads();
#pragma unroll
    for (int it = 0; it < 6; ++it) { const int q = tid + NT * it; if (q < 94 * 32) { const int rr = q >> 5, cc = q & 31, t = t0 - 30 + rr; u32x4_t av = (u32x4_t){0u, 0u, 0u, 0u}, gv = av;
            if (t >= 0) { const bf16_t* pp = a.proj + ((size_t)b * SEQ + t) * DINP + C_CONV + cc * 8; av = *(const u32x4_t*)pp; gv = *(const u32x4_t*)(pp + 256); }
#pragma unroll
            for (int e = 0; e < 8; ++e) { const unsigned aw = av[e >> 1], gw = gv[e >> 1]; const float x = __uint_as_float((e & 1) ? (aw & 0xffff0000u) : (aw << 16)), gt = __uint_as_float((e & 1) ? (gw & 0xffff0000u) : (gw << 16));
                hs[rr * 256 + e * 32 + cc] = t >= 0 ? x * sigmf(gt) : 0.f; } } }
    __syncthreads();
    float acc[32];
#pragma unroll
    for (int tt = 0; tt < 32; ++tt) acc[tt] = bias;
#pragma unroll
    for (int j = 0; j < 62; ++j) { const float x = hs[(th * 32 + j) * 256 + p];
#pragma unroll
        for (int tt = 0; tt < 32; ++tt) if (j - tt >= 0 && j - tt <= 30) acc[tt] += x * w[j - tt]; }
    __syncthreads();
#pragma unroll
    for (int tt = 0; tt < 32; ++tt) hs[(th * 32 + tt) * 256 + p] = acc[tt];
    __syncthreads();
    const int wave = tid >> 6, lane = tid & 63; const float* lg = a.conv_lg + l * 256; const float* lb = a.conv_lb + l * 256;
    LAS bf16_t* hn = (LAS bf16_t*)(lds + 94 * 256 * 4);
    const int n0 = wave * 32, fr = lane & 15, fq = lane >> 4; const bf16_t* wp = a.Wpw + (size_t)l * 65536;
    bf16x8 bfr[8][2];
#pragma unroll
    for (int ks = 0; ks < 8; ++ks)
#pragma unroll
        for (int n = 0; n < 2; ++n) bfr[ks][n] = *(const bf16x8*)(wp + (size_t)(n0 + 16 * n + fr) * 256 + 32 * ks + 8 * fq);
#pragma unroll 2
    for (int i8 = 0; i8 < 8; ++i8) { const int tt = wave * 8 + i8; float v[4], sm = 0.f;
#pragma unroll
        for (int i = 0; i < 4; ++i) { v[i] = hs[tt * 256 + lane + 64 * i]; sm += v[i]; }
        const float mu = wsum(sm) * (1.f / 256.f); float q = 0.f;
#pragma unroll
        for (int i = 0; i < 4; ++i) q += (v[i] - mu) * (v[i] - mu);
        const float rs = rsqrtf(wsum(q) * (1.f / 256.f) + 1e-5f);
#pragma unroll
        for (int i = 0; i < 4; ++i) { const int pp = lane + 64 * i, ch = (pp & 31) * 8 + (pp >> 5); const float y = (v[i] - mu) * rs * lg[ch] + lb[ch]; hn[tt * 264 + ch] = f2bf(siluf(y)); } }
    __syncthreads();
    { f32x4 acc[4][2];
#pragma unroll
      for (int m = 0; m < 4; ++m)
#pragma unroll
          for (int n = 0; n < 2; ++n) acc[m][n] = (f32x4){0.f, 0.f, 0.f, 0.f};
#pragma unroll
      for (int ks = 0; ks < 8; ++ks) { bf16x8 afr[4];
#pragma unroll
          for (int m = 0; m < 4; ++m) afr[m] = *(const LAS bf16x8*)(hn + (16 * m + fr) * 264 + 32 * ks + 8 * fq);
#pragma unroll
          for (int m = 0; m < 4; ++m)
#pragma unroll
              for (int n = 0; n < 2; ++n) acc[m][n] = __builtin_amdgcn_mfma_f32_16x16x32_bf16(afr[m], bfr[ks][n], acc[m][n], 0, 0, 0); }
#pragma unroll
      for (int m = 0; m < 4; ++m)
#pragma unroll
          for (int r = 0; r < 4; ++r) { bf16_t* op = a.ocat + ((size_t)b * SEQ + t0 + 16 * m + fq * 4 + r) * DM + 512 + n0 + fr;
#pragma unroll
              for (int n = 0; n < 2; ++n) op[16 * n] = f2bf(acc[m][n][r]); } }
}
__device__ __forceinline__ void ph_x1_small(const Args& a, int l, LAS char* lds) {
    int tid = threadIdx.x; asm volatile("" : "+v"(tid));
    volatile LAS int* slot = (volatile LAS int*)(lds + MISC_OFF + 64);
    unsigned* wq = a.wq + 256 + 64 * l;
    __syncthreads();
    if (tid == 0) slot[0] = (int)__hip_atomic_fetch_add(wq, 1u, __ATOMIC_RELAXED, __HIP_MEMORY_SCOPE_AGENT);
    __syncthreads();
    for (int n = 0;; ++n) {
        const int idx = slot[n & 1];
        if (idx >= 1024) break;
        if (tid == 0) slot[(n + 1) & 1] = (int)__hip_atomic_fetch_add(wq, 1u, __ATOMIC_RELAXED, __HIP_MEMORY_SCOPE_AGENT);
        if (idx < 512) conv_unit(a, l, lds, idx); else prep_unit(a, lds, idx - 512);
        __syncthreads();
    }
    __syncthreads();
}

namespace ret {
using nsa::f32x16; using nsa::u32x4; using nsa::u32x2; using nsa::pk2;
__device__ __forceinline__ float lg2g(int h) { return log2f(1.f - exp2f(-5.f - (float)h)); }
}
__device__ __forceinline__ void ph_ret_prep(const Args& a, LAS char* lds, int vcu, int G) {
    int tid = threadIdx.x; asm volatile("" : "+v"(tid)); asm volatile("" : "+s"(vcu));
    LAS bf16_t* tK = (LAS bf16_t*)lds; LAS bf16_t* tV = (LAS bf16_t*)(lds + 256 * 72 * 2);
    for (int u = vcu; u < NB * 64; u += G) { const int b = u >> 6, tb = u & 63;
        __syncthreads();
#pragma unroll
        for (int it = 0; it < 2; ++it) { const int item = tid + NT * it, tok = item >> 4, h = (item >> 2) & 3, ch = item & 3; const int pos = tb * 64 + tok; const size_t row = (size_t)b * SEQ + pos;
            const bf16_t* p = a.proj + row * DINP; const int c0 = h * 64 + 8 * ch;
            const u32x4_t ql = *(const u32x4_t*)(p + C_RQ + c0), qh = *(const u32x4_t*)(p + C_RQ + c0 + 32), kl = *(const u32x4_t*)(p + C_RK + c0), kh = *(const u32x4_t*)(p + C_RK + c0 + 32);
            const u32x4_t vl = *(const u32x4_t*)(p + C_RV + c0), vh = *(const u32x4_t*)(p + C_RV + c0 + 32);
            const float* cs = a.rot + ((size_t)pos * 32 + 8 * ch) * 2; float co[8], si[8];
#pragma unroll
            for (int e = 0; e < 4; ++e) { const f32x4 t4 = *(const f32x4*)(cs + 4 * e); co[2 * e] = t4[0]; si[2 * e] = t4[1]; co[2 * e + 1] = t4[2]; si[2 * e + 1] = t4[3]; }
            const float zeta = exp2f((float)(127 - (pos & 127)) * ret::lg2g(h));
            u32x4_t oql, oqh, okl, okh;
#pragma unroll
            for (int e2 = 0; e2 < 4; ++e2) { float r1[2], r2[2], k1[2], k2[2];
#pragma unroll
                for (int e1 = 0; e1 < 2; ++e1) { const int e = e2 * 2 + e1; const float x1 = __uint_as_float(e1 ? (ql[e2] & 0xffff0000u) : (ql[e2] << 16)), x2 = __uint_as_float(e1 ? (qh[e2] & 0xffff0000u) : (qh[e2] << 16));
                    const float y1 = __uint_as_float(e1 ? (kl[e2] & 0xffff0000u) : (kl[e2] << 16)), y2 = __uint_as_float(e1 ? (kh[e2] & 0xffff0000u) : (kh[e2] << 16));
                    r1[e1] = x1 * co[e] - x2 * si[e]; r2[e1] = x1 * si[e] + x2 * co[e]; k1[e1] = y1 * co[e] - y2 * si[e]; k2[e1] = y1 * si[e] + y2 * co[e];
                    tK[(c0 + e) * 72 + tok] = f2bf(k1[e1] * zeta); tK[(c0 + 32 + e) * 72 + tok] = f2bf(k2[e1] * zeta);
                    tV[(c0 + e) * 72 + tok] = (bf16_t)(e1 ? (vl[e2] >> 16) : (vl[e2] & 0xffffu)); tV[(c0 + 32 + e) * 72 + tok] = (bf16_t)(e1 ? (vh[e2] >> 16) : (vh[e2] & 0xffffu)); }
                oql[e2] = nsa::pk2(r1[0], r1[1]); oqh[e2] = nsa::pk2(r2[0], r2[1]); okl[e2] = nsa::pk2(k1[0], k1[1]); okh[e2] = nsa::pk2(k2[0], k2[1]); }
            *(u32x4_t*)(a.qrb + row * 256 + c0) = oql; *(u32x4_t*)(a.qrb + row * 256 + c0 + 32) = oqh; *(u32x4_t*)(a.krb + row * 256 + c0) = okl; *(u32x4_t*)(a.krb + row * 256 + c0 + 32) = okh; }
        __syncthreads();
#pragma unroll
        for (int it = 0; it < 4; ++it) { const int q = tid + NT * it, ri = q >> 3, cc = (q & 7) * 8; const size_t o = ((size_t)b * 256 + ri) * SEQ + tb * 64 + cc;
            *(u32x4_t*)(a.KzT + o) = *(const LAS u32x4_t*)(tK + ri * 72 + cc); *(u32x4_t*)(a.VrT + o) = *(const LAS u32x4_t*)(tV + ri * 72 + cc); }
    }
}
__device__ __forceinline__ void ret_state_unit(const Args& a, const int u0) {
    using namespace ret;
    int tid = threadIdx.x; asm volatile("" : "+v"(tid));
    const int w = tid >> 6, lane = tid & 63, hi = lane >> 5, r = lane & 31;
    if (w >= 4) return;
    { const int u = u0; const int h = u & 3, et = w >> 1, dt = w & 1; const float gc = exp2f(128.f * lg2g(h));
        const bf16_t* va = a.VrT + ((size_t)u * 64 + 32 * et + r) * SEQ + 8 * hi; const bf16_t* kb = a.KzT + ((size_t)u * 64 + 32 * dt + r) * SEQ + 8 * hi;
        f32x16 S;
#pragma unroll
        for (int i = 0; i < 16; ++i) S[i] = 0.f;
        bf16x8 A[8], B[8];
#pragma unroll
        for (int s2 = 0; s2 < 8; ++s2) { A[s2] = *(const bf16x8*)(va + 16 * s2); B[s2] = *(const bf16x8*)(kb + 16 * s2); }
        for (int c = 0; c < 32; ++c) {
            bf16_t* sp = a.ST + (((size_t)u * 32 + c) * 64 + 32 * et + 4 * hi) * 64 + 32 * dt + r;
#pragma unroll
            for (int i = 0; i < 16; ++i) sp[((i & 3) + 8 * (i >> 2)) * 64] = f2bf(S[i]);
            f32x16 KV;
#pragma unroll
            for (int i = 0; i < 16; ++i) KV[i] = 0.f;
            bf16x8 An[8], Bn[8]; const int cn = c < 31 ? c + 1 : c;
#pragma unroll
            for (int s2 = 0; s2 < 8; ++s2) { An[s2] = *(const bf16x8*)(va + cn * 128 + 16 * s2); Bn[s2] = *(const bf16x8*)(kb + cn * 128 + 16 * s2); }
#pragma unroll
            for (int s2 = 0; s2 < 8; ++s2) KV = __builtin_amdgcn_mfma_f32_32x32x16_bf16(A[s2], B[s2], KV, 0, 0, 0);
#pragma unroll
            for (int i = 0; i < 16; ++i) S[i] = gc * S[i] + KV[i];
#pragma unroll
            for (int s2 = 0; s2 < 8; ++s2) { A[s2] = An[s2]; B[s2] = Bn[s2]; }
        }
    }
}
__device__ __forceinline__ void ret_out_unit(const Args& a, int l, const int u0, LAS char* lds) {
    using namespace ret;
    int tid = threadIdx.x; asm volatile("" : "+v"(tid));
    const int w = tid >> 6, lane = tid & 63, hi = lane >> 5, r = lane & 31, h = w >> 1, pr = w & 1;
    const float lg = lg2g(h); const float* gn = a.ret_gn + l * 256 + h * 64;
    const int u = u0, b = u >> 5, c = u & 31, bh = b * 4 + h;
    constexpr int RK = 144, RV = 272, KH = 128 * RK  , VH = 64 * RV  , VOFF = 4 * KH;
    u32x4_t kreg[8], vreg[8];
#pragma unroll
    for (int i = 0; i < 8; ++i) { const int q = tid + NT * i, kr = q >> 5, cc = q & 31; kreg[i] = *(const u32x4_t*)(a.krb + ((size_t)b * SEQ + c * 128 + kr) * 256 + cc * 8); }
#pragma unroll
    for (int i = 0; i < 8; ++i) { const int q = tid + NT * i, vr = q >> 4, cc = q & 15; vreg[i] = *(const u32x4_t*)(a.VrT + ((size_t)b * 256 + vr) * SEQ + c * 128 + cc * 8); }
    const bf16_t* stp = a.ST + ((size_t)bh * 32 + c) * 4096;
    bf16x8 A0[4], A1[4];
#pragma unroll
    for (int sx = 0; sx < 4; ++sx) { A0[sx] = *(const bf16x8*)(stp + r * 64 + 16 * sx + 8 * hi); A1[sx] = *(const bf16x8*)(stp + (32 + r) * 64 + 16 * sx + 8 * hi); }
    __syncthreads();
#pragma unroll
    for (int i = 0; i < 8; ++i) { const int q = tid + NT * i, kr = q >> 5, cc = q & 31; *(LAS u32x4_t*)(lds + (cc >> 3) * KH + kr * RK + (cc & 7) * 16) = kreg[i]; }
#pragma unroll
    for (int i = 0; i < 8; ++i) { const int q = tid + NT * i, vr = q >> 4, cc = q & 15; LAS char* p = lds + VOFF + (vr >> 6) * VH + (vr & 63) * RV + (cc >> 1) * 32 + (cc & 1) * 8;
        *(LAS nsa::u32x2*)p = (nsa::u32x2){vreg[i].x, vreg[i].y}; *(LAS nsa::u32x2*)(p + 16) = (nsa::u32x2){vreg[i].z, vreg[i].w}; }
    __syncthreads();
    const LAS char* kl = lds + h * KH; const LAS char* vl = lds + VOFF + h * VH;
#pragma unroll 1
    for (int qi = 0; qi < 2; ++qi) { const int q = pr ? (qi ? 2 : 1) : (qi ? 3 : 0); const size_t row = (size_t)b * SEQ + c * 128 + 32 * q + r;
        bf16x8 Qf[4];
#pragma unroll
        for (int sx = 0; sx < 4; ++sx) Qf[sx] = *(const bf16x8*)(a.qrb + row * 256 + h * 64 + 16 * sx + 8 * hi);
        const bf16_t* gp = a.proj + row * DINP + C_RG + h * 64 + 4 * hi; u32x2 gt[4][2];
#pragma unroll
        for (int q4 = 0; q4 < 4; ++q4)
#pragma unroll
            for (int et = 0; et < 2; ++et) gt[q4][et] = *(const u32x2*)(gp + 32 * et + 8 * q4);
        f32x16 O0, O1;
#pragma unroll
        for (int i = 0; i < 16; ++i) { O0[i] = 0.f; O1[i] = 0.f; }
#pragma unroll
        for (int sx = 0; sx < 4; ++sx) { O0 = __builtin_amdgcn_mfma_f32_32x32x16_bf16(A0[sx], Qf[sx], O0, 0, 0, 0); O1 = __builtin_amdgcn_mfma_f32_32x32x16_bf16(A1[sx], Qf[sx], O1, 0, 0, 0); }
        const float xi = exp2f((float)(32 * q + r + 1) * lg);
#pragma unroll
        for (int i = 0; i < 16; ++i) { O0[i] *= xi; O1[i] *= xi; }
        for (int kt = 0; kt <= q; ++kt) {
            bf16x8 ka[4], v0[2], v1[2];
#pragma unroll
            for (int sx = 0; sx < 4; ++sx) ka[sx] = *(const LAS bf16x8*)(kl + (32 * kt + r) * RK + sx * 32 + hi * 16);
#pragma unroll
            for (int s2 = 0; s2 < 2; ++s2) { v0[s2] = *(const LAS bf16x8*)(vl + r * RV + (2 * kt + s2) * 32 + hi * 16); v1[s2] = *(const LAS bf16x8*)(vl + (32 + r) * RV + (2 * kt + s2) * 32 + hi * 16); }
            f32x16 S;
#pragma unroll
            for (int i = 0; i < 16; ++i) S[i] = 0.f;
#pragma unroll
            for (int sx = 0; sx < 4; ++sx) S = __builtin_amdgcn_mfma_f32_32x32x16_bf16(ka[sx], Qf[sx], S, 0, 0, 0);
            const int dbase = 32 * (q - kt) + r - 4 * hi;
#pragma unroll
            for (int i = 0; i < 16; ++i) { const int dl = dbase - ((i & 3) + 8 * (i >> 2)); S[i] = dl >= 0 ? S[i] * exp2f((float)dl * lg) : 0.f; }
#pragma unroll
            for (int s2 = 0; s2 < 2; ++s2) { u32x4 pw;
#pragma unroll
                for (int x = 0; x < 4; ++x) pw[x] = pk2(S[8 * s2 + 2 * x], S[8 * s2 + 2 * x + 1]);
                const bf16x8 Pf = __builtin_bit_cast(bf16x8, pw);
                O0 = __builtin_amdgcn_mfma_f32_32x32x16_bf16(v0[s2], Pf, O0, 0, 0, 0); O1 = __builtin_amdgcn_mfma_f32_32x32x16_bf16(v1[s2], Pf, O1, 0, 0, 0); }
        }
        float sm = 0.f;
#pragma unroll
        for (int i = 0; i < 16; ++i) sm += O0[i] + O1[i];
        sm += __shfl_xor(sm, 32); const float mu = sm * (1.f / 64.f); float vq = 0.f;
#pragma unroll
        for (int i = 0; i < 16; ++i) { const float d0 = O0[i] - mu, d1 = O1[i] - mu; vq += d0 * d0 + d1 * d1; }
        vq += __shfl_xor(vq, 32); const float rs = rsqrtf(vq * (1.f / 64.f) + 1e-5f);
        bf16_t* op = a.ocat + row * DM + 768 + h * 64 + 4 * hi;
#pragma unroll
        for (int q4 = 0; q4 < 4; ++q4) {
#pragma unroll
            for (int et = 0; et < 2; ++et) { const int e0 = 32 * et + 8 * q4; const f32x4 gg = *(const f32x4*)(gn + e0 + 4 * hi);
                float o[4];
#pragma unroll
                for (int x = 0; x < 4; ++x) { const float ov = et ? O1[4 * q4 + x] : O0[4 * q4 + x]; const unsigned gw = x < 2 ? gt[q4][et].x : gt[q4][et].y; const float gv = __uint_as_float((x & 1) ? (gw & 0xffff0000u) : (gw << 16));
                    o[x] = siluf(gv) * (ov - mu) * rs * gg[x]; }
                u32x2 ow; ow.x = pk2(o[0], o[1]); ow.y = pk2(o[2], o[3]); *(u32x2*)(op + e0) = ow; } }
    }
}


__device__ __forceinline__ void conv_super2(const ConvJob& c, int st0, int tid_) {
    const int nsn = c.Npad / 256, lane = tid_ & 63, wv = tid_ >> 6;
    float v[2][32];
#pragma unroll
    for (int t = 0; t < 2; ++t) { const int st = st0 + t, n0 = (st % nsn) * 256, k0 = (st / nsn) * 64;
#pragma unroll
        for (int q = 0; q < 4; ++q) { const int n = n0 + q * 64 + lane; int sc;
            if (c.mode == 2) { const int pn = n >> 8, i = n & 255; sc = i < 128 ? 128 * pn + i : DFF + 128 * pn + (i - 128); } else sc = n < c.nvalid ? n : -1;
#pragma unroll
            for (int e = 0; e < 8; ++e) v[t][q * 8 + e] = sc >= 0 ? c.src[(size_t)(k0 + 8 * wv + e) * c.ldsrc + sc] : 0.f; } }
#pragma unroll
    for (int t = 0; t < 2; ++t) { const int st = st0 + t, n0 = (st % nsn) * 256, k0 = (st / nsn) * 64; float gs[8];
#pragma unroll
        for (int e = 0; e < 8; ++e) gs[e] = c.g ? c.g[k0 + 8 * wv + e] : 1.f;
#pragma unroll
        for (int q = 0; q < 4; ++q) { const int n = n0 + q * 64 + lane; const float cs = (c.mode == 1 && (n < 512 || (n >= C_RK && n < C_RV))) ? 0.125f : 1.f;
            u32x4_t w; w.x = pk2bf(v[t][q * 8 + 0] * gs[0] * cs, v[t][q * 8 + 1] * gs[1] * cs); w.y = pk2bf(v[t][q * 8 + 2] * gs[2] * cs, v[t][q * 8 + 3] * gs[3] * cs);
            w.z = pk2bf(v[t][q * 8 + 4] * gs[4] * cs, v[t][q * 8 + 5] * gs[5] * cs); w.w = pk2bf(v[t][q * 8 + 6] * gs[6] * cs, v[t][q * 8 + 7] * gs[7] * cs);
            *(u32x4_t*)(c.dst + (size_t)n * c.K + k0 + 8 * wv) = w; } }
}
constexpr int DEF_ITEMS0 = (192 + 64 + 64 + 352 + 176 + 4 * (352 + 176)) / 2, DEF_ITEMS1 = 4 * (352 + 176) / 2;
__device__ __forceinline__ void deferred_item(const Args& a, int l, int it2, LAS char* lds) {
    int tid_ = threadIdx.x; asm volatile("" : "+v"(tid_));
    int job, st; const int it = it2 * 2;
    if (l == 0) {
        if (it < 192) { job = 1; st = it; }
        else if (it < 256) { job = 2; st = it - 192; }
        else if (it < 320) { job = 3; st = it - 256; }
        else if (it < 672) { job = 14; st = it - 320; }
        else if (it < 848) { job = 15; st = it - 672; }
        else { const int r = it - 848, e = r / 528, q = r % 528; if (q < 352) { job = 16 + e; st = q; } else { job = 24 + e; st = q - 352; } }
    } else { const int e = 4 + it / 528, q = it % 528; if (q < 352) { job = 16 + e; st = q; } else { job = 24 + e; st = q - 352; } }
    const ConvJob c = get_job(a, job);
    conv_super2(c, st, tid_);
}

constexpr int MIX_ITEMS = 32 + 1024 + 256;
__device__ __forceinline__ void ph_mix(const Args& a, int l, LAS char* lds) {
    int tid = threadIdx.x; asm volatile("" : "+v"(tid));
    volatile LAS int* slot = (volatile LAS int*)(lds + MISC_OFF + 64);
    unsigned* wq = a.wq + 64 * l; unsigned* rsdone = a.wq + 128 + 64 * l; unsigned* tmo = a.wq + 192;
    if (tid == 0) slot[0] = (int)__hip_atomic_fetch_add(wq, 1u, __ATOMIC_RELAXED, __HIP_MEMORY_SCOPE_AGENT);
    __syncthreads();
    for (int n = 0;; ++n) {
        const int idx = slot[n & 1];
        if (idx >= MIX_ITEMS + (l == 0 ? DEF_ITEMS0 : DEF_ITEMS1)) break;
        if (tid == 0) slot[(n + 1) & 1] = (int)__hip_atomic_fetch_add(wq, 1u, __ATOMIC_RELAXED, __HIP_MEMORY_SCOPE_AGENT);
        if (idx >= MIX_ITEMS) { deferred_item(a, l, idx - MIX_ITEMS, lds); }
        else if (idx < 32) {
            ret_state_unit(a, idx);
            asm volatile("s_waitcnt vmcnt(0)" ::: "memory"); __syncthreads();
            if (tid == 0) { __builtin_amdgcn_fence(__ATOMIC_RELEASE, "agent"); asm volatile("s_waitcnt vmcnt(0)" ::: "memory"); (void)__hip_atomic_fetch_add(rsdone, 1u, __ATOMIC_RELAXED, __HIP_MEMORY_SCOPE_AGENT); }
        } else if (idx >= 32 + 512 && idx < 32 + 512 + 256) {
            if (tid == 0) { unsigned sp = 0;
                while (__hip_atomic_load(rsdone, __ATOMIC_RELAXED, __HIP_MEMORY_SCOPE_AGENT) < 32u) { __builtin_amdgcn_s_sleep(2); if (++sp > (1u << 22)) { __hip_atomic_store(tmo, 1u, __ATOMIC_RELAXED, __HIP_MEMORY_SCOPE_AGENT); break; } }
                __builtin_amdgcn_fence(__ATOMIC_ACQUIRE, "agent"); asm volatile("s_waitcnt vmcnt(0)" ::: "memory"); }
            __syncthreads();
            ret_out_unit(a, l, idx - (32 + 512), lds);
        } else { const int i = idx < 32 + 512 ? idx - 32 : idx - 32 - 256; nsa_unit(a, lds, 63 - (i >> 4), i & 15); }
        __syncthreads();
    }
    __syncthreads();
}

__device__ __forceinline__ void ph_route(const Args& a, LAS char* lds, int vcu, int G) {
    int tid_ = threadIdx.x; asm volatile("" : "+v"(tid_)); asm volatile("" : "+s"(vcu));
    const int lane = tid_ & 63, wv = tid_ >> 6; const float* g = a.ln_ffn + DM; LAS float* gr = (LAS float*)lds;
    LAS int* sel = (LAS int*)(lds + 32768);
    LAS int* lcnt = sel + 256;
    LAS float* rsl = (LAS float*)(lcnt + 16);
    __syncthreads();
    for (int q = tid_; q < DM * 8; q += NT) { const int k = q >> 3; gr[(((k & 7) * 128 + (k >> 3)) << 3) + (q & 7)] = a.router[q] * g[k]; }
    for (int r0 = vcu * 128; r0 < NTOK; r0 += G * 128) {
        if (tid_ < 16) lcnt[tid_] = 0;
        __syncthreads();
        for (int i = 0; i < 16; ++i) { const int rl = wv * 16 + i, row = r0 + rl; float lg[8];
#pragma unroll
            for (int e = 0; e < 8; ++e) lg[e] = 0.f;
            u32x4_t xr[2];
#pragma unroll
            for (int h = 0; h < 2; ++h) xr[h] = *(const u32x4_t*)(a.xb + (size_t)row * DM + lane * 8 + 512 * h);
#pragma unroll
            for (int h = 0; h < 2; ++h)
#pragma unroll
                for (int jj = 0; jj < 8; ++jj) { const int kk = (jj * 128 + lane + 64 * h) * 8; const f32x4 q0 = *(const LAS f32x4*)(gr + kk), q1 = *(const LAS f32x4*)(gr + kk + 4);
                    const unsigned wd = xr[h][jj >> 1]; const float x = __uint_as_float((jj & 1) ? (wd & 0xffff0000u) : (wd << 16));
                    lg[0] += x * q0[0]; lg[1] += x * q0[1]; lg[2] += x * q0[2]; lg[3] += x * q0[3]; lg[4] += x * q1[0]; lg[5] += x * q1[1]; lg[6] += x * q1[2]; lg[7] += x * q1[3]; }
            const float rs = row_rstd(a.ssq, row);
#pragma unroll
            for (int e = 0; e < 8; ++e) lg[e] = wsum(lg[e]) * rs;
            int e1 = 0; float v1 = lg[0];
#pragma unroll
            for (int e = 1; e < 8; ++e) if (lg[e] > v1) { v1 = lg[e]; e1 = e; }
            int e2 = -1; float v2 = -INFINITY;
#pragma unroll
            for (int e = 0; e < 8; ++e) if (e != e1 && lg[e] > v2) { v2 = lg[e]; e2 = e; }
            if (lane == 0) { const float g1 = 1.f / (1.f + __expf(v2 - v1)); a.gate[row * 2] = g1; a.gate[row * 2 + 1] = 1.f - g1; sel[rl * 2] = e1; sel[rl * 2 + 1] = e2; rsl[rl] = rs; } }
        __syncthreads();
        int e = 0, rank = 0;
        if (tid_ < 256) { e = sel[tid_]; rank = __hip_atomic_fetch_add(&lcnt[e], 1, __ATOMIC_RELAXED, __HIP_MEMORY_SCOPE_WORKGROUP); }
        __syncthreads();
        if (tid_ < 8) lcnt[8 + tid_] = atomicAdd(&a.cnt[tid_], lcnt[tid_]);
        __syncthreads();
        if (tid_ < 256) { const int ix = lcnt[8 + e] + rank; a.tok_list[e * NTOK + ix] = (r0 + (tid_ >> 1)) * 2 + (tid_ & 1); a.slot[(r0 + (tid_ >> 1)) * 2 + (tid_ & 1)] = e * NTOK + ix; a.rsrow[e * NTOK + ix] = rsl[tid_ >> 1]; }
        __syncthreads();
    }
}
__device__ __forceinline__ void ph_route_build(const Args& a, int vcu, int G) {
    int tid_ = threadIdx.x; asm volatile("" : "+v"(tid_)); asm volatile("" : "+s"(vcu));
    for (int idx = vcu * NT + tid_; idx < NEXP * NTOK; idx += G * NT) { const int e = idx >> 15, i = idx & (NTOK - 1);
        int ps = 0; for (int q = 0; q < e; ++q) ps += (a.cnt[q] + 255) & ~255;
        const int ce = a.cnt[e], pe = (ce + 255) & ~255;
        if (i < ce) { const int en = a.tok_list[e * NTOK + i]; a.row_tok[ps + i] = en >> 1; a.slot[en] = ps + i; } else if (i < pe) a.row_tok[ps + i] = -1;
        if (i < pe && (i & 255) == 0) a.tile_exp[(ps + i) >> 8] = e;
        if (idx == 0) { int tot = 0; for (int q = 0; q < 8; ++q) tot += (a.cnt[q] + 255) & ~255; a.meta[0] = tot >> 8; } }
}
__device__ __forceinline__ void ph_final(const Args& a, LAS char* lds, int vcu, int G) {
    int tid_ = threadIdx.x; asm volatile("" : "+v"(tid_)); asm volatile("" : "+s"(vcu));
    const int lane = tid_ & 63; float* xio = a.xres;
    const LAS int* mps = (const LAS int*)(lds + MOE_TAB_OFF);
    f32x4 gf[4];
#pragma unroll
    for (int i = 0; i < 4; ++i) gf[i] = *(const f32x4*)(a.ln_final + lane * 4 + i * 256);
    for (int row0 = (vcu * NW + (tid_ >> 6)) * 4; row0 < NTOK; row0 += G * NW * 4) {
        int s1[4], s2[4]; float g1[4], g2[4];
#pragma unroll
        for (int r = 0; r < 4; ++r) { const int q1 = a.slot[(row0 + r) * 2], q2 = a.slot[(row0 + r) * 2 + 1]; s1[r] = mps[q1 >> 15] + (q1 & (NTOK - 1)); s2[r] = mps[q2 >> 15] + (q2 & (NTOK - 1)); g1[r] = a.gate[(row0 + r) * 2]; g2[r] = a.gate[(row0 + r) * 2 + 1]; }
        uint2 xq[4][4], pq[4][4], qq[4][4];
#pragma unroll
        for (int r = 0; r < 4; ++r)
#pragma unroll
            for (int i = 0; i < 4; ++i) { const int c = lane * 4 + i * 256; xq[r][i] = *(const uint2*)(a.xb + (size_t)(row0 + r) * DM + c); pq[r][i] = *(const uint2*)(a.ysorted + (size_t)s1[r] * DM + c); qq[r][i] = *(const uint2*)(a.ysorted + (size_t)s2[r] * DM + c); }
#pragma unroll
        for (int r = 0; r < 4; ++r) { float v[16]; float ss = 0.f;
#pragma unroll
            for (int i = 0; i < 4; ++i) {
#pragma unroll
                for (int jj = 0; jj < 4; ++jj) { const unsigned xw = jj < 2 ? xq[r][i].x : xq[r][i].y, pw = jj < 2 ? pq[r][i].x : pq[r][i].y, qw = jj < 2 ? qq[r][i].x : qq[r][i].y;
                    const float xv = __uint_as_float((jj & 1) ? (xw & 0xffff0000u) : (xw << 16)), pv = __uint_as_float((jj & 1) ? (pw & 0xffff0000u) : (pw << 16)), qv = __uint_as_float((jj & 1) ? (qw & 0xffff0000u) : (qw << 16));
                    v[i * 4 + jj] = xv + g1[r] * pv + g2[r] * qv; ss += v[i * 4 + jj] * v[i * 4 + jj]; } }
            const float rs = rsqrtf(wsum(ss) * (1.f / DM) + 1e-6f);
#pragma unroll
            for (int i = 0; i < 4; ++i) { f32x4 o; o[0] = v[i * 4] * rs * gf[i][0]; o[1] = v[i * 4 + 1] * rs * gf[i][1]; o[2] = v[i * 4 + 2] * rs * gf[i][2]; o[3] = v[i * 4 + 3] * rs * gf[i][3];
                *(f32x4*)(xio + (size_t)(row0 + r) * DM + lane * 4 + i * 256) = o; } } }
}

__global__ void __launch_bounds__(NT, 2) mega(Args a) {
    extern __shared__ __attribute__((aligned(16))) char lds[];
    volatile LAS unsigned* misc = (volatile LAS unsigned*)((LAS char*)lds + MISC_OFF);
    if (threadIdx.x < 64) misc[threadIdx.x] = 0u;
    __syncthreads();
    XcdBarrier bar = xcd_barrier_post(a.bar, misc);
    const int G = gridDim.x, vcu = blockIdx.x;
    LAS char* const lds3 = (LAS char*)lds;
#ifndef REP_PRO
#define REP_PRO 1
#endif
#ifndef REP_GEMM
#define REP_GEMM 1
#endif
#ifndef REP_NSA
#define REP_NSA 1
#endif
#ifndef REP_X
#define REP_X 1
#endif
#ifndef PROBE_ID
#define PROBE_ID -1
#endif
#define TS_OFF (MISC_OFF - 512)
#define STAMP(k) do { if (PROBE_ID >= 0 && threadIdx.x == 0) ((volatile LAS unsigned long long*)(lds3 + TS_OFF))[k] = __builtin_amdgcn_s_memrealtime(); } while (0)
#define GRID_BAR() xcd_barrier(bar)
#define AS4 __attribute__((address_space(4)))
#if defined(__HIP_DEVICE_COMPILE__)
#define LA const AS4 Args* ap_ = (const AS4 Args*)__builtin_amdgcn_kernarg_segment_ptr(); asm volatile("" : "+s"(ap_)); Args A; __builtin_memcpy(&A, ap_, sizeof(Args))
#else
#define LA const Args A = a
#endif

    int tsn_ = 1; STAMP(0);
    { LA; ph_prologue(A, lds3, vcu, G); }
    GRID_BAR(); STAMP(tsn_); ++tsn_;
#pragma unroll 1
    for (int l = 0; l < 2; ++l) {
        for (int rep = 0; rep < REP_GEMM; ++rep) { LA; pg8::Gemm g{A.xb, A.Win + (size_t)l * DINP * DM, NTOK, DINP, DM}; pg8::StaticOrder S; S.init(NTOK, DINP, G, vcu);
          pg8::gemm_phase<pg8::EIn, pg8::StaticOrder, 0>((PG8_LAS unsigned char*)lds3, g, S, pg8::EIn{A.proj, A.ssq}, nullptr, nullptr, 0); }
        GRID_BAR(); STAMP(tsn_); ++tsn_;
#pragma unroll 1
        for (int rep = 0; rep < REP_X; ++rep) {
#pragma unroll 1
        for (int kv = 0; kv < 2; ++kv) { const int i = l * 2 + kv;
            { LA; pg8::Gemm g{A.proj, A.W1b + (size_t)i * 256 * 2048, 4096, 256, 2048}; pg8::StaticOrder S; S.init(4096, 256, G, (vcu + G - kv * 16) % G);
              pg8::gemm_phase<pg8::ESiluBias, pg8::StaticOrder, 2>((PG8_LAS unsigned char*)lds3, g, S, pg8::ESiluBias{A.hc + (size_t)kv * 4096 * 256, A.bias1 + i * 256}, nullptr, nullptr, (size_t)(kv ? C_VC : C_KC));
              pg8::Unit cu; if (S.next(0, cu)) { asm volatile("s_waitcnt vmcnt(0)" ::: "memory"); __syncthreads(); __builtin_amdgcn_fence(__ATOMIC_ACQUIRE, "agent"); asm volatile("s_waitcnt vmcnt(0)" ::: "memory"); __syncthreads();
                  if (kv == 0) ph_gemm(lds3, APlain{A.hc, 256}, A.W2b + (size_t)i * 256 * 256, 256, EpiStore{A.kcb, 64, 0, 64}, SchedOne{cu.pm}, 0, 1);
                  else         ph_gemm(lds3, APlain{A.hc + (size_t)4096 * 256, 256}, A.W2b + (size_t)i * 256 * 256, 256, EpiStoreT{A.vcT}, SchedOne{cu.pm}, 0, 1); } } }
        { LA; ph_x1_small(A, l, lds3); }
        }
        GRID_BAR();
        { LA; ph_mix(A, l, lds3); }
        GRID_BAR(); STAMP(tsn_); ++tsn_;
        { LA; pg8::Gemm g{A.ocat, A.Wout + (size_t)l * DM * DM, NTOK, DM, DM}; pg8::StaticOrder S; S.init(NTOK, DM, G, vcu);
          pg8::gemm_phase<pg8::ERes, pg8::StaticOrder, 0>((PG8_LAS unsigned char*)lds3, g, S, pg8::ERes{A.xb, A.ssq}, nullptr, nullptr, 0); }
        GRID_BAR(); STAMP(tsn_); ++tsn_;
        if (l == 0) {
            for (int rep = 0; rep < REP_GEMM; ++rep) { LA; pg8::Gemm g{A.xb, A.W13, NTOK, 2 * DFF, DM}; pg8::StaticOrder S; S.init(NTOK, 2 * DFF, G, vcu);
              pg8::gemm_phase<pg8::ESwiglu, pg8::StaticOrder, 0>((PG8_LAS unsigned char*)lds3, g, S, pg8::ESwiglu{A.hbuf, A.ssq}, nullptr, nullptr, 0); }
            GRID_BAR(); STAMP(tsn_); ++tsn_;
            { LA; pg8::Gemm g{A.hbuf, A.W2, NTOK, DM, DFF}; pg8::StaticOrder S; S.init(NTOK, DM, G, vcu);
              pg8::gemm_phase<pg8::ERes, pg8::StaticOrder, 0>((PG8_LAS unsigned char*)lds3, g, S, pg8::ERes{A.xb, A.ssq}, nullptr, nullptr, 0); }
            GRID_BAR(); STAMP(tsn_); ++tsn_;
        }
            }
    { LA; ph_route(A, lds3, vcu, G); }
    GRID_BAR(); STAMP(tsn_); ++tsn_;
    { LA; moe_table(A.cnt, lds3); }
    for (int rep = 0; rep < REP_GEMM; ++rep) { LA; const int Mm = ((const LAS int*)(lds3 + MOE_TAB_OFF))[8]; pg8::Gemm g{A.xb, A.Wm13, Mm, 2 * DFF, DM}; pg8::StaticOrder S; S.init(Mm, 2 * DFF, G, vcu);
      pg8::gemm_phase<pg8::ESwigluMoe, pg8::StaticOrder, 1, true>((PG8_LAS unsigned char*)lds3, g, S, pg8::ESwigluMoe{A.hbuf, A.rsrow, A.tok_list, (const PG8_LAS int*)(lds3 + MOE_TAB_OFF)}, A.tok_list, nullptr, (size_t)2 * DFF * DM); }
    GRID_BAR(); STAMP(tsn_); ++tsn_;
    for (int rep = 0; rep < REP_GEMM; ++rep) { LA; const int Mm = ((const LAS int*)(lds3 + MOE_TAB_OFF))[8]; pg8::Gemm g{A.hbuf, A.Wm2, Mm, DM, DFF}; pg8::StaticOrder S; S.init(Mm, DM, G, vcu);
      pg8::gemm_phase<pg8::EStore, pg8::StaticOrder, 0, true>((PG8_LAS unsigned char*)lds3, g, S, pg8::EStore{A.ysorted, DM}, nullptr, nullptr, (size_t)DM * DFF); }
    GRID_BAR(); STAMP(tsn_); ++tsn_;
    { LA; ph_final(A, lds3, vcu, G); }
    STAMP(tsn_);
    if (PROBE_ID >= 0 && blockIdx.x == 0 && threadIdx.x == 0) { volatile LAS unsigned long long* ts = (volatile LAS unsigned long long*)(lds3 + TS_OFF); const unsigned long long d = ts[PROBE_ID + 1] - ts[PROBE_ID]; const unsigned long long t2 = __builtin_amdgcn_s_memrealtime(); while (__builtin_amdgcn_s_memrealtime() - t2 < 8ull * d) __builtin_amdgcn_s_sleep(8); }
}

static inline size_t al256(size_t x) { return (x + 255) & ~(size_t)255; }
extern "C" void kernel_launch(void* const* d_in, const int* in_sizes, int n_in, void* d_out, int out_size, void* d_ws, size_t ws_size, hipStream_t stream) {
    static int grid = 0;
    Args a{};
    const float** ins = (const float**)&a.x;
    for (int i = 0; i < 20; ++i) ins[i] = (const float*)d_in[i];
    a.xres = (float*)d_out;
    char* w = (char*)d_ws; size_t off = 0;
    auto take = [&](size_t bytes) { char* p = w + off; off = al256(off + bytes); return p; };
    a.bar = (unsigned*)take(XCD_BAR_WORDS * 4);
    a.cnt = (int*)take(256);
    a.meta = (int*)take(256);
    a.wq = (unsigned*)take(4096);
    const size_t ctl_bytes = off;
    char* regY = w + off;
    a.Wm13 = (bf16_t*)take((size_t)NEXP * 2 * DFF * DM * 2);
    a.Win = (bf16_t*)take((size_t)2 * DINP * DM * 2);
    a.Wout = (bf16_t*)take((size_t)2 * DM * DM * 2);
    a.W13 = (bf16_t*)take((size_t)2 * DFF * DM * 2);
    a.W2 = (bf16_t*)take((size_t)DM * DFF * 2);
    a.ysorted = (bf16_t*)regY;
    if (off < (size_t)(regY - w) + (size_t)PMAX * DM * 2) off = al256((size_t)(regY - w) + (size_t)PMAX * DM * 2);
    a.xb = (bf16_t*)take((size_t)NTOK * DM * 2);
    a.Wm2 = (bf16_t*)take((size_t)NEXP * DM * DFF * 2);
    a.W1b = (bf16_t*)take((size_t)4 * 256 * 2048 * 2);
    a.W2b = (bf16_t*)take((size_t)4 * 256 * 256 * 2);
    a.Wpw = (bf16_t*)take((size_t)2 * 256 * 256 * 2);
    a.bias1 = (float*)take(4 * 256 * 4);
    a.rot = (float*)take((size_t)4096 * 32 * 2 * 4);
    a.ssq = (float*)take((size_t)NTOK * NSLOT * 4);
    a.tok_list = (int*)take((size_t)NEXP * NTOK * 4);
    a.row_tok = (int*)take((size_t)PMAX * 4);
    a.slot = (int*)take((size_t)NTOK * 2 * 4);
    a.tile_exp = (int*)take(1024 * 4);
    a.gate = (float*)take((size_t)NTOK * 2 * 4);
    a.rsrow = (float*)take((size_t)NEXP * NTOK * 4);
    char* regR = w + off;
    a.proj = (bf16_t*)take((size_t)NTOK * DINP * 2);
    a.ocat = (bf16_t*)take((size_t)NTOK * DM * 2);
    a.hc = (bf16_t*)take((size_t)2 * 4096 * 256 * 2);
    a.kcb = (bf16_t*)take((size_t)4096 * 64 * 2);
    a.hconv = (bf16_t*)take((size_t)NTOK * 256 * 2);
    a.vcT = (bf16_t*)take((size_t)16 * 64 * 256 * 2);
    a.VsT = (bf16_t*)take((size_t)16 * 64 * SEQ * 2);
    a.VwT = (bf16_t*)take((size_t)16 * 64 * SEQ * 2);
    a.qrb = (bf16_t*)take((size_t)NTOK * 256 * 2);
    a.krb = (bf16_t*)take((size_t)NTOK * 256 * 2);
    a.KzT = (bf16_t*)take((size_t)32 * 64 * SEQ * 2);
    a.VrT = (bf16_t*)take((size_t)32 * 64 * SEQ * 2);
    a.ST = (bf16_t*)take((size_t)32 * 32 * 4096 * 2);
    a.hbuf = (bf16_t*)regR;
    const size_t need = (size_t)(regR - w) + (size_t)PMAX * DFF * 2;
    if (grid == 0) {
        if (need > ws_size || off > ws_size || n_in != 20) { fprintf(stderr, "kernel_launch: workspace too small: need %zu / %zu have %zu\n", need, off, ws_size); grid = -1; return; }
        int dev = 0, cus = 0;
        if (hipGetDevice(&dev) != hipSuccess || hipDeviceGetAttribute(&cus, hipDeviceAttributeMultiprocessorCount, dev) != hipSuccess) { grid = -1; return; }
        if (hipFuncSetAttribute((const void*)mega, hipFuncAttributeMaxDynamicSharedMemorySize, LDS_BYTES) != hipSuccess) { fprintf(stderr, "kernel_launch: hipFuncSetAttribute failed\n"); grid = -1; return; }
        int per_cu = 0;
        if (hipOccupancyMaxActiveBlocksPerMultiprocessor(&per_cu, (const void*)mega, NT, LDS_BYTES) != hipSuccess || per_cu < 1) { fprintf(stderr, "kernel_launch: occupancy query says %d\n", per_cu); }
        (void)hipGetLastError();
        grid = cus;
    }
    if (grid < 0) return;
    (void)hipMemsetAsync(w, 0, ctl_bytes, stream);
    hipLaunchKernelGGL(mega, dim3(grid), dim3(NT), LDS_BYTES, stream, a);
}
```
